# Optimizing an MI355X kernel written in HIP

```python
import jax, jax.numpy as jnp
from jax import lax
import numpy as np

D_MODEL = 1024
BATCH = 4
SEQ = 8192
DEPTH = 1

MIX_WIDTH = D_MODEL
A_HEADS = 4
A_WIDTH = MIX_WIDTH // 2
A_HEAD_DIM = A_WIDTH // A_HEADS
CHUNK = 128
B_WIDTH = MIX_WIDTH - A_WIDTH
CONV_WIDTH = 3
IN_WIDTH = 2 * A_WIDTH + 3 * B_WIDTH
MEM_LEN = 256
X_HEADS = 4
X_HEAD_DIM = D_MODEL // X_HEADS
PEER_HEADS = 8
N_KEYS = 128
N_EXPERTS = N_KEYS * N_KEYS
PEER_TOPK = 16
D_KEY = 256
HALF_KEY = D_KEY // 2
PEER_BLOCK = 128
LN_EPS = 1e-5
DN_ALPHA = (2 * DEPTH) ** 0.25
DN_BETA = (8 * DEPTH) ** -0.25

kernel_name = "hybrid_sgu_shortconv_xattn_peer_deepnorm"


def _layernorm(x, g, b):
    xf = x.astype(jnp.float32)
    mu = jnp.mean(xf, axis=-1, keepdims=True)
    var = jnp.mean(jnp.square(xf - mu), axis=-1, keepdims=True)
    y = (xf - mu) * lax.rsqrt(var + LN_EPS) * g.astype(jnp.float32) + b.astype(jnp.float32)
    return y.astype(x.dtype)


def _gelu(x):
    return jax.nn.gelu(x, approximate=False)


def _hybrid_mixer(x, w_in, b_in, sgu_g, sgu_b, w_spatial, b_spatial, conv_w, w_out):
    bsz, seq, _ = x.shape
    z = jnp.einsum('bsd,de->bse', x, w_in) + b_in
    u_a, v_a, h_b, gate_b, gate_c = jnp.split(
        z, [A_WIDTH, 2 * A_WIDTH, 2 * A_WIDTH + B_WIDTH, 2 * A_WIDTH + 2 * B_WIDTH], axis=-1)
    u_a = _gelu(u_a)
    v_a = _gelu(v_a).reshape(bsz, seq // CHUNK, CHUNK, A_HEADS, A_HEAD_DIM)
    v_a = _layernorm(v_a, sgu_g, sgu_b)
    causal = jnp.tril(jnp.ones((CHUNK, CHUNK), dtype=bool))
    ws = jnp.where(causal[None], w_spatial, 0.0)
    mixed = jnp.einsum('hts,bcshd->bcthd', ws, v_a) + b_spatial.T[:, :, None]
    y_a = u_a * mixed.reshape(bsz, seq, A_WIDTH)
    zc = gate_c * h_b
    conv = lax.conv_general_dilated(
        zc, conv_w, window_strides=(1,), padding=((CONV_WIDTH - 1, 0),),
        dimension_numbers=('NWC', 'WIO', 'NWC'), feature_group_count=B_WIDTH)
    y_b = gate_b * conv
    y = jnp.concatenate([y_a, y_b], axis=-1)
    return jnp.einsum('bse,ed->bsd', y, w_out)


def _cross_attention(x, mem, w_q, w_kv, w_o):
    bsz, seq, _ = x.shape
    q = jnp.einsum('bsd,de->bse', x, w_q).reshape(bsz, seq, X_HEADS, X_HEAD_DIM)
    kv = jnp.einsum('bmd,de->bme', mem, w_kv).reshape(bsz, mem.shape[1], 2, X_HEADS, X_HEAD_DIM)
    k, v = kv[:, :, 0], kv[:, :, 1]
    scores = jnp.einsum('bshk,bmhk->bhsm', q, k).astype(jnp.float32) * (X_HEAD_DIM ** -0.5)
    p = jax.nn.softmax(scores, axis=-1).astype(x.dtype)
    o = jnp.einsum('bhsm,bmhk->bshk', p, v).reshape(bsz, seq, D_MODEL)
    return jnp.einsum('bsd,de->bse', o, w_o)


def _peer(x, w_query, sub_keys, w_down, w_up):
    bsz, seq, _ = x.shape
    n_tok = bsz * seq
    xt = x.reshape(n_tok, D_MODEL)
    q = jnp.einsum('td,de->te', xt, w_query).reshape(n_tok, PEER_HEADS, 2, HALF_KEY)
    sc = jnp.einsum('thpk,hpnk->thpn', q, sub_keys).astype(jnp.float32)
    va, ia = lax.top_k(sc[:, :, 0], PEER_TOPK)
    vb, ib = lax.top_k(sc[:, :, 1], PEER_TOPK)
    cand = (va[..., :, None] + vb[..., None, :]).reshape(n_tok, PEER_HEADS, PEER_TOPK * PEER_TOPK)
    top, flat = lax.top_k(cand, PEER_TOPK)
    expert = (jnp.take_along_axis(ia, flat // PEER_TOPK, axis=-1) * N_KEYS
              + jnp.take_along_axis(ib, flat % PEER_TOPK, axis=-1))
    gate = jax.nn.softmax(top, axis=-1).astype(x.dtype)
    n_blk = n_tok // PEER_BLOCK
    hk = PEER_HEADS * PEER_TOPK
    expert = expert.reshape(n_blk, PEER_BLOCK, hk)
    gate = gate.reshape(n_blk, PEER_BLOCK, hk)

    def block(args):
        xb, eb, gb = args
        act = _gelu(jnp.einsum('tkd,td->tk', w_down[eb], xb))
        return jnp.einsum('tk,tkd->td', gb * act, w_up[eb])

    out = lax.map(block, (xt.reshape(n_blk, PEER_BLOCK, D_MODEL), expert, gate))
    return out.reshape(bsz, seq, D_MODEL)


def _normal(k, shape, scale):
    return jax.random.normal(k, shape, jnp.float32) * scale


def setup_inputs(seed: int = 0) -> dict:
    key = jax.random.key(seed)
    ks = jax.random.split(key, 24)
    L, D = DEPTH, D_MODEL
    return {
        "x": _normal(ks[0], (BATCH, SEQ, D), 1.0),
        "mem": _normal(ks[1], (BATCH, MEM_LEN, D), 1.0),
        "w_in": _normal(ks[2], (L, D, IN_WIDTH), D ** -0.5),
        "b_in": _normal(ks[3], (L, IN_WIDTH), 0.02),
        "sgu_g": 1.0 + _normal(ks[4], (L, A_HEADS, A_HEAD_DIM), 0.02),
        "sgu_b": _normal(ks[5], (L, A_HEADS, A_HEAD_DIM), 0.02),
        "w_spatial": _normal(ks[6], (L, A_HEADS, CHUNK, CHUNK), CHUNK ** -0.5),
        "b_spatial": 1.0 + _normal(ks[7], (L, A_HEADS, CHUNK), 0.02),
        "conv_w": _normal(ks[8], (L, CONV_WIDTH, 1, B_WIDTH), CONV_WIDTH ** -0.5),
        "w_mix_out": _normal(ks[9], (L, MIX_WIDTH, D), MIX_WIDTH ** -0.5 * DN_BETA),
        "ln1_g": 1.0 + _normal(ks[10], (L, D), 0.02),
        "ln1_b": _normal(ks[11], (L, D), 0.02),
        "w_xq": _normal(ks[12], (L, D, D), D ** -0.5),
        "w_xkv": jnp.concatenate([_normal(ks[13], (L, D, D), D ** -0.5),
                                  _normal(ks[14], (L, D, D), D ** -0.5 * DN_BETA)], axis=-1),
        "w_xo": _normal(ks[15], (L, D, D), D ** -0.5 * DN_BETA),
        "ln2_g": 1.0 + _normal(ks[16], (L, D), 0.02),
        "ln2_b": _normal(ks[17], (L, D), 0.02),
        "w_pq": _normal(ks[18], (L, D, PEER_HEADS * D_KEY), D ** -0.5),
        "sub_keys": _normal(ks[19], (L, PEER_HEADS, 2, N_KEYS, HALF_KEY), HALF_KEY ** -0.5),
        "w_down": _normal(ks[20], (L, N_EXPERTS, D), D ** -0.5),
        "w_up": _normal(ks[21], (L, N_EXPERTS, D), DN_BETA),
        "ln3_g": 1.0 + _normal(ks[22], (L, D), 0.02),
        "ln3_b": _normal(ks[23], (L, D), 0.02),
    }


def reference(x, mem, w_in, b_in, sgu_g, sgu_b, w_spatial, b_spatial, conv_w, w_mix_out,
              ln1_g, ln1_b, w_xq, w_xkv, w_xo, ln2_g, ln2_b, w_pq, sub_keys, w_down, w_up,
              ln3_g, ln3_b):
    for l in range(DEPTH):
        h = _hybrid_mixer(x, w_in[l], b_in[l], sgu_g[l], sgu_b[l], w_spatial[l], b_spatial[l],
                          conv_w[l], w_mix_out[l])
        x = _layernorm(DN_ALPHA * x + h, ln1_g[l], ln1_b[l])
        h = _cross_attention(x, mem, w_xq[l], w_xkv[l], w_xo[l])
        x = _layernorm(DN_ALPHA * x + h, ln2_g[l], ln2_b[l])
        h = _peer(x, w_pq[l], sub_keys[l], w_down[l], w_up[l])
        x = _layernorm(DN_ALPHA * x + h, ln3_g[l], ln3_b[l])
    return x
```

```cpp
#include <hip/hip_runtime.h>
#include <stdint.h>

#define DM 1024
#define NTOK 32768
#define SEQ 8192
#define INW 2560
#define ALPHA 1.189207115002721f
#define LN_EPS 1e-5f

__device__ __forceinline__ float gelu_f(float x) { return 0.5f * x * (1.0f + erff(x * 0.70710678118654752f)); }

template <int TB>
__global__ __launch_bounds__(256) void sgemm_k(const float* __restrict__ A, int lda, long sA, const float* __restrict__ B, int ldb, long sB,
                                              float* __restrict__ C, int ldc, long sC, int K, const float* __restrict__ bias, int nb2, long sA2, long sB2, long sC2) {
  __shared__ float As[16][68];
  __shared__ float Bs[16][68];
  const int z = blockIdx.z, z1 = z / nb2, z2 = z % nb2;
  A += z1 * sA + z2 * sA2; B += z1 * sB + z2 * sB2; C += z1 * sC + z2 * sC2;
  const int tid = threadIdx.x, tx = tid & 15, ty = tid >> 4;
  const int m0 = blockIdx.y * 64, n0 = blockIdx.x * 64;
  float acc[4][4];
#pragma unroll
  for (int i = 0; i < 4; ++i)
#pragma unroll
    for (int j = 0; j < 4; ++j) acc[i][j] = 0.f;
  for (int k0 = 0; k0 < K; k0 += 16) {
    {
      const int r = tid >> 2, kk = (tid & 3) * 4;
      const float4 v = *(const float4*)(A + (long)(m0 + r) * lda + k0 + kk);
      As[kk + 0][r] = v.x; As[kk + 1][r] = v.y; As[kk + 2][r] = v.z; As[kk + 3][r] = v.w;
    }
    if (TB == 0) {
      const int kk = tid >> 4, n = (tid & 15) * 4;
      const float4 v = *(const float4*)(B + (long)(k0 + kk) * ldb + n0 + n);
      Bs[kk][n + 0] = v.x; Bs[kk][n + 1] = v.y; Bs[kk][n + 2] = v.z; Bs[kk][n + 3] = v.w;
    } else {
      const int r = tid >> 2, kk = (tid & 3) * 4;
      const float4 v = *(const float4*)(B + (long)(n0 + r) * ldb + k0 + kk);
      Bs[kk + 0][r] = v.x; Bs[kk + 1][r] = v.y; Bs[kk + 2][r] = v.z; Bs[kk + 3][r] = v.w;
    }
    __syncthreads();
#pragma unroll
    for (int k = 0; k < 16; ++k) {
      float a[4], b[4];
#pragma unroll
      for (int i = 0; i < 4; ++i) a[i] = As[k][ty * 4 + i];
#pragma unroll
      for (int j = 0; j < 4; ++j) b[j] = Bs[k][tx * 4 + j];
#pragma unroll
      for (int i = 0; i < 4; ++i)
#pragma unroll
        for (int j = 0; j < 4; ++j) acc[i][j] += a[i] * b[j];
    }
    __syncthreads();
  }
#pragma unroll
  for (int i = 0; i < 4; ++i) {
    float4 o;
    const int n = n0 + tx * 4;
    o.x = acc[i][0]; o.y = acc[i][1]; o.z = acc[i][2]; o.w = acc[i][3];
    if (bias) { o.x += bias[n]; o.y += bias[n + 1]; o.z += bias[n + 2]; o.w += bias[n + 3]; }
    *(float4*)(C + (long)(m0 + ty * 4 + i) * ldc + n) = o;
  }
}

__global__ __launch_bounds__(256) void mixer_a_k(const float* __restrict__ Z, const float* __restrict__ sgu_g, const float* __restrict__ sgu_b,
                                                 const float* __restrict__ w_sp, const float* __restrict__ b_sp, float* __restrict__ Y) {
  __shared__ float vln[128][128];
  const int chunk = blockIdx.x, h = blockIdx.y, tid = threadIdx.x, lane = tid & 63, wid = tid >> 6;
  const long t0 = (long)chunk * 128;
  for (int s = wid; s < 128; s += 4) {
    const float* zr = Z + (t0 + s) * INW + 512 + h * 128;
    float a = gelu_f(zr[lane]), b = gelu_f(zr[lane + 64]);
    float sum = a + b;
#pragma unroll
    for (int o = 32; o > 0; o >>= 1) sum += __shfl_xor(sum, o);
    const float mu = sum * (1.f / 128.f);
    const float da = a - mu, db = b - mu;
    float q = da * da + db * db;
#pragma unroll
    for (int o = 32; o > 0; o >>= 1) q += __shfl_xor(q, o);
    const float rstd = rsqrtf(q * (1.f / 128.f) + LN_EPS);
    vln[s][lane] = da * rstd * sgu_g[h * 128 + lane] + sgu_b[h * 128 + lane];
    vln[s][lane + 64] = db * rstd * sgu_g[h * 128 + lane + 64] + sgu_b[h * 128 + lane + 64];
  }
  __syncthreads();
  const int d = tid & 127, tg = tid >> 7;
  for (int t = tg; t < 128; t += 2) {
    const float* wr = w_sp + ((long)h * 128 + t) * 128;
    float acc = 0.f;
    for (int s = 0; s <= t; ++s) acc += wr[s] * vln[s][d];
    acc += b_sp[h * 128 + t];
    const float u = gelu_f(Z[(t0 + t) * INW + h * 128 + d]);
    Y[(t0 + t) * DM + h * 128 + d] = u * acc;
  }
}

__global__ __launch_bounds__(256) void mixer_b_k(const float* __restrict__ Z, const float* __restrict__ conv_w, float* __restrict__ Y) {
  const long idx = (long)blockIdx.x * 256 + threadIdx.x;
  const int c = (int)(idx & 511);
  const long t = idx >> 9;
  const int s = (int)(t % SEQ);
  float conv = 0.f;
#pragma unroll
  for (int k = 0; k < 3; ++k) {
    const int ss = s - 2 + k;
    if (ss >= 0) {
      const float* zr = Z + (t - 2 + k) * INW;
      conv += conv_w[k * 512 + c] * (zr[2048 + c] * zr[1024 + c]);
    }
  }
  Y[t * DM + 512 + c] = Z[t * INW + 1536 + c] * conv;
}

__global__ __launch_bounds__(256) void ln_res_k(const float* __restrict__ Xin, const float* __restrict__ H, const float* __restrict__ g,
                                                const float* __restrict__ b, float* __restrict__ Out) {
  const int lane = threadIdx.x & 63, wid = threadIdx.x >> 6;
  const long row = (long)blockIdx.x * 4 + wid;
  const float* xr = Xin + row * DM;
  const float* hr = H + row * DM;
  float v[16];
  float sum = 0.f;
#pragma unroll
  for (int i = 0; i < 4; ++i) {
    const float4 a = *(const float4*)(xr + i * 256 + lane * 4);
    const float4 c = *(const float4*)(hr + i * 256 + lane * 4);
    v[i * 4 + 0] = ALPHA * a.x + c.x; v[i * 4 + 1] = ALPHA * a.y + c.y; v[i * 4 + 2] = ALPHA * a.z + c.z; v[i * 4 + 3] = ALPHA * a.w + c.w;
    sum += v[i * 4 + 0] + v[i * 4 + 1] + v[i * 4 + 2] + v[i * 4 + 3];
  }
#pragma unroll
  for (int o = 32; o > 0; o >>= 1) sum += __shfl_xor(sum, o);
  const float mu = sum * (1.f / DM);
  float q = 0.f;
#pragma unroll
  for (int i = 0; i < 16; ++i) { const float dlt = v[i] - mu; q += dlt * dlt; }
#pragma unroll
  for (int o = 32; o > 0; o >>= 1) q += __shfl_xor(q, o);
  const float rstd = rsqrtf(q * (1.f / DM) + LN_EPS);
#pragma unroll
  for (int i = 0; i < 4; ++i) {
    const int c0 = i * 256 + lane * 4;
    const float4 gg = *(const float4*)(g + c0);
    const float4 bb = *(const float4*)(b + c0);
    float4 o;
    o.x = (v[i * 4 + 0] - mu) * rstd * gg.x + bb.x; o.y = (v[i * 4 + 1] - mu) * rstd * gg.y + bb.y;
    o.z = (v[i * 4 + 2] - mu) * rstd * gg.z + bb.z; o.w = (v[i * 4 + 3] - mu) * rstd * gg.w + bb.w;
    *(float4*)(Out + row * DM + c0) = o;
  }
}

__global__ __launch_bounds__(256) void softmax256_k(float* __restrict__ S, float scale) {
  const int lane = threadIdx.x & 63, wid = threadIdx.x >> 6;
  const long row = (long)blockIdx.x * 4 + wid;
  float4 v = *(float4*)(S + row * 256 + lane * 4);
  v.x *= scale; v.y *= scale; v.z *= scale; v.w *= scale;
  float m = fmaxf(fmaxf(v.x, v.y), fmaxf(v.z, v.w));
#pragma unroll
  for (int o = 32; o > 0; o >>= 1) m = fmaxf(m, __shfl_xor(m, o));
  v.x = expf(v.x - m); v.y = expf(v.y - m); v.z = expf(v.z - m); v.w = expf(v.w - m);
  float s = v.x + v.y + v.z + v.w;
#pragma unroll
  for (int o = 32; o > 0; o >>= 1) s += __shfl_xor(s, o);
  const float inv = 1.f / s;
  v.x *= inv; v.y *= inv; v.z *= inv; v.w *= inv;
  *(float4*)(S + row * 256 + lane * 4) = v;
}

__global__ __launch_bounds__(128) void peer_route_k(const float* __restrict__ PQ, const float* __restrict__ sub_keys, int* __restrict__ experts, float* __restrict__ gates) {
  __shared__ float pqs[2][2048];
  __shared__ float scs[2 * 16][129];
  __shared__ float vtop[2 * 16][16];
  __shared__ int itop[2 * 16][16];
  const int tid = threadIdx.x;
  const long t0 = (long)blockIdx.x * 2;
  for (int i = tid; i < 2 * 2048; i += 128) pqs[i >> 11][i & 2047] = PQ[t0 * 2048 + i];
  __syncthreads();
  for (int hp = 0; hp < 16; ++hp) {
    const float* kr = sub_keys + ((long)hp * 128 + tid) * 128;
    float a0 = 0.f, a1 = 0.f;
    for (int k = 0; k < 128; k += 4) {
      const float4 kv = *(const float4*)(kr + k);
      const float* q0 = &pqs[0][hp * 128 + k];
      const float* q1 = &pqs[1][hp * 128 + k];
      a0 += q0[0] * kv.x; a0 += q0[1] * kv.y; a0 += q0[2] * kv.z; a0 += q0[3] * kv.w;
      a1 += q1[0] * kv.x; a1 += q1[1] * kv.y; a1 += q1[2] * kv.z; a1 += q1[3] * kv.w;
    }
    scs[0 * 16 + hp][tid] = a0; scs[1 * 16 + hp][tid] = a1;
  }
  __syncthreads();
  if (tid < 32) {
    const float* row = scs[tid];
    float pv = 3.0e38f; int pi = -1;
    for (int r = 0; r < 16; ++r) {
      float bv = -3.0e38f; int bi = 1 << 30;
      for (int n = 0; n < 128; ++n) {
        const float v = row[n];
        const bool after = (v < pv) || (v == pv && n > pi);
        const bool better = (v > bv) || (v == bv && n < bi);
        if (after && better) { bv = v; bi = n; }
      }
      vtop[tid][r] = bv; itop[tid][r] = bi; pv = bv; pi = bi;
    }
  }
  __syncthreads();
  if (tid < 16) {
    const int tk = tid >> 3, h = tid & 7;
    const float* va = vtop[tk * 16 + h * 2 + 0];
    const float* vb = vtop[tk * 16 + h * 2 + 1];
    const int* ia = itop[tk * 16 + h * 2 + 0];
    const int* ib = itop[tk * 16 + h * 2 + 1];
    float pv = 3.0e38f; int pi = -1;
    float topv0 = 0.f, ssum = 0.f;
    int* eo = experts + (t0 + tk) * 128 + h * 16;
    float* go = gates + (t0 + tk) * 128 + h * 16;
    for (int r = 0; r < 16; ++r) {
      float bv = -3.0e38f; int bi = 1 << 30;
      for (int c = 0; c < 256; ++c) {
        const float v = va[c >> 4] + vb[c & 15];
        const bool after = (v < pv) || (v == pv && c > pi);
        const bool better = (v > bv) || (v == bv && c < bi);
        if (after && better) { bv = v; bi = c; }
      }
      pv = bv; pi = bi;
      if (r == 0) topv0 = bv;
      const float e = expf(bv - topv0);
      ssum += e;
      eo[r] = ia[bi >> 4] * 128 + ib[bi & 15];
      go[r] = e;
    }
    const float inv = 1.f / ssum;
    for (int r = 0; r < 16; ++r) go[r] *= inv;
  }
}

__global__ __launch_bounds__(256) void peer_apply_k(const float* __restrict__ X2, const int* __restrict__ experts, const float* __restrict__ gates,
                                                    const float* __restrict__ w_down, const float* __restrict__ w_up, const float* __restrict__ g,
                                                    const float* __restrict__ b, float* __restrict__ Out) {
  __shared__ float xs[1024];
  __shared__ float coef[128];
  __shared__ int es[128];
  __shared__ float red[8];
  const int tid = threadIdx.x, lane = tid & 63, wid = tid >> 6;
  const long t = blockIdx.x;
  *(float4*)(xs + tid * 4) = *(const float4*)(X2 + t * DM + tid * 4);
  if (tid < 128) es[tid] = experts[t * 128 + tid];
  __syncthreads();
  for (int k = wid; k < 128; k += 4) {
    const float* wr = w_down + (long)es[k] * DM;
    float acc = 0.f;
#pragma unroll
    for (int i = 0; i < 4; ++i) {
      const float4 w = *(const float4*)(wr + i * 256 + lane * 4);
      const float4 x = *(const float4*)(xs + i * 256 + lane * 4);
      acc += w.x * x.x + w.y * x.y + w.z * x.z + w.w * x.w;
    }
#pragma unroll
    for (int o = 32; o > 0; o >>= 1) acc += __shfl_xor(acc, o);
    if (lane == 0) coef[k] = gates[t * 128 + k] * gelu_f(acc);
  }
  __syncthreads();
  float4 acc = {0.f, 0.f, 0.f, 0.f};
  for (int k = 0; k < 128; ++k) {
    const float c = coef[k];
    const float4 w = *(const float4*)(w_up + (long)es[k] * DM + tid * 4);
    acc.x += c * w.x; acc.y += c * w.y; acc.z += c * w.z; acc.w += c * w.w;
  }
  const float4 xv = *(const float4*)(xs + tid * 4);
  float v0 = ALPHA * xv.x + acc.x, v1 = ALPHA * xv.y + acc.y, v2 = ALPHA * xv.z + acc.z, v3 = ALPHA * xv.w + acc.w;
  float sum = v0 + v1 + v2 + v3;
#pragma unroll
  for (int o = 32; o > 0; o >>= 1) sum += __shfl_xor(sum, o);
  if (lane == 0) red[wid] = sum;
  __syncthreads();
  const float mu = (red[0] + red[1] + red[2] + red[3]) * (1.f / DM);
  const float d0 = v0 - mu, d1 = v1 - mu, d2 = v2 - mu, d3 = v3 - mu;
  float q = d0 * d0 + d1 * d1 + d2 * d2 + d3 * d3;
#pragma unroll
  for (int o = 32; o > 0; o >>= 1) q += __shfl_xor(q, o);
  if (lane == 0) red[4 + wid] = q;
  __syncthreads();
  const float rstd = rsqrtf((red[4] + red[5] + red[6] + red[7]) * (1.f / DM) + LN_EPS);
  const float4 gg = *(const float4*)(g + tid * 4);
  const float4 bb = *(const float4*)(b + tid * 4);
  float4 o;
  o.x = d0 * rstd * gg.x + bb.x; o.y = d1 * rstd * gg.y + bb.y; o.z = d2 * rstd * gg.z + bb.z; o.w = d3 * rstd * gg.w + bb.w;
  *(float4*)(Out + t * DM + tid * 4) = o;
}

static void sgemm(hipStream_t st, int tb, const float* A, int lda, long sA, const float* B, int ldb, long sB, float* C, int ldc, long sC, int M, int N, int K,
                  const float* bias, int nb1, int nb2, long sA2, long sB2, long sC2) {
  dim3 grid(N / 64, M / 64, nb1 * nb2);
  if (tb) sgemm_k<1><<<grid, 256, 0, st>>>(A, lda, sA, B, ldb, sB, C, ldc, sC, K, bias, nb2, sA2, sB2, sC2);
  else    sgemm_k<0><<<grid, 256, 0, st>>>(A, lda, sA, B, ldb, sB, C, ldc, sC, K, bias, nb2, sA2, sB2, sC2);
}

extern "C" void kernel_launch(void* const* d_in, const int* in_sizes, int n_in, void* d_out, int out_size, void* d_ws, size_t ws_size, hipStream_t stream) {
  const float* x = (const float*)d_in[0];
  const float* mem = (const float*)d_in[1];
  const float* w_in = (const float*)d_in[2];
  const float* b_in = (const float*)d_in[3];
  const float* sgu_g = (const float*)d_in[4];
  const float* sgu_b = (const float*)d_in[5];
  const float* w_sp = (const float*)d_in[6];
  const float* b_sp = (const float*)d_in[7];
  const float* conv_w = (const float*)d_in[8];
  const float* w_mo = (const float*)d_in[9];
  const float* ln1_g = (const float*)d_in[10];
  const float* ln1_b = (const float*)d_in[11];
  const float* w_xq = (const float*)d_in[12];
  const float* w_xkv = (const float*)d_in[13];
  const float* w_xo = (const float*)d_in[14];
  const float* ln2_g = (const float*)d_in[15];
  const float* ln2_b = (const float*)d_in[16];
  const float* w_pq = (const float*)d_in[17];
  const float* sub_keys = (const float*)d_in[18];
  const float* w_down = (const float*)d_in[19];
  const float* w_up = (const float*)d_in[20];
  const float* ln3_g = (const float*)d_in[21];
  const float* ln3_b = (const float*)d_in[22];
  float* out = (float*)d_out;

  const size_t SZ = (size_t)NTOK * DM;
  float* ws = (float*)d_ws;
  float* R0 = ws;
  float* R1 = ws + SZ;
  float* Zb = ws;
  float* R3 = ws + (size_t)NTOK * INW;
  float* KV = R3 + SZ;
  int* experts = (int*)(KV + (size_t)1024 * 2048);
  float* gates = (float*)(experts + (size_t)NTOK * 128);

  sgemm(stream, 0, x, DM, 0, w_in, INW, 0, Zb, INW, 0, NTOK, INW, DM, b_in, 1, 1, 0, 0, 0);
  float* Y = R3;
  mixer_a_k<<<dim3(NTOK / 128, 4), 256, 0, stream>>>(Zb, sgu_g, sgu_b, w_sp, b_sp, Y);
  mixer_b_k<<<NTOK * 512 / 256, 256, 0, stream>>>(Zb, conv_w, Y);
  sgemm(stream, 0, Y, DM, 0, w_mo, DM, 0, R0, DM, 0, NTOK, DM, DM, nullptr, 1, 1, 0, 0, 0);
  float* X1 = R1;
  ln_res_k<<<NTOK / 4, 256, 0, stream>>>(x, R0, ln1_g, ln1_b, X1);
  float* Q = R3;
  sgemm(stream, 0, X1, DM, 0, w_xq, DM, 0, Q, DM, 0, NTOK, DM, DM, nullptr, 1, 1, 0, 0, 0);
  sgemm(stream, 0, mem, DM, 0, w_xkv, 2048, 0, KV, 2048, 0, 1024, 2048, DM, nullptr, 1, 1, 0, 0, 0);
  float* S = R0;
  sgemm(stream, 1, Q, DM, (long)SEQ * DM, KV, 2048, (long)256 * 2048, S, 256, (long)4 * SEQ * 256, SEQ, 256, 256, nullptr, 4, 4, 256, 256, (long)SEQ * 256);
  softmax256_k<<<NTOK * 4 / 4, 256, 0, stream>>>(S, 0.0625f);
  float* O = R3;
  sgemm(stream, 0, S, 256, (long)4 * SEQ * 256, KV + 1024, 2048, (long)256 * 2048, O, DM, (long)SEQ * DM, SEQ, 256, 256, nullptr, 4, 4, (long)SEQ * 256, 256, 256);
  sgemm(stream, 0, O, DM, 0, w_xo, DM, 0, R0, DM, 0, NTOK, DM, DM, nullptr, 1, 1, 0, 0, 0);
  float* X2 = R3;
  ln_res_k<<<NTOK / 4, 256, 0, stream>>>(X1, R0, ln2_g, ln2_b, X2);
  float* PQ = ws;
  sgemm(stream, 0, X2, DM, 0, w_pq, 2048, 0, PQ, 2048, 0, NTOK, 2048, DM, nullptr, 1, 1, 0, 0, 0);
  peer_route_k<<<NTOK / 2, 128, 0, stream>>>(PQ, sub_keys, experts, gates);
  peer_apply_k<<<NTOK, 256, 0, stream>>>(X2, experts, gates, w_down, w_up, ln3_g, ln3_b, out);
}
```

```cpp
#include <hip/hip_runtime.h>
#include <stdint.h>

#define DM 1024
#define NTOK 32768
#define SEQ 8192
#define INW 2560
#define ALPHA 1.189207115002721f
#define LN_EPS 1e-5f

__device__ __forceinline__ float gelu_f(float x) { return 0.5f * x * (1.0f + erff(x * 0.70710678118654752f)); }

typedef unsigned short bf16_t;
typedef short bf16x8 __attribute__((ext_vector_type(8)));
typedef float f32x4 __attribute__((ext_vector_type(4)));
typedef unsigned u32x4 __attribute__((ext_vector_type(4)));
typedef unsigned u32x2 __attribute__((ext_vector_type(2)));
#define LAS __attribute__((address_space(3)))
extern __shared__ __attribute__((aligned(16))) char smem_raw[];

typedef float f32x2_t __attribute__((ext_vector_type(2)));
typedef __bf16 bf16x2_t __attribute__((ext_vector_type(2)));
__device__ __forceinline__ unsigned pk_bf16(float lo, float hi) { const f32x2_t v = {lo, hi}; return __builtin_bit_cast(unsigned, __builtin_convertvector(v, bf16x2_t)); }
__device__ __forceinline__ float bf_lo(unsigned u) { return __uint_as_float(u << 16); }
__device__ __forceinline__ float bf_hi(unsigned u) { return __uint_as_float(u & 0xffff0000u); }

template <int BN, class Epi>
__device__ __forceinline__ void wg_gemm(const bf16_t* __restrict__ A, int lda, const bf16_t* __restrict__ Bt, int ldb, int K, Epi&& epi) {
  constexpr int NT = BN / 64;
  constexpr int STAGE_BYTES = (128 + BN) * 128;
  constexpr int LA = 2, LB = BN / 64;
  LAS char* lds = (LAS char*)smem_raw;
  const int tid = threadIdx.x, lane = tid & 63, wid = tid >> 6, wr = wid >> 2, wc = wid & 3, fr = lane & 15, fq = lane >> 4;
  f32x4 acc[4][NT];
#pragma unroll
  for (int m = 0; m < 4; ++m)
#pragma unroll
    for (int n = 0; n < NT; ++n) acc[m][n] = (f32x4){0.f, 0.f, 0.f, 0.f};
  const int nk = K / 64;
  auto stage = [&](int buf, int kt) {
    LAS char* base = lds + buf * STAGE_BYTES;
#pragma unroll
    for (int i = 0; i < LA; ++i) {
      const int q = tid + i * 512, row = q >> 3, c = (q & 7) ^ (row & 7);
      __builtin_amdgcn_global_load_lds((const unsigned*)(A + (long)row * lda + kt * 64 + c * 8), (LAS unsigned*)(base + q * 16), 16, 0, 0);
    }
#pragma unroll
    for (int i = 0; i < LB; ++i) {
      const int q = tid + i * 512, row = q >> 3, c = (q & 7) ^ (row & 7);
      __builtin_amdgcn_global_load_lds((const unsigned*)(Bt + (long)row * ldb + kt * 64 + c * 8), (LAS unsigned*)(base + 16384 + q * 16), 16, 0, 0);
    }
  };
  asm volatile("s_waitcnt vmcnt(0)" ::: "memory");
  __builtin_amdgcn_s_barrier();
  asm volatile("" ::: "memory");
  stage(0, 0);
  if (nk > 1) stage(1, 1);
  for (int kt = 0; kt < nk; ++kt) {
    if (kt + 1 < nk) asm volatile("s_waitcnt vmcnt(%0)" ::"n"(LA + LB) : "memory");
    else asm volatile("s_waitcnt vmcnt(0)" ::: "memory");
    __builtin_amdgcn_s_barrier();
    asm volatile("" ::: "memory");
    if (kt + 2 < nk) stage((kt + 2) % 3, kt + 2);
    LAS const char* base = lds + (kt % 3) * STAGE_BYTES;
    bf16x8 af[4][2], bfr[NT][2];
#pragma unroll
    for (int m = 0; m < 4; ++m)
#pragma unroll
      for (int kk = 0; kk < 2; ++kk) {
        const int row = wr * 64 + m * 16 + fr, c = (kk * 4 + fq) ^ (fr & 7);
        af[m][kk] = *(LAS const bf16x8*)(base + row * 128 + c * 16);
      }
#pragma unroll
    for (int n = 0; n < NT; ++n)
#pragma unroll
      for (int kk = 0; kk < 2; ++kk) {
        const int row = wc * (BN / 4) + n * 16 + fr, c = (kk * 4 + fq) ^ (fr & 7);
        bfr[n][kk] = *(LAS const bf16x8*)(base + 16384 + row * 128 + c * 16);
      }
#pragma unroll
    for (int kk = 0; kk < 2; ++kk)
#pragma unroll
      for (int m = 0; m < 4; ++m)
#pragma unroll
        for (int n = 0; n < NT; ++n) acc[m][n] = __builtin_amdgcn_mfma_f32_16x16x32_bf16(bfr[n][kk], af[m][kk], acc[m][n], 0, 0, 0);
  }
  epi(acc, wr, wc, fr, fq);
}

#define GEMM_LDS_BYTES (3 * (128 + 256) * 128)
#define RED_OFF GEMM_LDS_BYTES
#define LDS_BYTES (GEMM_LDS_BYTES + 4096)

__global__ __launch_bounds__(256) void cvt_bf16_k(const float* __restrict__ in, bf16_t* __restrict__ out, long n8) {
  for (long i = (long)blockIdx.x * 256 + threadIdx.x; i < n8; i += (long)gridDim.x * 256) {
    const float4 a = *(const float4*)(in + i * 8), b = *(const float4*)(in + i * 8 + 4);
    u32x4 o; o.x = pk_bf16(a.x, a.y); o.y = pk_bf16(a.z, a.w); o.z = pk_bf16(b.x, b.y); o.w = pk_bf16(b.z, b.w);
    *(u32x4*)(out + i * 8) = o;
  }
}
__global__ __launch_bounds__(256) void cvt_transpose_k(const float* __restrict__ W, bf16_t* __restrict__ WT, int K, int N) {
  __shared__ float t[64][65];
  const int k0 = blockIdx.y * 64, n0 = blockIdx.x * 64, tid = threadIdx.x;
  for (int i = tid; i < 64 * 64; i += 256) { const int kk = i >> 6, nn = i & 63; t[kk][nn] = W[(long)(k0 + kk) * N + n0 + nn]; }
  __syncthreads();
  for (int i = tid; i < 64 * 32; i += 256) { const int nn = i >> 5, kp = (i & 31) * 2; *(unsigned*)(WT + (long)(n0 + nn) * K + k0 + kp) = pk_bf16(t[kp][nn], t[kp + 1][nn]); }
}

__global__ __launch_bounds__(256) void cvt_wsp_k(const float* __restrict__ w, bf16_t* __restrict__ o) {
  const int i = blockIdx.x * 256 + threadIdx.x;
  const int t = (i >> 7) & 127, sidx = i & 127;
  const float v = (sidx <= t) ? w[i] : 0.f;
  o[i] = (bf16_t)(pk_bf16(v, 0.f) & 0xffffu);
}
__global__ __launch_bounds__(256) void cvt_f32_k(const bf16_t* __restrict__ in, float* __restrict__ out, long n8) {
  for (long i = (long)blockIdx.x * 256 + threadIdx.x; i < n8; i += (long)gridDim.x * 256) {
    const u32x4 v = *(const u32x4*)(in + i * 8);
    float4 a, b; a.x = bf_lo(v.x); a.y = bf_hi(v.x); a.z = bf_lo(v.y); a.w = bf_hi(v.y); b.x = bf_lo(v.z); b.y = bf_hi(v.z); b.z = bf_lo(v.w); b.w = bf_hi(v.w);
    *(float4*)(out + i * 8) = a; *(float4*)(out + i * 8 + 4) = b;
  }
}

struct P {
  const float* x; const float* mem; const float* b_in; const float* sgu_g; const float* sgu_b; const float* b_sp; const float* conv_w;
  const float* ln1_g; const float* ln1_b; const float* ln2_g; const float* ln2_b; const float* ln3_g; const float* ln3_b;
  const bf16_t* XB; const bf16_t* w_inT; const bf16_t* w_moT; const bf16_t* wsb;
  bf16_t* ZB; bf16_t* VT; bf16_t* Y; float* PRE; bf16_t* X1;
  const bf16_t* w_xqT; const bf16_t* w_xkvT; const bf16_t* w_xoT; const bf16_t* memB;
  bf16_t* Kc; bf16_t* VTc; bf16_t* Q; bf16_t* Pb; bf16_t* O; bf16_t* X2;
  const bf16_t* w_pqT; const bf16_t* skb; bf16_t* PQ; int* experts; float* gates;
  const bf16_t* WD; const bf16_t* WU; float* out;
};

__device__ __forceinline__ void wg_sync_mem() { asm volatile("s_waitcnt vmcnt(0) lgkmcnt(0)" ::: "memory"); __syncthreads(); }

__device__ __forceinline__ void phase_inproj(const P& p, int tile) {
  for (int nt = 0; nt < INW / 256; ++nt) {
    wg_gemm<256>(p.XB + (long)tile * 128 * DM, DM, p.w_inT + (long)nt * 256 * DM, DM, DM, [&](f32x4 (&acc)[4][4], int wr, int wc, int fr, int fq) {
#pragma unroll
      for (int m = 0; m < 4; ++m)
#pragma unroll
        for (int n = 0; n < 4; ++n) {
          const int row = tile * 128 + wr * 64 + m * 16 + fr, col = nt * 256 + wc * 64 + n * 16 + fq * 4;
          const float4 bv = *(const float4*)(p.b_in + col);
          float o0 = acc[m][n][0] + bv.x, o1 = acc[m][n][1] + bv.y, o2 = acc[m][n][2] + bv.z, o3 = acc[m][n][3] + bv.w;
          if (nt < 4) { o0 = gelu_f(o0); o1 = gelu_f(o1); o2 = gelu_f(o2); o3 = gelu_f(o3); }
          u32x2 w; w.x = pk_bf16(o0, o1); w.y = pk_bf16(o2, o3);
          *(u32x2*)(p.ZB + (long)row * INW + col) = w;
        }
    });
  }
}

__device__ __forceinline__ void phase_mixer(const P& p, int tile) {
  const int tid = threadIdx.x, lane = tid & 63, wid = tid >> 6;
  const long t0 = (long)tile * 128;
  for (int it = tid; it < 128 * 64; it += 512) {
    const int tl = it >> 6, c = (it & 63) * 8;
    const long t = t0 + tl;
    const int sq = (int)(t % SEQ);
    float conv[8];
#pragma unroll
    for (int j = 0; j < 8; ++j) conv[j] = 0.f;
#pragma unroll
    for (int k = 0; k < 3; ++k) {
      if (sq - 2 + k >= 0) {
        const bf16_t* zr = p.ZB + (t - 2 + k) * INW;
        const u32x4 hb = *(const u32x4*)(zr + 1024 + c), gc = *(const u32x4*)(zr + 2048 + c);
        const float4 w0 = *(const float4*)(p.conv_w + k * 512 + c), w1 = *(const float4*)(p.conv_w + k * 512 + c + 4);
        conv[0] += w0.x * (bf_lo(hb.x) * bf_lo(gc.x)); conv[1] += w0.y * (bf_hi(hb.x) * bf_hi(gc.x));
        conv[2] += w0.z * (bf_lo(hb.y) * bf_lo(gc.y)); conv[3] += w0.w * (bf_hi(hb.y) * bf_hi(gc.y));
        conv[4] += w1.x * (bf_lo(hb.z) * bf_lo(gc.z)); conv[5] += w1.y * (bf_hi(hb.z) * bf_hi(gc.z));
        conv[6] += w1.z * (bf_lo(hb.w) * bf_lo(gc.w)); conv[7] += w1.w * (bf_hi(hb.w) * bf_hi(gc.w));
      }
    }
    const u32x4 gb = *(const u32x4*)(p.ZB + t * INW + 1536 + c);
    u32x4 o;
    o.x = pk_bf16(bf_lo(gb.x) * conv[0], bf_hi(gb.x) * conv[1]); o.y = pk_bf16(bf_lo(gb.y) * conv[2], bf_hi(gb.y) * conv[3]);
    o.z = pk_bf16(bf_lo(gb.z) * conv[4], bf_hi(gb.z) * conv[5]); o.w = pk_bf16(bf_lo(gb.w) * conv[6], bf_hi(gb.w) * conv[7]);
    *(u32x4*)(p.Y + t * DM + 512 + c) = o;
  }
  for (int h = 0; h < 4; ++h) {
    float a0[16], a1[16];
    const float g0 = p.sgu_g[h * 128 + 2 * lane], g1 = p.sgu_g[h * 128 + 2 * lane + 1], b0 = p.sgu_b[h * 128 + 2 * lane], b1 = p.sgu_b[h * 128 + 2 * lane + 1];
#pragma unroll
    for (int i = 0; i < 16; ++i) {
      const unsigned v = *(const unsigned*)(p.ZB + (t0 + wid * 16 + i) * INW + 512 + h * 128 + 2 * lane);
      const float x0 = bf_lo(v), x1 = bf_hi(v);
      float sum = x0 + x1;
#pragma unroll
      for (int o = 32; o > 0; o >>= 1) sum += __shfl_xor(sum, o);
      const float mu = sum * (1.f / 128.f);
      const float d0 = x0 - mu, d1 = x1 - mu;
      float q = d0 * d0 + d1 * d1;
#pragma unroll
      for (int o = 32; o > 0; o >>= 1) q += __shfl_xor(q, o);
      const float rstd = rsqrtf(q * (1.f / 128.f) + LN_EPS);
      a0[i] = d0 * rstd * g0 + b0; a1[i] = d1 * rstd * g1 + b1;
    }
    bf16_t* vt = p.VT + ((long)tile * 4 + h) * 128 * 128;
    u32x4 o;
    o.x = pk_bf16(a0[0], a0[1]); o.y = pk_bf16(a0[2], a0[3]); o.z = pk_bf16(a0[4], a0[5]); o.w = pk_bf16(a0[6], a0[7]);
    *(u32x4*)(vt + (2 * lane) * 128 + wid * 16) = o;
    o.x = pk_bf16(a0[8], a0[9]); o.y = pk_bf16(a0[10], a0[11]); o.z = pk_bf16(a0[12], a0[13]); o.w = pk_bf16(a0[14], a0[15]);
    *(u32x4*)(vt + (2 * lane) * 128 + wid * 16 + 8) = o;
    o.x = pk_bf16(a1[0], a1[1]); o.y = pk_bf16(a1[2], a1[3]); o.z = pk_bf16(a1[4], a1[5]); o.w = pk_bf16(a1[6], a1[7]);
    *(u32x4*)(vt + (2 * lane + 1) * 128 + wid * 16) = o;
    o.x = pk_bf16(a1[8], a1[9]); o.y = pk_bf16(a1[10], a1[11]); o.z = pk_bf16(a1[12], a1[13]); o.w = pk_bf16(a1[14], a1[15]);
    *(u32x4*)(vt + (2 * lane + 1) * 128 + wid * 16 + 8) = o;
  }
  wg_sync_mem();
  for (int h = 0; h < 4; ++h) {
    wg_gemm<128>(p.wsb + h * 128 * 128, 128, p.VT + ((long)tile * 4 + h) * 128 * 128, 128, 128, [&](f32x4 (&acc)[4][2], int wr, int wc, int fr, int fq) {
#pragma unroll
      for (int m = 0; m < 4; ++m)
#pragma unroll
        for (int n = 0; n < 2; ++n) {
          const int rl = wr * 64 + m * 16 + fr, col = wc * 32 + n * 16 + fq * 4;
          const float bs = p.b_sp[h * 128 + rl];
          const u32x2 uv = *(const u32x2*)(p.ZB + (t0 + rl) * INW + h * 128 + col);
          u32x2 w;
          w.x = pk_bf16(bf_lo(uv.x) * (acc[m][n][0] + bs), bf_hi(uv.x) * (acc[m][n][1] + bs));
          w.y = pk_bf16(bf_lo(uv.y) * (acc[m][n][2] + bs), bf_hi(uv.y) * (acc[m][n][3] + bs));
          *(u32x2*)(p.Y + (t0 + rl) * DM + h * 128 + col) = w;
        }
    });
  }
}

__device__ __forceinline__ void ln_rows16(const float* __restrict__ PRE, long r0, const float* __restrict__ g, const float* __restrict__ b, bf16_t* __restrict__ Out, int lane) {
  for (int i = 0; i < 16; ++i) {
    const float* pr = PRE + (r0 + i) * DM;
    float4 v[4];
    float sum = 0.f;
#pragma unroll
    for (int j = 0; j < 4; ++j) { v[j] = *(const float4*)(pr + j * 256 + lane * 4); sum += (v[j].x + v[j].y) + (v[j].z + v[j].w); }
#pragma unroll
    for (int o = 32; o > 0; o >>= 1) sum += __shfl_xor(sum, o);
    const float mu = sum * (1.f / DM);
    float q = 0.f;
#pragma unroll
    for (int j = 0; j < 4; ++j) { v[j].x -= mu; v[j].y -= mu; v[j].z -= mu; v[j].w -= mu; q += (v[j].x * v[j].x + v[j].y * v[j].y) + (v[j].z * v[j].z + v[j].w * v[j].w); }
#pragma unroll
    for (int o = 32; o > 0; o >>= 1) q += __shfl_xor(q, o);
    const float rstd = rsqrtf(q * (1.f / DM) + LN_EPS);
#pragma unroll
    for (int j = 0; j < 4; ++j) {
      const int c0 = j * 256 + lane * 4;
      const float4 gg = *(const float4*)(g + c0), bb = *(const float4*)(b + c0);
      u32x2 w; w.x = pk_bf16(v[j].x * rstd * gg.x + bb.x, v[j].y * rstd * gg.y + bb.y); w.y = pk_bf16(v[j].z * rstd * gg.z + bb.z, v[j].w * rstd * gg.w + bb.w);
      *(u32x2*)(Out + (r0 + i) * DM + c0) = w;
    }
  }
}

__device__ __forceinline__ void phase_outproj(const P& p, int tile) {
  const long t0 = (long)tile * 128;
  for (int nt = 0; nt < 4; ++nt) {
    wg_gemm<256>(p.Y + t0 * DM, DM, p.w_moT + (long)nt * 256 * DM, DM, DM, [&](f32x4 (&acc)[4][4], int wr, int wc, int fr, int fq) {
#pragma unroll
      for (int m = 0; m < 4; ++m)
#pragma unroll
        for (int n = 0; n < 4; ++n) {
          const long row = t0 + wr * 64 + m * 16 + fr; const int col = nt * 256 + wc * 64 + n * 16 + fq * 4;
          const float4 xv = *(const float4*)(p.x + row * DM + col);
          float4 o; o.x = ALPHA * xv.x + acc[m][n][0]; o.y = ALPHA * xv.y + acc[m][n][1]; o.z = ALPHA * xv.z + acc[m][n][2]; o.w = ALPHA * xv.w + acc[m][n][3];
          *(float4*)(p.PRE + row * DM + col) = o;
        }
    });
  }
  wg_sync_mem();
  ln_rows16(p.PRE, t0 + (threadIdx.x >> 6) * 16, p.ln1_g, p.ln1_b, p.X1, threadIdx.x & 63);
}

__device__ __forceinline__ void phase_kv(const P& p, int unit) {
  const int rt = unit >> 3, nt = unit & 7;
  wg_gemm<256>(p.memB + (long)rt * 128 * DM, DM, p.w_xkvT + (long)nt * 256 * DM, DM, DM, [&](f32x4 (&acc)[4][4], int wr, int wc, int fr, int fq) {
    const int b = rt >> 1, hh = nt & 3;
#pragma unroll
    for (int m = 0; m < 4; ++m)
#pragma unroll
      for (int n = 0; n < 4; ++n) {
        const int mm = (rt & 1) * 128 + wr * 64 + m * 16 + fr, d = wc * 64 + n * 16 + fq * 4;
        if (nt < 4) {
          u32x2 w; w.x = pk_bf16(acc[m][n][0], acc[m][n][1]); w.y = pk_bf16(acc[m][n][2], acc[m][n][3]);
          *(u32x2*)(p.Kc + ((long)(b * 4 + hh) * 256 + mm) * 256 + d) = w;
        } else {
          bf16_t* vt = p.VTc + ((long)(b * 4 + hh) * 256 + d) * 256 + mm;
          const unsigned w0 = pk_bf16(acc[m][n][0], acc[m][n][1]), w1 = pk_bf16(acc[m][n][2], acc[m][n][3]);
          vt[0] = (bf16_t)(w0 & 0xffffu); vt[256] = (bf16_t)(w0 >> 16); vt[512] = (bf16_t)(w1 & 0xffffu); vt[768] = (bf16_t)(w1 >> 16);
        }
      }
  });
}

__device__ __forceinline__ void phase_qproj(const P& p, int tile) {
  const long t0 = (long)tile * 128;
  for (int nt = 0; nt < 4; ++nt) {
    wg_gemm<256>(p.X1 + t0 * DM, DM, p.w_xqT + (long)nt * 256 * DM, DM, DM, [&](f32x4 (&acc)[4][4], int wr, int wc, int fr, int fq) {
#pragma unroll
      for (int m = 0; m < 4; ++m)
#pragma unroll
        for (int n = 0; n < 4; ++n) {
          const long row = t0 + wr * 64 + m * 16 + fr; const int col = nt * 256 + wc * 64 + n * 16 + fq * 4;
          u32x2 w; w.x = pk_bf16(acc[m][n][0] * 0.0625f, acc[m][n][1] * 0.0625f); w.y = pk_bf16(acc[m][n][2] * 0.0625f, acc[m][n][3] * 0.0625f);
          *(u32x2*)(p.Q + row * DM + col) = w;
        }
    });
  }
}

__device__ __forceinline__ void phase_attn(const P& p, int tile) {
  const long t0 = (long)tile * 128;
  const int b = tile >> 6;
  LAS float* red = (LAS float*)((LAS char*)smem_raw + RED_OFF);
  for (int h = 0; h < 4; ++h) {
    bf16_t* Pw = p.Pb + ((long)tile * 4 + h) * 128 * 256;
    wg_gemm<256>(p.Q + t0 * DM + h * 256, DM, p.Kc + (long)(b * 4 + h) * 256 * 256, 256, 256, [&](f32x4 (&acc)[4][4], int wr, int wc, int fr, int fq) {
      float rmax[4];
#pragma unroll
      for (int m = 0; m < 4; ++m) {
        float mx = -3.0e38f;
#pragma unroll
        for (int n = 0; n < 4; ++n) mx = fmaxf(mx, fmaxf(fmaxf(acc[m][n][0], acc[m][n][1]), fmaxf(acc[m][n][2], acc[m][n][3])));
        mx = fmaxf(mx, __shfl_xor(mx, 16)); mx = fmaxf(mx, __shfl_xor(mx, 32));
        if (fq == 0) red[(wr * 64 + m * 16 + fr) * 4 + wc] = mx;
      }
      __syncthreads();
#pragma unroll
      for (int m = 0; m < 4; ++m) {
        const f32x4 r = *(LAS const f32x4*)(red + (wr * 64 + m * 16 + fr) * 4);
        rmax[m] = fmaxf(fmaxf(r[0], r[1]), fmaxf(r[2], r[3]));
      }
#pragma unroll
      for (int m = 0; m < 4; ++m) {
        float sm = 0.f;
#pragma unroll
        for (int n = 0; n < 4; ++n)
#pragma unroll
          for (int j = 0; j < 4; ++j) { const float e = __expf(acc[m][n][j] - rmax[m]); acc[m][n][j] = e; sm += e; }
        sm += __shfl_xor(sm, 16); sm += __shfl_xor(sm, 32);
        if (fq == 0) red[512 + (wr * 64 + m * 16 + fr) * 4 + wc] = sm;
      }
      __syncthreads();
#pragma unroll
      for (int m = 0; m < 4; ++m) {
        const f32x4 r = *(LAS const f32x4*)(red + 512 + (wr * 64 + m * 16 + fr) * 4);
        const float inv = 1.f / ((r[0] + r[1]) + (r[2] + r[3]));
        const int rl = wr * 64 + m * 16 + fr;
#pragma unroll
        for (int n = 0; n < 4; ++n) {
          u32x2 w; w.x = pk_bf16(acc[m][n][0] * inv, acc[m][n][1] * inv); w.y = pk_bf16(acc[m][n][2] * inv, acc[m][n][3] * inv);
          *(u32x2*)(Pw + rl * 256 + wc * 64 + n * 16 + fq * 4) = w;
        }
      }
    });
    wg_sync_mem();
    wg_gemm<256>(Pw, 256, p.VTc + (long)(b * 4 + h) * 256 * 256, 256, 256, [&](f32x4 (&acc)[4][4], int wr, int wc, int fr, int fq) {
#pragma unroll
      for (int m = 0; m < 4; ++m)
#pragma unroll
        for (int n = 0; n < 4; ++n) {
          const long row = t0 + wr * 64 + m * 16 + fr; const int col = h * 256 + wc * 64 + n * 16 + fq * 4;
          u32x2 w; w.x = pk_bf16(acc[m][n][0], acc[m][n][1]); w.y = pk_bf16(acc[m][n][2], acc[m][n][3]);
          *(u32x2*)(p.O + row * DM + col) = w;
        }
    });
  }
}

__device__ __forceinline__ void phase_oproj(const P& p, int tile) {
  const long t0 = (long)tile * 128;
  for (int nt = 0; nt < 4; ++nt) {
    wg_gemm<256>(p.O + t0 * DM, DM, p.w_xoT + (long)nt * 256 * DM, DM, DM, [&](f32x4 (&acc)[4][4], int wr, int wc, int fr, int fq) {
#pragma unroll
      for (int m = 0; m < 4; ++m)
#pragma unroll
        for (int n = 0; n < 4; ++n) {
          const long row = t0 + wr * 64 + m * 16 + fr; const int col = nt * 256 + wc * 64 + n * 16 + fq * 4;
          const u32x2 xv = *(const u32x2*)(p.X1 + row * DM + col);
          float4 o; o.x = ALPHA * bf_lo(xv.x) + acc[m][n][0]; o.y = ALPHA * bf_hi(xv.x) + acc[m][n][1]; o.z = ALPHA * bf_lo(xv.y) + acc[m][n][2]; o.w = ALPHA * bf_hi(xv.y) + acc[m][n][3];
          *(float4*)(p.PRE + row * DM + col) = o;
        }
    });
  }
  wg_sync_mem();
  ln_rows16(p.PRE, t0 + (threadIdx.x >> 6) * 16, p.ln2_g, p.ln2_b, p.X2, threadIdx.x & 63);
}

__device__ __forceinline__ void phase_pq(const P& p, int tile) {
  const long t0 = (long)tile * 128;
  for (int nt = 0; nt < 8; ++nt) {
    wg_gemm<256>(p.X2 + t0 * DM, DM, p.w_pqT + (long)nt * 256 * DM, DM, DM, [&](f32x4 (&acc)[4][4], int wr, int wc, int fr, int fq) {
#pragma unroll
      for (int m = 0; m < 4; ++m)
#pragma unroll
        for (int n = 0; n < 4; ++n) {
          const long row = t0 + wr * 64 + m * 16 + fr; const int col = nt * 256 + wc * 64 + n * 16 + fq * 4;
          u32x2 w; w.x = pk_bf16(acc[m][n][0], acc[m][n][1]); w.y = pk_bf16(acc[m][n][2], acc[m][n][3]);
          *(u32x2*)(p.PQ + row * 2048 + col) = w;
        }
    });
  }
}

__device__ __forceinline__ unsigned cand_entry(int s) {
  unsigned e = 255u; int base = 0;
#pragma unroll
  for (int i = 0; i < 16; ++i) { const int cnt = 16 / (i + 1); if (s >= base && s < base + cnt) e = (unsigned)i | ((unsigned)(s - base) << 4); base += cnt; }
  return e;
}
template <int CTRL> __device__ __forceinline__ unsigned dpp_u(unsigned x) { return (unsigned)__builtin_amdgcn_mov_dpp((int)x, CTRL, 0xf, 0xf, true); }
template <int CTRL> __device__ __forceinline__ float dpp_f(float x) { return __int_as_float(__builtin_amdgcn_mov_dpp(__float_as_int(x), CTRL, 0xf, 0xf, true)); }
__device__ __forceinline__ unsigned umin_(unsigned a, unsigned b) { return a < b ? a : b; }
__device__ __forceinline__ unsigned row_min_u(unsigned x) {
  x = umin_(x, dpp_u<0x128>(x)); x = umin_(x, dpp_u<0x124>(x)); x = umin_(x, dpp_u<0x122>(x)); x = umin_(x, dpp_u<0x121>(x)); return x;
}
__device__ __forceinline__ float row_max_f(float x) { x = fmaxf(x, dpp_f<0x128>(x)); x = fmaxf(x, dpp_f<0x124>(x)); x = fmaxf(x, dpp_f<0x122>(x)); x = fmaxf(x, dpp_f<0x121>(x)); return x; }
__device__ __forceinline__ float row_sum_f(float x) { x += dpp_f<0x128>(x); x += dpp_f<0x124>(x); x += dpp_f<0x122>(x); x += dpp_f<0x121>(x); return x; }
__device__ __forceinline__ unsigned f2key(float f) { const unsigned b = __float_as_uint(f); return b ^ ((unsigned)((int)b >> 31) | 0x80000000u); }
__device__ __forceinline__ float key2f(unsigned k) { return __uint_as_float(k ^ ((k & 0x80000000u) ? 0x80000000u : 0xffffffffu)); }

#define KEYS_OFF 65536
#define KEY_STRIDE 528
template <int N> __device__ __forceinline__ unsigned top16_row(const unsigned (&k)[N], int r) {
  unsigned pm1 = 0xFFFFFFFEu, mine = 0;
#pragma unroll
  for (int rd = 0; rd < 16; ++rd) {
    unsigned d = pm1 - k[0];
#pragma unroll
    for (int i = 1; i < N; ++i) d = umin_(d, pm1 - k[i]);
    d = row_min_u(d);
    const unsigned nxt = pm1 - d;
    mine = (r == rd) ? nxt : mine;
    pm1 = nxt - 1;
  }
  return mine;
}

__device__ __forceinline__ void phase_route(const P& p, int tile) {
  const long t0 = (long)tile * 128;
  const int tid = threadIdx.x, lane = tid & 63, wid = tid >> 6, r = lane & 15, g = lane >> 4;
  LAS char* lds = (LAS char*)smem_raw;
  LAS unsigned char* tab = (LAS unsigned char*)(lds + RED_OFF);
  if (tid < 64) tab[tid] = (unsigned char)cand_entry(tid);
  unsigned ci[4], cj[4]; bool cval[4];
#pragma unroll
  for (int q = 0; q < 4; ++q) { const unsigned e = cand_entry(r * 4 + q); cval[q] = (e != 255u); ci[q] = ((unsigned)(g * 16) + (e & 15u)) * 4u; cj[q] = ((unsigned)(g * 16) + ((e >> 4) & 15u)) * 4u; }
  for (int h = 0; h < 8; ++h) {
    unsigned top[2][4];
#pragma unroll
    for (int ph = 0; ph < 2; ++ph) {
      wg_gemm<128>(p.PQ + t0 * 2048 + h * 256 + ph * 128, 2048, p.skb + (long)(h * 2 + ph) * 128 * 128, 128, 128, [&](f32x4 (&acc)[4][2], int wr, int wc, int fr, int fq) {
#pragma unroll
        for (int m = 0; m < 4; ++m)
#pragma unroll
          for (int n = 0; n < 2; ++n) {
            const int row = wr * 64 + m * 16 + fr, col = wc * 32 + n * 16 + fq * 4;
            u32x4 kk;
            kk.x = (f2key(acc[m][n][0]) & ~127u) | (unsigned)(127 - col); kk.y = (f2key(acc[m][n][1]) & ~127u) | (unsigned)(126 - col);
            kk.z = (f2key(acc[m][n][2]) & ~127u) | (unsigned)(125 - col); kk.w = (f2key(acc[m][n][3]) & ~127u) | (unsigned)(124 - col);
            *(LAS u32x4*)(lds + KEYS_OFF + row * KEY_STRIDE + col * 4) = kk;
          }
      });
      __syncthreads();
#pragma unroll
      for (int ps = 0; ps < 4; ++ps) {
        const int tk = wid * 16 + ps * 4 + g;
        const u32x4 k0 = *(LAS const u32x4*)(lds + KEYS_OFF + tk * KEY_STRIDE + r * 32), k1 = *(LAS const u32x4*)(lds + KEYS_OFF + tk * KEY_STRIDE + r * 32 + 16);
        const unsigned k[8] = {k0.x, k0.y, k0.z, k0.w, k1.x, k1.y, k1.z, k1.w};
        top[ph][ps] = top16_row<8>(k, r);
      }
    }
#pragma unroll
    for (int ps = 0; ps < 4; ++ps) {
      const int tk = wid * 16 + ps * 4 + g;
      const unsigned A = top[0][ps], B = top[1][ps];
      const float fa = key2f(A & ~127u), fb = key2f(B & ~127u);
      unsigned k2[4];
#pragma unroll
      for (int q = 0; q < 4; ++q) {
        const float va = __int_as_float(__builtin_amdgcn_ds_bpermute((int)ci[q], __float_as_int(fa)));
        const float vb = __int_as_float(__builtin_amdgcn_ds_bpermute((int)cj[q], __float_as_int(fb)));
        const unsigned kk = (f2key(va + vb) & ~63u) | (unsigned)(63 - (r * 4 + q));
        k2[q] = cval[q] ? kk : 0u;
      }
      const unsigned mine = top16_row<4>(k2, r);
      const unsigned slot = 63u - (mine & 63u);
      const unsigned e = tab[slot];
      const unsigned ka = (unsigned)__builtin_amdgcn_ds_bpermute((int)(((unsigned)(g * 16) + (e & 15u)) * 4u), (int)A);
      const unsigned kb = (unsigned)__builtin_amdgcn_ds_bpermute((int)(((unsigned)(g * 16) + ((e >> 4) & 15u)) * 4u), (int)B);
      const int expert = (int)((127u - (ka & 127u)) * 128u + (127u - (kb & 127u)));
      const float c = key2f(mine & ~63u);
      const float mx = row_max_f(c);
      const float ex = __expf(c - mx);
      const float sm = row_sum_f(ex);
      p.experts[(t0 + tk) * 128 + h * 16 + r] = expert;
      p.gates[(t0 + tk) * 128 + h * 16 + r] = ex / sm;
    }
  }
}

__device__ __forceinline__ float dot2bf(unsigned a, unsigned b, float c) { return __builtin_amdgcn_fdot2_f32_bf16(__builtin_bit_cast(bf16x2_t, a), __builtin_bit_cast(bf16x2_t, b), c, false); }
__device__ __forceinline__ void phase_gather(const P& p, int tile) {
  const int tid = threadIdx.x, lane = tid & 63, wid = tid >> 6, r = lane & 15, g = lane >> 4;
  for (int ti = 0; ti < 16; ++ti) {
    const long t = (long)tile * 128 + wid * 16 + ti;
    u32x4 xr[8];
#pragma unroll
    for (int i = 0; i < 8; ++i) xr[i] = *(const u32x4*)(p.X2 + t * DM + r * 8 + 128 * i);
    const int e0 = p.experts[t * 128 + r * 4 + g], e1 = p.experts[t * 128 + (16 + r) * 4 + g];
    const float g0 = p.gates[t * 128 + r * 4 + g], g1 = p.gates[t * 128 + (16 + r) * 4 + g];
    float d0 = 0.f, d1 = 0.f;
#pragma unroll 2
    for (int it = 0; it < 32; ++it) {
      const int e = __builtin_amdgcn_ds_bpermute((g * 16 + (it & 15)) * 4, (it < 16) ? e0 : e1);
      const bf16_t* row = p.WD + (long)e * DM + r * 8;
      float acc = 0.f;
#pragma unroll
      for (int i = 0; i < 8; ++i) {
        const u32x4 w = *(const u32x4*)(row + 128 * i);
        acc = dot2bf(w.x, xr[i].x, acc); acc = dot2bf(w.y, xr[i].y, acc); acc = dot2bf(w.z, xr[i].z, acc); acc = dot2bf(w.w, xr[i].w, acc);
      }
      acc = row_sum_f(acc);
      const bool mine = ((it & 15) == r);
      d0 = (mine && it < 16) ? acc : d0;
      d1 = (mine && it >= 16) ? acc : d1;
    }
    const float c0 = g0 * gelu_f(d0), c1 = g1 * gelu_f(d1);
    float o[16];
#pragma unroll
    for (int i = 0; i < 16; ++i) o[i] = 0.f;
#pragma unroll 8
    for (int k = 0; k < 128; ++k) {
      const int srcl = (k & 3) * 16 + ((k >> 2) & 15);
      const float c = __int_as_float(__builtin_amdgcn_readlane(__float_as_int((k < 64) ? c0 : c1), srcl));
      const int e = __builtin_amdgcn_readlane((k < 64) ? e0 : e1, srcl);
      const bf16_t* row = p.WU + (long)e * DM + lane * 8;
      const u32x4 w0 = *(const u32x4*)row, w1 = *(const u32x4*)(row + 512);
      o[0] += c * bf_lo(w0.x); o[1] += c * bf_hi(w0.x); o[2] += c * bf_lo(w0.y); o[3] += c * bf_hi(w0.y);
      o[4] += c * bf_lo(w0.z); o[5] += c * bf_hi(w0.z); o[6] += c * bf_lo(w0.w); o[7] += c * bf_hi(w0.w);
      o[8] += c * bf_lo(w1.x); o[9] += c * bf_hi(w1.x); o[10] += c * bf_lo(w1.y); o[11] += c * bf_hi(w1.y);
      o[12] += c * bf_lo(w1.z); o[13] += c * bf_hi(w1.z); o[14] += c * bf_lo(w1.w); o[15] += c * bf_hi(w1.w);
    }
    const u32x4 xa = *(const u32x4*)(p.X2 + t * DM + lane * 8), xb = *(const u32x4*)(p.X2 + t * DM + 512 + lane * 8);
    o[0] += ALPHA * bf_lo(xa.x); o[1] += ALPHA * bf_hi(xa.x); o[2] += ALPHA * bf_lo(xa.y); o[3] += ALPHA * bf_hi(xa.y);
    o[4] += ALPHA * bf_lo(xa.z); o[5] += ALPHA * bf_hi(xa.z); o[6] += ALPHA * bf_lo(xa.w); o[7] += ALPHA * bf_hi(xa.w);
    o[8] += ALPHA * bf_lo(xb.x); o[9] += ALPHA * bf_hi(xb.x); o[10] += ALPHA * bf_lo(xb.y); o[11] += ALPHA * bf_hi(xb.y);
    o[12] += ALPHA * bf_lo(xb.z); o[13] += ALPHA * bf_hi(xb.z); o[14] += ALPHA * bf_lo(xb.w); o[15] += ALPHA * bf_hi(xb.w);
    float sum = 0.f;
#pragma unroll
    for (int i = 0; i < 16; ++i) sum += o[i];
#pragma unroll
    for (int s = 32; s > 0; s >>= 1) sum += __shfl_xor(sum, s);
    const float mu = sum * (1.f / DM);
    float q = 0.f;
#pragma unroll
    for (int i = 0; i < 16; ++i) { o[i] -= mu; q += o[i] * o[i]; }
#pragma unroll
    for (int s = 32; s > 0; s >>= 1) q += __shfl_xor(q, s);
    const float rstd = rsqrtf(q * (1.f / DM) + LN_EPS);
#pragma unroll
    for (int hh = 0; hh < 2; ++hh) {
      const int c0i = hh * 512 + lane * 8;
      const float4 ga = *(const float4*)(p.ln3_g + c0i), gb = *(const float4*)(p.ln3_g + c0i + 4), ba = *(const float4*)(p.ln3_b + c0i), bb = *(const float4*)(p.ln3_b + c0i + 4);
      float4 oa, ob;
      oa.x = o[hh * 8 + 0] * rstd * ga.x + ba.x; oa.y = o[hh * 8 + 1] * rstd * ga.y + ba.y; oa.z = o[hh * 8 + 2] * rstd * ga.z + ba.z; oa.w = o[hh * 8 + 3] * rstd * ga.w + ba.w;
      ob.x = o[hh * 8 + 4] * rstd * gb.x + bb.x; ob.y = o[hh * 8 + 5] * rstd * gb.y + bb.y; ob.z = o[hh * 8 + 6] * rstd * gb.z + bb.z; ob.w = o[hh * 8 + 7] * rstd * gb.w + bb.w;
      *(float4*)(p.out + t * DM + c0i) = oa; *(float4*)(p.out + t * DM + c0i + 4) = ob;
    }
  }
}
__global__ __launch_bounds__(512) void k_gather(P p) { phase_gather(p, blockIdx.x); }

__global__ __launch_bounds__(512) void k_pq(P p) { phase_pq(p, blockIdx.x); }
__global__ __launch_bounds__(512) void k_route(P p) { phase_route(p, blockIdx.x); }

__global__ __launch_bounds__(512) void k_kv(P p) { phase_kv(p, blockIdx.x); }
__global__ __launch_bounds__(512) void k_qproj(P p) { phase_qproj(p, blockIdx.x); }
__global__ __launch_bounds__(512) void k_attn(P p) { phase_attn(p, blockIdx.x); }
__global__ __launch_bounds__(512) void k_oproj(P p) { phase_oproj(p, blockIdx.x); }

__global__ __launch_bounds__(512) void k_inproj(P p) { phase_inproj(p, blockIdx.x); }
__global__ __launch_bounds__(512) void k_mixer(P p) { phase_mixer(p, blockIdx.x); }
__global__ __launch_bounds__(512) void k_outproj(P p) { phase_outproj(p, blockIdx.x); }

template <int TB>
__global__ __launch_bounds__(256) void sgemm_k(const float* __restrict__ A, int lda, long sA, const float* __restrict__ B, int ldb, long sB,
                                              float* __restrict__ C, int ldc, long sC, int K, const float* __restrict__ bias, int nb2, long sA2, long sB2, long sC2) {
  __shared__ float As[16][68];
  __shared__ float Bs[16][68];
  const int z = blockIdx.z, z1 = z / nb2, z2 = z % nb2;
  A += z1 * sA + z2 * sA2; B += z1 * sB + z2 * sB2; C += z1 * sC + z2 * sC2;
  const int tid = threadIdx.x, tx = tid & 15, ty = tid >> 4;
  const int m0 = blockIdx.y * 64, n0 = blockIdx.x * 64;
  float acc[4][4];
#pragma unroll
  for (int i = 0; i < 4; ++i)
#pragma unroll
    for (int j = 0; j < 4; ++j) acc[i][j] = 0.f;
  for (int k0 = 0; k0 < K; k0 += 16) {
    {
      const int r = tid >> 2, kk = (tid & 3) * 4;
      const float4 v = *(const float4*)(A + (long)(m0 + r) * lda + k0 + kk);
      As[kk + 0][r] = v.x; As[kk + 1][r] = v.y; As[kk + 2][r] = v.z; As[kk + 3][r] = v.w;
    }
    if (TB == 0) {
      const int kk = tid >> 4, n = (tid & 15) * 4;
      const float4 v = *(const float4*)(B + (long)(k0 + kk) * ldb + n0 + n);
      Bs[kk][n + 0] = v.x; Bs[kk][n + 1] = v.y; Bs[kk][n + 2] = v.z; Bs[kk][n + 3] = v.w;
    } else {
      const int r = tid >> 2, kk = (tid & 3) * 4;
      const float4 v = *(const float4*)(B + (long)(n0 + r) * ldb + k0 + kk);
      Bs[kk + 0][r] = v.x; Bs[kk + 1][r] = v.y; Bs[kk + 2][r] = v.z; Bs[kk + 3][r] = v.w;
    }
    __syncthreads();
#pragma unroll
    for (int k = 0; k < 16; ++k) {
      float a[4], b[4];
#pragma unroll
      for (int i = 0; i < 4; ++i) a[i] = As[k][ty * 4 + i];
#pragma unroll
      for (int j = 0; j < 4; ++j) b[j] = Bs[k][tx * 4 + j];
#pragma unroll
      for (int i = 0; i < 4; ++i)
#pragma unroll
        for (int j = 0; j < 4; ++j) acc[i][j] += a[i] * b[j];
    }
    __syncthreads();
  }
#pragma unroll
  for (int i = 0; i < 4; ++i) {
    float4 o;
    const int n = n0 + tx * 4;
    o.x = acc[i][0]; o.y = acc[i][1]; o.z = acc[i][2]; o.w = acc[i][3];
    if (bias) { o.x += bias[n]; o.y += bias[n + 1]; o.z += bias[n + 2]; o.w += bias[n + 3]; }
    *(float4*)(C + (long)(m0 + ty * 4 + i) * ldc + n) = o;
  }
}

__global__ __launch_bounds__(256) void mixer_a_k(const float* __restrict__ Z, const float* __restrict__ sgu_g, const float* __restrict__ sgu_b,
                                                 const float* __restrict__ w_sp, const float* __restrict__ b_sp, float* __restrict__ Y) {
  __shared__ float vln[128][128];
  const int chunk = blockIdx.x, h = blockIdx.y, tid = threadIdx.x, lane = tid & 63, wid = tid >> 6;
  const long t0 = (long)chunk * 128;
  for (int s = wid; s < 128; s += 4) {
    const float* zr = Z + (t0 + s) * INW + 512 + h * 128;
    float a = gelu_f(zr[lane]), b = gelu_f(zr[lane + 64]);
    float sum = a + b;
#pragma unroll
    for (int o = 32; o > 0; o >>= 1) sum += __shfl_xor(sum, o);
    const float mu = sum * (1.f / 128.f);
    const float da = a - mu, db = b - mu;
    float q = da * da + db * db;
#pragma unroll
    for (int o = 32; o > 0; o >>= 1) q += __shfl_xor(q, o);
    const float rstd = rsqrtf(q * (1.f / 128.f) + LN_EPS);
    vln[s][lane] = da * rstd * sgu_g[h * 128 + lane] + sgu_b[h * 128 + lane];
    vln[s][lane + 64] = db * rstd * sgu_g[h * 128 + lane + 64] + sgu_b[h * 128 + lane + 64];
  }
  __syncthreads();
  const int d = tid & 127, tg = tid >> 7;
  for (int t = tg; t < 128; t += 2) {
    const float* wr = w_sp + ((long)h * 128 + t) * 128;
    float acc = 0.f;
    for (int s = 0; s <= t; ++s) acc += wr[s] * vln[s][d];
    acc += b_sp[h * 128 + t];
    const float u = gelu_f(Z[(t0 + t) * INW + h * 128 + d]);
    Y[(t0 + t) * DM + h * 128 + d] = u * acc;
  }
}

__global__ __launch_bounds__(256) void mixer_b_k(const float* __restrict__ Z, const float* __restrict__ conv_w, float* __restrict__ Y) {
  const long idx = (long)blockIdx.x * 256 + threadIdx.x;
  const int c = (int)(idx & 511);
  const long t = idx >> 9;
  const int s = (int)(t % SEQ);
  float conv = 0.f;
#pragma unroll
  for (int k = 0; k < 3; ++k) {
    const int ss = s - 2 + k;
    if (ss >= 0) {
      const float* zr = Z + (t - 2 + k) * INW;
      conv += conv_w[k * 512 + c] * (zr[2048 + c] * zr[1024 + c]);
    }
  }
  Y[t * DM + 512 + c] = Z[t * INW + 1536 + c] * conv;
}

__global__ __launch_bounds__(256) void ln_res_k(const float* __restrict__ Xin, const float* __restrict__ H, const float* __restrict__ g,
                                                const float* __restrict__ b, float* __restrict__ Out) {
  const int lane = threadIdx.x & 63, wid = threadIdx.x >> 6;
  const long row = (long)blockIdx.x * 4 + wid;
  const float* xr = Xin + row * DM;
  const float* hr = H + row * DM;
  float v[16];
  float sum = 0.f;
#pragma unroll
  for (int i = 0; i < 4; ++i) {
    const float4 a = *(const float4*)(xr + i * 256 + lane * 4);
    const float4 c = *(const float4*)(hr + i * 256 + lane * 4);
    v[i * 4 + 0] = ALPHA * a.x + c.x; v[i * 4 + 1] = ALPHA * a.y + c.y; v[i * 4 + 2] = ALPHA * a.z + c.z; v[i * 4 + 3] = ALPHA * a.w + c.w;
    sum += v[i * 4 + 0] + v[i * 4 + 1] + v[i * 4 + 2] + v[i * 4 + 3];
  }
#pragma unroll
  for (int o = 32; o > 0; o >>= 1) sum += __shfl_xor(sum, o);
  const float mu = sum * (1.f / DM);
  float q = 0.f;
#pragma unroll
  for (int i = 0; i < 16; ++i) { const float dlt = v[i] - mu; q += dlt * dlt; }
#pragma unroll
  for (int o = 32; o > 0; o >>= 1) q += __shfl_xor(q, o);
  const float rstd = rsqrtf(q * (1.f / DM) + LN_EPS);
#pragma unroll
  for (int i = 0; i < 4; ++i) {
    const int c0 = i * 256 + lane * 4;
    const float4 gg = *(const float4*)(g + c0);
    const float4 bb = *(const float4*)(b + c0);
    float4 o;
    o.x = (v[i * 4 + 0] - mu) * rstd * gg.x + bb.x; o.y = (v[i * 4 + 1] - mu) * rstd * gg.y + bb.y;
    o.z = (v[i * 4 + 2] - mu) * rstd * gg.z + bb.z; o.w = (v[i * 4 + 3] - mu) * rstd * gg.w + bb.w;
    *(float4*)(Out + row * DM + c0) = o;
  }
}

__global__ __launch_bounds__(256) void softmax256_k(float* __restrict__ S, float scale) {
  const int lane = threadIdx.x & 63, wid = threadIdx.x >> 6;
  const long row = (long)blockIdx.x * 4 + wid;
  float4 v = *(float4*)(S + row * 256 + lane * 4);
  v.x *= scale; v.y *= scale; v.z *= scale; v.w *= scale;
  float m = fmaxf(fmaxf(v.x, v.y), fmaxf(v.z, v.w));
#pragma unroll
  for (int o = 32; o > 0; o >>= 1) m = fmaxf(m, __shfl_xor(m, o));
  v.x = expf(v.x - m); v.y = expf(v.y - m); v.z = expf(v.z - m); v.w = expf(v.w - m);
  float s = v.x + v.y + v.z + v.w;
#pragma unroll
  for (int o = 32; o > 0; o >>= 1) s += __shfl_xor(s, o);
  const float inv = 1.f / s;
  v.x *= inv; v.y *= inv; v.z *= inv; v.w *= inv;
  *(float4*)(S + row * 256 + lane * 4) = v;
}

__global__ __launch_bounds__(128) void peer_route_k(const float* __restrict__ PQ, const float* __restrict__ sub_keys, int* __restrict__ experts, float* __restrict__ gates) {
  __shared__ float pqs[2][2048];
  __shared__ float scs[2 * 16][129];
  __shared__ float vtop[2 * 16][16];
  __shared__ int itop[2 * 16][16];
  const int tid = threadIdx.x;
  const long t0 = (long)blockIdx.x * 2;
  for (int i = tid; i < 2 * 2048; i += 128) pqs[i >> 11][i & 2047] = PQ[t0 * 2048 + i];
  __syncthreads();
  for (int hp = 0; hp < 16; ++hp) {
    const float* kr = sub_keys + ((long)hp * 128 + tid) * 128;
    float a0 = 0.f, a1 = 0.f;
    for (int k = 0; k < 128; k += 4) {
      const float4 kv = *(const float4*)(kr + k);
      const float* q0 = &pqs[0][hp * 128 + k];
      const float* q1 = &pqs[1][hp * 128 + k];
      a0 += q0[0] * kv.x; a0 += q0[1] * kv.y; a0 += q0[2] * kv.z; a0 += q0[3] * kv.w;
      a1 += q1[0] * kv.x; a1 += q1[1] * kv.y; a1 += q1[2] * kv.z; a1 += q1[3] * kv.w;
    }
    scs[0 * 16 + hp][tid] = a0; scs[1 * 16 + hp][tid] = a1;
  }
  __syncthreads();
  if (tid < 32) {
    const float* row = scs[tid];
    float pv = 3.0e38f; int pi = -1;
    for (int r = 0; r < 16; ++r) {
      float bv = -3.0e38f; int bi = 1 << 30;
      for (int n = 0; n < 128; ++n) {
        const float v = row[n];
        const bool after = (v < pv) || (v == pv && n > pi);
        const bool better = (v > bv) || (v == bv && n < bi);
        if (after && better) { bv = v; bi = n; }
      }
      vtop[tid][r] = bv; itop[tid][r] = bi; pv = bv; pi = bi;
    }
  }
  __syncthreads();
  if (tid < 16) {
    const int tk = tid >> 3, h = tid & 7;
    const float* va = vtop[tk * 16 + h * 2 + 0];
    const float* vb = vtop[tk * 16 + h * 2 + 1];
    const int* ia = itop[tk * 16 + h * 2 + 0];
    const int* ib = itop[tk * 16 + h * 2 + 1];
    float pv = 3.0e38f; int pi = -1;
    float topv0 = 0.f, ssum = 0.f;
    int* eo = experts + (t0 + tk) * 128 + h * 16;
    float* go = gates + (t0 + tk) * 128 + h * 16;
    for (int r = 0; r < 16; ++r) {
      float bv = -3.0e38f; int bi = 1 << 30;
      for (int c = 0; c < 256; ++c) {
        const float v = va[c >> 4] + vb[c & 15];
        const bool after = (v < pv) || (v == pv && c > pi);
        const bool better = (v > bv) || (v == bv && c < bi);
        if (after && better) { bv = v; bi = c; }
      }
      pv = bv; pi = bi;
      if (r == 0) topv0 = bv;
      const float e = expf(bv - topv0);
      ssum += e;
      eo[r] = ia[bi >> 4] * 128 + ib[bi & 15];
      go[r] = e;
    }
    const float inv = 1.f / ssum;
    for (int r = 0; r < 16; ++r) go[r] *= inv;
  }
}

__global__ __launch_bounds__(256) void peer_apply_k(const bf16_t* __restrict__ X2, const int* __restrict__ experts, const float* __restrict__ gates,
                                                    const float* __restrict__ w_down, const float* __restrict__ w_up, const float* __restrict__ g,
                                                    const float* __restrict__ b, float* __restrict__ Out) {
  __shared__ float xs[1024];
  __shared__ float coef[128];
  __shared__ int es[128];
  __shared__ float red[8];
  const int tid = threadIdx.x, lane = tid & 63, wid = tid >> 6;
  const long t = blockIdx.x;
  { const u32x2 xv = *(const u32x2*)(X2 + t * DM + tid * 4); float4 xf; xf.x = bf_lo(xv.x); xf.y = bf_hi(xv.x); xf.z = bf_lo(xv.y); xf.w = bf_hi(xv.y); *(float4*)(xs + tid * 4) = xf; }
  if (tid < 128) es[tid] = experts[t * 128 + tid];
  __syncthreads();
  for (int k = wid; k < 128; k += 4) {
    const float* wr = w_down + (long)es[k] * DM;
    float acc = 0.f;
#pragma unroll
    for (int i = 0; i < 4; ++i) {
      const float4 w = *(const float4*)(wr + i * 256 + lane * 4);
      const float4 x = *(const float4*)(xs + i * 256 + lane * 4);
      acc += w.x * x.x + w.y * x.y + w.z * x.z + w.w * x.w;
    }
#pragma unroll
    for (int o = 32; o > 0; o >>= 1) acc += __shfl_xor(acc, o);
    if (lane == 0) coef[k] = gates[t * 128 + k] * gelu_f(acc);
  }
  __syncthreads();
  float4 acc = {0.f, 0.f, 0.f, 0.f};
  for (int k = 0; k < 128; ++k) {
    const float c = coef[k];
    const float4 w = *(const float4*)(w_up + (long)es[k] * DM + tid * 4);
    acc.x += c * w.x; acc.y += c * w.y; acc.z += c * w.z; acc.w += c * w.w;
  }
  const float4 xv = *(const float4*)(xs + tid * 4);
  float v0 = ALPHA * xv.x + acc.x, v1 = ALPHA * xv.y + acc.y, v2 = ALPHA * xv.z + acc.z, v3 = ALPHA * xv.w + acc.w;
  float sum = v0 + v1 + v2 + v3;
#pragma unroll
  for (int o = 32; o > 0; o >>= 1) sum += __shfl_xor(sum, o);
  if (lane == 0) red[wid] = sum;
  __syncthreads();
  const float mu = (red[0] + red[1] + red[2] + red[3]) * (1.f / DM);
  const float d0 = v0 - mu, d1 = v1 - mu, d2 = v2 - mu, d3 = v3 - mu;
  float q = d0 * d0 + d1 * d1 + d2 * d2 + d3 * d3;
#pragma unroll
  for (int o = 32; o > 0; o >>= 1) q += __shfl_xor(q, o);
  if (lane == 0) red[4 + wid] = q;
  __syncthreads();
  const float rstd = rsqrtf((red[4] + red[5] + red[6] + red[7]) * (1.f / DM) + LN_EPS);
  const float4 gg = *(const float4*)(g + tid * 4);
  const float4 bb = *(const float4*)(b + tid * 4);
  float4 o;
  o.x = d0 * rstd * gg.x + bb.x; o.y = d1 * rstd * gg.y + bb.y; o.z = d2 * rstd * gg.z + bb.z; o.w = d3 * rstd * gg.w + bb.w;
  *(float4*)(Out + t * DM + tid * 4) = o;
}

static void sgemm(hipStream_t st, int tb, const float* A, int lda, long sA, const float* B, int ldb, long sB, float* C, int ldc, long sC, int M, int N, int K,
                  const float* bias, int nb1, int nb2, long sA2, long sB2, long sC2) {
  dim3 grid(N / 64, M / 64, nb1 * nb2);
  if (tb) sgemm_k<1><<<grid, 256, 0, st>>>(A, lda, sA, B, ldb, sB, C, ldc, sC, K, bias, nb2, sA2, sB2, sC2);
  else    sgemm_k<0><<<grid, 256, 0, st>>>(A, lda, sA, B, ldb, sB, C, ldc, sC, K, bias, nb2, sA2, sB2, sC2);
}

extern "C" void kernel_launch(void* const* d_in, const int* in_sizes, int n_in, void* d_out, int out_size, void* d_ws, size_t ws_size, hipStream_t stream) {
  const float* x = (const float*)d_in[0];
  const float* mem = (const float*)d_in[1];
  const float* w_in = (const float*)d_in[2];
  const float* b_in = (const float*)d_in[3];
  const float* sgu_g = (const float*)d_in[4];
  const float* sgu_b = (const float*)d_in[5];
  const float* w_sp = (const float*)d_in[6];
  const float* b_sp = (const float*)d_in[7];
  const float* conv_w = (const float*)d_in[8];
  const float* w_mo = (const float*)d_in[9];
  const float* ln1_g = (const float*)d_in[10];
  const float* ln1_b = (const float*)d_in[11];
  const float* w_xq = (const float*)d_in[12];
  const float* w_xkv = (const float*)d_in[13];
  const float* w_xo = (const float*)d_in[14];
  const float* ln2_g = (const float*)d_in[15];
  const float* ln2_b = (const float*)d_in[16];
  const float* w_pq = (const float*)d_in[17];
  const float* sub_keys = (const float*)d_in[18];
  const float* w_down = (const float*)d_in[19];
  const float* w_up = (const float*)d_in[20];
  const float* ln3_g = (const float*)d_in[21];
  const float* ln3_b = (const float*)d_in[22];
  float* out = (float*)d_out;

  const size_t SZ = (size_t)NTOK * DM;
  float* ws = (float*)d_ws;
  float* R0 = ws;
  float* R1 = ws + SZ;
  float* Zb = ws;
  float* R3 = ws + (size_t)NTOK * INW;
  float* KV = R3 + SZ;
  int* experts = (int*)(KV + (size_t)1024 * 2048);
  float* gates = (float*)(experts + (size_t)NTOK * 128);

  char* wsb8 = (char*)d_ws;
  const size_t MiB = (size_t)1 << 20;
  P p{};
  p.x = x; p.mem = mem; p.b_in = b_in; p.sgu_g = sgu_g; p.sgu_b = sgu_b; p.b_sp = b_sp; p.conv_w = conv_w;
  p.ln1_g = ln1_g; p.ln1_b = ln1_b; p.ln2_g = ln2_g; p.ln2_b = ln2_b; p.ln3_g = ln3_g; p.ln3_b = ln3_b;
  bf16_t* XB = (bf16_t*)(wsb8 + 0 * MiB);
  bf16_t* ZB = (bf16_t*)(wsb8 + 64 * MiB);
  bf16_t* VT = (bf16_t*)(wsb8 + 224 * MiB);
  bf16_t* Yb = (bf16_t*)(wsb8 + 256 * MiB);
  float* PRE = (float*)(wsb8 + 320 * MiB);
  bf16_t* X1b = (bf16_t*)(wsb8 + 0 * MiB);
  bf16_t* WB = (bf16_t*)(wsb8 + 488 * MiB);
  bf16_t* w_inT = WB; bf16_t* w_moT = w_inT + (size_t)INW * DM; bf16_t* wspb = w_moT + (size_t)DM * DM;
  p.XB = XB; p.w_inT = w_inT; p.w_moT = w_moT; p.wsb = wspb; p.ZB = ZB; p.VT = VT; p.Y = Yb; p.PRE = PRE; p.X1 = X1b;
  static bool attr_done = false;
  if (!attr_done) {
    (void)hipFuncSetAttribute((const void*)k_inproj, hipFuncAttributeMaxDynamicSharedMemorySize, GEMM_LDS_BYTES);
    (void)hipFuncSetAttribute((const void*)k_mixer, hipFuncAttributeMaxDynamicSharedMemorySize, GEMM_LDS_BYTES);
    (void)hipFuncSetAttribute((const void*)k_outproj, hipFuncAttributeMaxDynamicSharedMemorySize, GEMM_LDS_BYTES);
    attr_done = true;
  }
  cvt_bf16_k<<<2048, 256, 0, stream>>>(x, XB, (long)NTOK * DM / 8);
  cvt_transpose_k<<<dim3(INW / 64, DM / 64), 256, 0, stream>>>(w_in, w_inT, DM, INW);
  cvt_transpose_k<<<dim3(DM / 64, DM / 64), 256, 0, stream>>>(w_mo, w_moT, DM, DM);
  cvt_wsp_k<<<256, 256, 0, stream>>>(w_sp, wspb);
  k_inproj<<<NTOK / 128, 512, GEMM_LDS_BYTES, stream>>>(p);
  k_mixer<<<NTOK / 128, 512, GEMM_LDS_BYTES, stream>>>(p);
  k_outproj<<<NTOK / 128, 512, GEMM_LDS_BYTES, stream>>>(p);
  bf16_t* Qb = (bf16_t*)(wsb8 + 64 * MiB); bf16_t* Pbuf = (bf16_t*)(wsb8 + 128 * MiB); bf16_t* Ob = (bf16_t*)(wsb8 + 192 * MiB); bf16_t* X2b = (bf16_t*)(wsb8 + 256 * MiB);
  bf16_t* w_xqT = wspb + 4 * 128 * 128; bf16_t* w_xkvT = w_xqT + (size_t)DM * DM; bf16_t* w_xoT = w_xkvT + (size_t)2048 * DM;
  bf16_t* memB = w_xoT + (size_t)DM * DM; bf16_t* Kc = memB + (size_t)1024 * DM; bf16_t* VTc = Kc + (size_t)1024 * DM;
  p.w_xqT = w_xqT; p.w_xkvT = w_xkvT; p.w_xoT = w_xoT; p.memB = memB; p.Kc = Kc; p.VTc = VTc; p.Q = Qb; p.Pb = Pbuf; p.O = Ob; p.X2 = X2b;
  static bool attr2_done = false;
  if (!attr2_done) {
    (void)hipFuncSetAttribute((const void*)k_kv, hipFuncAttributeMaxDynamicSharedMemorySize, LDS_BYTES);
    (void)hipFuncSetAttribute((const void*)k_qproj, hipFuncAttributeMaxDynamicSharedMemorySize, LDS_BYTES);
    (void)hipFuncSetAttribute((const void*)k_attn, hipFuncAttributeMaxDynamicSharedMemorySize, LDS_BYTES);
    (void)hipFuncSetAttribute((const void*)k_oproj, hipFuncAttributeMaxDynamicSharedMemorySize, LDS_BYTES);
    attr2_done = true;
  }
  cvt_bf16_k<<<512, 256, 0, stream>>>(mem, memB, (long)1024 * DM / 8);
  cvt_transpose_k<<<dim3(DM / 64, DM / 64), 256, 0, stream>>>(w_xq, w_xqT, DM, DM);
  cvt_transpose_k<<<dim3(2048 / 64, DM / 64), 256, 0, stream>>>(w_xkv, w_xkvT, DM, 2048);
  cvt_transpose_k<<<dim3(DM / 64, DM / 64), 256, 0, stream>>>(w_xo, w_xoT, DM, DM);
  k_kv<<<64, 512, LDS_BYTES, stream>>>(p);
  k_qproj<<<NTOK / 128, 512, LDS_BYTES, stream>>>(p);
  k_attn<<<NTOK / 128, 512, LDS_BYTES, stream>>>(p);
  k_oproj<<<NTOK / 128, 512, LDS_BYTES, stream>>>(p);
  float* X2 = R3;
  cvt_f32_k<<<2048, 256, 0, stream>>>(X2b, X2, (long)NTOK * DM / 8);
  bf16_t* PQb = (bf16_t*)(wsb8 + 64 * MiB);
  bf16_t* w_pqT = (bf16_t*)(wsb8 + 448 * MiB); bf16_t* skb = (bf16_t*)(wsb8 + 452 * MiB);
  p.w_pqT = w_pqT; p.skb = skb; p.PQ = PQb; p.experts = experts; p.gates = gates;
  static bool attr3_done = false;
  if (!attr3_done) {
    (void)hipFuncSetAttribute((const void*)k_pq, hipFuncAttributeMaxDynamicSharedMemorySize, LDS_BYTES);
    (void)hipFuncSetAttribute((const void*)k_route, hipFuncAttributeMaxDynamicSharedMemorySize, LDS_BYTES);
    attr3_done = true;
  }
  cvt_bf16_k<<<128, 256, 0, stream>>>(sub_keys, skb, (long)8 * 2 * 128 * 128 / 8);
  cvt_transpose_k<<<dim3(2048 / 64, DM / 64), 256, 0, stream>>>(w_pq, w_pqT, DM, 2048);
  PQb = (bf16_t*)(wsb8 + 320 * MiB); p.PQ = PQb;
  k_pq<<<NTOK / 128, 512, LDS_BYTES, stream>>>(p);
  k_route<<<NTOK / 128, 512, LDS_BYTES, stream>>>(p);
  bf16_t* WDb = (bf16_t*)(wsb8 + 0 * MiB); bf16_t* WUb = (bf16_t*)(wsb8 + 32 * MiB);
  p.WD = WDb; p.WU = WUb; p.out = out;
  cvt_bf16_k<<<2048, 256, 0, stream>>>(w_down, WDb, (long)16384 * DM / 8);
  cvt_bf16_k<<<2048, 256, 0, stream>>>(w_up, WUb, (long)16384 * DM / 8);
  k_gather<<<NTOK / 128, 512, 0, stream>>>(p);
}
```

```cpp
#include <hip/hip_runtime.h>
#include <stdint.h>
#include <cstdio>

#define DM 1024
#define NTOK 32768
#define SEQ 8192
#define INW 2560
#define ALPHA 1.189207115002721f
#define LN_EPS 1e-5f

__device__ __forceinline__ float gelu_f(float v) {
  const float t = __builtin_amdgcn_rcpf(fabsf(v) * 0.2316418882f + 1.0f);
  float q = t * 0.5307027145f + (-0.7265760135f); q = q * t + 0.7107068705f; q = q * t + (-0.142248368f); q = q * t + 0.127414796f; q = q * t;
  const float e = __builtin_amdgcn_exp2f((v * v) * (-0.72134752044f));
  const float m = v * (q * e);
  return v < 0.f ? m : v - m;
}

typedef unsigned short bf16_t;
typedef short bf16x8 __attribute__((ext_vector_type(8)));
typedef float f32x4 __attribute__((ext_vector_type(4)));
typedef unsigned u32x4 __attribute__((ext_vector_type(4)));
typedef unsigned u32x2 __attribute__((ext_vector_type(2)));
#define LAS __attribute__((address_space(3)))
extern __shared__ __attribute__((aligned(16))) char smem_raw[];

typedef float f32x2_t __attribute__((ext_vector_type(2)));
typedef __bf16 bf16x2_t __attribute__((ext_vector_type(2)));
__device__ __forceinline__ unsigned pk_bf16(float lo, float hi) { const f32x2_t v = {lo, hi}; return __builtin_bit_cast(unsigned, __builtin_convertvector(v, bf16x2_t)); }
__device__ __forceinline__ int otid() { int t = threadIdx.x; asm volatile("" : "+v"(t)); return t; }
__device__ __forceinline__ unsigned pack4_i8(float a, float b, float c, float d) {
  const int ia = __float2int_rn(a), ib = __float2int_rn(b), ic = __float2int_rn(c), id = __float2int_rn(d);
  return ((unsigned)ia & 0xffu) | (((unsigned)ib & 0xffu) << 8) | (((unsigned)ic & 0xffu) << 16) | ((unsigned)id << 24);
}
__device__ __forceinline__ float bf_lo(unsigned u) { return __uint_as_float(u << 16); }
__device__ __forceinline__ float bf_hi(unsigned u) { return __uint_as_float(u & 0xffff0000u); }

template <int BN, class Epi>
__device__ __forceinline__ void wg_gemm(const bf16_t* __restrict__ A, int lda, const bf16_t* __restrict__ Bt, int ldb, int K, Epi&& epi) {
  constexpr int NT = BN / 64;
  constexpr int STAGE_BYTES = (128 + BN) * 128;
  constexpr int LA = 2, LB = BN / 64;
  LAS char* lds = (LAS char*)smem_raw;
  const int tid = otid(), lane = tid & 63, wid = tid >> 6, wr = wid >> 2, wc = wid & 3, fr = lane & 15, fq = lane >> 4;
  f32x4 acc[4][NT];
#pragma unroll
  for (int m = 0; m < 4; ++m)
#pragma unroll
    for (int n = 0; n < NT; ++n) acc[m][n] = (f32x4){0.f, 0.f, 0.f, 0.f};
  const int nk = K / 64;
  auto stage = [&](int buf, int kt) {
    LAS char* base = lds + buf * STAGE_BYTES;
#pragma unroll
    for (int i = 0; i < LA; ++i) {
      const int q = tid + i * 512, row = q >> 3, c = (q & 7) ^ (row & 7);
      __builtin_amdgcn_global_load_lds((const unsigned*)(A + (long)row * lda + kt * 64 + c * 8), (LAS unsigned*)(base + q * 16), 16, 0, 2);
    }
#pragma unroll
    for (int i = 0; i < LB; ++i) {
      const int q = tid + i * 512, row = q >> 3, c = (q & 7) ^ (row & 7);
      __builtin_amdgcn_global_load_lds((const unsigned*)(Bt + (long)row * ldb + kt * 64 + c * 8), (LAS unsigned*)(base + 16384 + q * 16), 16, 0, 0);
    }
  };
  asm volatile("s_waitcnt vmcnt(0)" ::: "memory");
  __builtin_amdgcn_s_barrier();
  asm volatile("" ::: "memory");
  stage(0, 0);
  if (nk > 1) stage(1, 1);
  for (int kt = 0; kt < nk; ++kt) {
    if (kt + 1 < nk) asm volatile("s_waitcnt vmcnt(%0)" ::"n"(LA + LB) : "memory");
    else asm volatile("s_waitcnt vmcnt(0)" ::: "memory");
    __builtin_amdgcn_s_barrier();
    asm volatile("" ::: "memory");
    if (kt + 2 < nk) stage((kt + 2) % 3, kt + 2);
    LAS const char* base = lds + (kt % 3) * STAGE_BYTES;
    bf16x8 af[4][2], bfr[NT][2];
#pragma unroll
    for (int m = 0; m < 4; ++m)
#pragma unroll
      for (int kk = 0; kk < 2; ++kk) {
        const int row = wr * 64 + m * 16 + fr, c = (kk * 4 + fq) ^ (fr & 7);
        af[m][kk] = *(LAS const bf16x8*)(base + row * 128 + c * 16);
      }
#pragma unroll
    for (int n = 0; n < NT; ++n)
#pragma unroll
      for (int kk = 0; kk < 2; ++kk) {
        const int row = wc * (BN / 4) + n * 16 + fr, c = (kk * 4 + fq) ^ (fr & 7);
        bfr[n][kk] = *(LAS const bf16x8*)(base + 16384 + row * 128 + c * 16);
      }
#pragma unroll
    for (int kk = 0; kk < 2; ++kk)
#pragma unroll
      for (int m = 0; m < 4; ++m)
#pragma unroll
        for (int n = 0; n < NT; ++n) acc[m][n] = __builtin_amdgcn_mfma_f32_16x16x32_bf16(bfr[n][kk], af[m][kk], acc[m][n], 0, 0, 0);
  }
  epi(acc, wr, wc, fr, fq);
}

typedef int v4i_t __attribute__((ext_vector_type(4)));
template <int BN, class Epi>
__device__ __forceinline__ void wg_gemm_i8(const signed char* __restrict__ A, int lda, const signed char* __restrict__ Bt, int ldb, int K, Epi&& epi) {
  constexpr int NT = BN / 64;
  constexpr int STAGE_BYTES = (128 + BN) * 128;
  constexpr int LA = 2, LB = BN / 64;
  LAS char* lds = (LAS char*)smem_raw;
  const int tid = otid(), lane = tid & 63, wid = tid >> 6, wr = wid >> 2, wc = wid & 3, fr = lane & 15, fq = lane >> 4;
  v4i_t acc[4][NT];
#pragma unroll
  for (int m = 0; m < 4; ++m)
#pragma unroll
    for (int n = 0; n < NT; ++n) acc[m][n] = (v4i_t){0, 0, 0, 0};
  const int nk = K / 128;
  auto stage = [&](int buf, int kt) {
    LAS char* base = lds + buf * STAGE_BYTES;
#pragma unroll
    for (int i = 0; i < LA; ++i) {
      const int q = tid + i * 512, row = q >> 3, c = (q & 7) ^ (row & 7);
      __builtin_amdgcn_global_load_lds((const unsigned*)(A + (long)row * lda + kt * 128 + c * 16), (LAS unsigned*)(base + q * 16), 16, 0, 2);
    }
#pragma unroll
    for (int i = 0; i < LB; ++i) {
      const int q = tid + i * 512, row = q >> 3, c = (q & 7) ^ (row & 7);
      __builtin_amdgcn_global_load_lds((const unsigned*)(Bt + (long)row * ldb + kt * 128 + c * 16), (LAS unsigned*)(base + 16384 + q * 16), 16, 0, 0);
    }
  };
  asm volatile("s_waitcnt vmcnt(0)" ::: "memory");
  __builtin_amdgcn_s_barrier();
  asm volatile("" ::: "memory");
  stage(0, 0);
  if (nk > 1) stage(1, 1);
  for (int kt = 0; kt < nk; ++kt) {
    if (kt + 1 < nk) asm volatile("s_waitcnt vmcnt(%0)" ::"n"(LA + LB) : "memory");
    else asm volatile("s_waitcnt vmcnt(0)" ::: "memory");
    __builtin_amdgcn_s_barrier();
    asm volatile("" ::: "memory");
    if (kt + 2 < nk) stage((kt + 2) % 3, kt + 2);
    LAS const char* base = lds + (kt % 3) * STAGE_BYTES;
    v4i_t af[4][2], bfr[NT][2];
#pragma unroll
    for (int m = 0; m < 4; ++m)
#pragma unroll
      for (int kk = 0; kk < 2; ++kk) {
        const int row = wr * 64 + m * 16 + fr, c = (kk * 4 + fq) ^ (fr & 7);
        af[m][kk] = *(LAS const v4i_t*)(base + row * 128 + c * 16);
      }
#pragma unroll
    for (int n = 0; n < NT; ++n)
#pragma unroll
      for (int kk = 0; kk < 2; ++kk) {
        const int row = wc * (BN / 4) + n * 16 + fr, c = (kk * 4 + fq) ^ (fr & 7);
        bfr[n][kk] = *(LAS const v4i_t*)(base + 16384 + row * 128 + c * 16);
      }
#pragma unroll
    for (int kk = 0; kk < 2; ++kk)
#pragma unroll
      for (int m = 0; m < 4; ++m)
#pragma unroll
        for (int n = 0; n < NT; ++n) acc[m][n] = __builtin_amdgcn_mfma_i32_16x16x64_i8(bfr[n][kk], af[m][kk], acc[m][n], 0, 0, 0);
  }
  epi(acc, wr, wc, fr, fq);
}

#define GEMM_LDS_BYTES (3 * (128 + 256) * 128)
#define RED_OFF GEMM_LDS_BYTES
#define XB_LDS_OFF (GEMM_LDS_BYTES + 4096)
#define LDS_BYTES (GEMM_LDS_BYTES + 4096 + 16)

struct P {
  const float* x; const float* mem; const float* b_in; const float* sgu_g; const float* sgu_b; const float* b_sp; const float* conv_w;
  const float* ln1_g; const float* ln1_b; const float* ln2_g; const float* ln2_b; const float* ln3_g; const float* ln3_b;
  const bf16_t* XB; const bf16_t* w_inT; const bf16_t* w_moT; const bf16_t* wsb;
  bf16_t* ZB; bf16_t* VT; bf16_t* Y; float* PRE; bf16_t* X1;
  const bf16_t* w_xqT; const bf16_t* w_xkvT; const bf16_t* w_xoT; const bf16_t* memB;
  bf16_t* Kc; bf16_t* VTc; bf16_t* Q; bf16_t* Pb; bf16_t* O; bf16_t* X2;
  const bf16_t* w_pqT; const bf16_t* skb; bf16_t* PQ; int* experts; float* gates;
  const unsigned char* WDq; const unsigned char* WUq; const float* sd; const float* su; float* out;
  signed char* w_inQ; float* sw_in; signed char* w_xqQ; float* sw_xq; float* SX1;
  char* slabs;
  unsigned* bar; unsigned char* XQ; float* SX; int* PD; float* H3;
  bf16_t* HALO;
  const float* w_in; const float* w_mo; const float* w_sp; const float* w_xq; const float* w_xkv; const float* w_xo; const float* w_pq; const float* sub_keys; const float* w_down; const float* w_up;
};

#define SLAB_BYTES (1792 * 1024)
#define OFF_XB 0
#define OFF_EXP 0
#define OFF_GATE (64 * 1024)
#define OFF_CQ (128 * 1024)
#define OFF_SC (144 * 1024)
#define OFF_ZB (256 * 1024)
#define OFF_VT (896 * 1024)
#define OFF_Y (1024 * 1024)
#define OFF_Q (1280 * 1024)
#define OFF_O (1536 * 1024)
__device__ __forceinline__ void wg_sync_mem() { asm volatile("s_waitcnt vmcnt(0) lgkmcnt(0)" ::: "memory"); __syncthreads(); }

#define OFF_SXB (128 * 1024)
__device__ __forceinline__ void phase_inproj(const P& p, int tile) {
  const signed char* xq = (const signed char*)(p.slabs + (size_t)tile * SLAB_BYTES + OFF_XB);
  const float* sxr = (const float*)(p.slabs + (size_t)tile * SLAB_BYTES + OFF_SXB);
  for (int nt = 0; nt < INW / 256; ++nt) {
    wg_gemm_i8<256>(xq, DM, p.w_inQ + (long)nt * 256 * DM, DM, DM, [&](v4i_t (&acc)[4][4], int wr, int wc, int fr, int fq) {
#pragma unroll
      for (int m = 0; m < 4; ++m) {
        const int rl = wr * 64 + m * 16 + fr;
        const float sr = sxr[rl];
#pragma unroll
        for (int n = 0; n < 4; ++n) {
          const int row = tile * 128 + rl, col = nt * 256 + wc * 64 + n * 16 + fq * 4;
          const float4 bv = *(const float4*)(p.b_in + col), sw = *(const float4*)(p.sw_in + col);
          float o0 = (float)acc[m][n][0] * (sr * sw.x) + bv.x, o1 = (float)acc[m][n][1] * (sr * sw.y) + bv.y, o2 = (float)acc[m][n][2] * (sr * sw.z) + bv.z, o3 = (float)acc[m][n][3] * (sr * sw.w) + bv.w;
          if (nt < 4) { o0 = gelu_f(o0); o1 = gelu_f(o1); o2 = gelu_f(o2); o3 = gelu_f(o3); }
          u32x2 w; w.x = pk_bf16(o0, o1); w.y = pk_bf16(o2, o3);
          *(u32x2*)(p.ZB + (long)row * INW + col) = w;
        }
      }
    });
  }
}

__device__ __forceinline__ void phase_mixer(const P& p, int tile) {
  const int tid = otid(), lane = tid & 63, wid = tid >> 6;
  const long t0 = (long)tile * 128;
  const bool seq_start = ((tile & 63) == 0);
#pragma unroll 2
  for (int it = tid; it < 128 * 64; it += 512) {
    const int tl = it >> 6, c = (it & 63) * 8;
    const long t = t0 + tl;
    float conv[8];
#pragma unroll
    for (int j = 0; j < 8; ++j) conv[j] = 0.f;
#pragma unroll
    for (int k = 0; k < 3; ++k) {
      const int rl = tl - 2 + k;
      const float4 w0 = *(const float4*)(p.conv_w + k * 512 + c), w1 = *(const float4*)(p.conv_w + k * 512 + c + 4);
      if (rl >= 0) {
        const bf16_t* zr = p.ZB + (t0 + rl) * INW;
        const u32x4 hb = *(const u32x4*)(zr + 1024 + c), gc = *(const u32x4*)(zr + 2048 + c);
        conv[0] += w0.x * (bf_lo(hb.x) * bf_lo(gc.x)); conv[1] += w0.y * (bf_hi(hb.x) * bf_hi(gc.x));
        conv[2] += w0.z * (bf_lo(hb.y) * bf_lo(gc.y)); conv[3] += w0.w * (bf_hi(hb.y) * bf_hi(gc.y));
        conv[4] += w1.x * (bf_lo(hb.z) * bf_lo(gc.z)); conv[5] += w1.y * (bf_hi(hb.z) * bf_hi(gc.z));
        conv[6] += w1.z * (bf_lo(hb.w) * bf_lo(gc.w)); conv[7] += w1.w * (bf_hi(hb.w) * bf_hi(gc.w));
      } else if (!seq_start) {
        const u32x4 zc = *(const u32x4*)(p.HALO + ((long)(tile - 1) * 2 + (rl + 2)) * 512 + c);
        conv[0] += w0.x * bf_lo(zc.x); conv[1] += w0.y * bf_hi(zc.x); conv[2] += w0.z * bf_lo(zc.y); conv[3] += w0.w * bf_hi(zc.y);
        conv[4] += w1.x * bf_lo(zc.z); conv[5] += w1.y * bf_hi(zc.z); conv[6] += w1.z * bf_lo(zc.w); conv[7] += w1.w * bf_hi(zc.w);
      }
    }
    const u32x4 gb = *(const u32x4*)(p.ZB + t * INW + 1536 + c);
    u32x4 o;
    o.x = pk_bf16(bf_lo(gb.x) * conv[0], bf_hi(gb.x) * conv[1]); o.y = pk_bf16(bf_lo(gb.y) * conv[2], bf_hi(gb.y) * conv[3]);
    o.z = pk_bf16(bf_lo(gb.z) * conv[4], bf_hi(gb.z) * conv[5]); o.w = pk_bf16(bf_lo(gb.w) * conv[6], bf_hi(gb.w) * conv[7]);
    *(u32x4*)(p.Y + t * DM + 512 + c) = o;
  }
  for (int h = 0; h < 4; ++h) {
    float a0[16], a1[16];
    const float g0 = p.sgu_g[h * 128 + 2 * lane], g1 = p.sgu_g[h * 128 + 2 * lane + 1], b0 = p.sgu_b[h * 128 + 2 * lane], b1 = p.sgu_b[h * 128 + 2 * lane + 1];
#pragma unroll
    for (int i = 0; i < 16; ++i) {
      const unsigned v = *(const unsigned*)(p.ZB + (t0 + wid * 16 + i) * INW + 512 + h * 128 + 2 * lane);
      const float x0 = bf_lo(v), x1 = bf_hi(v);
      float sum = x0 + x1;
#pragma unroll
      for (int o = 32; o > 0; o >>= 1) sum += __shfl_xor(sum, o);
      const float mu = sum * (1.f / 128.f);
      const float d0 = x0 - mu, d1 = x1 - mu;
      float q = d0 * d0 + d1 * d1;
#pragma unroll
      for (int o = 32; o > 0; o >>= 1) q += __shfl_xor(q, o);
      const float rstd = rsqrtf(q * (1.f / 128.f) + LN_EPS);
      a0[i] = d0 * rstd * g0 + b0; a1[i] = d1 * rstd * g1 + b1;
    }
    bf16_t* vt = p.VT + ((long)tile * 4 + h) * 128 * 128;
    u32x4 o;
    o.x = pk_bf16(a0[0], a0[1]); o.y = pk_bf16(a0[2], a0[3]); o.z = pk_bf16(a0[4], a0[5]); o.w = pk_bf16(a0[6], a0[7]);
    *(u32x4*)(vt + (2 * lane) * 128 + wid * 16) = o;
    o.x = pk_bf16(a0[8], a0[9]); o.y = pk_bf16(a0[10], a0[11]); o.z = pk_bf16(a0[12], a0[13]); o.w = pk_bf16(a0[14], a0[15]);
    *(u32x4*)(vt + (2 * lane) * 128 + wid * 16 + 8) = o;
    o.x = pk_bf16(a1[0], a1[1]); o.y = pk_bf16(a1[2], a1[3]); o.z = pk_bf16(a1[4], a1[5]); o.w = pk_bf16(a1[6], a1[7]);
    *(u32x4*)(vt + (2 * lane + 1) * 128 + wid * 16) = o;
    o.x = pk_bf16(a1[8], a1[9]); o.y = pk_bf16(a1[10], a1[11]); o.z = pk_bf16(a1[12], a1[13]); o.w = pk_bf16(a1[14], a1[15]);
    *(u32x4*)(vt + (2 * lane + 1) * 128 + wid * 16 + 8) = o;
  }
  wg_sync_mem();
  for (int h = 0; h < 4; ++h) {
    wg_gemm<128>(p.wsb + h * 128 * 128, 128, p.VT + ((long)tile * 4 + h) * 128 * 128, 128, 128, [&](f32x4 (&acc)[4][2], int wr, int wc, int fr, int fq) {
#pragma unroll
      for (int m = 0; m < 4; ++m)
#pragma unroll
        for (int n = 0; n < 2; ++n) {
          const int rl = wr * 64 + m * 16 + fr, col = wc * 32 + n * 16 + fq * 4;
          const float bs = p.b_sp[h * 128 + rl];
          const u32x2 uv = *(const u32x2*)(p.ZB + (t0 + rl) * INW + h * 128 + col);
          u32x2 w;
          w.x = pk_bf16(bf_lo(uv.x) * (acc[m][n][0] + bs), bf_hi(uv.x) * (acc[m][n][1] + bs));
          w.y = pk_bf16(bf_lo(uv.y) * (acc[m][n][2] + bs), bf_hi(uv.y) * (acc[m][n][3] + bs));
          *(u32x2*)(p.Y + (t0 + rl) * DM + h * 128 + col) = w;
        }
    });
  }
}

__device__ __forceinline__ void ln_rows16(const float* __restrict__ PRE, long r0, const float* __restrict__ g, const float* __restrict__ b, bf16_t* __restrict__ Out, int lane) {
#pragma unroll 2
  for (int i = 0; i < 16; ++i) {
    const bf16_t* pr = (const bf16_t*)PRE + (r0 + i) * DM;
    float4 v[4];
    float sum = 0.f;
#pragma unroll
    for (int j = 0; j < 4; ++j) { const u32x2 pv = *(const u32x2*)(pr + j * 256 + lane * 4); v[j].x = bf_lo(pv.x); v[j].y = bf_hi(pv.x); v[j].z = bf_lo(pv.y); v[j].w = bf_hi(pv.y); sum += (v[j].x + v[j].y) + (v[j].z + v[j].w); }
#pragma unroll
    for (int o = 32; o > 0; o >>= 1) sum += __shfl_xor(sum, o);
    const float mu = sum * (1.f / DM);
    float q = 0.f;
#pragma unroll
    for (int j = 0; j < 4; ++j) { v[j].x -= mu; v[j].y -= mu; v[j].z -= mu; v[j].w -= mu; q += (v[j].x * v[j].x + v[j].y * v[j].y) + (v[j].z * v[j].z + v[j].w * v[j].w); }
#pragma unroll
    for (int o = 32; o > 0; o >>= 1) q += __shfl_xor(q, o);
    const float rstd = rsqrtf(q * (1.f / DM) + LN_EPS);
#pragma unroll
    for (int j = 0; j < 4; ++j) {
      const int c0 = j * 256 + lane * 4;
      const float4 gg = *(const float4*)(g + c0), bb = *(const float4*)(b + c0);
      u32x2 w; w.x = pk_bf16(v[j].x * rstd * gg.x + bb.x, v[j].y * rstd * gg.y + bb.y); w.y = pk_bf16(v[j].z * rstd * gg.z + bb.z, v[j].w * rstd * gg.w + bb.w);
      *(u32x2*)(Out + (r0 + i) * DM + c0) = w;
    }
  }
}

__device__ __forceinline__ void ln_rows16_q(const float* __restrict__ PRE, long r0, const float* __restrict__ g, const float* __restrict__ b, bf16_t* __restrict__ Out,
                                            unsigned char* __restrict__ XQ, float* __restrict__ SX, int lane) {
#pragma unroll 2
  for (int i = 0; i < 16; ++i) {
    const bf16_t* pr = (const bf16_t*)PRE + (r0 + i) * DM;
    float4 v[4];
    float sum = 0.f;
#pragma unroll
    for (int j = 0; j < 4; ++j) { const u32x2 pv = *(const u32x2*)(pr + j * 256 + lane * 4); v[j].x = bf_lo(pv.x); v[j].y = bf_hi(pv.x); v[j].z = bf_lo(pv.y); v[j].w = bf_hi(pv.y); sum += (v[j].x + v[j].y) + (v[j].z + v[j].w); }
#pragma unroll
    for (int o = 32; o > 0; o >>= 1) sum += __shfl_xor(sum, o);
    const float mu = sum * (1.f / DM);
    float q = 0.f;
#pragma unroll
    for (int j = 0; j < 4; ++j) { v[j].x -= mu; v[j].y -= mu; v[j].z -= mu; v[j].w -= mu; q += (v[j].x * v[j].x + v[j].y * v[j].y) + (v[j].z * v[j].z + v[j].w * v[j].w); }
#pragma unroll
    for (int o = 32; o > 0; o >>= 1) q += __shfl_xor(q, o);
    const float rstd = rsqrtf(q * (1.f / DM) + LN_EPS);
    float amax = 0.f;
#pragma unroll
    for (int j = 0; j < 4; ++j) {
      const int c0 = j * 256 + lane * 4;
      const float4 gg = *(const float4*)(g + c0), bb = *(const float4*)(b + c0);
      v[j].x = v[j].x * rstd * gg.x + bb.x; v[j].y = v[j].y * rstd * gg.y + bb.y; v[j].z = v[j].z * rstd * gg.z + bb.z; v[j].w = v[j].w * rstd * gg.w + bb.w;
      u32x2 w; w.x = pk_bf16(v[j].x, v[j].y); w.y = pk_bf16(v[j].z, v[j].w);
      *(u32x2*)(Out + (r0 + i) * DM + c0) = w;
      amax = fmaxf(amax, fmaxf(fmaxf(fabsf(v[j].x), fabsf(v[j].y)), fmaxf(fabsf(v[j].z), fabsf(v[j].w))));
    }
#pragma unroll
    for (int o = 32; o > 0; o >>= 1) amax = fmaxf(amax, __shfl_xor(amax, o));
    const float inv = amax > 0.f ? 127.f / amax : 0.f;
#pragma unroll
    for (int j = 0; j < 4; ++j) *(unsigned*)(XQ + (r0 + i) * DM + j * 256 + lane * 4) = pack4_i8(v[j].x * inv, v[j].y * inv, v[j].z * inv, v[j].w * inv);
    if (lane == 0) SX[r0 + i] = amax * (1.f / 127.f);
  }
}

__device__ __forceinline__ void phase_outproj(const P& p, int tile) {
  const long t0 = (long)tile * 128;
  for (int nt = 0; nt < 4; ++nt) {
    wg_gemm<256>(p.Y + t0 * DM, DM, p.w_moT + (long)nt * 256 * DM, DM, DM, [&](f32x4 (&acc)[4][4], int wr, int wc, int fr, int fq) {
#pragma unroll
      for (int m = 0; m < 4; ++m)
#pragma unroll
        for (int n = 0; n < 4; ++n) {
          const long row = t0 + wr * 64 + m * 16 + fr; const int col = nt * 256 + wc * 64 + n * 16 + fq * 4;
          const float4 xv = *(const float4*)(p.x + row * DM + col);
          u32x2 o; o.x = pk_bf16(ALPHA * xv.x + acc[m][n][0], ALPHA * xv.y + acc[m][n][1]); o.y = pk_bf16(ALPHA * xv.z + acc[m][n][2], ALPHA * xv.w + acc[m][n][3]);
          *(u32x2*)((bf16_t*)p.PRE + row * DM + col) = o;
        }
    });
  }
  wg_sync_mem();
  ln_rows16_q(p.PRE, t0 + (threadIdx.x >> 6) * 16, p.ln1_g, p.ln1_b, p.X1, p.XQ, p.SX1, threadIdx.x & 63);
}

__device__ __forceinline__ void phase_kv(const P& p, int unit) {
  const int rt = unit >> 5, nc = unit & 31;
  wg_gemm<64>(p.memB + (long)rt * 128 * DM, DM, p.w_xkvT + (long)nc * 64 * DM, DM, DM, [&](f32x4 (&acc)[4][1], int wr, int wc, int fr, int fq) {
    const int b = rt >> 1, col = nc * 64 + wc * 16 + fq * 4, hh = (col >> 8) & 3, d = col & 255;
#pragma unroll
    for (int m = 0; m < 4; ++m) {
      const int mm = (rt & 1) * 128 + wr * 64 + m * 16 + fr;
      if (col < 1024) {
        u32x2 w; w.x = pk_bf16(acc[m][0][0], acc[m][0][1]); w.y = pk_bf16(acc[m][0][2], acc[m][0][3]);
        *(u32x2*)(p.Kc + ((long)(b * 4 + hh) * 256 + mm) * 256 + d) = w;
      } else {
        bf16_t* vt = p.VTc + ((long)(b * 4 + hh) * 256 + d) * 256 + mm;
        const unsigned w0 = pk_bf16(acc[m][0][0], acc[m][0][1]), w1 = pk_bf16(acc[m][0][2], acc[m][0][3]);
        vt[0] = (bf16_t)(w0 & 0xffffu); vt[256] = (bf16_t)(w0 >> 16); vt[512] = (bf16_t)(w1 & 0xffffu); vt[768] = (bf16_t)(w1 >> 16);
      }
    }
  });
}

__device__ __forceinline__ void phase_qproj(const P& p, int tile) {
  const long t0 = (long)tile * 128;
  for (int nt = 0; nt < 4; ++nt) {
    wg_gemm_i8<256>((const signed char*)p.XQ + t0 * DM, DM, p.w_xqQ + (long)nt * 256 * DM, DM, DM, [&](v4i_t (&acc)[4][4], int wr, int wc, int fr, int fq) {
#pragma unroll
      for (int m = 0; m < 4; ++m) {
        const long row = t0 + wr * 64 + m * 16 + fr;
        const float sr = p.SX1[row] * 0.0625f;
#pragma unroll
        for (int n = 0; n < 4; ++n) {
          const int col = nt * 256 + wc * 64 + n * 16 + fq * 4;
          const float4 sw = *(const float4*)(p.sw_xq + col);
          u32x2 w; w.x = pk_bf16((float)acc[m][n][0] * (sr * sw.x), (float)acc[m][n][1] * (sr * sw.y)); w.y = pk_bf16((float)acc[m][n][2] * (sr * sw.z), (float)acc[m][n][3] * (sr * sw.w));
          *(u32x2*)(p.Q + row * DM + col) = w;
        }
      }
    });
  }
}

__device__ __forceinline__ void phase_attn(const P& p, int tile) {
  const long t0 = (long)tile * 128;
  const int b = tile >> 6;
  LAS float* red = (LAS float*)((LAS char*)smem_raw + RED_OFF);
  for (int h = 0; h < 4; ++h) {
    bf16_t* Pw = p.Pb + ((long)tile * 4 + h) * 128 * 256;
    wg_gemm<256>(p.Q + t0 * DM + h * 256, DM, p.Kc + (long)(b * 4 + h) * 256 * 256, 256, 256, [&](f32x4 (&acc)[4][4], int wr, int wc, int fr, int fq) {
      float rmax[4];
#pragma unroll
      for (int m = 0; m < 4; ++m) {
        float mx = -3.0e38f;
#pragma unroll
        for (int n = 0; n < 4; ++n) mx = fmaxf(mx, fmaxf(fmaxf(acc[m][n][0], acc[m][n][1]), fmaxf(acc[m][n][2], acc[m][n][3])));
        mx = fmaxf(mx, __shfl_xor(mx, 16)); mx = fmaxf(mx, __shfl_xor(mx, 32));
        if (fq == 0) red[(wr * 64 + m * 16 + fr) * 4 + wc] = mx;
      }
      __syncthreads();
#pragma unroll
      for (int m = 0; m < 4; ++m) {
        const f32x4 r = *(LAS const f32x4*)(red + (wr * 64 + m * 16 + fr) * 4);
        rmax[m] = fmaxf(fmaxf(r[0], r[1]), fmaxf(r[2], r[3]));
      }
#pragma unroll
      for (int m = 0; m < 4; ++m) {
        float sm = 0.f;
#pragma unroll
        for (int n = 0; n < 4; ++n)
#pragma unroll
          for (int j = 0; j < 4; ++j) { const float e = __expf(acc[m][n][j] - rmax[m]); acc[m][n][j] = e; sm += e; }
        sm += __shfl_xor(sm, 16); sm += __shfl_xor(sm, 32);
        if (fq == 0) red[512 + (wr * 64 + m * 16 + fr) * 4 + wc] = sm;
      }
      __syncthreads();
#pragma unroll
      for (int m = 0; m < 4; ++m) {
        const f32x4 r = *(LAS const f32x4*)(red + 512 + (wr * 64 + m * 16 + fr) * 4);
        const float inv = 1.f / ((r[0] + r[1]) + (r[2] + r[3]));
        const int rl = wr * 64 + m * 16 + fr;
#pragma unroll
        for (int n = 0; n < 4; ++n) {
          u32x2 w; w.x = pk_bf16(acc[m][n][0] * inv, acc[m][n][1] * inv); w.y = pk_bf16(acc[m][n][2] * inv, acc[m][n][3] * inv);
          *(u32x2*)(Pw + rl * 256 + wc * 64 + n * 16 + fq * 4) = w;
        }
      }
    });
    wg_sync_mem();
    wg_gemm<256>(Pw, 256, p.VTc + (long)(b * 4 + h) * 256 * 256, 256, 256, [&](f32x4 (&acc)[4][4], int wr, int wc, int fr, int fq) {
#pragma unroll
      for (int m = 0; m < 4; ++m)
#pragma unroll
        for (int n = 0; n < 4; ++n) {
          const long row = t0 + wr * 64 + m * 16 + fr; const int col = h * 256 + wc * 64 + n * 16 + fq * 4;
          u32x2 w; w.x = pk_bf16(acc[m][n][0], acc[m][n][1]); w.y = pk_bf16(acc[m][n][2], acc[m][n][3]);
          *(u32x2*)(p.O + row * DM + col) = w;
        }
    });
  }
}

__device__ __forceinline__ void phase_oproj(const P& p, int tile) {
  const long t0 = (long)tile * 128;
  for (int nt = 0; nt < 4; ++nt) {
    wg_gemm<256>(p.O + t0 * DM, DM, p.w_xoT + (long)nt * 256 * DM, DM, DM, [&](f32x4 (&acc)[4][4], int wr, int wc, int fr, int fq) {
#pragma unroll
      for (int m = 0; m < 4; ++m)
#pragma unroll
        for (int n = 0; n < 4; ++n) {
          const long row = t0 + wr * 64 + m * 16 + fr; const int col = nt * 256 + wc * 64 + n * 16 + fq * 4;
          const u32x2 xv = *(const u32x2*)(p.X1 + row * DM + col);
          u32x2 o; o.x = pk_bf16(ALPHA * bf_lo(xv.x) + acc[m][n][0], ALPHA * bf_hi(xv.x) + acc[m][n][1]); o.y = pk_bf16(ALPHA * bf_lo(xv.y) + acc[m][n][2], ALPHA * bf_hi(xv.y) + acc[m][n][3]);
          *(u32x2*)((bf16_t*)p.PRE + row * DM + col) = o;
        }
    });
  }
  wg_sync_mem();
  ln_rows16_q(p.PRE, t0 + (threadIdx.x >> 6) * 16, p.ln2_g, p.ln2_b, p.X2, p.XQ, p.SX, threadIdx.x & 63);
}

__device__ __forceinline__ void phase_pq(const P& p, int tile) {
  const long t0 = (long)tile * 128;
  for (int nt = 0; nt < 8; ++nt) {
    wg_gemm<256>(p.X2 + t0 * DM, DM, p.w_pqT + (long)nt * 256 * DM, DM, DM, [&](f32x4 (&acc)[4][4], int wr, int wc, int fr, int fq) {
#pragma unroll
      for (int m = 0; m < 4; ++m)
#pragma unroll
        for (int n = 0; n < 4; ++n) {
          const long row = t0 + wr * 64 + m * 16 + fr; const int col = nt * 256 + wc * 64 + n * 16 + fq * 4;
          u32x2 w; w.x = pk_bf16(acc[m][n][0], acc[m][n][1]); w.y = pk_bf16(acc[m][n][2], acc[m][n][3]);
          *(u32x2*)(p.PQ + row * 2048 + col) = w;
        }
    });
  }
}

__device__ __forceinline__ unsigned cand_entry(int s) {
  unsigned e = 255u; int base = 0;
#pragma unroll
  for (int i = 0; i < 16; ++i) { const int cnt = 16 / (i + 1); if (s >= base && s < base + cnt) e = (unsigned)i | ((unsigned)(s - base) << 4); base += cnt; }
  return e;
}
template <int CTRL> __device__ __forceinline__ unsigned dpp_u(unsigned x) { return (unsigned)__builtin_amdgcn_mov_dpp((int)x, CTRL, 0xf, 0xf, true); }
template <int CTRL> __device__ __forceinline__ float dpp_f(float x) { return __int_as_float(__builtin_amdgcn_mov_dpp(__float_as_int(x), CTRL, 0xf, 0xf, true)); }
__device__ __forceinline__ unsigned umin_(unsigned a, unsigned b) { return a < b ? a : b; }
__device__ __forceinline__ unsigned row_min_u(unsigned x) {
  x = umin_(x, dpp_u<0x128>(x)); x = umin_(x, dpp_u<0x124>(x)); x = umin_(x, dpp_u<0x122>(x)); x = umin_(x, dpp_u<0x121>(x)); return x;
}
__device__ __forceinline__ float row_max_f(float x) { x = fmaxf(x, dpp_f<0x128>(x)); x = fmaxf(x, dpp_f<0x124>(x)); x = fmaxf(x, dpp_f<0x122>(x)); x = fmaxf(x, dpp_f<0x121>(x)); return x; }
__device__ __forceinline__ float row_sum_f(float x) { x += dpp_f<0x128>(x); x += dpp_f<0x124>(x); x += dpp_f<0x122>(x); x += dpp_f<0x121>(x); return x; }
__device__ __forceinline__ unsigned f2key(float f) { const unsigned b = __float_as_uint(f); return b ^ ((unsigned)((int)b >> 31) | 0x80000000u); }
__device__ __forceinline__ float key2f(unsigned k) { return __uint_as_float(k ^ ((k & 0x80000000u) ? 0x80000000u : 0xffffffffu)); }

#define KEYS_OFF 65536
#define KEY_STRIDE 528
template <int N> __device__ __forceinline__ unsigned top16_row(const unsigned (&k)[N], int r) {
  unsigned pm1 = 0xFFFFFFFEu, mine = 0;
#pragma unroll
  for (int rd = 0; rd < 16; ++rd) {
    unsigned d = pm1 - k[0];
#pragma unroll
    for (int i = 1; i < N; ++i) d = umin_(d, pm1 - k[i]);
    d = row_min_u(d);
    const unsigned nxt = pm1 - d;
    mine = (r == rd) ? nxt : mine;
    pm1 = nxt - 1;
  }
  return mine;
}

__device__ __forceinline__ void phase_route(const P& p, int tile) {
  const long t0 = (long)tile * 128;
  const int tid = otid(), lane = tid & 63, wid = tid >> 6, r = lane & 15, g = lane >> 4;
  LAS char* lds = (LAS char*)smem_raw;
  LAS unsigned char* tab = (LAS unsigned char*)(lds + RED_OFF);
  if (tid < 64) tab[tid] = (unsigned char)cand_entry(tid);
  unsigned ci[4], cj[4]; bool cval[4];
#pragma unroll
  for (int q = 0; q < 4; ++q) { const unsigned e = cand_entry(r * 4 + q); cval[q] = (e != 255u); ci[q] = ((unsigned)(g * 16) + (e & 15u)) * 4u; cj[q] = ((unsigned)(g * 16) + ((e >> 4) & 15u)) * 4u; }
  for (int h = 0; h < 8; ++h) {
    unsigned top[2][4];
#pragma unroll
    for (int ph = 0; ph < 2; ++ph) {
      wg_gemm<128>(p.PQ + t0 * 2048 + h * 256 + ph * 128, 2048, p.skb + (long)(h * 2 + ph) * 128 * 128, 128, 128, [&](f32x4 (&acc)[4][2], int wr, int wc, int fr, int fq) {
#pragma unroll
        for (int m = 0; m < 4; ++m)
#pragma unroll
          for (int n = 0; n < 2; ++n) {
            const int row = wr * 64 + m * 16 + fr, col = wc * 32 + n * 16 + fq * 4;
            u32x4 kk;
            kk.x = (f2key(acc[m][n][0]) & ~127u) | (unsigned)(127 - col); kk.y = (f2key(acc[m][n][1]) & ~127u) | (unsigned)(126 - col);
            kk.z = (f2key(acc[m][n][2]) & ~127u) | (unsigned)(125 - col); kk.w = (f2key(acc[m][n][3]) & ~127u) | (unsigned)(124 - col);
            *(LAS u32x4*)(lds + KEYS_OFF + row * KEY_STRIDE + col * 4) = kk;
          }
      });
      __syncthreads();
#pragma unroll
      for (int ps = 0; ps < 4; ++ps) {
        const int tk = wid * 16 + ps * 4 + g;
        const u32x4 k0 = *(LAS const u32x4*)(lds + KEYS_OFF + tk * KEY_STRIDE + r * 32), k1 = *(LAS const u32x4*)(lds + KEYS_OFF + tk * KEY_STRIDE + r * 32 + 16);
        const unsigned k[8] = {k0.x, k0.y, k0.z, k0.w, k1.x, k1.y, k1.z, k1.w};
        top[ph][ps] = top16_row<8>(k, r);
      }
    }
#pragma unroll
    for (int ps = 0; ps < 4; ++ps) {
      const int tk = wid * 16 + ps * 4 + g;
      const unsigned A = top[0][ps], B = top[1][ps];
      const float fa = key2f(A & ~127u), fb = key2f(B & ~127u);
      unsigned k2[4];
#pragma unroll
      for (int q = 0; q < 4; ++q) {
        const float va = __int_as_float(__builtin_amdgcn_ds_bpermute((int)ci[q], __float_as_int(fa)));
        const float vb = __int_as_float(__builtin_amdgcn_ds_bpermute((int)cj[q], __float_as_int(fb)));
        const unsigned kk = (f2key(va + vb) & ~63u) | (unsigned)(63 - (r * 4 + q));
        k2[q] = cval[q] ? kk : 0u;
      }
      const unsigned mine = top16_row<4>(k2, r);
      const unsigned slot = 63u - (mine & 63u);
      const unsigned e = tab[slot];
      const unsigned ka = (unsigned)__builtin_amdgcn_ds_bpermute((int)(((unsigned)(g * 16) + (e & 15u)) * 4u), (int)A);
      const unsigned kb = (unsigned)__builtin_amdgcn_ds_bpermute((int)(((unsigned)(g * 16) + ((e >> 4) & 15u)) * 4u), (int)B);
      const int expert = (int)((127u - (ka & 127u)) * 128u + (127u - (kb & 127u)));
      const float c = key2f(mine & ~63u);
      const float mx = row_max_f(c);
      const float ex = __expf(c - mx);
      const float sm = row_sum_f(ex);
      p.experts[(t0 + tk) * 128 + h * 16 + r] = expert;
      p.gates[(t0 + tk) * 128 + h * 16 + r] = ex / sm;
    }
  }
}

__device__ __forceinline__ f32x2_t ub01(unsigned w) { return (f32x2_t){(float)(w & 0xffu), (float)((w >> 8) & 0xffu)}; }
__device__ __forceinline__ f32x2_t ub23(unsigned w) { return (f32x2_t){(float)((w >> 16) & 0xffu), (float)(w >> 24)}; }
__device__ __forceinline__ int sum8_i(int x) {
  x += (int)dpp_u<0xB1>((unsigned)x); x += (int)dpp_u<0x4E>((unsigned)x); x += (int)dpp_u<0x141>((unsigned)x); return x;
}
struct GMeta { u32x4 xq; int er0, er1; };
__device__ __forceinline__ void phase_gdown(const P& p) {
  const int tid = otid(), lane = tid & 63, wid = tid >> 6, grp = lane >> 3, r8 = lane & 7;
  const int slice = blockIdx.x & 7, chunk = blockIdx.x >> 3;
  const unsigned char* tab = p.WDq + slice * 128 + r8 * 16;
  const char* sl = p.slabs + (size_t)(chunk * 8 + wid) * SLAB_BYTES;
  int* pd = (int*)(sl + OFF_ZB) + slice * 128 * 128;
  const unsigned char* xqb = (const unsigned char*)(sl + OFF_VT);
  const int* exb = (const int*)(sl + OFF_EXP);
  auto meta = [&](int ti, GMeta& m) {
    const int t = (ti < 127 ? ti : 127);
    m.xq = *(const u32x4*)(xqb + t * DM + slice * 128 + r8 * 16);
    m.er0 = exb[t * 128 + lane]; m.er1 = exb[t * 128 + 64 + lane];
  };
  auto issue = [&](const GMeta& m, u32x4 (&w)[16]) {
#pragma unroll
    for (int it = 0; it < 16; ++it) {
      const int e = __builtin_amdgcn_ds_bpermute(((it & 7) * 8 + grp) * 4, (it < 8) ? m.er0 : m.er1);
      w[it] = *(const u32x4*)(tab + (long)e * DM);
    }
  };
  auto consume = [&](int ti, const GMeta& m, const u32x4 (&w)[16]) {
    int c0 = 0, c1 = 0;
#pragma unroll
    for (int it = 0; it < 16; ++it) {
      int acc = __builtin_amdgcn_sdot4((int)w[it].x, (int)m.xq.x, 0, false);
      acc = __builtin_amdgcn_sdot4((int)w[it].y, (int)m.xq.y, acc, false); acc = __builtin_amdgcn_sdot4((int)w[it].z, (int)m.xq.z, acc, false); acc = __builtin_amdgcn_sdot4((int)w[it].w, (int)m.xq.w, acc, false);
      acc = sum8_i(acc);
      const bool mine = ((it & 7) == r8);
      c0 = (mine && it < 8) ? acc : c0;
      c1 = (mine && it >= 8) ? acc : c1;
    }
    pd[ti * 128 + r8 * 8 + grp] = c0; pd[ti * 128 + 64 + r8 * 8 + grp] = c1;
  };
  GMeta mA, mB; u32x4 wA[16], wB[16];
  meta(0, mA); issue(mA, wA); meta(1, mB);
  for (int ti = 0; ti < 128; ti += 2) {
    issue(mB, wB);
    consume(ti, mA, wA);
    meta(ti + 2, mA);
    issue(mA, wA);
    consume(ti + 1, mB, wB);
    meta(ti + 3, mB);
  }
}
__device__ __forceinline__ int cq_index(int k) { return ((k >> 5) * 8 + (k & 7)) * 4 + ((k >> 3) & 3); }
__device__ __forceinline__ void phase_gcomb(const P& p, int tile) {
  const int tid = otid(), lane = tid & 63, wid = tid >> 6;
  signed char* cq = (signed char*)(p.slabs + (size_t)tile * SLAB_BYTES + OFF_CQ);
  float* sc = (float*)(p.slabs + (size_t)tile * SLAB_BYTES + OFF_SC);
#pragma unroll 4
  for (int ti = 0; ti < 16; ++ti) {
    const int tl = wid * 16 + ti;
    const long t = (long)tile * 128 + tl;
    int s0 = 0, s1 = 0;
#pragma unroll
    for (int j = 0; j < 8; ++j) { s0 += p.PD[(j * 128 + tl) * 128 + lane]; s1 += p.PD[(j * 128 + tl) * 128 + 64 + lane]; }
    const int e0 = p.experts[t * 128 + lane], e1 = p.experts[t * 128 + 64 + lane];
    const float sx = p.SX[t];
    const float c0 = p.gates[t * 128 + lane] * gelu_f((float)s0 * p.sd[e0] * sx) * p.su[e0];
    const float c1 = p.gates[t * 128 + 64 + lane] * gelu_f((float)s1 * p.sd[e1] * sx) * p.su[e1];
    float amax = fmaxf(fabsf(c0), fabsf(c1));
#pragma unroll
    for (int o = 32; o > 0; o >>= 1) amax = fmaxf(amax, __shfl_xor(amax, o));
    const float inv = amax > 0.f ? 127.f / amax : 0.f;
    cq[tl * 128 + cq_index(lane)] = (signed char)__float2int_rn(c0 * inv);
    cq[tl * 128 + cq_index(lane + 64)] = (signed char)__float2int_rn(c1 * inv);
    if (lane == 0) sc[tl] = amax * (1.f / 127.f);
  }
}
struct UMeta { int er0, er1; unsigned cq[4]; };
__device__ __forceinline__ void phase_gup(const P& p) {
  const int tid = otid(), lane = tid & 63, wid = tid >> 6, grp = lane >> 3, r8 = lane & 7;
  const int slice = blockIdx.x & 7, chunk = blockIdx.x >> 3;
  const unsigned char* tab = p.WUq + slice * 128 + r8 * 16;
  char* sl = p.slabs + (size_t)(chunk * 8 + wid) * SLAB_BYTES;
  const int* exb = (const int*)(sl + OFF_EXP);
  const unsigned* cqb = (const unsigned*)(sl + OFF_CQ);
  const float* scb = (const float*)(sl + OFF_SC);
  bf16_t* h3b = (bf16_t*)(sl + OFF_ZB);
  auto meta = [&](int ti, UMeta& m) {
    const int t = (ti < 127 ? ti : 127);
    m.er0 = exb[t * 128 + lane]; m.er1 = exb[t * 128 + 64 + lane];
#pragma unroll
    for (int j = 0; j < 4; ++j) m.cq[j] = cqb[t * 32 + j * 8 + grp];
  };
  auto issue = [&](const UMeta& m, u32x4 (&w)[16]) {
#pragma unroll
    for (int it = 0; it < 16; ++it) {
      const int e = __builtin_amdgcn_ds_bpermute(((it & 7) * 8 + grp) * 4, (it < 8) ? m.er0 : m.er1);
      w[it] = *(const u32x4*)(tab + (long)e * DM);
    }
  };
  auto consume = [&](int ti, const UMeta& m, const u32x4 (&w)[16]) {
    int o[16];
#pragma unroll
    for (int i = 0; i < 16; ++i) o[i] = 0;
#pragma unroll
    for (int j = 0; j < 4; ++j) {
      const unsigned x0[4] = {w[4 * j].x, w[4 * j].y, w[4 * j].z, w[4 * j].w}, x1[4] = {w[4 * j + 1].x, w[4 * j + 1].y, w[4 * j + 1].z, w[4 * j + 1].w};
      const unsigned x2[4] = {w[4 * j + 2].x, w[4 * j + 2].y, w[4 * j + 2].z, w[4 * j + 2].w}, x3[4] = {w[4 * j + 3].x, w[4 * j + 3].y, w[4 * j + 3].z, w[4 * j + 3].w};
#pragma unroll
      for (int d = 0; d < 4; ++d) {
        const unsigned t0 = __builtin_amdgcn_perm(x1[d], x0[d], 0x05010400u), t1 = __builtin_amdgcn_perm(x1[d], x0[d], 0x07030602u);
        const unsigned u0 = __builtin_amdgcn_perm(x3[d], x2[d], 0x05010400u), u1 = __builtin_amdgcn_perm(x3[d], x2[d], 0x07030602u);
        o[d * 4 + 0] = __builtin_amdgcn_sdot4((int)__builtin_amdgcn_perm(u0, t0, 0x05040100u), (int)m.cq[j], o[d * 4 + 0], false);
        o[d * 4 + 1] = __builtin_amdgcn_sdot4((int)__builtin_amdgcn_perm(u0, t0, 0x07060302u), (int)m.cq[j], o[d * 4 + 1], false);
        o[d * 4 + 2] = __builtin_amdgcn_sdot4((int)__builtin_amdgcn_perm(u1, t1, 0x05040100u), (int)m.cq[j], o[d * 4 + 2], false);
        o[d * 4 + 3] = __builtin_amdgcn_sdot4((int)__builtin_amdgcn_perm(u1, t1, 0x07060302u), (int)m.cq[j], o[d * 4 + 3], false);
      }
    }
    const float sct = scb[ti];
    float f[16];
#pragma unroll
    for (int i = 0; i < 16; ++i) {
      int a = o[i];
      a += (int)dpp_u<0x128>((unsigned)a);
      a += __shfl_xor(a, 16);
      a += __shfl_xor(a, 32);
      f[i] = (float)a * sct;
    }
    if (grp == 0) {
      bf16_t* dst = h3b + ti * DM + slice * 128 + r8 * 16;
      u32x4 q0, q1;
      q0.x = pk_bf16(f[0], f[1]); q0.y = pk_bf16(f[2], f[3]); q0.z = pk_bf16(f[4], f[5]); q0.w = pk_bf16(f[6], f[7]);
      q1.x = pk_bf16(f[8], f[9]); q1.y = pk_bf16(f[10], f[11]); q1.z = pk_bf16(f[12], f[13]); q1.w = pk_bf16(f[14], f[15]);
      *(u32x4*)dst = q0; *(u32x4*)(dst + 8) = q1;
    }
  };
  UMeta mA, mB; u32x4 wA[16], wB[16];
  meta(0, mA); issue(mA, wA); meta(1, mB);
  for (int ti = 0; ti < 128; ti += 2) {
    issue(mB, wB);
    consume(ti, mA, wA);
    meta(ti + 2, mA);
    issue(mA, wA);
    consume(ti + 1, mB, wB);
    meta(ti + 3, mB);
  }
}
__device__ __forceinline__ void phase_ln3(const P& p, int tile) {
  const int tid = otid(), lane = tid & 63, wid = tid >> 6;
#pragma unroll 2
  for (int ti = 0; ti < 16; ++ti) {
    const long t = (long)tile * 128 + wid * 16 + ti;
    float4 v[4];
    float sum = 0.f;
#pragma unroll
    for (int j = 0; j < 4; ++j) {
      const int c0 = j * 256 + lane * 4;
      const u32x2 hv = *(const u32x2*)((const bf16_t*)p.H3 + t * DM + c0);
      const u32x2 xv = *(const u32x2*)(p.X2 + t * DM + c0);
      v[j].x = bf_lo(hv.x) + ALPHA * bf_lo(xv.x); v[j].y = bf_hi(hv.x) + ALPHA * bf_hi(xv.x); v[j].z = bf_lo(hv.y) + ALPHA * bf_lo(xv.y); v[j].w = bf_hi(hv.y) + ALPHA * bf_hi(xv.y);
      sum += (v[j].x + v[j].y) + (v[j].z + v[j].w);
    }
#pragma unroll
    for (int o = 32; o > 0; o >>= 1) sum += __shfl_xor(sum, o);
    const float mu = sum * (1.f / DM);
    float q = 0.f;
#pragma unroll
    for (int j = 0; j < 4; ++j) { v[j].x -= mu; v[j].y -= mu; v[j].z -= mu; v[j].w -= mu; q += (v[j].x * v[j].x + v[j].y * v[j].y) + (v[j].z * v[j].z + v[j].w * v[j].w); }
#pragma unroll
    for (int o = 32; o > 0; o >>= 1) q += __shfl_xor(q, o);
    const float rstd = rsqrtf(q * (1.f / DM) + LN_EPS);
#pragma unroll
    for (int j = 0; j < 4; ++j) {
      const int c0 = j * 256 + lane * 4;
      const float4 gg = *(const float4*)(p.ln3_g + c0), bb = *(const float4*)(p.ln3_b + c0);
      float4 o; o.x = v[j].x * rstd * gg.x + bb.x; o.y = v[j].y * rstd * gg.y + bb.y; o.z = v[j].z * rstd * gg.z + bb.z; o.w = v[j].w * rstd * gg.w + bb.w;
      *(float4*)(p.out + t * DM + c0) = o;
    }
  }
}

__device__ __forceinline__ void prep_transpose_tile(const float* __restrict__ W, bf16_t* __restrict__ WT, int K, int N, int tileidx) {
  LAS float* scr = (LAS float*)smem_raw;
  const int ntn = N / 64, k0 = (tileidx / ntn) * 64, n0 = (tileidx % ntn) * 64, tid = threadIdx.x;
#pragma unroll
  for (int i = 0; i < 8; ++i) { const int e = tid + i * 512, kk = e >> 6, nn = e & 63; scr[kk * 65 + nn] = W[(long)(k0 + kk) * N + n0 + nn]; }
  __syncthreads();
#pragma unroll
  for (int i = 0; i < 4; ++i) { const int e = tid + i * 512, nn = e >> 5, kp = (e & 31) * 2; *(unsigned*)(WT + (long)(n0 + nn) * K + k0 + kp) = pk_bf16(scr[kp * 65 + nn], scr[(kp + 1) * 65 + nn]); }
  __syncthreads();
}
__device__ __forceinline__ void prep_quant_strip(const float* __restrict__ W, signed char* __restrict__ Q, float* __restrict__ sc, int K, int N, int strip) {
  LAS float* scr = (LAS float*)smem_raw;
  LAS float* pmax = scr + 64 * 65;
  LAS float* inv = pmax + 8 * 64;
  const int n0 = strip * 64, tid = threadIdx.x, nn = tid & 63, kg = tid >> 6;
  float amax = 0.f;
  for (int k0 = 0; k0 < K; k0 += 64)
#pragma unroll
    for (int i = 0; i < 8; ++i) amax = fmaxf(amax, fabsf(W[(long)(k0 + kg + 8 * i) * N + n0 + nn]));
  pmax[kg * 64 + nn] = amax;
  __syncthreads();
  if (tid < 64) {
    float m = 0.f;
#pragma unroll
    for (int j = 0; j < 8; ++j) m = fmaxf(m, pmax[j * 64 + tid]);
    inv[tid] = m > 0.f ? 127.f / m : 0.f;
    sc[n0 + tid] = m * (1.f / 127.f);
  }
  __syncthreads();
  const float iv = inv[nn];
  for (int k0 = 0; k0 < K; k0 += 64) {
#pragma unroll
    for (int i = 0; i < 8; ++i) { const int kk = kg + 8 * i; scr[kk * 65 + nn] = W[(long)(k0 + kk) * N + n0 + nn] * iv; }
    __syncthreads();
#pragma unroll
    for (int i = 0; i < 2; ++i) {
      const int dd = tid + i * 512, n = dd >> 4, k4 = (dd & 15) * 4;
      *(unsigned*)(Q + (long)(n0 + n) * K + k0 + k4) = pack4_i8(scr[k4 * 65 + n], scr[(k4 + 1) * 65 + n], scr[(k4 + 2) * 65 + n], scr[(k4 + 3) * 65 + n]);
    }
    __syncthreads();
  }
}
__device__ __forceinline__ void prep_cvt(const float* __restrict__ in, bf16_t* __restrict__ out, long n8) {
  for (long i = (long)blockIdx.x * 512 + threadIdx.x; i < n8; i += (long)gridDim.x * 512) {
    const float4 a = *(const float4*)(in + i * 8), b = *(const float4*)(in + i * 8 + 4);
    u32x4 o; o.x = pk_bf16(a.x, a.y); o.y = pk_bf16(a.z, a.w); o.z = pk_bf16(b.x, b.y); o.w = pk_bf16(b.z, b.w);
    *(u32x4*)(out + i * 8) = o;
  }
}
__device__ __forceinline__ void phase_prep(const P& p) {
  const int T_IN = 16 * 40, T_SQ = 16 * 16, T_W2 = 16 * 32;
  const int total = T_IN + T_SQ + T_SQ + T_W2 + T_SQ + T_W2;
  for (int it = blockIdx.x; it < total; it += gridDim.x) {
    int r = it;
    if (r < T_IN) { if (r < 40) prep_quant_strip(p.w_in, p.w_inQ, p.sw_in, DM, INW, r); continue; } r -= T_IN;
    if (r < T_SQ) { prep_transpose_tile(p.w_mo, (bf16_t*)p.w_moT, DM, DM, r); continue; } r -= T_SQ;
    if (r < T_SQ) { if (r < 16) prep_quant_strip(p.w_xq, p.w_xqQ, p.sw_xq, DM, DM, r); continue; } r -= T_SQ;
    if (r < T_W2) { prep_transpose_tile(p.w_xkv, (bf16_t*)p.w_xkvT, DM, 2048, r); continue; } r -= T_W2;
    if (r < T_SQ) { prep_transpose_tile(p.w_xo, (bf16_t*)p.w_xoT, DM, DM, r); continue; } r -= T_SQ;
    prep_transpose_tile(p.w_pq, (bf16_t*)p.w_pqT, DM, 2048, r);
  }
  prep_cvt(p.mem, (bf16_t*)p.memB, (long)1024 * DM / 8);
  prep_cvt(p.sub_keys, (bf16_t*)p.skb, (long)8 * 2 * 128 * 128 / 8);
  {
    const int lane = threadIdx.x & 63, gw = blockIdx.x * 8 + (threadIdx.x >> 6), ngw = gridDim.x * 8;
    for (int row = gw; row < 2 * 16384; row += ngw) {
      const int tb = row >> 14, e = row & 16383;
      const float* src = (tb ? p.w_up : p.w_down) + (long)e * DM;
      float4 v[4];
      float amax = 0.f;
#pragma unroll
      for (int i = 0; i < 4; ++i) { v[i] = *(const float4*)(src + 256 * i + lane * 4); amax = fmaxf(amax, fmaxf(fmaxf(fabsf(v[i].x), fabsf(v[i].y)), fmaxf(fabsf(v[i].z), fabsf(v[i].w)))); }
#pragma unroll
      for (int s = 32; s > 0; s >>= 1) amax = fmaxf(amax, __shfl_xor(amax, s));
      const float inv = amax > 0.f ? 127.f / amax : 0.f;
      unsigned char* dst = (unsigned char*)(tb ? p.WUq : p.WDq) + (long)e * DM;
      const float off = 0.f;
#pragma unroll
      for (int i = 0; i < 4; ++i) *(unsigned*)(dst + 256 * i + lane * 4) = pack4_i8(v[i].x * inv + off, v[i].y * inv + off, v[i].z * inv + off, v[i].w * inv + off);
      if (lane == 0) { float* sc = (float*)(tb ? p.su : p.sd); sc[e] = amax * (1.f / 127.f); }
    }
  }
  for (int i = blockIdx.x * 512 + threadIdx.x; i < 4 * 128 * 128 / 2; i += gridDim.x * 512) {
    const int e = i * 2, t = (e >> 7) & 127, sidx = e & 127;
    const float2 v = *(const float2*)(p.w_sp + e);
    *(unsigned*)((bf16_t*)p.wsb + e) = pk_bf16(sidx <= t ? v.x : 0.f, (sidx + 1) <= t ? v.y : 0.f);
  }
}
__device__ __forceinline__ void phase_xcvt(const P& p, int tile) {
  const int lane = threadIdx.x & 63, wid = threadIdx.x >> 6;
  signed char* xq = (signed char*)(p.slabs + (size_t)tile * SLAB_BYTES + OFF_XB);
  float* sxr = (float*)(p.slabs + (size_t)tile * SLAB_BYTES + OFF_SXB);
#pragma unroll 2
  for (int i = 0; i < 16; ++i) {
    const int rl = wid * 16 + i;
    const float* src = p.x + ((long)tile * 128 + rl) * DM;
    float4 v[4];
    float amax = 0.f;
#pragma unroll
    for (int j = 0; j < 4; ++j) { v[j] = *(const float4*)(src + 256 * j + lane * 4); amax = fmaxf(amax, fmaxf(fmaxf(fabsf(v[j].x), fabsf(v[j].y)), fmaxf(fabsf(v[j].z), fabsf(v[j].w)))); }
#pragma unroll
    for (int o = 32; o > 0; o >>= 1) amax = fmaxf(amax, __shfl_xor(amax, o));
    const float inv = amax > 0.f ? 127.f / amax : 0.f;
#pragma unroll
    for (int j = 0; j < 4; ++j) *(unsigned*)(xq + rl * DM + 256 * j + lane * 4) = pack4_i8(v[j].x * inv, v[j].y * inv, v[j].z * inv, v[j].w * inv);
    if (lane == 0) sxr[rl] = amax * (1.f / 127.f);
  }
}
__device__ __forceinline__ void phase_halo(const P& p, int tile) {
  const int tid = otid();
  if (tid < 128) {
    const int rr = tid >> 6, c = (tid & 63) * 8;
    const bf16_t* zr = p.ZB + ((long)tile * 128 + 126 + rr) * INW;
    const u32x4 hb = *(const u32x4*)(zr + 1024 + c), gc = *(const u32x4*)(zr + 2048 + c);
    u32x4 o;
    o.x = pk_bf16(bf_lo(hb.x) * bf_lo(gc.x), bf_hi(hb.x) * bf_hi(gc.x)); o.y = pk_bf16(bf_lo(hb.y) * bf_lo(gc.y), bf_hi(hb.y) * bf_hi(gc.y));
    o.z = pk_bf16(bf_lo(hb.z) * bf_lo(gc.z), bf_hi(hb.z) * bf_hi(gc.z)); o.w = pk_bf16(bf_lo(hb.w) * bf_lo(gc.w), bf_hi(hb.w) * bf_hi(gc.w));
    *(u32x4*)(p.HALO + ((long)tile * 2 + rr) * 512 + c) = o;
  }
}

__device__ __forceinline__ P tile_view(const P& p, int tile) {
  P q = p;
  char* sl = p.slabs + (size_t)tile * SLAB_BYTES;
  const long t0 = (long)tile * 128;
  q.XB = (bf16_t*)(sl + OFF_XB) - t0 * DM; q.X1 = (bf16_t*)(sl + OFF_XB) - t0 * DM;
  q.experts = (int*)(sl + OFF_EXP) - t0 * 128; q.gates = (float*)(sl + OFF_GATE) - t0 * 128;
  q.ZB = (bf16_t*)(sl + OFF_ZB) - t0 * INW; q.PRE = (float*)((bf16_t*)(sl + OFF_ZB) - t0 * DM); q.PQ = (bf16_t*)(sl + OFF_ZB) - t0 * 2048;
  q.PD = (int*)(sl + OFF_ZB); q.H3 = (float*)((bf16_t*)(sl + OFF_ZB) - t0 * DM);
  q.VT = (bf16_t*)(sl + OFF_VT) - (long)tile * 4 * 128 * 128; q.XQ = (unsigned char*)(sl + OFF_VT) - t0 * DM;
  q.Y = (bf16_t*)(sl + OFF_Y) - t0 * DM; q.Pb = (bf16_t*)(sl + OFF_Y) - (long)tile * 4 * 128 * 256;
  q.Q = (bf16_t*)(sl + OFF_Q) - t0 * DM; q.X2 = (bf16_t*)(sl + OFF_Q) - t0 * DM;
  q.O = (bf16_t*)(sl + OFF_O) - t0 * DM;
  return q;
}

#define XB_TMO      128
#define XB_XCNT(j)  (256  + 64 * (j))
#define XB_XSUB(j)  (1280 + 64 * (j))
#define XB_XGEN(j)  (2304 + 64 * (j))
#define XB_TOP      3328
#define XB_TOPGEN   3392
#define XCD_BAR_WORDS 3456
#define XB_SPIN_CAP (1u << 18)

__device__ __forceinline__ unsigned xb_ld(unsigned* p)              { return __hip_atomic_load(p, __ATOMIC_RELAXED, __HIP_MEMORY_SCOPE_AGENT); }
__device__ __forceinline__ unsigned xb_add(unsigned* p, unsigned v) { return __hip_atomic_fetch_add(p, v, __ATOMIC_RELAXED, __HIP_MEMORY_SCOPE_AGENT); }
__device__ __forceinline__ unsigned xb_xcc_id() { return (unsigned)__builtin_amdgcn_s_getreg((3 << 11) | 20) & 0xFu; }
#define XB_SPIN(cond, bar) do { unsigned _sp = 0; while (cond) { __builtin_amdgcn_s_sleep(1); \
    if ((++_sp & 255u) == 0u) { if (xb_ld(&(bar)[XB_TMO])) break; if (_sp > XB_SPIN_CAP) { atomicAdd(&(bar)[XB_TMO], 1u); break; } } } } while (0)

struct XcdBarrier {
    unsigned* bar; unsigned x;
    volatile LAS unsigned* st;
};

__device__ __forceinline__ XcdBarrier xcd_barrier_post(unsigned* bar, volatile LAS unsigned* st) {
    XcdBarrier b; b.bar = bar; b.x = xb_xcc_id(); b.st = st;
    if (threadIdx.x == 0) (void)xb_add(&bar[XB_XCNT(b.x)], 1u);
    return b;
}
__device__ __forceinline__ void xcd_barrier_complete(unsigned* bar, unsigned x, unsigned& nloc, unsigned& nx) {
    const unsigned G = gridDim.x * gridDim.y * gridDim.z;
    unsigned sum, cnt, mine, sp = 0u;
    for (;;) {
        sum = 0u; cnt = 0u; mine = 0u;
#pragma unroll
        for (unsigned j = 0; j < 16; ++j) { const unsigned c = xb_ld(&bar[XB_XCNT(j)]); sum += c; cnt += (c > 0u) ? 1u : 0u; mine = (j == x) ? c : mine; }
        if (sum == G) break;
        __builtin_amdgcn_s_sleep(1);
        if ((++sp & 255u) == 0u) { if (xb_ld(&bar[XB_TMO])) break; if (sp > XB_SPIN_CAP) { atomicAdd(&bar[XB_TMO], 1u); break; } }
    }
    nloc = mine > 0u ? mine : 1u; nx = cnt > 0u ? cnt : 1u;
}

__device__ __forceinline__ void xcd_barrier(const XcdBarrier& b) {
    asm volatile("s_waitcnt vmcnt(0)" ::: "memory");
    __syncthreads();
    if (threadIdx.x == 0) {
        unsigned* bar = b.bar;
        __builtin_amdgcn_s_waitcnt(0);
        unsigned nloc = b.st[0], nx = b.st[1];
        if (nloc == 0u) { xcd_barrier_complete(bar, b.x, nloc, nx); b.st[0] = nloc; b.st[1] = nx; }
        const unsigned old = xb_add(&bar[XB_XSUB(b.x)], 1u);
        const unsigned gen = old / nloc;
        if (old + 1u == (gen + 1u) * nloc) {
            __builtin_amdgcn_fence(__ATOMIC_RELEASE, "agent");
            asm volatile("s_waitcnt vmcnt(0)" ::: "memory");
            const unsigned og = xb_add(&bar[XB_TOP], 1u);
            const unsigned tg = og / nx;
            if (og + 1u == (tg + 1u) * nx) xb_add(&bar[XB_TOPGEN], 1u);
            else XB_SPIN(xb_ld(&bar[XB_TOPGEN]) == tg, bar);
            __builtin_amdgcn_fence(__ATOMIC_ACQUIRE, "agent");
            xb_add(&bar[XB_XGEN(b.x)], 1u);
            asm volatile("s_waitcnt vmcnt(0)" ::: "memory");
        } else {
            XB_SPIN(xb_ld(&bar[XB_XGEN(b.x)]) == gen, bar);
            __builtin_amdgcn_fence(__ATOMIC_ACQUIRE, "agent");
            asm volatile("s_waitcnt vmcnt(0)" ::: "memory");
        }
    }
    __syncthreads();
}


__global__ __launch_bounds__(512) void mega_k(P pg) {
  const int tile = blockIdx.x;
  volatile LAS unsigned* xbw = (volatile LAS unsigned*)((LAS char*)smem_raw + XB_LDS_OFF);
  if (threadIdx.x < 4) xbw[threadIdx.x] = 0u;
  __syncthreads();
  XcdBarrier xb = xcd_barrier_post(pg.bar, xbw);
  const P p = tile_view(pg, tile);
  phase_prep(pg);
  phase_xcvt(p, tile);
  xcd_barrier(xb);
  phase_inproj(p, tile);
  wg_sync_mem();
  phase_halo(p, tile);
  phase_kv(p, tile);
  xcd_barrier(xb);
  phase_mixer(p, tile);
  wg_sync_mem();
  phase_outproj(p, tile);
  wg_sync_mem();
  phase_qproj(p, tile);
  wg_sync_mem();
  phase_attn(p, tile);
  wg_sync_mem();
  phase_oproj(p, tile);
  wg_sync_mem();
  phase_pq(p, tile);
  wg_sync_mem();
  phase_route(p, tile);
  xcd_barrier(xb);
  phase_gdown(pg);
  xcd_barrier(xb);
  phase_gcomb(p, tile);
  xcd_barrier(xb);
  phase_gup(pg);
  xcd_barrier(xb);
  phase_ln3(p, tile);
}

extern "C" void kernel_launch(void* const* d_in, const int* in_sizes, int n_in, void* d_out, int out_size, void* d_ws, size_t ws_size, hipStream_t stream) {
  static int grid_blocks = 0;
  if (grid_blocks == 0) {
    int dev = 0, cus = 0, per_cu = 0;
    (void)hipGetDevice(&dev);
    (void)hipDeviceGetAttribute(&cus, hipDeviceAttributeMultiprocessorCount, dev);
    if (hipFuncSetAttribute((const void*)mega_k, hipFuncAttributeMaxDynamicSharedMemorySize, LDS_BYTES) != hipSuccess) fprintf(stderr, "kernel_launch: hipFuncSetAttribute failed\n");
    if (hipOccupancyMaxActiveBlocksPerMultiprocessor(&per_cu, (const void*)mega_k, 512, LDS_BYTES) != hipSuccess || per_cu < 1) { fprintf(stderr, "kernel_launch: occupancy query says %d blocks/CU\n", per_cu); per_cu = 1; }
    (void)hipGetLastError();
    grid_blocks = NTOK / 128;
    if (cus * per_cu < grid_blocks) fprintf(stderr, "kernel_launch: device holds only %d x %d resident blocks, need %d\n", cus, per_cu, grid_blocks);
  }
  char* w8 = (char*)d_ws;
  const size_t MiB = (size_t)1 << 20;
  P p{};
  p.x = (const float*)d_in[0]; p.mem = (const float*)d_in[1]; p.w_in = (const float*)d_in[2]; p.b_in = (const float*)d_in[3];
  p.sgu_g = (const float*)d_in[4]; p.sgu_b = (const float*)d_in[5]; p.w_sp = (const float*)d_in[6]; p.b_sp = (const float*)d_in[7];
  p.conv_w = (const float*)d_in[8]; p.w_mo = (const float*)d_in[9]; p.ln1_g = (const float*)d_in[10]; p.ln1_b = (const float*)d_in[11];
  p.w_xq = (const float*)d_in[12]; p.w_xkv = (const float*)d_in[13]; p.w_xo = (const float*)d_in[14]; p.ln2_g = (const float*)d_in[15]; p.ln2_b = (const float*)d_in[16];
  p.w_pq = (const float*)d_in[17]; p.sub_keys = (const float*)d_in[18]; p.w_down = (const float*)d_in[19]; p.w_up = (const float*)d_in[20];
  p.ln3_g = (const float*)d_in[21]; p.ln3_b = (const float*)d_in[22];
  p.out = (float*)d_out;
  p.slabs = w8;
  bf16_t* wb = (bf16_t*)(w8 + 448 * MiB);
  p.w_inT = wb; p.w_inQ = (signed char*)wb; wb += (size_t)INW * DM / 2; p.sw_in = (float*)wb; wb += 2 * INW; p.w_moT = wb; wb += (size_t)DM * DM; p.wsb = wb; wb += 4 * 128 * 128;
  p.w_xqT = wb; p.w_xqQ = (signed char*)wb; wb += (size_t)DM * DM / 2; p.sw_xq = (float*)wb; wb += 2 * DM; p.w_xkvT = wb; wb += (size_t)2048 * DM; p.w_xoT = wb; wb += (size_t)DM * DM;
  p.memB = wb; wb += (size_t)1024 * DM; p.Kc = wb; wb += (size_t)1024 * DM; p.VTc = wb; wb += (size_t)1024 * DM;
  p.w_pqT = wb; wb += (size_t)2048 * DM; p.skb = wb; wb += (size_t)8 * 2 * 128 * 128;
  p.WDq = (const unsigned char*)wb; wb += (size_t)16384 * DM / 2; p.WUq = (const unsigned char*)wb; wb += (size_t)16384 * DM / 2;
  p.sd = (const float*)wb; wb += 2 * 16384; p.su = (const float*)wb; wb += 2 * 16384;
  p.HALO = wb; wb += (size_t)256 * 2 * 512;
  p.SX = (float*)wb; wb += 2 * NTOK; p.SX1 = (float*)wb; wb += 2 * NTOK;
  p.bar = (unsigned*)wb; wb += 2 * 4096;
  if ((size_t)((char*)wb - w8) > ws_size) fprintf(stderr, "kernel_launch: workspace too small\n");
  (void)hipMemsetAsync(p.bar, 0, XCD_BAR_WORDS * 4, stream);
  void* args[] = {&p};
  hipError_t e = hipLaunchCooperativeKernel((const void*)mega_k, dim3(grid_blocks), dim3(512), args, LDS_BYTES, stream);
  if (e != hipSuccess) fprintf(stderr, "cooperative launch failed: %s (grid %d)\n", hipGetErrorString(e), grid_blocks);
}
```

```cpp
#include <hip/hip_runtime.h>
#include <stdint.h>
#include <cstdio>

#define DM 1024
#define NTOK 32768
#define SEQ 8192
#define INW 2560
#define ALPHA 1.189207115002721f
#define LN_EPS 1e-5f

__device__ __forceinline__ float gelu_f(float v) {
  const float t = __builtin_amdgcn_rcpf(fabsf(v) * 0.2316418882f + 1.0f);
  float q = t * 0.5307027145f + (-0.7265760135f); q = q * t + 0.7107068705f; q = q * t + (-0.142248368f); q = q * t + 0.127414796f; q = q * t;
  const float e = __builtin_amdgcn_exp2f((v * v) * (-0.72134752044f));
  const float m = v * (q * e);
  return v < 0.f ? m : v - m;
}

typedef unsigned short bf16_t;
typedef short bf16x8 __attribute__((ext_vector_type(8)));
typedef float f32x4 __attribute__((ext_vector_type(4)));
typedef unsigned u32x4 __attribute__((ext_vector_type(4)));
typedef unsigned u32x2 __attribute__((ext_vector_type(2)));
#define LAS __attribute__((address_space(3)))
extern __shared__ __attribute__((aligned(16))) char smem_raw[];

typedef float f32x2_t __attribute__((ext_vector_type(2)));
typedef __bf16 bf16x2_t __attribute__((ext_vector_type(2)));
typedef _Float16 f16x2_t __attribute__((ext_vector_type(2)));
__device__ __forceinline__ unsigned pk_f16(float lo, float hi) { const f32x2_t v = {lo, hi}; return __builtin_bit_cast(unsigned, __builtin_convertvector(v, f16x2_t)); }
__device__ __forceinline__ float f16_lo(unsigned u) { return (float)__builtin_bit_cast(f16x2_t, u)[0]; }
__device__ __forceinline__ float f16_hi(unsigned u) { return (float)__builtin_bit_cast(f16x2_t, u)[1]; }
__device__ __forceinline__ unsigned pk_bf16(float lo, float hi) { const f32x2_t v = {lo, hi}; return __builtin_bit_cast(unsigned, __builtin_convertvector(v, bf16x2_t)); }
__device__ __forceinline__ int otid() { int t = threadIdx.x; asm volatile("" : "+v"(t)); return t; }
__device__ __forceinline__ unsigned pack4_i8(float a, float b, float c, float d) {
  const int ia = __float2int_rn(a), ib = __float2int_rn(b), ic = __float2int_rn(c), id = __float2int_rn(d);
  return ((unsigned)ia & 0xffu) | (((unsigned)ib & 0xffu) << 8) | (((unsigned)ic & 0xffu) << 16) | ((unsigned)id << 24);
}
__device__ __forceinline__ float bf_lo(unsigned u) { return __uint_as_float(u << 16); }
__device__ __forceinline__ float bf_hi(unsigned u) { return __uint_as_float(u & 0xffff0000u); }

template <int BN, class Epi>
__device__ __forceinline__ void wg_gemm(const bf16_t* __restrict__ A, int lda, const bf16_t* __restrict__ Bt, int ldb, int K, Epi&& epi) {
  constexpr int NT = BN / 64;
  constexpr int STAGE_BYTES = (128 + BN) * 128;
  constexpr int LA = 2, LB = BN / 64;
  LAS char* lds = (LAS char*)smem_raw;
  const int tid = otid(), lane = tid & 63, wid = tid >> 6, wr = wid >> 2, wc = wid & 3, fr = lane & 15, fq = lane >> 4;
  f32x4 acc[4][NT];
#pragma unroll
  for (int m = 0; m < 4; ++m)
#pragma unroll
    for (int n = 0; n < NT; ++n) acc[m][n] = (f32x4){0.f, 0.f, 0.f, 0.f};
  const int nk = K / 64;
  auto stage = [&](int buf, int kt) {
    LAS char* base = lds + buf * STAGE_BYTES;
#pragma unroll
    for (int i = 0; i < LA; ++i) {
      const int q = tid + i * 512, row = q >> 3, c = (q & 7) ^ (row & 7);
      __builtin_amdgcn_global_load_lds((const unsigned*)(A + (long)row * lda + kt * 64 + c * 8), (LAS unsigned*)(base + q * 16), 16, 0, 2);
    }
#pragma unroll
    for (int i = 0; i < LB; ++i) {
      const int q = tid + i * 512, row = q >> 3, c = (q & 7) ^ (row & 7);
      __builtin_amdgcn_global_load_lds((const unsigned*)(Bt + (long)row * ldb + kt * 64 + c * 8), (LAS unsigned*)(base + 16384 + q * 16), 16, 0, 0);
    }
  };
  asm volatile("s_waitcnt vmcnt(0)" ::: "memory");
  __builtin_amdgcn_s_barrier();
  asm volatile("" ::: "memory");
  stage(0, 0);
  if (nk > 1) stage(1, 1);
  for (int kt = 0; kt < nk; ++kt) {
    if (kt + 1 < nk) asm volatile("s_waitcnt vmcnt(%0)" ::"n"(LA + LB) : "memory");
    else asm volatile("s_waitcnt vmcnt(0)" ::: "memory");
    __builtin_amdgcn_s_barrier();
    asm volatile("" ::: "memory");
    if (kt + 2 < nk) stage((kt + 2) % 3, kt + 2);
    LAS const char* base = lds + (kt % 3) * STAGE_BYTES;
    bf16x8 af[4][2], bfr[NT][2];
#pragma unroll
    for (int m = 0; m < 4; ++m)
#pragma unroll
      for (int kk = 0; kk < 2; ++kk) {
        const int row = wr * 64 + m * 16 + fr, c = (kk * 4 + fq) ^ (fr & 7);
        af[m][kk] = *(LAS const bf16x8*)(base + row * 128 + c * 16);
      }
#pragma unroll
    for (int n = 0; n < NT; ++n)
#pragma unroll
      for (int kk = 0; kk < 2; ++kk) {
        const int row = wc * (BN / 4) + n * 16 + fr, c = (kk * 4 + fq) ^ (fr & 7);
        bfr[n][kk] = *(LAS const bf16x8*)(base + 16384 + row * 128 + c * 16);
      }
#pragma unroll
    for (int kk = 0; kk < 2; ++kk)
#pragma unroll
      for (int m = 0; m < 4; ++m)
#pragma unroll
        for (int n = 0; n < NT; ++n) acc[m][n] = __builtin_amdgcn_mfma_f32_16x16x32_bf16(bfr[n][kk], af[m][kk], acc[m][n], 0, 0, 0);
  }
  epi(acc, wr, wc, fr, fq);
}

typedef int v4i_t __attribute__((ext_vector_type(4)));
template <int BN, class Epi>
__device__ __forceinline__ void wg_gemm_i8(const signed char* __restrict__ A, int lda, const signed char* __restrict__ Bt, int ldb, int K, Epi&& epi) {
  constexpr int NT = BN / 64;
  constexpr int STAGE_BYTES = (128 + BN) * 128;
  constexpr int LA = 2, LB = BN / 64;
  LAS char* lds = (LAS char*)smem_raw;
  const int tid = otid(), lane = tid & 63, wid = tid >> 6, wr = wid >> 2, wc = wid & 3, fr = lane & 15, fq = lane >> 4;
  v4i_t acc[4][NT];
#pragma unroll
  for (int m = 0; m < 4; ++m)
#pragma unroll
    for (int n = 0; n < NT; ++n) acc[m][n] = (v4i_t){0, 0, 0, 0};
  const int nk = K / 128;
  auto stage = [&](int buf, int kt) {
    LAS char* base = lds + buf * STAGE_BYTES;
#pragma unroll
    for (int i = 0; i < LA; ++i) {
      const int q = tid + i * 512, row = q >> 3, c = (q & 7) ^ (row & 7);
      __builtin_amdgcn_global_load_lds((const unsigned*)(A + (long)row * lda + kt * 128 + c * 16), (LAS unsigned*)(base + q * 16), 16, 0, 2);
    }
#pragma unroll
    for (int i = 0; i < LB; ++i) {
      const int q = tid + i * 512, row = q >> 3, c = (q & 7) ^ (row & 7);
      __builtin_amdgcn_global_load_lds((const unsigned*)(Bt + (long)row * ldb + kt * 128 + c * 16), (LAS unsigned*)(base + 16384 + q * 16), 16, 0, 0);
    }
  };
  asm volatile("s_waitcnt vmcnt(0)" ::: "memory");
  __builtin_amdgcn_s_barrier();
  asm volatile("" ::: "memory");
  stage(0, 0);
  if (nk > 1) stage(1, 1);
  for (int kt = 0; kt < nk; ++kt) {
    if (kt + 1 < nk) asm volatile("s_waitcnt vmcnt(%0)" ::"n"(LA + LB) : "memory");
    else asm volatile("s_waitcnt vmcnt(0)" ::: "memory");
    __builtin_amdgcn_s_barrier();
    asm volatile("" ::: "memory");
    if (kt + 2 < nk) stage((kt + 2) % 3, kt + 2);
    LAS const char* base = lds + (kt % 3) * STAGE_BYTES;
    v4i_t af[4][2], bfr[NT][2];
#pragma unroll
    for (int m = 0; m < 4; ++m)
#pragma unroll
      for (int kk = 0; kk < 2; ++kk) {
        const int row = wr * 64 + m * 16 + fr, c = (kk * 4 + fq) ^ (fr & 7);
        af[m][kk] = *(LAS const v4i_t*)(base + row * 128 + c * 16);
      }
#pragma unroll
    for (int n = 0; n < NT; ++n)
#pragma unroll
      for (int kk = 0; kk < 2; ++kk) {
        const int row = wc * (BN / 4) + n * 16 + fr, c = (kk * 4 + fq) ^ (fr & 7);
        bfr[n][kk] = *(LAS const v4i_t*)(base + 16384 + row * 128 + c * 16);
      }
#pragma unroll
    for (int kk = 0; kk < 2; ++kk)
#pragma unroll
      for (int m = 0; m < 4; ++m)
#pragma unroll
        for (int n = 0; n < NT; ++n) acc[m][n] = __builtin_amdgcn_mfma_i32_16x16x64_i8(bfr[n][kk], af[m][kk], acc[m][n], 0, 0, 0);
  }
  epi(acc, wr, wc, fr, fq);
}

#define GEMM_LDS_BYTES (3 * (128 + 256) * 128)
#define RED_OFF GEMM_LDS_BYTES
#define XB_LDS_OFF (GEMM_LDS_BYTES + 4096)
#define LDS_BYTES (GEMM_LDS_BYTES + 4096 + 16)

struct P {
  const float* x; const float* mem; const float* b_in; const float* sgu_g; const float* sgu_b; const float* b_sp; const float* conv_w;
  const float* ln1_g; const float* ln1_b; const float* ln2_g; const float* ln2_b; const float* ln3_g; const float* ln3_b;
  const bf16_t* XB; const bf16_t* w_inT; const bf16_t* w_moT; const bf16_t* wsb;
  bf16_t* ZB; bf16_t* VT; bf16_t* Y; float* PRE; bf16_t* X1;
  const bf16_t* w_xqT; const bf16_t* w_xkvT; const bf16_t* w_xoT; const bf16_t* memB;
  bf16_t* Kc; bf16_t* VTc; bf16_t* Q; bf16_t* Pb; bf16_t* O; bf16_t* X2;
  const bf16_t* w_pqT;
  const bf16_t* wpqB;
  const bf16_t* skb; unsigned* KEYS; unsigned char* X1Q; int* experts; float* gates;
  const unsigned char* WDq; const unsigned char* WUq; const float* sd; const float* su; float* out;
  signed char* w_inQ; float* sw_in; signed char* w_xqQ; float* sw_xq; float* SX1;
  char* slabs;
  unsigned* bar; unsigned char* XQ; float* SX; int* PD; float* H3;
  bf16_t* HALO;
  const float* w_in; const float* w_mo; const float* w_sp; const float* w_xq; const float* w_xkv; const float* w_xo; const float* w_pq; const float* sub_keys; const float* w_down; const float* w_up;
};

#define SLAB_BYTES (1792 * 1024)
#define OFF_XB 0
#define OFF_EXP 0
#define OFF_GATE (64 * 1024)
#define OFF_CQ (128 * 1024)
#define OFF_SC (144 * 1024)
#define OFF_X2Q (128 * 1024)
#define OFF_ZB (256 * 1024)
#define OFF_VT (896 * 1024)
#define OFF_Y (1024 * 1024)
#define OFF_Q (1280 * 1024)
#define OFF_O (1536 * 1024)
__device__ __forceinline__ void wg_sync_mem() { asm volatile("s_waitcnt vmcnt(0) lgkmcnt(0)" ::: "memory"); __syncthreads(); }

#define OFF_SXB (128 * 1024)
__device__ __forceinline__ void phase_inproj(const P& p, int tile) {
  const signed char* xq = (const signed char*)(p.slabs + (size_t)tile * SLAB_BYTES + OFF_XB);
  const float* sxr = (const float*)(p.slabs + (size_t)tile * SLAB_BYTES + OFF_SXB);
  for (int nt = 0; nt < INW / 256; ++nt) {
    wg_gemm_i8<256>(xq, DM, p.w_inQ + (long)nt * 256 * DM, DM, DM, [&](v4i_t (&acc)[4][4], int wr, int wc, int fr, int fq) {
#pragma unroll
      for (int m = 0; m < 4; ++m) {
        const int rl = wr * 64 + m * 16 + fr;
        const float sr = sxr[rl];
#pragma unroll
        for (int n = 0; n < 4; ++n) {
          const int row = tile * 128 + rl, col = nt * 256 + wc * 64 + n * 16 + fq * 4;
          const float4 bv = *(const float4*)(p.b_in + col), sw = *(const float4*)(p.sw_in + col);
          float o0 = (float)acc[m][n][0] * (sr * sw.x) + bv.x, o1 = (float)acc[m][n][1] * (sr * sw.y) + bv.y, o2 = (float)acc[m][n][2] * (sr * sw.z) + bv.z, o3 = (float)acc[m][n][3] * (sr * sw.w) + bv.w;
          if (nt < 4) { o0 = gelu_f(o0); o1 = gelu_f(o1); o2 = gelu_f(o2); o3 = gelu_f(o3); }
          u32x2 w; w.x = pk_bf16(o0, o1); w.y = pk_bf16(o2, o3);
          *(u32x2*)(p.ZB + (long)row * INW + col) = w;
        }
      }
    });
  }
}

__device__ __forceinline__ void phase_mixer(const P& p, int tile) {
  const int tid = otid(), lane = tid & 63, wid = tid >> 6;
  const long t0 = (long)tile * 128;
  const bool seq_start = ((tile & 63) == 0);
#pragma unroll 2
  for (int it = tid; it < 128 * 64; it += 512) {
    const int tl = it >> 6, c = (it & 63) * 8;
    const long t = t0 + tl;
    float conv[8];
#pragma unroll
    for (int j = 0; j < 8; ++j) conv[j] = 0.f;
#pragma unroll
    for (int k = 0; k < 3; ++k) {
      const int rl = tl - 2 + k;
      const float4 w0 = *(const float4*)(p.conv_w + k * 512 + c), w1 = *(const float4*)(p.conv_w + k * 512 + c + 4);
      if (rl >= 0) {
        const bf16_t* zr = p.ZB + (t0 + rl) * INW;
        const u32x4 hb = *(const u32x4*)(zr + 1024 + c), gc = *(const u32x4*)(zr + 2048 + c);
        conv[0] += w0.x * (bf_lo(hb.x) * bf_lo(gc.x)); conv[1] += w0.y * (bf_hi(hb.x) * bf_hi(gc.x));
        conv[2] += w0.z * (bf_lo(hb.y) * bf_lo(gc.y)); conv[3] += w0.w * (bf_hi(hb.y) * bf_hi(gc.y));
        conv[4] += w1.x * (bf_lo(hb.z) * bf_lo(gc.z)); conv[5] += w1.y * (bf_hi(hb.z) * bf_hi(gc.z));
        conv[6] += w1.z * (bf_lo(hb.w) * bf_lo(gc.w)); conv[7] += w1.w * (bf_hi(hb.w) * bf_hi(gc.w));
      } else if (!seq_start) {
        const u32x4 zc = *(const u32x4*)(p.HALO + ((long)(tile - 1) * 2 + (rl + 2)) * 512 + c);
        conv[0] += w0.x * bf_lo(zc.x); conv[1] += w0.y * bf_hi(zc.x); conv[2] += w0.z * bf_lo(zc.y); conv[3] += w0.w * bf_hi(zc.y);
        conv[4] += w1.x * bf_lo(zc.z); conv[5] += w1.y * bf_hi(zc.z); conv[6] += w1.z * bf_lo(zc.w); conv[7] += w1.w * bf_hi(zc.w);
      }
    }
    const u32x4 gb = *(const u32x4*)(p.ZB + t * INW + 1536 + c);
    u32x4 o;
    o.x = pk_bf16(bf_lo(gb.x) * conv[0], bf_hi(gb.x) * conv[1]); o.y = pk_bf16(bf_lo(gb.y) * conv[2], bf_hi(gb.y) * conv[3]);
    o.z = pk_bf16(bf_lo(gb.z) * conv[4], bf_hi(gb.z) * conv[5]); o.w = pk_bf16(bf_lo(gb.w) * conv[6], bf_hi(gb.w) * conv[7]);
    *(u32x4*)(p.Y + t * DM + 512 + c) = o;
  }
  for (int h = 0; h < 4; ++h) {
    float a0[16], a1[16];
    const float g0 = p.sgu_g[h * 128 + 2 * lane], g1 = p.sgu_g[h * 128 + 2 * lane + 1], b0 = p.sgu_b[h * 128 + 2 * lane], b1 = p.sgu_b[h * 128 + 2 * lane + 1];
#pragma unroll
    for (int i = 0; i < 16; ++i) {
      const unsigned v = *(const unsigned*)(p.ZB + (t0 + wid * 16 + i) * INW + 512 + h * 128 + 2 * lane);
      const float x0 = bf_lo(v), x1 = bf_hi(v);
      float sum = x0 + x1;
#pragma unroll
      for (int o = 32; o > 0; o >>= 1) sum += __shfl_xor(sum, o);
      const float mu = sum * (1.f / 128.f);
      const float d0 = x0 - mu, d1 = x1 - mu;
      float q = d0 * d0 + d1 * d1;
#pragma unroll
      for (int o = 32; o > 0; o >>= 1) q += __shfl_xor(q, o);
      const float rstd = rsqrtf(q * (1.f / 128.f) + LN_EPS);
      a0[i] = d0 * rstd * g0 + b0; a1[i] = d1 * rstd * g1 + b1;
    }
    bf16_t* vt = p.VT + ((long)tile * 4 + h) * 128 * 128;
    u32x4 o;
    o.x = pk_bf16(a0[0], a0[1]); o.y = pk_bf16(a0[2], a0[3]); o.z = pk_bf16(a0[4], a0[5]); o.w = pk_bf16(a0[6], a0[7]);
    *(u32x4*)(vt + (2 * lane) * 128 + wid * 16) = o;
    o.x = pk_bf16(a0[8], a0[9]); o.y = pk_bf16(a0[10], a0[11]); o.z = pk_bf16(a0[12], a0[13]); o.w = pk_bf16(a0[14], a0[15]);
    *(u32x4*)(vt + (2 * lane) * 128 + wid * 16 + 8) = o;
    o.x = pk_bf16(a1[0], a1[1]); o.y = pk_bf16(a1[2], a1[3]); o.z = pk_bf16(a1[4], a1[5]); o.w = pk_bf16(a1[6], a1[7]);
    *(u32x4*)(vt + (2 * lane + 1) * 128 + wid * 16) = o;
    o.x = pk_bf16(a1[8], a1[9]); o.y = pk_bf16(a1[10], a1[11]); o.z = pk_bf16(a1[12], a1[13]); o.w = pk_bf16(a1[14], a1[15]);
    *(u32x4*)(vt + (2 * lane + 1) * 128 + wid * 16 + 8) = o;
  }
  wg_sync_mem();
  for (int h = 0; h < 4; ++h) {
    wg_gemm<128>(p.wsb + h * 128 * 128, 128, p.VT + ((long)tile * 4 + h) * 128 * 128, 128, 128, [&](f32x4 (&acc)[4][2], int wr, int wc, int fr, int fq) {
#pragma unroll
      for (int m = 0; m < 4; ++m)
#pragma unroll
        for (int n = 0; n < 2; ++n) {
          const int rl = wr * 64 + m * 16 + fr, col = wc * 32 + n * 16 + fq * 4;
          const float bs = p.b_sp[h * 128 + rl];
          const u32x2 uv = *(const u32x2*)(p.ZB + (t0 + rl) * INW + h * 128 + col);
          u32x2 w;
          w.x = pk_bf16(bf_lo(uv.x) * (acc[m][n][0] + bs), bf_hi(uv.x) * (acc[m][n][1] + bs));
          w.y = pk_bf16(bf_lo(uv.y) * (acc[m][n][2] + bs), bf_hi(uv.y) * (acc[m][n][3] + bs));
          *(u32x2*)(p.Y + (t0 + rl) * DM + h * 128 + col) = w;
        }
    });
  }
}

__device__ __forceinline__ void ln_rows16(const float* __restrict__ PRE, long r0, const float* __restrict__ g, const float* __restrict__ b, bf16_t* __restrict__ Out, int lane) {
#pragma unroll 2
  for (int i = 0; i < 16; ++i) {
    const bf16_t* pr = (const bf16_t*)PRE + (r0 + i) * DM;
    float4 v[4];
    float sum = 0.f;
#pragma unroll
    for (int j = 0; j < 4; ++j) { const u32x2 pv = *(const u32x2*)(pr + j * 256 + lane * 4); v[j].x = bf_lo(pv.x); v[j].y = bf_hi(pv.x); v[j].z = bf_lo(pv.y); v[j].w = bf_hi(pv.y); sum += (v[j].x + v[j].y) + (v[j].z + v[j].w); }
#pragma unroll
    for (int o = 32; o > 0; o >>= 1) sum += __shfl_xor(sum, o);
    const float mu = sum * (1.f / DM);
    float q = 0.f;
#pragma unroll
    for (int j = 0; j < 4; ++j) { v[j].x -= mu; v[j].y -= mu; v[j].z -= mu; v[j].w -= mu; q += (v[j].x * v[j].x + v[j].y * v[j].y) + (v[j].z * v[j].z + v[j].w * v[j].w); }
#pragma unroll
    for (int o = 32; o > 0; o >>= 1) q += __shfl_xor(q, o);
    const float rstd = rsqrtf(q * (1.f / DM) + LN_EPS);
#pragma unroll
    for (int j = 0; j < 4; ++j) {
      const int c0 = j * 256 + lane * 4;
      const float4 gg = *(const float4*)(g + c0), bb = *(const float4*)(b + c0);
      u32x2 w; w.x = pk_bf16(v[j].x * rstd * gg.x + bb.x, v[j].y * rstd * gg.y + bb.y); w.y = pk_bf16(v[j].z * rstd * gg.z + bb.z, v[j].w * rstd * gg.w + bb.w);
      *(u32x2*)(Out + (r0 + i) * DM + c0) = w;
    }
  }
}

__device__ __forceinline__ void ln_rows16_q(const float* __restrict__ PRE, long r0, const float* __restrict__ g, const float* __restrict__ b, bf16_t* __restrict__ Out,
                                            unsigned char* __restrict__ XQ, float* __restrict__ SX, int lane) {
#pragma unroll 2
  for (int i = 0; i < 16; ++i) {
    const bf16_t* pr = (const bf16_t*)PRE + (r0 + i) * DM;
    float4 v[4];
    float sum = 0.f;
#pragma unroll
    for (int j = 0; j < 4; ++j) { const u32x2 pv = *(const u32x2*)(pr + j * 256 + lane * 4); v[j].x = bf_lo(pv.x); v[j].y = bf_hi(pv.x); v[j].z = bf_lo(pv.y); v[j].w = bf_hi(pv.y); sum += (v[j].x + v[j].y) + (v[j].z + v[j].w); }
#pragma unroll
    for (int o = 32; o > 0; o >>= 1) sum += __shfl_xor(sum, o);
    const float mu = sum * (1.f / DM);
    float q = 0.f;
#pragma unroll
    for (int j = 0; j < 4; ++j) { v[j].x -= mu; v[j].y -= mu; v[j].z -= mu; v[j].w -= mu; q += (v[j].x * v[j].x + v[j].y * v[j].y) + (v[j].z * v[j].z + v[j].w * v[j].w); }
#pragma unroll
    for (int o = 32; o > 0; o >>= 1) q += __shfl_xor(q, o);
    const float rstd = rsqrtf(q * (1.f / DM) + LN_EPS);
    float amax = 0.f;
#pragma unroll
    for (int j = 0; j < 4; ++j) {
      const int c0 = j * 256 + lane * 4;
      const float4 gg = *(const float4*)(g + c0), bb = *(const float4*)(b + c0);
      v[j].x = v[j].x * rstd * gg.x + bb.x; v[j].y = v[j].y * rstd * gg.y + bb.y; v[j].z = v[j].z * rstd * gg.z + bb.z; v[j].w = v[j].w * rstd * gg.w + bb.w;
      u32x2 w; w.x = pk_bf16(v[j].x, v[j].y); w.y = pk_bf16(v[j].z, v[j].w);
      *(u32x2*)(Out + (r0 + i) * DM + c0) = w;
      amax = fmaxf(amax, fmaxf(fmaxf(fabsf(v[j].x), fabsf(v[j].y)), fmaxf(fabsf(v[j].z), fabsf(v[j].w))));
    }
#pragma unroll
    for (int o = 32; o > 0; o >>= 1) amax = fmaxf(amax, __shfl_xor(amax, o));
    const float inv = amax > 0.f ? 127.f / amax : 0.f;
#pragma unroll
    for (int j = 0; j < 4; ++j) *(unsigned*)(XQ + (r0 + i) * DM + j * 256 + lane * 4) = pack4_i8(v[j].x * inv, v[j].y * inv, v[j].z * inv, v[j].w * inv);
    if (lane == 0) SX[r0 + i] = amax * (1.f / 127.f);
  }
}

__device__ __forceinline__ void phase_outproj(const P& p, int tile) {
  const long t0 = (long)tile * 128;
  for (int nt = 0; nt < 4; ++nt) {
    wg_gemm<256>(p.Y + t0 * DM, DM, p.w_moT + (long)nt * 256 * DM, DM, DM, [&](f32x4 (&acc)[4][4], int wr, int wc, int fr, int fq) {
#pragma unroll
      for (int m = 0; m < 4; ++m)
#pragma unroll
        for (int n = 0; n < 4; ++n) {
          const long row = t0 + wr * 64 + m * 16 + fr; const int col = nt * 256 + wc * 64 + n * 16 + fq * 4;
          const float4 xv = *(const float4*)(p.x + row * DM + col);
          u32x2 o; o.x = pk_bf16(ALPHA * xv.x + acc[m][n][0], ALPHA * xv.y + acc[m][n][1]); o.y = pk_bf16(ALPHA * xv.z + acc[m][n][2], ALPHA * xv.w + acc[m][n][3]);
          *(u32x2*)((bf16_t*)p.PRE + row * DM + col) = o;
        }
    });
  }
  wg_sync_mem();
  ln_rows16_q(p.PRE, t0 + (threadIdx.x >> 6) * 16, p.ln1_g, p.ln1_b, p.X1, p.X1Q, p.SX1, threadIdx.x & 63);
}

__device__ __forceinline__ void phase_kv(const P& p, int unit) {
  const int rt = unit >> 5, nc = unit & 31;
  wg_gemm<64>(p.memB + (long)rt * 128 * DM, DM, p.w_xkvT + (long)nc * 64 * DM, DM, DM, [&](f32x4 (&acc)[4][1], int wr, int wc, int fr, int fq) {
    const int b = rt >> 1, col = nc * 64 + wc * 16 + fq * 4, hh = (col >> 8) & 3, d = col & 255;
#pragma unroll
    for (int m = 0; m < 4; ++m) {
      const int mm = (rt & 1) * 128 + wr * 64 + m * 16 + fr;
      if (col < 1024) {
        u32x2 w; w.x = pk_bf16(acc[m][0][0], acc[m][0][1]); w.y = pk_bf16(acc[m][0][2], acc[m][0][3]);
        *(u32x2*)(p.Kc + ((long)(b * 4 + hh) * 256 + mm) * 256 + d) = w;
      } else {
        bf16_t* vt = p.VTc + ((long)(b * 4 + hh) * 256 + d) * 256 + mm;
        const unsigned w0 = pk_bf16(acc[m][0][0], acc[m][0][1]), w1 = pk_bf16(acc[m][0][2], acc[m][0][3]);
        vt[0] = (bf16_t)(w0 & 0xffffu); vt[256] = (bf16_t)(w0 >> 16); vt[512] = (bf16_t)(w1 & 0xffffu); vt[768] = (bf16_t)(w1 >> 16);
      }
    }
  });
}

__device__ __forceinline__ void phase_qproj(const P& p, int tile) {
  const long t0 = (long)tile * 128;
  for (int nt = 0; nt < 4; ++nt) {
    wg_gemm_i8<256>((const signed char*)p.X1Q + t0 * DM, DM, p.w_xqQ + (long)nt * 256 * DM, DM, DM, [&](v4i_t (&acc)[4][4], int wr, int wc, int fr, int fq) {
#pragma unroll
      for (int m = 0; m < 4; ++m) {
        const long row = t0 + wr * 64 + m * 16 + fr;
        const float sr = p.SX1[row] * 0.0625f;
#pragma unroll
        for (int n = 0; n < 4; ++n) {
          const int col = nt * 256 + wc * 64 + n * 16 + fq * 4;
          const float4 sw = *(const float4*)(p.sw_xq + col);
          u32x2 w; w.x = pk_bf16((float)acc[m][n][0] * (sr * sw.x), (float)acc[m][n][1] * (sr * sw.y)); w.y = pk_bf16((float)acc[m][n][2] * (sr * sw.z), (float)acc[m][n][3] * (sr * sw.w));
          *(u32x2*)(p.Q + row * DM + col) = w;
        }
      }
    });
  }
}

__device__ __forceinline__ void phase_attn(const P& p, int tile) {
  const long t0 = (long)tile * 128;
  const int b = tile >> 6;
  LAS float* red = (LAS float*)((LAS char*)smem_raw + RED_OFF);
  for (int h = 0; h < 4; ++h) {
    bf16_t* Pw = p.Pb + ((long)tile * 4 + h) * 128 * 256;
    wg_gemm<256>(p.Q + t0 * DM + h * 256, DM, p.Kc + (long)(b * 4 + h) * 256 * 256, 256, 256, [&](f32x4 (&acc)[4][4], int wr, int wc, int fr, int fq) {
      float rmax[4];
#pragma unroll
      for (int m = 0; m < 4; ++m) {
        float mx = -3.0e38f;
#pragma unroll
        for (int n = 0; n < 4; ++n) mx = fmaxf(mx, fmaxf(fmaxf(acc[m][n][0], acc[m][n][1]), fmaxf(acc[m][n][2], acc[m][n][3])));
        mx = fmaxf(mx, __shfl_xor(mx, 16)); mx = fmaxf(mx, __shfl_xor(mx, 32));
        if (fq == 0) red[(wr * 64 + m * 16 + fr) * 4 + wc] = mx;
      }
      __syncthreads();
#pragma unroll
      for (int m = 0; m < 4; ++m) {
        const f32x4 r = *(LAS const f32x4*)(red + (wr * 64 + m * 16 + fr) * 4);
        rmax[m] = fmaxf(fmaxf(r[0], r[1]), fmaxf(r[2], r[3]));
      }
#pragma unroll
      for (int m = 0; m < 4; ++m) {
        float sm = 0.f;
#pragma unroll
        for (int n = 0; n < 4; ++n)
#pragma unroll
          for (int j = 0; j < 4; ++j) { const float e = __expf(acc[m][n][j] - rmax[m]); acc[m][n][j] = e; sm += e; }
        sm += __shfl_xor(sm, 16); sm += __shfl_xor(sm, 32);
        if (fq == 0) red[512 + (wr * 64 + m * 16 + fr) * 4 + wc] = sm;
      }
      __syncthreads();
#pragma unroll
      for (int m = 0; m < 4; ++m) {
        const f32x4 r = *(LAS const f32x4*)(red + 512 + (wr * 64 + m * 16 + fr) * 4);
        const float inv = 1.f / ((r[0] + r[1]) + (r[2] + r[3]));
        const int rl = wr * 64 + m * 16 + fr;
#pragma unroll
        for (int n = 0; n < 4; ++n) {
          u32x2 w; w.x = pk_bf16(acc[m][n][0] * inv, acc[m][n][1] * inv); w.y = pk_bf16(acc[m][n][2] * inv, acc[m][n][3] * inv);
          *(u32x2*)(Pw + rl * 256 + wc * 64 + n * 16 + fq * 4) = w;
        }
      }
    });
    wg_sync_mem();
    wg_gemm<256>(Pw, 256, p.VTc + (long)(b * 4 + h) * 256 * 256, 256, 256, [&](f32x4 (&acc)[4][4], int wr, int wc, int fr, int fq) {
#pragma unroll
      for (int m = 0; m < 4; ++m)
#pragma unroll
        for (int n = 0; n < 4; ++n) {
          const long row = t0 + wr * 64 + m * 16 + fr; const int col = h * 256 + wc * 64 + n * 16 + fq * 4;
          u32x2 w; w.x = pk_bf16(acc[m][n][0], acc[m][n][1]); w.y = pk_bf16(acc[m][n][2], acc[m][n][3]);
          *(u32x2*)(p.O + row * DM + col) = w;
        }
    });
  }
}

__device__ __forceinline__ void phase_oproj(const P& p, int tile) {
  const long t0 = (long)tile * 128;
  for (int nt = 0; nt < 4; ++nt) {
    wg_gemm<256>(p.O + t0 * DM, DM, p.w_xoT + (long)nt * 256 * DM, DM, DM, [&](f32x4 (&acc)[4][4], int wr, int wc, int fr, int fq) {
#pragma unroll
      for (int m = 0; m < 4; ++m)
#pragma unroll
        for (int n = 0; n < 4; ++n) {
          const long row = t0 + wr * 64 + m * 16 + fr; const int col = nt * 256 + wc * 64 + n * 16 + fq * 4;
          const u32x2 xv = *(const u32x2*)(p.X1 + row * DM + col);
          u32x2 o; o.x = pk_bf16(ALPHA * bf_lo(xv.x) + acc[m][n][0], ALPHA * bf_hi(xv.x) + acc[m][n][1]); o.y = pk_bf16(ALPHA * bf_lo(xv.y) + acc[m][n][2], ALPHA * bf_hi(xv.y) + acc[m][n][3]);
          *(u32x2*)((bf16_t*)p.PRE + row * DM + col) = o;
        }
    });
  }
  wg_sync_mem();
  ln_rows16_q(p.PRE, t0 + (threadIdx.x >> 6) * 16, p.ln2_g, p.ln2_b, p.X2, p.XQ, p.SX, threadIdx.x & 63);
}

__device__ __forceinline__ unsigned f2key(float f) { const unsigned b = __float_as_uint(f); return b ^ ((unsigned)((int)b >> 31) | 0x80000000u); }
__device__ __forceinline__ float key2f(unsigned k) { return __uint_as_float(k ^ ((k & 0x80000000u) ? 0x80000000u : 0xffffffffu)); }
__device__ __forceinline__ void phase_pq(const P& p, int tile) {
  const long t0 = (long)tile * 128;
  for (int nt = 0; nt < 8; ++nt) {
    wg_gemm<256>(p.X2 + t0 * DM, DM, p.w_pqT + (long)nt * 256 * DM, DM, DM, [&](f32x4 (&acc)[4][4], int wr, int wc, int fr, int fq) {
#pragma unroll
      for (int m = 0; m < 4; ++m)
#pragma unroll
        for (int n = 0; n < 4; ++n) {
          const long row = t0 + wr * 64 + m * 16 + fr; const int col = nt * 256 + wc * 64 + n * 16 + fq * 4;
          u32x2 w; w.x = pk_f16(acc[m][n][0], acc[m][n][1]); w.y = pk_f16(acc[m][n][2], acc[m][n][3]);
          *(u32x2*)((unsigned short*)p.KEYS + row * 2048 + col) = w;
        }
    });
  }
}

__device__ __forceinline__ void phase_mt(const P& p, int unit) {
  const int hp = unit >> 2, nt = unit & 3;
  wg_gemm<256>(p.skb + (long)hp * 128 * 128, 128, p.wpqB + (long)nt * 256 * 2048 + hp * 128, 2048, 128, [&](f32x4 (&acc)[4][4], int wr, int wc, int fr, int fq) {
#pragma unroll
    for (int m = 0; m < 4; ++m)
#pragma unroll
      for (int n = 0; n < 4; ++n) {
        const int row = hp * 128 + wr * 64 + m * 16 + fr, col = nt * 256 + wc * 64 + n * 16 + fq * 4;
        u32x2 w; w.x = pk_bf16(acc[m][n][0], acc[m][n][1]); w.y = pk_bf16(acc[m][n][2], acc[m][n][3]);
        *(u32x2*)((bf16_t*)p.w_pqT + (long)row * DM + col) = w;
      }
  });
}

__device__ __forceinline__ unsigned cand_entry(int s) {
  unsigned e = 255u; int base = 0;
#pragma unroll
  for (int i = 0; i < 16; ++i) { const int cnt = 16 / (i + 1); if (s >= base && s < base + cnt) e = (unsigned)i | ((unsigned)(s - base) << 4); base += cnt; }
  return e;
}
template <int CTRL> __device__ __forceinline__ unsigned dpp_u(unsigned x) { return (unsigned)__builtin_amdgcn_mov_dpp((int)x, CTRL, 0xf, 0xf, true); }
template <int CTRL> __device__ __forceinline__ float dpp_f(float x) { return __int_as_float(__builtin_amdgcn_mov_dpp(__float_as_int(x), CTRL, 0xf, 0xf, true)); }
__device__ __forceinline__ unsigned umin_(unsigned a, unsigned b) { return a < b ? a : b; }
__device__ __forceinline__ unsigned row_min_u(unsigned x) {
  x = umin_(x, dpp_u<0x128>(x)); x = umin_(x, dpp_u<0x124>(x)); x = umin_(x, dpp_u<0x122>(x)); x = umin_(x, dpp_u<0x121>(x)); return x;
}
__device__ __forceinline__ float row_max_f(float x) { x = fmaxf(x, dpp_f<0x128>(x)); x = fmaxf(x, dpp_f<0x124>(x)); x = fmaxf(x, dpp_f<0x122>(x)); x = fmaxf(x, dpp_f<0x121>(x)); return x; }
__device__ __forceinline__ float row_sum_f(float x) { x += dpp_f<0x128>(x); x += dpp_f<0x124>(x); x += dpp_f<0x122>(x); x += dpp_f<0x121>(x); return x; }

#define KEYS_OFF 65536
#define KEY_STRIDE 528
template <int N> __device__ __forceinline__ unsigned top16_row(const unsigned (&k)[N], int r) {
  unsigned pm1 = 0xFFFFFFFEu, mine = 0;
#pragma unroll
  for (int rd = 0; rd < 16; ++rd) {
    unsigned d = pm1 - k[0];
#pragma unroll
    for (int i = 1; i < N; ++i) d = umin_(d, pm1 - k[i]);
    d = row_min_u(d);
    const unsigned nxt = pm1 - d;
    mine = (r == rd) ? nxt : mine;
    pm1 = nxt - 1;
  }
  return mine;
}

__device__ __forceinline__ void phase_route(const P& p, int tile) {
  const long t0 = (long)tile * 128;
  const int tid = otid(), lane = tid & 63, wid = tid >> 6, r = lane & 15, g = lane >> 4;
  LAS char* lds = (LAS char*)smem_raw;
  LAS unsigned char* tab = (LAS unsigned char*)(lds + RED_OFF);
  if (tid < 64) tab[tid] = (unsigned char)cand_entry(tid);
  unsigned ci[4], cj[4]; bool cval[4];
#pragma unroll
  for (int q = 0; q < 4; ++q) { const unsigned e = cand_entry(r * 4 + q); cval[q] = (e != 255u); ci[q] = ((unsigned)(g * 16) + (e & 15u)) * 4u; cj[q] = ((unsigned)(g * 16) + ((e >> 4) & 15u)) * 4u; }
  __syncthreads();
  auto load_keys = [&](int hp, u32x4 (&kb)[4]) {
#pragma unroll
    for (int ps = 0; ps < 4; ++ps) kb[ps] = *(const u32x4*)((const unsigned short*)p.KEYS + (t0 + wid * 16 + ps * 4 + g) * 2048 + hp * 128 + r * 8);
  };
  auto top_keys = [&](const u32x4 (&kb)[4], unsigned (&tp)[4]) {
#pragma unroll
    for (int ps = 0; ps < 4; ++ps) {
      const unsigned w[4] = {kb[ps].x, kb[ps].y, kb[ps].z, kb[ps].w};
      unsigned k[8];
#pragma unroll
      for (int i = 0; i < 4; ++i) {
        k[2 * i] = (f2key(f16_lo(w[i])) & ~127u) | (unsigned)(127 - (r * 8 + 2 * i));
        k[2 * i + 1] = (f2key(f16_hi(w[i])) & ~127u) | (unsigned)(126 - (r * 8 + 2 * i));
      }
      tp[ps] = top16_row<8>(k, r);
    }
  };
  u32x4 kA[4], kB[4];
  load_keys(0, kA);
  for (int h = 0; h < 8; ++h) {
    unsigned top[2][4];
    load_keys(h * 2 + 1, kB);
    top_keys(kA, top[0]);
    load_keys(h < 7 ? h * 2 + 2 : 15, kA);
    top_keys(kB, top[1]);
#pragma unroll
    for (int ps = 0; ps < 4; ++ps) {
      const int tk = wid * 16 + ps * 4 + g;
      const unsigned A = top[0][ps], B = top[1][ps];
      const float fa = key2f(A & ~127u), fb = key2f(B & ~127u);
      unsigned k2[4];
#pragma unroll
      for (int q = 0; q < 4; ++q) {
        const float va = __int_as_float(__builtin_amdgcn_ds_bpermute((int)ci[q], __float_as_int(fa)));
        const float vb = __int_as_float(__builtin_amdgcn_ds_bpermute((int)cj[q], __float_as_int(fb)));
        const unsigned kk = (f2key(va + vb) & ~63u) | (unsigned)(63 - (r * 4 + q));
        k2[q] = cval[q] ? kk : 0u;
      }
      const unsigned mine = top16_row<4>(k2, r);
      const unsigned slot = 63u - (mine & 63u);
      const unsigned e = tab[slot];
      const unsigned ka = (unsigned)__builtin_amdgcn_ds_bpermute((int)(((unsigned)(g * 16) + (e & 15u)) * 4u), (int)A);
      const unsigned kb = (unsigned)__builtin_amdgcn_ds_bpermute((int)(((unsigned)(g * 16) + ((e >> 4) & 15u)) * 4u), (int)B);
      const int expert = (int)((127u - (ka & 127u)) * 128u + (127u - (kb & 127u)));
      const float c = key2f(mine & ~63u);
      const float mx = row_max_f(c);
      const float ex = __expf(c - mx);
      const float sm = row_sum_f(ex);
      p.experts[(t0 + tk) * 128 + h * 16 + r] = expert;
      p.gates[(t0 + tk) * 128 + h * 16 + r] = ex / sm;
    }
  }
}

__device__ __forceinline__ f32x2_t ub01(unsigned w) { return (f32x2_t){(float)(w & 0xffu), (float)((w >> 8) & 0xffu)}; }
__device__ __forceinline__ f32x2_t ub23(unsigned w) { return (f32x2_t){(float)((w >> 16) & 0xffu), (float)(w >> 24)}; }
__device__ __forceinline__ int sum8_i(int x) {
  x += (int)dpp_u<0xB1>((unsigned)x); x += (int)dpp_u<0x4E>((unsigned)x); x += (int)dpp_u<0x141>((unsigned)x); return x;
}
struct GMeta { u32x4 xq; int er0, er1; };
__device__ __forceinline__ void phase_gdown(const P& p) {
  const int tid = otid(), lane = tid & 63, wid = tid >> 6, grp = lane >> 3, r8 = lane & 7;
  const int slice = blockIdx.x & 7, chunk = blockIdx.x >> 3;
  const unsigned char* tab = p.WDq + slice * 128 + r8 * 16;
  const char* sl = p.slabs + (size_t)(chunk * 8 + wid) * SLAB_BYTES;
  int* pd = (int*)(sl + OFF_ZB) + slice * 128 * 128;
  const unsigned char* xqb = (const unsigned char*)(sl + OFF_X2Q);
  const int* exb = (const int*)(sl + OFF_EXP);
  auto meta = [&](int ti, GMeta& m) {
    const int t = (ti < 127 ? ti : 127);
    m.xq = *(const u32x4*)(xqb + t * DM + slice * 128 + r8 * 16);
    m.er0 = exb[t * 128 + lane]; m.er1 = exb[t * 128 + 64 + lane];
  };
  auto issue = [&](const GMeta& m, u32x4 (&w)[16]) {
#pragma unroll
    for (int it = 0; it < 16; ++it) {
      const int e = __builtin_amdgcn_ds_bpermute(((it & 7) * 8 + grp) * 4, (it < 8) ? m.er0 : m.er1);
      w[it] = *(const u32x4*)(tab + (long)e * DM);
    }
  };
  auto consume = [&](int ti, const GMeta& m, const u32x4 (&w)[16]) {
    int c0 = 0, c1 = 0;
#pragma unroll
    for (int it = 0; it < 16; ++it) {
      int acc = __builtin_amdgcn_sdot4((int)w[it].x, (int)m.xq.x, 0, false);
      acc = __builtin_amdgcn_sdot4((int)w[it].y, (int)m.xq.y, acc, false); acc = __builtin_amdgcn_sdot4((int)w[it].z, (int)m.xq.z, acc, false); acc = __builtin_amdgcn_sdot4((int)w[it].w, (int)m.xq.w, acc, false);
      acc = sum8_i(acc);
      const bool mine = ((it & 7) == r8);
      c0 = (mine && it < 8) ? acc : c0;
      c1 = (mine && it >= 8) ? acc : c1;
    }
    pd[ti * 128 + r8 * 8 + grp] = c0; pd[ti * 128 + 64 + r8 * 8 + grp] = c1;
  };
  GMeta mA, mB; u32x4 wA[16], wB[16];
  meta(0, mA); issue(mA, wA); meta(1, mB);
  for (int ti = 0; ti < 128; ti += 2) {
    issue(mB, wB);
    consume(ti, mA, wA);
    meta(ti + 2, mA);
    issue(mA, wA);
    consume(ti + 1, mB, wB);
    meta(ti + 3, mB);
  }
}
__device__ __forceinline__ int cq_index(int k) { return ((k >> 5) * 8 + (k & 7)) * 4 + ((k >> 3) & 3); }
__device__ __forceinline__ void phase_gcomb(const P& p, int tile) {
  const int tid = otid(), lane = tid & 63, wid = tid >> 6;
  signed char* cq = (signed char*)(p.slabs + (size_t)tile * SLAB_BYTES + OFF_CQ);
  float* sc = (float*)(p.slabs + (size_t)tile * SLAB_BYTES + OFF_SC);
#pragma unroll 4
  for (int ti = 0; ti < 16; ++ti) {
    const int tl = wid * 16 + ti;
    const long t = (long)tile * 128 + tl;
    int s0 = 0, s1 = 0;
#pragma unroll
    for (int j = 0; j < 8; ++j) { s0 += p.PD[(j * 128 + tl) * 128 + lane]; s1 += p.PD[(j * 128 + tl) * 128 + 64 + lane]; }
    const int e0 = p.experts[t * 128 + lane], e1 = p.experts[t * 128 + 64 + lane];
    const float sx = p.SX[t];
    const float c0 = p.gates[t * 128 + lane] * gelu_f((float)s0 * p.sd[e0] * sx) * p.su[e0];
    const float c1 = p.gates[t * 128 + 64 + lane] * gelu_f((float)s1 * p.sd[e1] * sx) * p.su[e1];
    float amax = fmaxf(fabsf(c0), fabsf(c1));
#pragma unroll
    for (int o = 32; o > 0; o >>= 1) amax = fmaxf(amax, __shfl_xor(amax, o));
    const float inv = amax > 0.f ? 127.f / amax : 0.f;
    cq[tl * 128 + cq_index(lane)] = (signed char)__float2int_rn(c0 * inv);
    cq[tl * 128 + cq_index(lane + 64)] = (signed char)__float2int_rn(c1 * inv);
    if (lane == 0) sc[tl] = amax * (1.f / 127.f);
  }
}
struct UMeta { int er0, er1; unsigned cq[4]; };
__device__ __forceinline__ void phase_gup(const P& p) {
  const int tid = otid(), lane = tid & 63, wid = tid >> 6, grp = lane >> 3, r8 = lane & 7;
  const int slice = blockIdx.x & 7, chunk = blockIdx.x >> 3;
  const unsigned char* tab = p.WUq + slice * 128 + r8 * 16;
  char* sl = p.slabs + (size_t)(chunk * 8 + wid) * SLAB_BYTES;
  const int* exb = (const int*)(sl + OFF_EXP);
  const unsigned* cqb = (const unsigned*)(sl + OFF_CQ);
  const float* scb = (const float*)(sl + OFF_SC);
  bf16_t* h3b = (bf16_t*)(sl + OFF_ZB);
  auto meta = [&](int ti, UMeta& m) {
    const int t = (ti < 127 ? ti : 127);
    m.er0 = exb[t * 128 + lane]; m.er1 = exb[t * 128 + 64 + lane];
#pragma unroll
    for (int j = 0; j < 4; ++j) m.cq[j] = cqb[t * 32 + j * 8 + grp];
  };
  auto issue = [&](const UMeta& m, u32x4 (&w)[16]) {
#pragma unroll
    for (int it = 0; it < 16; ++it) {
      const int e = __builtin_amdgcn_ds_bpermute(((it & 7) * 8 + grp) * 4, (it < 8) ? m.er0 : m.er1);
      w[it] = *(const u32x4*)(tab + (long)e * DM);
    }
  };
  auto consume = [&](int ti, const UMeta& m, const u32x4 (&w)[16]) {
    int o[16];
#pragma unroll
    for (int i = 0; i < 16; ++i) o[i] = 0;
#pragma unroll
    for (int j = 0; j < 4; ++j) {
      const unsigned x0[4] = {w[4 * j].x, w[4 * j].y, w[4 * j].z, w[4 * j].w}, x1[4] = {w[4 * j + 1].x, w[4 * j + 1].y, w[4 * j + 1].z, w[4 * j + 1].w};
      const unsigned x2[4] = {w[4 * j + 2].x, w[4 * j + 2].y, w[4 * j + 2].z, w[4 * j + 2].w}, x3[4] = {w[4 * j + 3].x, w[4 * j + 3].y, w[4 * j + 3].z, w[4 * j + 3].w};
#pragma unroll
      for (int d = 0; d < 4; ++d) {
        const unsigned t0 = __builtin_amdgcn_perm(x1[d], x0[d], 0x05010400u), t1 = __builtin_amdgcn_perm(x1[d], x0[d], 0x07030602u);
        const unsigned u0 = __builtin_amdgcn_perm(x3[d], x2[d], 0x05010400u), u1 = __builtin_amdgcn_perm(x3[d], x2[d], 0x07030602u);
        o[d * 4 + 0] = __builtin_amdgcn_sdot4((int)__builtin_amdgcn_perm(u0, t0, 0x05040100u), (int)m.cq[j], o[d * 4 + 0], false);
        o[d * 4 + 1] = __builtin_amdgcn_sdot4((int)__builtin_amdgcn_perm(u0, t0, 0x07060302u), (int)m.cq[j], o[d * 4 + 1], false);
        o[d * 4 + 2] = __builtin_amdgcn_sdot4((int)__builtin_amdgcn_perm(u1, t1, 0x05040100u), (int)m.cq[j], o[d * 4 + 2], false);
        o[d * 4 + 3] = __builtin_amdgcn_sdot4((int)__builtin_amdgcn_perm(u1, t1, 0x07060302u), (int)m.cq[j], o[d * 4 + 3], false);
      }
    }
    const float sct = scb[ti];
    float f[16];
#pragma unroll
    for (int i = 0; i < 16; ++i) {
      int a = o[i];
      a += (int)dpp_u<0x128>((unsigned)a);
      a += __shfl_xor(a, 16);
      a += __shfl_xor(a, 32);
      f[i] = (float)a * sct;
    }
    if (grp == 0) {
      bf16_t* dst = h3b + ti * DM + slice * 128 + r8 * 16;
      u32x4 q0, q1;
      q0.x = pk_bf16(f[0], f[1]); q0.y = pk_bf16(f[2], f[3]); q0.z = pk_bf16(f[4], f[5]); q0.w = pk_bf16(f[6], f[7]);
      q1.x = pk_bf16(f[8], f[9]); q1.y = pk_bf16(f[10], f[11]); q1.z = pk_bf16(f[12], f[13]); q1.w = pk_bf16(f[14], f[15]);
      *(u32x4*)dst = q0; *(u32x4*)(dst + 8) = q1;
    }
  };
  UMeta mA, mB; u32x4 wA[16], wB[16];
  meta(0, mA); issue(mA, wA); meta(1, mB);
  for (int ti = 0; ti < 128; ti += 2) {
    issue(mB, wB);
    consume(ti, mA, wA);
    meta(ti + 2, mA);
    issue(mA, wA);
    consume(ti + 1, mB, wB);
    meta(ti + 3, mB);
  }
}
__device__ __forceinline__ void phase_ln3(const P& p, int tile) {
  const int tid = otid(), lane = tid & 63, wid = tid >> 6;
#pragma unroll 2
  for (int ti = 0; ti < 16; ++ti) {
    const long t = (long)tile * 128 + wid * 16 + ti;
    float4 v[4];
    float sum = 0.f;
#pragma unroll
    for (int j = 0; j < 4; ++j) {
      const int c0 = j * 256 + lane * 4;
      const u32x2 hv = *(const u32x2*)((const bf16_t*)p.H3 + t * DM + c0);
      const u32x2 xv = *(const u32x2*)(p.X2 + t * DM + c0);
      v[j].x = bf_lo(hv.x) + ALPHA * bf_lo(xv.x); v[j].y = bf_hi(hv.x) + ALPHA * bf_hi(xv.x); v[j].z = bf_lo(hv.y) + ALPHA * bf_lo(xv.y); v[j].w = bf_hi(hv.y) + ALPHA * bf_hi(xv.y);
      sum += (v[j].x + v[j].y) + (v[j].z + v[j].w);
    }
#pragma unroll
    for (int o = 32; o > 0; o >>= 1) sum += __shfl_xor(sum, o);
    const float mu = sum * (1.f / DM);
    float q = 0.f;
#pragma unroll
    for (int j = 0; j < 4; ++j) { v[j].x -= mu; v[j].y -= mu; v[j].z -= mu; v[j].w -= mu; q += (v[j].x * v[j].x + v[j].y * v[j].y) + (v[j].z * v[j].z + v[j].w * v[j].w); }
#pragma unroll
    for (int o = 32; o > 0; o >>= 1) q += __shfl_xor(q, o);
    const float rstd = rsqrtf(q * (1.f / DM) + LN_EPS);
#pragma unroll
    for (int j = 0; j < 4; ++j) {
      const int c0 = j * 256 + lane * 4;
      const float4 gg = *(const float4*)(p.ln3_g + c0), bb = *(const float4*)(p.ln3_b + c0);
      float4 o; o.x = v[j].x * rstd * gg.x + bb.x; o.y = v[j].y * rstd * gg.y + bb.y; o.z = v[j].z * rstd * gg.z + bb.z; o.w = v[j].w * rstd * gg.w + bb.w;
      *(float4*)(p.out + t * DM + c0) = o;
    }
  }
}

__device__ __forceinline__ void prep_transpose_tile(const float* __restrict__ W, bf16_t* __restrict__ WT, int K, int N, int tileidx) {
  LAS float* scr = (LAS float*)smem_raw;
  const int ntn = N / 64, k0 = (tileidx / ntn) * 64, n0 = (tileidx % ntn) * 64, tid = threadIdx.x;
#pragma unroll
  for (int i = 0; i < 8; ++i) { const int e = tid + i * 512, kk = e >> 6, nn = e & 63; scr[kk * 65 + nn] = W[(long)(k0 + kk) * N + n0 + nn]; }
  __syncthreads();
#pragma unroll
  for (int i = 0; i < 4; ++i) { const int e = tid + i * 512, nn = e >> 5, kp = (e & 31) * 2; *(unsigned*)(WT + (long)(n0 + nn) * K + k0 + kp) = pk_bf16(scr[kp * 65 + nn], scr[(kp + 1) * 65 + nn]); }
  __syncthreads();
}
__device__ __forceinline__ void prep_quant_strip(const float* __restrict__ W, signed char* __restrict__ Q, float* __restrict__ sc, int K, int N, int strip) {
  LAS float* scr = (LAS float*)smem_raw;
  LAS float* pmax = scr + 64 * 65;
  LAS float* inv = pmax + 8 * 64;
  const int n0 = strip * 64, tid = threadIdx.x, nn = tid & 63, kg = tid >> 6;
  float amax = 0.f;
  for (int k0 = 0; k0 < K; k0 += 64)
#pragma unroll
    for (int i = 0; i < 8; ++i) amax = fmaxf(amax, fabsf(W[(long)(k0 + kg + 8 * i) * N + n0 + nn]));
  pmax[kg * 64 + nn] = amax;
  __syncthreads();
  if (tid < 64) {
    float m = 0.f;
#pragma unroll
    for (int j = 0; j < 8; ++j) m = fmaxf(m, pmax[j * 64 + tid]);
    inv[tid] = m > 0.f ? 127.f / m : 0.f;
    sc[n0 + tid] = m * (1.f / 127.f);
  }
  __syncthreads();
  const float iv = inv[nn];
  for (int k0 = 0; k0 < K; k0 += 64) {
#pragma unroll
    for (int i = 0; i < 8; ++i) { const int kk = kg + 8 * i; scr[kk * 65 + nn] = W[(long)(k0 + kk) * N + n0 + nn] * iv; }
    __syncthreads();
#pragma unroll
    for (int i = 0; i < 2; ++i) {
      const int dd = tid + i * 512, n = dd >> 4, k4 = (dd & 15) * 4;
      *(unsigned*)(Q + (long)(n0 + n) * K + k0 + k4) = pack4_i8(scr[k4 * 65 + n], scr[(k4 + 1) * 65 + n], scr[(k4 + 2) * 65 + n], scr[(k4 + 3) * 65 + n]);
    }
    __syncthreads();
  }
}
__device__ __forceinline__ void prep_cvt(const float* __restrict__ in, bf16_t* __restrict__ out, long n8) {
  for (long i = (long)blockIdx.x * 512 + threadIdx.x; i < n8; i += (long)gridDim.x * 512) {
    const float4 a = *(const float4*)(in + i * 8), b = *(const float4*)(in + i * 8 + 4);
    u32x4 o; o.x = pk_bf16(a.x, a.y); o.y = pk_bf16(a.z, a.w); o.z = pk_bf16(b.x, b.y); o.w = pk_bf16(b.z, b.w);
    *(u32x4*)(out + i * 8) = o;
  }
}
__device__ __forceinline__ void phase_prep(const P& p) {
  const int T_IN = 16 * 40, T_SQ = 16 * 16, T_W2 = 16 * 32;
  const int total = T_IN + T_SQ + T_SQ + T_W2 + T_SQ + T_W2;
  for (int it = blockIdx.x; it < total; it += gridDim.x) {
    int r = it;
    if (r < T_IN) { if (r < 40) prep_quant_strip(p.w_in, p.w_inQ, p.sw_in, DM, INW, r); continue; } r -= T_IN;
    if (r < T_SQ) { prep_transpose_tile(p.w_mo, (bf16_t*)p.w_moT, DM, DM, r); continue; } r -= T_SQ;
    if (r < T_SQ) { if (r < 16) prep_quant_strip(p.w_xq, p.w_xqQ, p.sw_xq, DM, DM, r); continue; } r -= T_SQ;
    if (r < T_W2) { prep_transpose_tile(p.w_xkv, (bf16_t*)p.w_xkvT, DM, 2048, r); continue; } r -= T_W2;
    if (r < T_SQ) { prep_transpose_tile(p.w_xo, (bf16_t*)p.w_xoT, DM, DM, r); continue; } r -= T_SQ;
    (void)r;
  }
  prep_cvt(p.mem, (bf16_t*)p.memB, (long)1024 * DM / 8);
  prep_cvt(p.sub_keys, (bf16_t*)p.skb, (long)8 * 2 * 128 * 128 / 8);
  prep_cvt(p.w_pq, (bf16_t*)p.wpqB, (long)DM * 2048 / 8);
  {
    const int lane = threadIdx.x & 63, gw = blockIdx.x * 8 + (threadIdx.x >> 6), ngw = gridDim.x * 8;
    for (int row = gw; row < 2 * 16384; row += ngw) {
      const int tb = row >> 14, e = row & 16383;
      const float* src = (tb ? p.w_up : p.w_down) + (long)e * DM;
      float4 v[4];
      float amax = 0.f;
#pragma unroll
      for (int i = 0; i < 4; ++i) { v[i] = *(const float4*)(src + 256 * i + lane * 4); amax = fmaxf(amax, fmaxf(fmaxf(fabsf(v[i].x), fabsf(v[i].y)), fmaxf(fabsf(v[i].z), fabsf(v[i].w)))); }
#pragma unroll
      for (int s = 32; s > 0; s >>= 1) amax = fmaxf(amax, __shfl_xor(amax, s));
      const float inv = amax > 0.f ? 127.f / amax : 0.f;
      unsigned char* dst = (unsigned char*)(tb ? p.WUq : p.WDq) + (long)e * DM;
      const float off = 0.f;
#pragma unroll
      for (int i = 0; i < 4; ++i) *(unsigned*)(dst + 256 * i + lane * 4) = pack4_i8(v[i].x * inv + off, v[i].y * inv + off, v[i].z * inv + off, v[i].w * inv + off);
      if (lane == 0) { float* sc = (float*)(tb ? p.su : p.sd); sc[e] = amax * (1.f / 127.f); }
    }
  }
  for (int i = blockIdx.x * 512 + threadIdx.x; i < 4 * 128 * 128 / 2; i += gridDim.x * 512) {
    const int e = i * 2, t = (e >> 7) & 127, sidx = e & 127;
    const float2 v = *(const float2*)(p.w_sp + e);
    *(unsigned*)((bf16_t*)p.wsb + e) = pk_bf16(sidx <= t ? v.x : 0.f, (sidx + 1) <= t ? v.y : 0.f);
  }
}
__device__ __forceinline__ void phase_xcvt(const P& p, int tile) {
  const int lane = threadIdx.x & 63, wid = threadIdx.x >> 6;
  signed char* xq = (signed char*)(p.slabs + (size_t)tile * SLAB_BYTES + OFF_XB);
  float* sxr = (float*)(p.slabs + (size_t)tile * SLAB_BYTES + OFF_SXB);
#pragma unroll 2
  for (int i = 0; i < 16; ++i) {
    const int rl = wid * 16 + i;
    const float* src = p.x + ((long)tile * 128 + rl) * DM;
    float4 v[4];
    float amax = 0.f;
#pragma unroll
    for (int j = 0; j < 4; ++j) { v[j] = *(const float4*)(src + 256 * j + lane * 4); amax = fmaxf(amax, fmaxf(fmaxf(fabsf(v[j].x), fabsf(v[j].y)), fmaxf(fabsf(v[j].z), fabsf(v[j].w)))); }
#pragma unroll
    for (int o = 32; o > 0; o >>= 1) amax = fmaxf(amax, __shfl_xor(amax, o));
    const float inv = amax > 0.f ? 127.f / amax : 0.f;
#pragma unroll
    for (int j = 0; j < 4; ++j) *(unsigned*)(xq + rl * DM + 256 * j + lane * 4) = pack4_i8(v[j].x * inv, v[j].y * inv, v[j].z * inv, v[j].w * inv);
    if (lane == 0) sxr[rl] = amax * (1.f / 127.f);
  }
}
__device__ __forceinline__ void phase_halo(const P& p, int tile) {
  const int tid = otid();
  if (tid < 128) {
    const int rr = tid >> 6, c = (tid & 63) * 8;
    const bf16_t* zr = p.ZB + ((long)tile * 128 + 126 + rr) * INW;
    const u32x4 hb = *(const u32x4*)(zr + 1024 + c), gc = *(const u32x4*)(zr + 2048 + c);
    u32x4 o;
    o.x = pk_bf16(bf_lo(hb.x) * bf_lo(gc.x), bf_hi(hb.x) * bf_hi(gc.x)); o.y = pk_bf16(bf_lo(hb.y) * bf_lo(gc.y), bf_hi(hb.y) * bf_hi(gc.y));
    o.z = pk_bf16(bf_lo(hb.z) * bf_lo(gc.z), bf_hi(hb.z) * bf_hi(gc.z)); o.w = pk_bf16(bf_lo(hb.w) * bf_lo(gc.w), bf_hi(hb.w) * bf_hi(gc.w));
    *(u32x4*)(p.HALO + ((long)tile * 2 + rr) * 512 + c) = o;
  }
}

__device__ __forceinline__ P tile_view(const P& p, int tile) {
  P q = p;
  char* sl = p.slabs + (size_t)tile * SLAB_BYTES;
  const long t0 = (long)tile * 128;
  q.XB = (bf16_t*)(sl + OFF_XB) - t0 * DM; q.X1 = (bf16_t*)(sl + OFF_XB) - t0 * DM;
  q.experts = (int*)(sl + OFF_EXP) - t0 * 128; q.gates = (float*)(sl + OFF_GATE) - t0 * 128;
  q.ZB = (bf16_t*)(sl + OFF_ZB) - t0 * INW; q.PRE = (float*)((bf16_t*)(sl + OFF_ZB) - t0 * DM); q.KEYS = (unsigned*)((unsigned short*)(sl + OFF_ZB) - t0 * 2048);
  q.PD = (int*)(sl + OFF_ZB); q.H3 = (float*)((bf16_t*)(sl + OFF_ZB) - t0 * DM);
  q.VT = (bf16_t*)(sl + OFF_VT) - (long)tile * 4 * 128 * 128; q.X1Q = (unsigned char*)(sl + OFF_VT) - t0 * DM; q.XQ = (unsigned char*)(sl + OFF_X2Q) - t0 * DM;
  q.Y = (bf16_t*)(sl + OFF_Y) - t0 * DM; q.Pb = (bf16_t*)(sl + OFF_Y) - (long)tile * 4 * 128 * 256;
  q.Q = (bf16_t*)(sl + OFF_Q) - t0 * DM; q.X2 = (bf16_t*)(sl + OFF_Q) - t0 * DM;
  q.O = (bf16_t*)(sl + OFF_O) - t0 * DM;
  return q;
}

#define XB_TMO      128
#define XB_XCNT(j)  (256  + 64 * (j))
#define XB_XSUB(j)  (1280 + 64 * (j))
#define XB_XGEN(j)  (2304 + 64 * (j))
#define XB_TOP      3328
#define XB_TOPGEN   3392
#define XCD_BAR_WORDS 3456
#define XB_SPIN_CAP (1u << 18)

__device__ __forceinline__ unsigned xb_ld(unsigned* p)              { return __hip_atomic_load(p, __ATOMIC_RELAXED, __HIP_MEMORY_SCOPE_AGENT); }
__device__ __forceinline__ unsigned xb_add(unsigned* p, unsigned v) { return __hip_atomic_fetch_add(p, v, __ATOMIC_RELAXED, __HIP_MEMORY_SCOPE_AGENT); }
__device__ __forceinline__ unsigned xb_xcc_id() { return (unsigned)__builtin_amdgcn_s_getreg((3 << 11) | 20) & 0xFu; }
#define XB_SPIN(cond, bar) do { unsigned _sp = 0; while (cond) { __builtin_amdgcn_s_sleep(1); \
    if ((++_sp & 255u) == 0u) { if (xb_ld(&(bar)[XB_TMO])) break; if (_sp > XB_SPIN_CAP) { atomicAdd(&(bar)[XB_TMO], 1u); break; } } } } while (0)

struct XcdBarrier {
    unsigned* bar; unsigned x;
    volatile LAS unsigned* st;
};

__device__ __forceinline__ XcdBarrier xcd_barrier_post(unsigned* bar, volatile LAS unsigned* st) {
    XcdBarrier b; b.bar = bar; b.x = xb_xcc_id(); b.st = st;
    if (threadIdx.x == 0) (void)xb_add(&bar[XB_XCNT(b.x)], 1u);
    return b;
}
__device__ __forceinline__ void xcd_barrier_complete(unsigned* bar, unsigned x, unsigned& nloc, unsigned& nx) {
    const unsigned G = gridDim.x * gridDim.y * gridDim.z;
    unsigned sum, cnt, mine, sp = 0u;
    for (;;) {
        sum = 0u; cnt = 0u; mine = 0u;
#pragma unroll
        for (unsigned j = 0; j < 16; ++j) { const unsigned c = xb_ld(&bar[XB_XCNT(j)]); sum += c; cnt += (c > 0u) ? 1u : 0u; mine = (j == x) ? c : mine; }
        if (sum == G) break;
        __builtin_amdgcn_s_sleep(1);
        if ((++sp & 255u) == 0u) { if (xb_ld(&bar[XB_TMO])) break; if (sp > XB_SPIN_CAP) { atomicAdd(&bar[XB_TMO], 1u); break; } }
    }
    nloc = mine > 0u ? mine : 1u; nx = cnt > 0u ? cnt : 1u;
}

__device__ __forceinline__ void xcd_barrier(const XcdBarrier& b) {
    asm volatile("s_waitcnt vmcnt(0)" ::: "memory");
    __syncthreads();
    if (threadIdx.x == 0) {
        unsigned* bar = b.bar;
        __builtin_amdgcn_s_waitcnt(0);
        unsigned nloc = b.st[0], nx = b.st[1];
        if (nloc == 0u) { xcd_barrier_complete(bar, b.x, nloc, nx); b.st[0] = nloc; b.st[1] = nx; }
        const unsigned old = xb_add(&bar[XB_XSUB(b.x)], 1u);
        const unsigned gen = old / nloc;
        if (old + 1u == (gen + 1u) * nloc) {
            __builtin_amdgcn_fence(__ATOMIC_RELEASE, "agent");
            asm volatile("s_waitcnt vmcnt(0)" ::: "memory");
            const unsigned og = xb_add(&bar[XB_TOP], 1u);
            const unsigned tg = og / nx;
            if (og + 1u == (tg + 1u) * nx) xb_add(&bar[XB_TOPGEN], 1u);
            else XB_SPIN(xb_ld(&bar[XB_TOPGEN]) == tg, bar);
            __builtin_amdgcn_fence(__ATOMIC_ACQUIRE, "agent");
            xb_add(&bar[XB_XGEN(b.x)], 1u);
            asm volatile("s_waitcnt vmcnt(0)" ::: "memory");
        } else {
            XB_SPIN(xb_ld(&bar[XB_XGEN(b.x)]) == gen, bar);
            __builtin_amdgcn_fence(__ATOMIC_ACQUIRE, "agent");
            asm volatile("s_waitcnt vmcnt(0)" ::: "memory");
        }
    }
    __syncthreads();
}


__global__ __launch_bounds__(512) void mega_k(P pg) {
  const int tile = blockIdx.x;
  volatile LAS unsigned* xbw = (volatile LAS unsigned*)((LAS char*)smem_raw + XB_LDS_OFF);
  if (threadIdx.x < 4) xbw[threadIdx.x] = 0u;
  __syncthreads();
  XcdBarrier xb = xcd_barrier_post(pg.bar, xbw);
  const P p = tile_view(pg, tile);
  phase_prep(pg);
  phase_xcvt(p, tile);
  xcd_barrier(xb);
  phase_inproj(p, tile);
  wg_sync_mem();
  phase_halo(p, tile);
  phase_kv(p, tile);
  if (tile < 64) phase_mt(p, tile);
  xcd_barrier(xb);
  phase_mixer(p, tile);
  wg_sync_mem();
  phase_outproj(p, tile);
  wg_sync_mem();
  phase_qproj(p, tile);
  wg_sync_mem();
  phase_attn(p, tile);
  wg_sync_mem();
  phase_oproj(p, tile);
  wg_sync_mem();
  phase_pq(p, tile);
  wg_sync_mem();
  phase_route(p, tile);
  xcd_barrier(xb);
  phase_gdown(pg);
  xcd_barrier(xb);
  phase_gcomb(p, tile);
  xcd_barrier(xb);
  phase_gup(pg);
  xcd_barrier(xb);
  phase_ln3(p, tile);
}

extern "C" void kernel_launch(void* const* d_in, const int* in_sizes, int n_in, void* d_out, int out_size, void* d_ws, size_t ws_size, hipStream_t stream) {
  static int grid_blocks = 0;
  if (grid_blocks == 0) {
    int dev = 0, cus = 0, per_cu = 0;
    (void)hipGetDevice(&dev);
    (void)hipDeviceGetAttribute(&cus, hipDeviceAttributeMultiprocessorCount, dev);
    if (hipFuncSetAttribute((const void*)mega_k, hipFuncAttributeMaxDynamicSharedMemorySize, LDS_BYTES) != hipSuccess) fprintf(stderr, "kernel_launch: hipFuncSetAttribute failed\n");
    if (hipOccupancyMaxActiveBlocksPerMultiprocessor(&per_cu, (const void*)mega_k, 512, LDS_BYTES) != hipSuccess || per_cu < 1) { fprintf(stderr, "kernel_launch: occupancy query says %d blocks/CU\n", per_cu); per_cu = 1; }
    (void)hipGetLastError();
    grid_blocks = NTOK / 128;
    if (cus * per_cu < grid_blocks) fprintf(stderr, "kernel_launch: device holds only %d x %d resident blocks, need %d\n", cus, per_cu, grid_blocks);
  }
  char* w8 = (char*)d_ws;
  const size_t MiB = (size_t)1 << 20;
  P p{};
  p.x = (const float*)d_in[0]; p.mem = (const float*)d_in[1]; p.w_in = (const float*)d_in[2]; p.b_in = (const float*)d_in[3];
  p.sgu_g = (const float*)d_in[4]; p.sgu_b = (const float*)d_in[5]; p.w_sp = (const float*)d_in[6]; p.b_sp = (const float*)d_in[7];
  p.conv_w = (const float*)d_in[8]; p.w_mo = (const float*)d_in[9]; p.ln1_g = (const float*)d_in[10]; p.ln1_b = (const float*)d_in[11];
  p.w_xq = (const float*)d_in[12]; p.w_xkv = (const float*)d_in[13]; p.w_xo = (const float*)d_in[14]; p.ln2_g = (const float*)d_in[15]; p.ln2_b = (const float*)d_in[16];
  p.w_pq = (const float*)d_in[17]; p.sub_keys = (const float*)d_in[18]; p.w_down = (const float*)d_in[19]; p.w_up = (const float*)d_in[20];
  p.ln3_g = (const float*)d_in[21]; p.ln3_b = (const float*)d_in[22];
  p.out = (float*)d_out;
  p.slabs = w8;
  bf16_t* wb = (bf16_t*)(w8 + 448 * MiB);
  p.w_inT = wb; p.w_inQ = (signed char*)wb; wb += (size_t)INW * DM / 2; p.sw_in = (float*)wb; wb += 2 * INW; p.w_moT = wb; wb += (size_t)DM * DM; p.wsb = wb; wb += 4 * 128 * 128;
  p.w_xqT = wb; p.w_xqQ = (signed char*)wb; wb += (size_t)DM * DM / 2; p.sw_xq = (float*)wb; wb += 2 * DM; p.w_xkvT = wb; wb += (size_t)2048 * DM; p.w_xoT = wb; wb += (size_t)DM * DM;
  p.memB = wb; wb += (size_t)1024 * DM; p.Kc = wb; wb += (size_t)1024 * DM; p.VTc = wb; wb += (size_t)1024 * DM;
  p.w_pqT = wb; wb += (size_t)2048 * DM; p.wpqB = wb; wb += (size_t)2048 * DM; p.skb = wb; wb += (size_t)8 * 2 * 128 * 128;
  p.WDq = (const unsigned char*)wb; wb += (size_t)16384 * DM / 2; p.WUq = (const unsigned char*)wb; wb += (size_t)16384 * DM / 2;
  p.sd = (const float*)wb; wb += 2 * 16384; p.su = (const float*)wb; wb += 2 * 16384;
  p.HALO = wb; wb += (size_t)256 * 2 * 512;
  p.SX = (float*)wb; wb += 2 * NTOK; p.SX1 = (float*)wb; wb += 2 * NTOK;
  p.bar = (unsigned*)wb; wb += 2 * 4096;
  if ((size_t)((char*)wb - w8) > ws_size) fprintf(stderr, "kernel_launch: workspace too small\n");
  (void)hipMemsetAsync(p.bar, 0, XCD_BAR_WORDS * 4, stream);
  void* args[] = {&p};
  hipError_t e = hipLaunchCooperativeKernel((const void*)mega_k, dim3(grid_blocks), dim3(512), args, LDS_BYTES, stream);
  if (e != hipSuccess) fprintf(stderr, "cooperative launch failed: %s (grid %d)\n", hipGetErrorString(e), grid_blocks);
}
```

```cpp
#include <hip/hip_runtime.h>
#include <stdint.h>
#include <cstdio>

#define DM 1024
#define NTOK 32768
#define SEQ 8192
#define INW 2560
#define ALPHA 1.189207115002721f
#define LN_EPS 1e-5f

__device__ __forceinline__ float gelu_f(float v) {
  const float t = __builtin_amdgcn_rcpf(fabsf(v) * 0.2316418882f + 1.0f);
  float q = t * 0.5307027145f + (-0.7265760135f); q = q * t + 0.7107068705f; q = q * t + (-0.142248368f); q = q * t + 0.127414796f; q = q * t;
  const float e = __builtin_amdgcn_exp2f((v * v) * (-0.72134752044f));
  const float m = v * (q * e);
  return v < 0.f ? m : v - m;
}

typedef unsigned short bf16_t;
typedef short bf16x8 __attribute__((ext_vector_type(8)));
typedef float f32x4 __attribute__((ext_vector_type(4)));
typedef unsigned u32x4 __attribute__((ext_vector_type(4)));
typedef unsigned u32x2 __attribute__((ext_vector_type(2)));
#define LAS __attribute__((address_space(3)))
extern __shared__ __attribute__((aligned(16))) char smem_raw[];

typedef float f32x2_t __attribute__((ext_vector_type(2)));
typedef __bf16 bf16x2_t __attribute__((ext_vector_type(2)));
typedef _Float16 f16x2_t __attribute__((ext_vector_type(2)));
__device__ __forceinline__ unsigned pk_f16(float lo, float hi) { const f32x2_t v = {lo, hi}; return __builtin_bit_cast(unsigned, __builtin_convertvector(v, f16x2_t)); }
__device__ __forceinline__ float f16_lo(unsigned u) { return (float)__builtin_bit_cast(f16x2_t, u)[0]; }
__device__ __forceinline__ float f16_hi(unsigned u) { return (float)__builtin_bit_cast(f16x2_t, u)[1]; }
__device__ __forceinline__ unsigned pk_bf16(float lo, float hi) { const f32x2_t v = {lo, hi}; return __builtin_bit_cast(unsigned, __builtin_convertvector(v, bf16x2_t)); }
__device__ __forceinline__ int otid() { int t = threadIdx.x; asm volatile("" : "+v"(t)); return t; }
__device__ __forceinline__ unsigned pack4_i8(float a, float b, float c, float d) {
  const int ia = __float2int_rn(a), ib = __float2int_rn(b), ic = __float2int_rn(c), id = __float2int_rn(d);
  return ((unsigned)ia & 0xffu) | (((unsigned)ib & 0xffu) << 8) | (((unsigned)ic & 0xffu) << 16) | ((unsigned)id << 24);
}
__device__ __forceinline__ float bf_lo(unsigned u) { return __uint_as_float(u << 16); }
__device__ __forceinline__ float bf_hi(unsigned u) { return __uint_as_float(u & 0xffff0000u); }

template <int BN, class Epi>
__device__ __forceinline__ void wg_gemm(const bf16_t* __restrict__ A, int lda, const bf16_t* __restrict__ Bt, int ldb, int K, Epi&& epi) {
  constexpr int NT = BN / 64;
  constexpr int STAGE_BYTES = (128 + BN) * 128;
  constexpr int LA = 2, LB = BN / 64;
  LAS char* lds = (LAS char*)smem_raw;
  const int tid = otid(), lane = tid & 63, wid = tid >> 6, wr = wid >> 2, wc = wid & 3, fr = lane & 15, fq = lane >> 4;
  f32x4 acc[4][NT];
#pragma unroll
  for (int m = 0; m < 4; ++m)
#pragma unroll
    for (int n = 0; n < NT; ++n) acc[m][n] = (f32x4){0.f, 0.f, 0.f, 0.f};
  const int nk = K / 64;
  auto stage = [&](int buf, int kt) {
    LAS char* base = lds + buf * STAGE_BYTES;
#pragma unroll
    for (int i = 0; i < LA; ++i) {
      const int q = tid + i * 512, row = q >> 3, c = (q & 7) ^ (row & 7);
      __builtin_amdgcn_global_load_lds((const unsigned*)(A + (long)row * lda + kt * 64 + c * 8), (LAS unsigned*)(base + q * 16), 16, 0, 2);
    }
#pragma unroll
    for (int i = 0; i < LB; ++i) {
      const int q = tid + i * 512, row = q >> 3, c = (q & 7) ^ (row & 7);
      __builtin_amdgcn_global_load_lds((const unsigned*)(Bt + (long)row * ldb + kt * 64 + c * 8), (LAS unsigned*)(base + 16384 + q * 16), 16, 0, 0);
    }
  };
  asm volatile("s_waitcnt vmcnt(0)" ::: "memory");
  __builtin_amdgcn_s_barrier();
  asm volatile("" ::: "memory");
  stage(0, 0);
  if (nk > 1) stage(1, 1);
  for (int kt = 0; kt < nk; ++kt) {
    if (kt + 1 < nk) asm volatile("s_waitcnt vmcnt(%0)" ::"n"(LA + LB) : "memory");
    else asm volatile("s_waitcnt vmcnt(0)" ::: "memory");
    __builtin_amdgcn_s_barrier();
    asm volatile("" ::: "memory");
    if (kt + 2 < nk) stage((kt + 2) % 3, kt + 2);
    LAS const char* base = lds + (kt % 3) * STAGE_BYTES;
    bf16x8 af[4][2], bfr[NT][2];
#pragma unroll
    for (int m = 0; m < 4; ++m)
#pragma unroll
      for (int kk = 0; kk < 2; ++kk) {
        const int row = wr * 64 + m * 16 + fr, c = (kk * 4 + fq) ^ (fr & 7);
        af[m][kk] = *(LAS const bf16x8*)(base + row * 128 + c * 16);
      }
#pragma unroll
    for (int n = 0; n < NT; ++n)
#pragma unroll
      for (int kk = 0; kk < 2; ++kk) {
        const int row = wc * (BN / 4) + n * 16 + fr, c = (kk * 4 + fq) ^ (fr & 7);
        bfr[n][kk] = *(LAS const bf16x8*)(base + 16384 + row * 128 + c * 16);
      }
#pragma unroll
    for (int kk = 0; kk < 2; ++kk)
#pragma unroll
      for (int m = 0; m < 4; ++m)
#pragma unroll
        for (int n = 0; n < NT; ++n) acc[m][n] = __builtin_amdgcn_mfma_f32_16x16x32_bf16(bfr[n][kk], af[m][kk], acc[m][n], 0, 0, 0);
  }
  epi(acc, wr, wc, fr, fq);
}

typedef int v4i_t __attribute__((ext_vector_type(4)));
template <int BN, class Epi>
__device__ __forceinline__ void wg_gemm_i8(const signed char* __restrict__ A, int lda, const signed char* __restrict__ Bt, int ldb, int K, Epi&& epi) {
  constexpr int NT = BN / 64;
  constexpr int STAGE_BYTES = (128 + BN) * 128;
  constexpr int LA = 2, LB = BN / 64;
  LAS char* lds = (LAS char*)smem_raw;
  const int tid = otid(), lane = tid & 63, wid = tid >> 6, wr = wid >> 2, wc = wid & 3, fr = lane & 15, fq = lane >> 4;
  v4i_t acc[4][NT];
#pragma unroll
  for (int m = 0; m < 4; ++m)
#pragma unroll
    for (int n = 0; n < NT; ++n) acc[m][n] = (v4i_t){0, 0, 0, 0};
  const int nk = K / 128;
  auto stage = [&](int buf, int kt) {
    LAS char* base = lds + buf * STAGE_BYTES;
#pragma unroll
    for (int i = 0; i < LA; ++i) {
      const int q = tid + i * 512, row = q >> 3, c = (q & 7) ^ (row & 7);
      __builtin_amdgcn_global_load_lds((const unsigned*)(A + (long)row * lda + kt * 128 + c * 16), (LAS unsigned*)(base + q * 16), 16, 0, 2);
    }
#pragma unroll
    for (int i = 0; i < LB; ++i) {
      const int q = tid + i * 512, row = q >> 3, c = (q & 7) ^ (row & 7);
      __builtin_amdgcn_global_load_lds((const unsigned*)(Bt + (long)row * ldb + kt * 128 + c * 16), (LAS unsigned*)(base + 16384 + q * 16), 16, 0, 0);
    }
  };
  asm volatile("s_waitcnt vmcnt(0)" ::: "memory");
  __builtin_amdgcn_s_barrier();
  asm volatile("" ::: "memory");
  stage(0, 0);
  if (nk > 1) stage(1, 1);
  for (int kt = 0; kt < nk; ++kt) {
    if (kt + 1 < nk) asm volatile("s_waitcnt vmcnt(%0)" ::"n"(LA + LB) : "memory");
    else asm volatile("s_waitcnt vmcnt(0)" ::: "memory");
    __builtin_amdgcn_s_barrier();
    asm volatile("" ::: "memory");
    if (kt + 2 < nk) stage((kt + 2) % 3, kt + 2);
    LAS const char* base = lds + (kt % 3) * STAGE_BYTES;
    v4i_t af[4][2], bfr[NT][2];
#pragma unroll
    for (int m = 0; m < 4; ++m)
#pragma unroll
      for (int kk = 0; kk < 2; ++kk) {
        const int row = wr * 64 + m * 16 + fr, c = (kk * 4 + fq) ^ (fr & 7);
        af[m][kk] = *(LAS const v4i_t*)(base + row * 128 + c * 16);
      }
#pragma unroll
    for (int n = 0; n < NT; ++n)
#pragma unroll
      for (int kk = 0; kk < 2; ++kk) {
        const int row = wc * (BN / 4) + n * 16 + fr, c = (kk * 4 + fq) ^ (fr & 7);
        bfr[n][kk] = *(LAS const v4i_t*)(base + 16384 + row * 128 + c * 16);
      }
#pragma unroll
    for (int kk = 0; kk < 2; ++kk)
#pragma unroll
      for (int m = 0; m < 4; ++m)
#pragma unroll
        for (int n = 0; n < NT; ++n) acc[m][n] = __builtin_amdgcn_mfma_i32_16x16x64_i8(bfr[n][kk], af[m][kk], acc[m][n], 0, 0, 0);
  }
  epi(acc, wr, wc, fr, fq);
}

#define GEMM_LDS_BYTES (3 * (128 + 256) * 128)
#define RED_OFF GEMM_LDS_BYTES
#define XB_LDS_OFF (GEMM_LDS_BYTES + 4096)
#define LDS_BYTES (GEMM_LDS_BYTES + 4096 + 16)

struct P {
  const float* x; const float* mem; const float* b_in; const float* sgu_g; const float* sgu_b; const float* b_sp; const float* conv_w;
  const float* ln1_g; const float* ln1_b; const float* ln2_g; const float* ln2_b; const float* ln3_g; const float* ln3_b;
  const bf16_t* XB; const bf16_t* w_inT; const bf16_t* w_moT; const bf16_t* wsb;
  bf16_t* ZB; bf16_t* VT; bf16_t* Y; float* PRE; bf16_t* X1;
  const bf16_t* w_xqT; const bf16_t* w_xkvT; const bf16_t* w_xoT; const bf16_t* memB;
  bf16_t* Kc; bf16_t* Vc; bf16_t* Q; bf16_t* Pb; bf16_t* X2;
  const bf16_t* wxqB; bf16_t* GTb; bf16_t* HT;
  const bf16_t* w_pqT;
  const bf16_t* wpqB;
  const bf16_t* skb; unsigned* KEYS; unsigned char* X1Q; int* experts; float* gates;
  const unsigned char* WDq; const unsigned char* WUq; const float* sd; const float* su; float* out;
  signed char* w_inQ; float* sw_in; signed char* GTq; float* sG; float* SX1;
  char* slabs;
  unsigned* bar; unsigned char* XQ; float* SX; int* PD; float* H3;
  bf16_t* HALO;
  const float* w_in; const float* w_mo; const float* w_sp; const float* w_xq; const float* w_xkv; const float* w_xo; const float* w_pq; const float* sub_keys; const float* w_down; const float* w_up;
};

#define SLAB_BYTES (1536 * 1024)
#define OFF_XB 0
#define OFF_EXP 0
#define OFF_GATE (64 * 1024)
#define OFF_CQ (128 * 1024)
#define OFF_SC (144 * 1024)
#define OFF_X2Q (128 * 1024)
#define OFF_ZB (256 * 1024)
#define OFF_VT (896 * 1024)
#define OFF_Y (1024 * 1024)
#define OFF_Q (1280 * 1024)
__device__ __forceinline__ void wg_sync_mem() { asm volatile("s_waitcnt vmcnt(0) lgkmcnt(0)" ::: "memory"); __syncthreads(); }

#define OFF_SXB (128 * 1024)
__device__ __forceinline__ void phase_inproj(const P& p, int tile) {
  const signed char* xq = (const signed char*)(p.slabs + (size_t)tile * SLAB_BYTES + OFF_XB);
  const float* sxr = (const float*)(p.slabs + (size_t)tile * SLAB_BYTES + OFF_SXB);
  for (int nt = 0; nt < INW / 256; ++nt) {
    wg_gemm_i8<256>(xq, DM, p.w_inQ + (long)nt * 256 * DM, DM, DM, [&](v4i_t (&acc)[4][4], int wr, int wc, int fr, int fq) {
#pragma unroll
      for (int m = 0; m < 4; ++m) {
        const int rl = wr * 64 + m * 16 + fr;
        const float sr = sxr[rl];
#pragma unroll
        for (int n = 0; n < 4; ++n) {
          const int row = tile * 128 + rl, col = nt * 256 + wc * 64 + n * 16 + fq * 4;
          const float4 bv = *(const float4*)(p.b_in + col), sw = *(const float4*)(p.sw_in + col);
          float o0 = (float)acc[m][n][0] * (sr * sw.x) + bv.x, o1 = (float)acc[m][n][1] * (sr * sw.y) + bv.y, o2 = (float)acc[m][n][2] * (sr * sw.z) + bv.z, o3 = (float)acc[m][n][3] * (sr * sw.w) + bv.w;
          if (nt < 4) { o0 = gelu_f(o0); o1 = gelu_f(o1); o2 = gelu_f(o2); o3 = gelu_f(o3); }
          u32x2 w; w.x = pk_bf16(o0, o1); w.y = pk_bf16(o2, o3);
          *(u32x2*)(p.ZB + (long)row * INW + col) = w;
        }
      }
    });
  }
}

__device__ __forceinline__ void phase_mixer(const P& p, int tile) {
  const int tid = otid(), lane = tid & 63, wid = tid >> 6;
  const long t0 = (long)tile * 128;
  const bool seq_start = ((tile & 63) == 0);
#pragma unroll 2
  for (int it = tid; it < 128 * 64; it += 512) {
    const int tl = it >> 6, c = (it & 63) * 8;
    const long t = t0 + tl;
    float conv[8];
#pragma unroll
    for (int j = 0; j < 8; ++j) conv[j] = 0.f;
#pragma unroll
    for (int k = 0; k < 3; ++k) {
      const int rl = tl - 2 + k;
      const float4 w0 = *(const float4*)(p.conv_w + k * 512 + c), w1 = *(const float4*)(p.conv_w + k * 512 + c + 4);
      if (rl >= 0) {
        const bf16_t* zr = p.ZB + (t0 + rl) * INW;
        const u32x4 hb = *(const u32x4*)(zr + 1024 + c), gc = *(const u32x4*)(zr + 2048 + c);
        conv[0] += w0.x * (bf_lo(hb.x) * bf_lo(gc.x)); conv[1] += w0.y * (bf_hi(hb.x) * bf_hi(gc.x));
        conv[2] += w0.z * (bf_lo(hb.y) * bf_lo(gc.y)); conv[3] += w0.w * (bf_hi(hb.y) * bf_hi(gc.y));
        conv[4] += w1.x * (bf_lo(hb.z) * bf_lo(gc.z)); conv[5] += w1.y * (bf_hi(hb.z) * bf_hi(gc.z));
        conv[6] += w1.z * (bf_lo(hb.w) * bf_lo(gc.w)); conv[7] += w1.w * (bf_hi(hb.w) * bf_hi(gc.w));
      } else if (!seq_start) {
        const u32x4 zc = *(const u32x4*)(p.HALO + ((long)(tile - 1) * 2 + (rl + 2)) * 512 + c);
        conv[0] += w0.x * bf_lo(zc.x); conv[1] += w0.y * bf_hi(zc.x); conv[2] += w0.z * bf_lo(zc.y); conv[3] += w0.w * bf_hi(zc.y);
        conv[4] += w1.x * bf_lo(zc.z); conv[5] += w1.y * bf_hi(zc.z); conv[6] += w1.z * bf_lo(zc.w); conv[7] += w1.w * bf_hi(zc.w);
      }
    }
    const u32x4 gb = *(const u32x4*)(p.ZB + t * INW + 1536 + c);
    u32x4 o;
    o.x = pk_bf16(bf_lo(gb.x) * conv[0], bf_hi(gb.x) * conv[1]); o.y = pk_bf16(bf_lo(gb.y) * conv[2], bf_hi(gb.y) * conv[3]);
    o.z = pk_bf16(bf_lo(gb.z) * conv[4], bf_hi(gb.z) * conv[5]); o.w = pk_bf16(bf_lo(gb.w) * conv[6], bf_hi(gb.w) * conv[7]);
    *(u32x4*)(p.Y + t * DM + 512 + c) = o;
  }
  for (int h = 0; h < 4; ++h) {
    float a0[16], a1[16];
    const float g0 = p.sgu_g[h * 128 + 2 * lane], g1 = p.sgu_g[h * 128 + 2 * lane + 1], b0 = p.sgu_b[h * 128 + 2 * lane], b1 = p.sgu_b[h * 128 + 2 * lane + 1];
#pragma unroll
    for (int i = 0; i < 16; ++i) {
      const unsigned v = *(const unsigned*)(p.ZB + (t0 + wid * 16 + i) * INW + 512 + h * 128 + 2 * lane);
      const float x0 = bf_lo(v), x1 = bf_hi(v);
      float sum = x0 + x1;
#pragma unroll
      for (int o = 32; o > 0; o >>= 1) sum += __shfl_xor(sum, o);
      const float mu = sum * (1.f / 128.f);
      const float d0 = x0 - mu, d1 = x1 - mu;
      float q = d0 * d0 + d1 * d1;
#pragma unroll
      for (int o = 32; o > 0; o >>= 1) q += __shfl_xor(q, o);
      const float rstd = rsqrtf(q * (1.f / 128.f) + LN_EPS);
      a0[i] = d0 * rstd * g0 + b0; a1[i] = d1 * rstd * g1 + b1;
    }
    bf16_t* vt = p.VT + ((long)tile * 4 + h) * 128 * 128;
    u32x4 o;
    o.x = pk_bf16(a0[0], a0[1]); o.y = pk_bf16(a0[2], a0[3]); o.z = pk_bf16(a0[4], a0[5]); o.w = pk_bf16(a0[6], a0[7]);
    *(u32x4*)(vt + (2 * lane) * 128 + wid * 16) = o;
    o.x = pk_bf16(a0[8], a0[9]); o.y = pk_bf16(a0[10], a0[11]); o.z = pk_bf16(a0[12], a0[13]); o.w = pk_bf16(a0[14], a0[15]);
    *(u32x4*)(vt + (2 * lane) * 128 + wid * 16 + 8) = o;
    o.x = pk_bf16(a1[0], a1[1]); o.y = pk_bf16(a1[2], a1[3]); o.z = pk_bf16(a1[4], a1[5]); o.w = pk_bf16(a1[6], a1[7]);
    *(u32x4*)(vt + (2 * lane + 1) * 128 + wid * 16) = o;
    o.x = pk_bf16(a1[8], a1[9]); o.y = pk_bf16(a1[10], a1[11]); o.z = pk_bf16(a1[12], a1[13]); o.w = pk_bf16(a1[14], a1[15]);
    *(u32x4*)(vt + (2 * lane + 1) * 128 + wid * 16 + 8) = o;
  }
  wg_sync_mem();
  for (int h = 0; h < 4; ++h) {
    wg_gemm<128>(p.wsb + h * 128 * 128, 128, p.VT + ((long)tile * 4 + h) * 128 * 128, 128, 128, [&](f32x4 (&acc)[4][2], int wr, int wc, int fr, int fq) {
#pragma unroll
      for (int m = 0; m < 4; ++m)
#pragma unroll
        for (int n = 0; n < 2; ++n) {
          const int rl = wr * 64 + m * 16 + fr, col = wc * 32 + n * 16 + fq * 4;
          const float bs = p.b_sp[h * 128 + rl];
          const u32x2 uv = *(const u32x2*)(p.ZB + (t0 + rl) * INW + h * 128 + col);
          u32x2 w;
          w.x = pk_bf16(bf_lo(uv.x) * (acc[m][n][0] + bs), bf_hi(uv.x) * (acc[m][n][1] + bs));
          w.y = pk_bf16(bf_lo(uv.y) * (acc[m][n][2] + bs), bf_hi(uv.y) * (acc[m][n][3] + bs));
          *(u32x2*)(p.Y + (t0 + rl) * DM + h * 128 + col) = w;
        }
    });
  }
}

__device__ __forceinline__ void ln_rows16(const float* __restrict__ PRE, long r0, const float* __restrict__ g, const float* __restrict__ b, bf16_t* __restrict__ Out, int lane) {
#pragma unroll 2
  for (int i = 0; i < 16; ++i) {
    const bf16_t* pr = (const bf16_t*)PRE + (r0 + i) * DM;
    float4 v[4];
    float sum = 0.f;
#pragma unroll
    for (int j = 0; j < 4; ++j) { const u32x2 pv = *(const u32x2*)(pr + j * 256 + lane * 4); v[j].x = bf_lo(pv.x); v[j].y = bf_hi(pv.x); v[j].z = bf_lo(pv.y); v[j].w = bf_hi(pv.y); sum += (v[j].x + v[j].y) + (v[j].z + v[j].w); }
#pragma unroll
    for (int o = 32; o > 0; o >>= 1) sum += __shfl_xor(sum, o);
    const float mu = sum * (1.f / DM);
    float q = 0.f;
#pragma unroll
    for (int j = 0; j < 4; ++j) { v[j].x -= mu; v[j].y -= mu; v[j].z -= mu; v[j].w -= mu; q += (v[j].x * v[j].x + v[j].y * v[j].y) + (v[j].z * v[j].z + v[j].w * v[j].w); }
#pragma unroll
    for (int o = 32; o > 0; o >>= 1) q += __shfl_xor(q, o);
    const float rstd = rsqrtf(q * (1.f / DM) + LN_EPS);
#pragma unroll
    for (int j = 0; j < 4; ++j) {
      const int c0 = j * 256 + lane * 4;
      const float4 gg = *(const float4*)(g + c0), bb = *(const float4*)(b + c0);
      u32x2 w; w.x = pk_bf16(v[j].x * rstd * gg.x + bb.x, v[j].y * rstd * gg.y + bb.y); w.y = pk_bf16(v[j].z * rstd * gg.z + bb.z, v[j].w * rstd * gg.w + bb.w);
      *(u32x2*)(Out + (r0 + i) * DM + c0) = w;
    }
  }
}

__device__ __forceinline__ void ln_rows16_q(const float* __restrict__ PRE, long r0, const float* __restrict__ g, const float* __restrict__ b, bf16_t* __restrict__ Out,
                                            unsigned char* __restrict__ XQ, float* __restrict__ SX, int lane) {
#pragma unroll 2
  for (int i = 0; i < 16; ++i) {
    const bf16_t* pr = (const bf16_t*)PRE + (r0 + i) * DM;
    float4 v[4];
    float sum = 0.f;
#pragma unroll
    for (int j = 0; j < 4; ++j) { const u32x2 pv = *(const u32x2*)(pr + j * 256 + lane * 4); v[j].x = bf_lo(pv.x); v[j].y = bf_hi(pv.x); v[j].z = bf_lo(pv.y); v[j].w = bf_hi(pv.y); sum += (v[j].x + v[j].y) + (v[j].z + v[j].w); }
#pragma unroll
    for (int o = 32; o > 0; o >>= 1) sum += __shfl_xor(sum, o);
    const float mu = sum * (1.f / DM);
    float q = 0.f;
#pragma unroll
    for (int j = 0; j < 4; ++j) { v[j].x -= mu; v[j].y -= mu; v[j].z -= mu; v[j].w -= mu; q += (v[j].x * v[j].x + v[j].y * v[j].y) + (v[j].z * v[j].z + v[j].w * v[j].w); }
#pragma unroll
    for (int o = 32; o > 0; o >>= 1) q += __shfl_xor(q, o);
    const float rstd = rsqrtf(q * (1.f / DM) + LN_EPS);
    float amax = 0.f;
#pragma unroll
    for (int j = 0; j < 4; ++j) {
      const int c0 = j * 256 + lane * 4;
      const float4 gg = *(const float4*)(g + c0), bb = *(const float4*)(b + c0);
      v[j].x = v[j].x * rstd * gg.x + bb.x; v[j].y = v[j].y * rstd * gg.y + bb.y; v[j].z = v[j].z * rstd * gg.z + bb.z; v[j].w = v[j].w * rstd * gg.w + bb.w;
      u32x2 w; w.x = pk_bf16(v[j].x, v[j].y); w.y = pk_bf16(v[j].z, v[j].w);
      *(u32x2*)(Out + (r0 + i) * DM + c0) = w;
      amax = fmaxf(amax, fmaxf(fmaxf(fabsf(v[j].x), fabsf(v[j].y)), fmaxf(fabsf(v[j].z), fabsf(v[j].w))));
    }
#pragma unroll
    for (int o = 32; o > 0; o >>= 1) amax = fmaxf(amax, __shfl_xor(amax, o));
    const float inv = amax > 0.f ? 127.f / amax : 0.f;
#pragma unroll
    for (int j = 0; j < 4; ++j) *(unsigned*)(XQ + (r0 + i) * DM + j * 256 + lane * 4) = pack4_i8(v[j].x * inv, v[j].y * inv, v[j].z * inv, v[j].w * inv);
    if (lane == 0) SX[r0 + i] = amax * (1.f / 127.f);
  }
}

__device__ __forceinline__ void phase_outproj(const P& p, int tile) {
  const long t0 = (long)tile * 128;
  for (int nt = 0; nt < 4; ++nt) {
    wg_gemm<256>(p.Y + t0 * DM, DM, p.w_moT + (long)nt * 256 * DM, DM, DM, [&](f32x4 (&acc)[4][4], int wr, int wc, int fr, int fq) {
#pragma unroll
      for (int m = 0; m < 4; ++m)
#pragma unroll
        for (int n = 0; n < 4; ++n) {
          const long row = t0 + wr * 64 + m * 16 + fr; const int col = nt * 256 + wc * 64 + n * 16 + fq * 4;
          const float4 xv = *(const float4*)(p.x + row * DM + col);
          u32x2 o; o.x = pk_bf16(ALPHA * xv.x + acc[m][n][0], ALPHA * xv.y + acc[m][n][1]); o.y = pk_bf16(ALPHA * xv.z + acc[m][n][2], ALPHA * xv.w + acc[m][n][3]);
          *(u32x2*)((bf16_t*)p.PRE + row * DM + col) = o;
        }
    });
  }
  wg_sync_mem();
  ln_rows16_q(p.PRE, t0 + (threadIdx.x >> 6) * 16, p.ln1_g, p.ln1_b, p.X1, p.X1Q, p.SX1, threadIdx.x & 63);
}

__device__ __forceinline__ void phase_kv(const P& p, int unit) {
  const int rt = unit >> 5, nc = unit & 31;
  wg_gemm<64>(p.memB + (long)rt * 128 * DM, DM, p.w_xkvT + (long)nc * 64 * DM, DM, DM, [&](f32x4 (&acc)[4][1], int wr, int wc, int fr, int fq) {
    const int b = rt >> 1, col = nc * 64 + wc * 16 + fq * 4, hh = (col >> 8) & 3, d = col & 255;
#pragma unroll
    for (int m = 0; m < 4; ++m) {
      const int mm = (rt & 1) * 128 + wr * 64 + m * 16 + fr;
      u32x2 w; w.x = pk_bf16(acc[m][0][0], acc[m][0][1]); w.y = pk_bf16(acc[m][0][2], acc[m][0][3]);
      *(u32x2*)((col < 1024 ? p.Kc : p.Vc) + ((long)(b * 4 + hh) * 256 + mm) * 256 + d) = w;
    }
  });
}

__device__ __forceinline__ void phase_gh(const P& p, int unit) {
  if (unit < 128) {
    const int bh = unit >> 3, rt = (unit >> 2) & 1, nt = unit & 3, h = bh & 3, b = bh >> 2;
    wg_gemm<256>(p.Kc + ((long)bh * 256 + rt * 128) * 256, 256, p.wxqB + (long)nt * 256 * DM + h * 256, DM, 256, [&](f32x4 (&acc)[4][4], int wr, int wc, int fr, int fq) {
#pragma unroll
      for (int m = 0; m < 4; ++m)
#pragma unroll
        for (int n = 0; n < 4; ++n) {
          const long row = (long)b * 1024 + h * 256 + rt * 128 + wr * 64 + m * 16 + fr; const int col = nt * 256 + wc * 64 + n * 16 + fq * 4;
          u32x2 w; w.x = pk_bf16(acc[m][n][0], acc[m][n][1]); w.y = pk_bf16(acc[m][n][2], acc[m][n][3]);
          *(u32x2*)(p.GTb + row * DM + col) = w;
        }
    });
  } else {
    const int u = unit - 128, bh = u >> 3, rt = u & 7, h = bh & 3, b = bh >> 2;
    wg_gemm<256>(p.w_xoT + (long)rt * 128 * DM + h * 256, DM, p.Vc + (long)bh * 256 * 256, 256, 256, [&](f32x4 (&acc)[4][4], int wr, int wc, int fr, int fq) {
#pragma unroll
      for (int m = 0; m < 4; ++m)
#pragma unroll
        for (int n = 0; n < 4; ++n) {
          const long row = (long)b * 1024 + rt * 128 + wr * 64 + m * 16 + fr; const int col = h * 256 + wc * 64 + n * 16 + fq * 4;
          u32x2 w; w.x = pk_bf16(acc[m][n][0], acc[m][n][1]); w.y = pk_bf16(acc[m][n][2], acc[m][n][3]);
          *(u32x2*)(p.HT + row * DM + col) = w;
        }
    });
  }
}

__device__ __forceinline__ void phase_gquant(const P& p) {
  const int lane = threadIdx.x & 63, wid = threadIdx.x >> 6;
#pragma unroll
  for (int i = 0; i < 2; ++i) {
    const long row = (long)blockIdx.x * 16 + wid * 2 + i;
    u32x2 v[4];
    float amax = 0.f;
#pragma unroll
    for (int j = 0; j < 4; ++j) {
      v[j] = *(const u32x2*)(p.GTb + row * DM + 256 * j + lane * 4);
      amax = fmaxf(amax, fmaxf(fmaxf(fabsf(bf_lo(v[j].x)), fabsf(bf_hi(v[j].x))), fmaxf(fabsf(bf_lo(v[j].y)), fabsf(bf_hi(v[j].y)))));
    }
#pragma unroll
    for (int o = 32; o > 0; o >>= 1) amax = fmaxf(amax, __shfl_xor(amax, o));
    const float inv = amax > 0.f ? 127.f / amax : 0.f;
#pragma unroll
    for (int j = 0; j < 4; ++j) *(unsigned*)(p.GTq + row * DM + 256 * j + lane * 4) = pack4_i8(bf_lo(v[j].x) * inv, bf_hi(v[j].x) * inv, bf_lo(v[j].y) * inv, bf_hi(v[j].y) * inv);
    if (lane == 0) p.sG[row] = amax * (1.f / 127.f);
  }
}

__device__ __forceinline__ void phase_scores(const P& p, int tile) {
  const long t0 = (long)tile * 128;
  const int b = tile >> 6;
  LAS float* red = (LAS float*)((LAS char*)smem_raw + RED_OFF);
  for (int h = 0; h < 4; ++h) {
    bf16_t* Pw = p.Pb + t0 * DM + h * 256;
    wg_gemm_i8<256>((const signed char*)p.X1Q + t0 * DM, DM, p.GTq + ((long)b * 1024 + h * 256) * DM, DM, DM, [&](v4i_t (&iacc)[4][4], int wr, int wc, int fr, int fq) {
      f32x4 acc[4][4];
      float rmax[4];
#pragma unroll
      for (int m = 0; m < 4; ++m) {
        const float sr = p.SX1[t0 + wr * 64 + m * 16 + fr] * 0.0625f;
#pragma unroll
        for (int n = 0; n < 4; ++n) {
          const float4 sw = *(const float4*)(p.sG + b * 1024 + h * 256 + wc * 64 + n * 16 + fq * 4);
          acc[m][n][0] = (float)iacc[m][n][0] * (sr * sw.x); acc[m][n][1] = (float)iacc[m][n][1] * (sr * sw.y);
          acc[m][n][2] = (float)iacc[m][n][2] * (sr * sw.z); acc[m][n][3] = (float)iacc[m][n][3] * (sr * sw.w);
        }
      }
#pragma unroll
      for (int m = 0; m < 4; ++m) {
        float mx = -3.0e38f;
#pragma unroll
        for (int n = 0; n < 4; ++n) mx = fmaxf(mx, fmaxf(fmaxf(acc[m][n][0], acc[m][n][1]), fmaxf(acc[m][n][2], acc[m][n][3])));
        mx = fmaxf(mx, __shfl_xor(mx, 16)); mx = fmaxf(mx, __shfl_xor(mx, 32));
        if (fq == 0) red[(wr * 64 + m * 16 + fr) * 4 + wc] = mx;
      }
      __syncthreads();
#pragma unroll
      for (int m = 0; m < 4; ++m) {
        const f32x4 r = *(LAS const f32x4*)(red + (wr * 64 + m * 16 + fr) * 4);
        rmax[m] = fmaxf(fmaxf(r[0], r[1]), fmaxf(r[2], r[3]));
      }
#pragma unroll
      for (int m = 0; m < 4; ++m) {
        float sm = 0.f;
#pragma unroll
        for (int n = 0; n < 4; ++n)
#pragma unroll
          for (int j = 0; j < 4; ++j) { const float e = __expf(acc[m][n][j] - rmax[m]); acc[m][n][j] = e; sm += e; }
        sm += __shfl_xor(sm, 16); sm += __shfl_xor(sm, 32);
        if (fq == 0) red[512 + (wr * 64 + m * 16 + fr) * 4 + wc] = sm;
      }
      __syncthreads();
#pragma unroll
      for (int m = 0; m < 4; ++m) {
        const f32x4 r = *(LAS const f32x4*)(red + 512 + (wr * 64 + m * 16 + fr) * 4);
        const float inv = 1.f / ((r[0] + r[1]) + (r[2] + r[3]));
        const int rl = wr * 64 + m * 16 + fr;
#pragma unroll
        for (int n = 0; n < 4; ++n) {
          u32x2 w; w.x = pk_bf16(acc[m][n][0] * inv, acc[m][n][1] * inv); w.y = pk_bf16(acc[m][n][2] * inv, acc[m][n][3] * inv);
          *(u32x2*)(Pw + rl * DM + wc * 64 + n * 16 + fq * 4) = w;
        }
      }
    });
  }
}

__device__ __forceinline__ void phase_oproj(const P& p, int tile) {
  const long t0 = (long)tile * 128;
  for (int nt = 0; nt < 4; ++nt) {
    wg_gemm<256>(p.Pb + t0 * DM, DM, p.HT + ((long)(tile >> 6) * 1024 + nt * 256) * DM, DM, DM, [&](f32x4 (&acc)[4][4], int wr, int wc, int fr, int fq) {
#pragma unroll
      for (int m = 0; m < 4; ++m)
#pragma unroll
        for (int n = 0; n < 4; ++n) {
          const long row = t0 + wr * 64 + m * 16 + fr; const int col = nt * 256 + wc * 64 + n * 16 + fq * 4;
          const u32x2 xv = *(const u32x2*)(p.X1 + row * DM + col);
          u32x2 o; o.x = pk_bf16(ALPHA * bf_lo(xv.x) + acc[m][n][0], ALPHA * bf_hi(xv.x) + acc[m][n][1]); o.y = pk_bf16(ALPHA * bf_lo(xv.y) + acc[m][n][2], ALPHA * bf_hi(xv.y) + acc[m][n][3]);
          *(u32x2*)((bf16_t*)p.PRE + row * DM + col) = o;
        }
    });
  }
  wg_sync_mem();
  ln_rows16_q(p.PRE, t0 + (threadIdx.x >> 6) * 16, p.ln2_g, p.ln2_b, p.X2, p.XQ, p.SX, threadIdx.x & 63);
}

__device__ __forceinline__ unsigned f2key(float f) { const unsigned b = __float_as_uint(f); return b ^ ((unsigned)((int)b >> 31) | 0x80000000u); }
__device__ __forceinline__ float key2f(unsigned k) { return __uint_as_float(k ^ ((k & 0x80000000u) ? 0x80000000u : 0xffffffffu)); }
__device__ __forceinline__ void phase_pq(const P& p, int tile) {
  const long t0 = (long)tile * 128;
  for (int nt = 0; nt < 8; ++nt) {
    wg_gemm<256>(p.X2 + t0 * DM, DM, p.w_pqT + (long)nt * 256 * DM, DM, DM, [&](f32x4 (&acc)[4][4], int wr, int wc, int fr, int fq) {
#pragma unroll
      for (int m = 0; m < 4; ++m)
#pragma unroll
        for (int n = 0; n < 4; ++n) {
          const long row = t0 + wr * 64 + m * 16 + fr; const int col = nt * 256 + wc * 64 + n * 16 + fq * 4;
          u32x2 w; w.x = pk_f16(acc[m][n][0], acc[m][n][1]); w.y = pk_f16(acc[m][n][2], acc[m][n][3]);
          *(u32x2*)((unsigned short*)p.KEYS + row * 2048 + col) = w;
        }
    });
  }
}

__device__ __forceinline__ void phase_mt(const P& p, int unit) {
  const int hp = unit >> 2, nt = unit & 3;
  wg_gemm<256>(p.skb + (long)hp * 128 * 128, 128, p.wpqB + (long)nt * 256 * 2048 + hp * 128, 2048, 128, [&](f32x4 (&acc)[4][4], int wr, int wc, int fr, int fq) {
#pragma unroll
    for (int m = 0; m < 4; ++m)
#pragma unroll
      for (int n = 0; n < 4; ++n) {
        const int row = hp * 128 + wr * 64 + m * 16 + fr, col = nt * 256 + wc * 64 + n * 16 + fq * 4;
        u32x2 w; w.x = pk_bf16(acc[m][n][0], acc[m][n][1]); w.y = pk_bf16(acc[m][n][2], acc[m][n][3]);
        *(u32x2*)((bf16_t*)p.w_pqT + (long)row * DM + col) = w;
      }
  });
}

__device__ __forceinline__ unsigned cand_entry(int s) {
  unsigned e = 255u; int base = 0;
#pragma unroll
  for (int i = 0; i < 16; ++i) { const int cnt = 16 / (i + 1); if (s >= base && s < base + cnt) e = (unsigned)i | ((unsigned)(s - base) << 4); base += cnt; }
  return e;
}
template <int CTRL> __device__ __forceinline__ unsigned dpp_u(unsigned x) { return (unsigned)__builtin_amdgcn_mov_dpp((int)x, CTRL, 0xf, 0xf, true); }
template <int CTRL> __device__ __forceinline__ float dpp_f(float x) { return __int_as_float(__builtin_amdgcn_mov_dpp(__float_as_int(x), CTRL, 0xf, 0xf, true)); }
__device__ __forceinline__ unsigned umin_(unsigned a, unsigned b) { return a < b ? a : b; }
__device__ __forceinline__ unsigned row_min_u(unsigned x) {
  x = umin_(x, dpp_u<0x128>(x)); x = umin_(x, dpp_u<0x124>(x)); x = umin_(x, dpp_u<0x122>(x)); x = umin_(x, dpp_u<0x121>(x)); return x;
}
__device__ __forceinline__ float row_max_f(float x) { x = fmaxf(x, dpp_f<0x128>(x)); x = fmaxf(x, dpp_f<0x124>(x)); x = fmaxf(x, dpp_f<0x122>(x)); x = fmaxf(x, dpp_f<0x121>(x)); return x; }
__device__ __forceinline__ float row_sum_f(float x) { x += dpp_f<0x128>(x); x += dpp_f<0x124>(x); x += dpp_f<0x122>(x); x += dpp_f<0x121>(x); return x; }

#define KEYS_OFF 65536
#define KEY_STRIDE 528
template <int N> __device__ __forceinline__ unsigned top16_row(const unsigned (&k)[N], int r) {
  unsigned pm1 = 0xFFFFFFFEu, mine = 0;
#pragma unroll
  for (int rd = 0; rd < 16; ++rd) {
    unsigned d = pm1 - k[0];
#pragma unroll
    for (int i = 1; i < N; ++i) d = umin_(d, pm1 - k[i]);
    d = row_min_u(d);
    const unsigned nxt = pm1 - d;
    mine = (r == rd) ? nxt : mine;
    pm1 = nxt - 1;
  }
  return mine;
}

__device__ __forceinline__ void phase_route(const P& p, int tile) {
  const long t0 = (long)tile * 128;
  const int tid = otid(), lane = tid & 63, wid = tid >> 6, r = lane & 15, g = lane >> 4;
  LAS char* lds = (LAS char*)smem_raw;
  LAS unsigned char* tab = (LAS unsigned char*)(lds + RED_OFF);
  if (tid < 64) tab[tid] = (unsigned char)cand_entry(tid);
  unsigned ci[4], cj[4]; bool cval[4];
#pragma unroll
  for (int q = 0; q < 4; ++q) { const unsigned e = cand_entry(r * 4 + q); cval[q] = (e != 255u); ci[q] = ((unsigned)(g * 16) + (e & 15u)) * 4u; cj[q] = ((unsigned)(g * 16) + ((e >> 4) & 15u)) * 4u; }
  __syncthreads();
  auto load_keys = [&](int hp, u32x4 (&kb)[4]) {
#pragma unroll
    for (int ps = 0; ps < 4; ++ps) kb[ps] = *(const u32x4*)((const unsigned short*)p.KEYS + (t0 + wid * 16 + ps * 4 + g) * 2048 + hp * 128 + r * 8);
  };
  auto top_keys = [&](const u32x4 (&kb)[4], unsigned (&tp)[4]) {
#pragma unroll
    for (int ps = 0; ps < 4; ++ps) {
      const unsigned w[4] = {kb[ps].x, kb[ps].y, kb[ps].z, kb[ps].w};
      unsigned k[8];
#pragma unroll
      for (int i = 0; i < 4; ++i) {
        k[2 * i] = (f2key(f16_lo(w[i])) & ~127u) | (unsigned)(127 - (r * 8 + 2 * i));
        k[2 * i + 1] = (f2key(f16_hi(w[i])) & ~127u) | (unsigned)(126 - (r * 8 + 2 * i));
      }
      tp[ps] = top16_row<8>(k, r);
    }
  };
  u32x4 kA[4], kB[4];
  load_keys(0, kA);
  for (int h = 0; h < 8; ++h) {
    unsigned top[2][4];
    load_keys(h * 2 + 1, kB);
    top_keys(kA, top[0]);
    load_keys(h < 7 ? h * 2 + 2 : 15, kA);
    top_keys(kB, top[1]);
#pragma unroll
    for (int ps = 0; ps < 4; ++ps) {
      const int tk = wid * 16 + ps * 4 + g;
      const unsigned A = top[0][ps], B = top[1][ps];
      const float fa = key2f(A & ~127u), fb = key2f(B & ~127u);
      unsigned k2[4];
#pragma unroll
      for (int q = 0; q < 4; ++q) {
        const float va = __int_as_float(__builtin_amdgcn_ds_bpermute((int)ci[q], __float_as_int(fa)));
        const float vb = __int_as_float(__builtin_amdgcn_ds_bpermute((int)cj[q], __float_as_int(fb)));
        const unsigned kk = (f2key(va + vb) & ~63u) | (unsigned)(63 - (r * 4 + q));
        k2[q] = cval[q] ? kk : 0u;
      }
      const unsigned mine = top16_row<4>(k2, r);
      const unsigned slot = 63u - (mine & 63u);
      const unsigned e = tab[slot];
      const unsigned ka = (unsigned)__builtin_amdgcn_ds_bpermute((int)(((unsigned)(g * 16) + (e & 15u)) * 4u), (int)A);
      const unsigned kb = (unsigned)__builtin_amdgcn_ds_bpermute((int)(((unsigned)(g * 16) + ((e >> 4) & 15u)) * 4u), (int)B);
      const int expert = (int)((127u - (ka & 127u)) * 128u + (127u - (kb & 127u)));
      const float c = key2f(mine & ~63u);
      const float mx = row_max_f(c);
      const float ex = __expf(c - mx);
      const float sm = row_sum_f(ex);
      p.experts[(t0 + tk) * 128 + h * 16 + r] = expert;
      p.gates[(t0 + tk) * 128 + h * 16 + r] = ex / sm;
    }
  }
}

__device__ __forceinline__ f32x2_t ub01(unsigned w) { return (f32x2_t){(float)(w & 0xffu), (float)((w >> 8) & 0xffu)}; }
__device__ __forceinline__ f32x2_t ub23(unsigned w) { return (f32x2_t){(float)((w >> 16) & 0xffu), (float)(w >> 24)}; }
__device__ __forceinline__ int sum8_i(int x) {
  x += (int)dpp_u<0xB1>((unsigned)x); x += (int)dpp_u<0x4E>((unsigned)x); x += (int)dpp_u<0x141>((unsigned)x); return x;
}
struct GMeta { u32x4 xq; int er0, er1; };
__device__ __forceinline__ void phase_gdown(const P& p) {
  const int tid = otid(), lane = tid & 63, wid = tid >> 6, grp = lane >> 3, r8 = lane & 7;
  const int slice = blockIdx.x & 7, chunk = blockIdx.x >> 3;
  const unsigned char* tab = p.WDq + slice * 128 + r8 * 16;
  const char* sl = p.slabs + (size_t)(chunk * 8 + wid) * SLAB_BYTES;
  int* pd = (int*)(sl + OFF_ZB) + slice * 128 * 128;
  const unsigned char* xqb = (const unsigned char*)(sl + OFF_X2Q);
  const int* exb = (const int*)(sl + OFF_EXP);
  auto meta = [&](int ti, GMeta& m) {
    const int t = (ti < 127 ? ti : 127);
    m.xq = *(const u32x4*)(xqb + t * DM + slice * 128 + r8 * 16);
    m.er0 = exb[t * 128 + lane]; m.er1 = exb[t * 128 + 64 + lane];
  };
  auto issue = [&](const GMeta& m, u32x4 (&w)[16]) {
#pragma unroll
    for (int it = 0; it < 16; ++it) {
      const int e = __builtin_amdgcn_ds_bpermute(((it & 7) * 8 + grp) * 4, (it < 8) ? m.er0 : m.er1);
      w[it] = *(const u32x4*)(tab + (long)e * DM);
    }
  };
  auto consume = [&](int ti, const GMeta& m, const u32x4 (&w)[16]) {
    int c0 = 0, c1 = 0;
#pragma unroll
    for (int it = 0; it < 16; ++it) {
      int acc = __builtin_amdgcn_sdot4((int)w[it].x, (int)m.xq.x, 0, false);
      acc = __builtin_amdgcn_sdot4((int)w[it].y, (int)m.xq.y, acc, false); acc = __builtin_amdgcn_sdot4((int)w[it].z, (int)m.xq.z, acc, false); acc = __builtin_amdgcn_sdot4((int)w[it].w, (int)m.xq.w, acc, false);
      acc = sum8_i(acc);
      const bool mine = ((it & 7) == r8);
      c0 = (mine && it < 8) ? acc : c0;
      c1 = (mine && it >= 8) ? acc : c1;
    }
    pd[ti * 128 + r8 * 8 + grp] = c0; pd[ti * 128 + 64 + r8 * 8 + grp] = c1;
  };
  GMeta mA, mB; u32x4 wA[16], wB[16];
  meta(0, mA); issue(mA, wA); meta(1, mB);
  for (int ti = 0; ti < 128; ti += 2) {
    issue(mB, wB);
    consume(ti, mA, wA);
    meta(ti + 2, mA);
    issue(mA, wA);
    consume(ti + 1, mB, wB);
    meta(ti + 3, mB);
  }
}
__device__ __forceinline__ int cq_index(int k) { return ((k >> 5) * 8 + (k & 7)) * 4 + ((k >> 3) & 3); }
__device__ __forceinline__ void phase_gcomb(const P& p, int tile) {
  const int tid = otid(), lane = tid & 63, wid = tid >> 6;
  signed char* cq = (signed char*)(p.slabs + (size_t)tile * SLAB_BYTES + OFF_CQ);
  float* sc = (float*)(p.slabs + (size_t)tile * SLAB_BYTES + OFF_SC);
#pragma unroll 4
  for (int ti = 0; ti < 16; ++ti) {
    const int tl = wid * 16 + ti;
    const long t = (long)tile * 128 + tl;
    int s0 = 0, s1 = 0;
#pragma unroll
    for (int j = 0; j < 8; ++j) { s0 += p.PD[(j * 128 + tl) * 128 + lane]; s1 += p.PD[(j * 128 + tl) * 128 + 64 + lane]; }
    const int e0 = p.experts[t * 128 + lane], e1 = p.experts[t * 128 + 64 + lane];
    const float sx = p.SX[t];
    const float c0 = p.gates[t * 128 + lane] * gelu_f((float)s0 * p.sd[e0] * sx) * p.su[e0];
    const float c1 = p.gates[t * 128 + 64 + lane] * gelu_f((float)s1 * p.sd[e1] * sx) * p.su[e1];
    float amax = fmaxf(fabsf(c0), fabsf(c1));
#pragma unroll
    for (int o = 32; o > 0; o >>= 1) amax = fmaxf(amax, __shfl_xor(amax, o));
    const float inv = amax > 0.f ? 127.f / amax : 0.f;
    cq[tl * 128 + cq_index(lane)] = (signed char)__float2int_rn(c0 * inv);
    cq[tl * 128 + cq_index(lane + 64)] = (signed char)__float2int_rn(c1 * inv);
    if (lane == 0) sc[tl] = amax * (1.f / 127.f);
  }
}
struct UMeta { int er0, er1; unsigned cq[4]; };
__device__ __forceinline__ void phase_gup(const P& p) {
  const int tid = otid(), lane = tid & 63, wid = tid >> 6, grp = lane >> 3, r8 = lane & 7;
  const int slice = blockIdx.x & 7, chunk = blockIdx.x >> 3;
  const unsigned char* tab = p.WUq + slice * 128 + r8 * 16;
  char* sl = p.slabs + (size_t)(chunk * 8 + wid) * SLAB_BYTES;
  const int* exb = (const int*)(sl + OFF_EXP);
  const unsigned* cqb = (const unsigned*)(sl + OFF_CQ);
  const float* scb = (const float*)(sl + OFF_SC);
  bf16_t* h3b = (bf16_t*)(sl + OFF_ZB);
  auto meta = [&](int ti, UMeta& m) {
    const int t = (ti < 127 ? ti : 127);
    m.er0 = exb[t * 128 + lane]; m.er1 = exb[t * 128 + 64 + lane];
#pragma unroll
    for (int j = 0; j < 4; ++j) m.cq[j] = cqb[t * 32 + j * 8 + grp];
  };
  auto issue = [&](const UMeta& m, u32x4 (&w)[16]) {
#pragma unroll
    for (int it = 0; it < 16; ++it) {
      const int e = __builtin_amdgcn_ds_bpermute(((it & 7) * 8 + grp) * 4, (it < 8) ? m.er0 : m.er1);
      w[it] = *(const u32x4*)(tab + (long)e * DM);
    }
  };
  auto consume = [&](int ti, const UMeta& m, const u32x4 (&w)[16]) {
    int o[16];
#pragma unroll
    for (int i = 0; i < 16; ++i) o[i] = 0;
#pragma unroll
    for (int j = 0; j < 4; ++j) {
      const unsigned x0[4] = {w[4 * j].x, w[4 * j].y, w[4 * j].z, w[4 * j].w}, x1[4] = {w[4 * j + 1].x, w[4 * j + 1].y, w[4 * j + 1].z, w[4 * j + 1].w};
      const unsigned x2[4] = {w[4 * j + 2].x, w[4 * j + 2].y, w[4 * j + 2].z, w[4 * j + 2].w}, x3[4] = {w[4 * j + 3].x, w[4 * j + 3].y, w[4 * j + 3].z, w[4 * j + 3].w};
#pragma unroll
      for (int d = 0; d < 4; ++d) {
        const unsigned t0 = __builtin_amdgcn_perm(x1[d], x0[d], 0x05010400u), t1 = __builtin_amdgcn_perm(x1[d], x0[d], 0x07030602u);
        const unsigned u0 = __builtin_amdgcn_perm(x3[d], x2[d], 0x05010400u), u1 = __builtin_amdgcn_perm(x3[d], x2[d], 0x07030602u);
        o[d * 4 + 0] = __builtin_amdgcn_sdot4((int)__builtin_amdgcn_perm(u0, t0, 0x05040100u), (int)m.cq[j], o[d * 4 + 0], false);
        o[d * 4 + 1] = __builtin_amdgcn_sdot4((int)__builtin_amdgcn_perm(u0, t0, 0x07060302u), (int)m.cq[j], o[d * 4 + 1], false);
        o[d * 4 + 2] = __builtin_amdgcn_sdot4((int)__builtin_amdgcn_perm(u1, t1, 0x05040100u), (int)m.cq[j], o[d * 4 + 2], false);
        o[d * 4 + 3] = __builtin_amdgcn_sdot4((int)__builtin_amdgcn_perm(u1, t1, 0x07060302u), (int)m.cq[j], o[d * 4 + 3], false);
      }
    }
    const float sct = scb[ti];
    float f[16];
#pragma unroll
    for (int i = 0; i < 16; ++i) {
      int a = o[i];
      a += (int)dpp_u<0x128>((unsigned)a);
      a += __shfl_xor(a, 16);
      a += __shfl_xor(a, 32);
      f[i] = (float)a * sct;
    }
    if (grp == 0) {
      bf16_t* dst = h3b + ti * DM + slice * 128 + r8 * 16;
      u32x4 q0, q1;
      q0.x = pk_bf16(f[0], f[1]); q0.y = pk_bf16(f[2], f[3]); q0.z = pk_bf16(f[4], f[5]); q0.w = pk_bf16(f[6], f[7]);
      q1.x = pk_bf16(f[8], f[9]); q1.y = pk_bf16(f[10], f[11]); q1.z = pk_bf16(f[12], f[13]); q1.w = pk_bf16(f[14], f[15]);
      *(u32x4*)dst = q0; *(u32x4*)(dst + 8) = q1;
    }
  };
  UMeta mA, mB; u32x4 wA[16], wB[16];
  meta(0, mA); issue(mA, wA); meta(1, mB);
  for (int ti = 0; ti < 128; ti += 2) {
    issue(mB, wB);
    consume(ti, mA, wA);
    meta(ti + 2, mA);
    issue(mA, wA);
    consume(ti + 1, mB, wB);
    meta(ti + 3, mB);
  }
}
__device__ __forceinline__ void phase_ln3(const P& p, int tile) {
  const int tid = otid(), lane = tid & 63, wid = tid >> 6;
#pragma unroll 2
  for (int ti = 0; ti < 16; ++ti) {
    const long t = (long)tile * 128 + wid * 16 + ti;
    float4 v[4];
    float sum = 0.f;
#pragma unroll
    for (int j = 0; j < 4; ++j) {
      const int c0 = j * 256 + lane * 4;
      const u32x2 hv = *(const u32x2*)((const bf16_t*)p.H3 + t * DM + c0);
      const u32x2 xv = *(const u32x2*)(p.X2 + t * DM + c0);
      v[j].x = bf_lo(hv.x) + ALPHA * bf_lo(xv.x); v[j].y = bf_hi(hv.x) + ALPHA * bf_hi(xv.x); v[j].z = bf_lo(hv.y) + ALPHA * bf_lo(xv.y); v[j].w = bf_hi(hv.y) + ALPHA * bf_hi(xv.y);
      sum += (v[j].x + v[j].y) + (v[j].z + v[j].w);
    }
#pragma unroll
    for (int o = 32; o > 0; o >>= 1) sum += __shfl_xor(sum, o);
    const float mu = sum * (1.f / DM);
    float q = 0.f;
#pragma unroll
    for (int j = 0; j < 4; ++j) { v[j].x -= mu; v[j].y -= mu; v[j].z -= mu; v[j].w -= mu; q += (v[j].x * v[j].x + v[j].y * v[j].y) + (v[j].z * v[j].z + v[j].w * v[j].w); }
#pragma unroll
    for (int o = 32; o > 0; o >>= 1) q += __shfl_xor(q, o);
    const float rstd = rsqrtf(q * (1.f / DM) + LN_EPS);
#pragma unroll
    for (int j = 0; j < 4; ++j) {
      const int c0 = j * 256 + lane * 4;
      const float4 gg = *(const float4*)(p.ln3_g + c0), bb = *(const float4*)(p.ln3_b + c0);
      float4 o; o.x = v[j].x * rstd * gg.x + bb.x; o.y = v[j].y * rstd * gg.y + bb.y; o.z = v[j].z * rstd * gg.z + bb.z; o.w = v[j].w * rstd * gg.w + bb.w;
      *(float4*)(p.out + t * DM + c0) = o;
    }
  }
}

__device__ __forceinline__ void prep_transpose_tile(const float* __restrict__ W, bf16_t* __restrict__ WT, int K, int N, int tileidx) {
  LAS float* scr = (LAS float*)smem_raw;
  const int ntn = N / 64, k0 = (tileidx / ntn) * 64, n0 = (tileidx % ntn) * 64, tid = threadIdx.x;
#pragma unroll
  for (int i = 0; i < 8; ++i) { const int e = tid + i * 512, kk = e >> 6, nn = e & 63; scr[kk * 65 + nn] = W[(long)(k0 + kk) * N + n0 + nn]; }
  __syncthreads();
#pragma unroll
  for (int i = 0; i < 4; ++i) { const int e = tid + i * 512, nn = e >> 5, kp = (e & 31) * 2; *(unsigned*)(WT + (long)(n0 + nn) * K + k0 + kp) = pk_bf16(scr[kp * 65 + nn], scr[(kp + 1) * 65 + nn]); }
  __syncthreads();
}
__device__ __forceinline__ void prep_quant_strip(const float* __restrict__ W, signed char* __restrict__ Q, float* __restrict__ sc, int K, int N, int strip) {
  LAS float* scr = (LAS float*)smem_raw;
  LAS float* pmax = scr + 64 * 65;
  LAS float* inv = pmax + 8 * 64;
  const int n0 = strip * 64, tid = threadIdx.x, nn = tid & 63, kg = tid >> 6;
  float amax = 0.f;
  for (int k0 = 0; k0 < K; k0 += 64)
#pragma unroll
    for (int i = 0; i < 8; ++i) amax = fmaxf(amax, fabsf(W[(long)(k0 + kg + 8 * i) * N + n0 + nn]));
  pmax[kg * 64 + nn] = amax;
  __syncthreads();
  if (tid < 64) {
    float m = 0.f;
#pragma unroll
    for (int j = 0; j < 8; ++j) m = fmaxf(m, pmax[j * 64 + tid]);
    inv[tid] = m > 0.f ? 127.f / m : 0.f;
    sc[n0 + tid] = m * (1.f / 127.f);
  }
  __syncthreads();
  const float iv = inv[nn];
  for (int k0 = 0; k0 < K; k0 += 64) {
#pragma unroll
    for (int i = 0; i < 8; ++i) { const int kk = kg + 8 * i; scr[kk * 65 + nn] = W[(long)(k0 + kk) * N + n0 + nn] * iv; }
    __syncthreads();
#pragma unroll
    for (int i = 0; i < 2; ++i) {
      const int dd = tid + i * 512, n = dd >> 4, k4 = (dd & 15) * 4;
      *(unsigned*)(Q + (long)(n0 + n) * K + k0 + k4) = pack4_i8(scr[k4 * 65 + n], scr[(k4 + 1) * 65 + n], scr[(k4 + 2) * 65 + n], scr[(k4 + 3) * 65 + n]);
    }
    __syncthreads();
  }
}
__device__ __forceinline__ void prep_cvt(const float* __restrict__ in, bf16_t* __restrict__ out, long n8) {
  for (long i = (long)blockIdx.x * 512 + threadIdx.x; i < n8; i += (long)gridDim.x * 512) {
    const float4 a = *(const float4*)(in + i * 8), b = *(const float4*)(in + i * 8 + 4);
    u32x4 o; o.x = pk_bf16(a.x, a.y); o.y = pk_bf16(a.z, a.w); o.z = pk_bf16(b.x, b.y); o.w = pk_bf16(b.z, b.w);
    *(u32x4*)(out + i * 8) = o;
  }
}
__device__ __forceinline__ void phase_prep(const P& p) {
  const int T_IN = 16 * 40, T_SQ = 16 * 16, T_W2 = 16 * 32;
  const int total = T_IN + T_SQ + T_SQ + T_W2 + T_SQ + T_W2;
  for (int it = blockIdx.x; it < total; it += gridDim.x) {
    int r = it;
    if (r < T_IN) { if (r < 40) prep_quant_strip(p.w_in, p.w_inQ, p.sw_in, DM, INW, r); continue; } r -= T_IN;
    if (r < T_SQ) { prep_transpose_tile(p.w_mo, (bf16_t*)p.w_moT, DM, DM, r); continue; } r -= T_SQ;
    if (r < T_SQ) { continue; } r -= T_SQ;
    if (r < T_W2) { prep_transpose_tile(p.w_xkv, (bf16_t*)p.w_xkvT, DM, 2048, r); continue; } r -= T_W2;
    if (r < T_SQ) { prep_transpose_tile(p.w_xo, (bf16_t*)p.w_xoT, DM, DM, r); continue; } r -= T_SQ;
    (void)r;
  }
  prep_cvt(p.mem, (bf16_t*)p.memB, (long)1024 * DM / 8);
  prep_cvt(p.sub_keys, (bf16_t*)p.skb, (long)8 * 2 * 128 * 128 / 8);
  prep_cvt(p.w_pq, (bf16_t*)p.wpqB, (long)DM * 2048 / 8);
  prep_cvt(p.w_xq, (bf16_t*)p.wxqB, (long)DM * DM / 8);
  {
    const int lane = threadIdx.x & 63, gw = blockIdx.x * 8 + (threadIdx.x >> 6), ngw = gridDim.x * 8;
    for (int row = gw; row < 2 * 16384; row += ngw) {
      const int tb = row >> 14, e = row & 16383;
      const float* src = (tb ? p.w_up : p.w_down) + (long)e * DM;
      float4 v[4];
      float amax = 0.f;
#pragma unroll
      for (int i = 0; i < 4; ++i) { v[i] = *(const float4*)(src + 256 * i + lane * 4); amax = fmaxf(amax, fmaxf(fmaxf(fabsf(v[i].x), fabsf(v[i].y)), fmaxf(fabsf(v[i].z), fabsf(v[i].w)))); }
#pragma unroll
      for (int s = 32; s > 0; s >>= 1) amax = fmaxf(amax, __shfl_xor(amax, s));
      const float inv = amax > 0.f ? 127.f / amax : 0.f;
      unsigned char* dst = (unsigned char*)(tb ? p.WUq : p.WDq) + (long)e * DM;
      const float off = 0.f;
#pragma unroll
      for (int i = 0; i < 4; ++i) *(unsigned*)(dst + 256 * i + lane * 4) = pack4_i8(v[i].x * inv + off, v[i].y * inv + off, v[i].z * inv + off, v[i].w * inv + off);
      if (lane == 0) { float* sc = (float*)(tb ? p.su : p.sd); sc[e] = amax * (1.f / 127.f); }
    }
  }
  for (int i = blockIdx.x * 512 + threadIdx.x; i < 4 * 128 * 128 / 2; i += gridDim.x * 512) {
    const int e = i * 2, t = (e >> 7) & 127, sidx = e & 127;
    const float2 v = *(const float2*)(p.w_sp + e);
    *(unsigned*)((bf16_t*)p.wsb + e) = pk_bf16(sidx <= t ? v.x : 0.f, (sidx + 1) <= t ? v.y : 0.f);
  }
}
__device__ __forceinline__ void phase_xcvt(const P& p, int tile) {
  const int lane = threadIdx.x & 63, wid = threadIdx.x >> 6;
  signed char* xq = (signed char*)(p.slabs + (size_t)tile * SLAB_BYTES + OFF_XB);
  float* sxr = (float*)(p.slabs + (size_t)tile * SLAB_BYTES + OFF_SXB);
#pragma unroll 2
  for (int i = 0; i < 16; ++i) {
    const int rl = wid * 16 + i;
    const float* src = p.x + ((long)tile * 128 + rl) * DM;
    float4 v[4];
    float amax = 0.f;
#pragma unroll
    for (int j = 0; j < 4; ++j) { v[j] = *(const float4*)(src + 256 * j + lane * 4); amax = fmaxf(amax, fmaxf(fmaxf(fabsf(v[j].x), fabsf(v[j].y)), fmaxf(fabsf(v[j].z), fabsf(v[j].w)))); }
#pragma unroll
    for (int o = 32; o > 0; o >>= 1) amax = fmaxf(amax, __shfl_xor(amax, o));
    const float inv = amax > 0.f ? 127.f / amax : 0.f;
#pragma unroll
    for (int j = 0; j < 4; ++j) *(unsigned*)(xq + rl * DM + 256 * j + lane * 4) = pack4_i8(v[j].x * inv, v[j].y * inv, v[j].z * inv, v[j].w * inv);
    if (lane == 0) sxr[rl] = amax * (1.f / 127.f);
  }
}
__device__ __forceinline__ void phase_halo(const P& p, int tile) {
  const int tid = otid();
  if (tid < 128) {
    const int rr = tid >> 6, c = (tid & 63) * 8;
    const bf16_t* zr = p.ZB + ((long)tile * 128 + 126 + rr) * INW;
    const u32x4 hb = *(const u32x4*)(zr + 1024 + c), gc = *(const u32x4*)(zr + 2048 + c);
    u32x4 o;
    o.x = pk_bf16(bf_lo(hb.x) * bf_lo(gc.x), bf_hi(hb.x) * bf_hi(gc.x)); o.y = pk_bf16(bf_lo(hb.y) * bf_lo(gc.y), bf_hi(hb.y) * bf_hi(gc.y));
    o.z = pk_bf16(bf_lo(hb.z) * bf_lo(gc.z), bf_hi(hb.z) * bf_hi(gc.z)); o.w = pk_bf16(bf_lo(hb.w) * bf_lo(gc.w), bf_hi(hb.w) * bf_hi(gc.w));
    *(u32x4*)(p.HALO + ((long)tile * 2 + rr) * 512 + c) = o;
  }
}

__device__ __forceinline__ P tile_view(const P& p, int tile) {
  P q = p;
  char* sl = p.slabs + (size_t)tile * SLAB_BYTES;
  const long t0 = (long)tile * 128;
  q.XB = (bf16_t*)(sl + OFF_XB) - t0 * DM; q.X1 = (bf16_t*)(sl + OFF_XB) - t0 * DM;
  q.experts = (int*)(sl + OFF_EXP) - t0 * 128; q.gates = (float*)(sl + OFF_GATE) - t0 * 128;
  q.ZB = (bf16_t*)(sl + OFF_ZB) - t0 * INW; q.PRE = (float*)((bf16_t*)(sl + OFF_ZB) - t0 * DM); q.KEYS = (unsigned*)((unsigned short*)(sl + OFF_ZB) - t0 * 2048);
  q.PD = (int*)(sl + OFF_ZB); q.H3 = (float*)((bf16_t*)(sl + OFF_ZB) - t0 * DM);
  q.VT = (bf16_t*)(sl + OFF_VT) - (long)tile * 4 * 128 * 128; q.X1Q = (unsigned char*)(sl + OFF_VT) - t0 * DM; q.XQ = (unsigned char*)(sl + OFF_X2Q) - t0 * DM;
  q.Y = (bf16_t*)(sl + OFF_Y) - t0 * DM; q.Pb = (bf16_t*)(sl + OFF_Y) - t0 * DM;
  q.Q = (bf16_t*)(sl + OFF_Q) - t0 * DM; q.X2 = (bf16_t*)(sl + OFF_Q) - t0 * DM;
  return q;
}

#define XB_TMO      128
#define XB_XCNT(j)  (256  + 64 * (j))
#define XB_XSUB(j)  (1280 + 64 * (j))
#define XB_XGEN(j)  (2304 + 64 * (j))
#define XB_TOP      3328
#define XB_TOPGEN   3392
#define XCD_BAR_WORDS 3456
#define XB_SPIN_CAP (1u << 18)

__device__ __forceinline__ unsigned xb_ld(unsigned* p)              { return __hip_atomic_load(p, __ATOMIC_RELAXED, __HIP_MEMORY_SCOPE_AGENT); }
__device__ __forceinline__ unsigned xb_add(unsigned* p, unsigned v) { return __hip_atomic_fetch_add(p, v, __ATOMIC_RELAXED, __HIP_MEMORY_SCOPE_AGENT); }
__device__ __forceinline__ unsigned xb_xcc_id() { return (unsigned)__builtin_amdgcn_s_getreg((3 << 11) | 20) & 0xFu; }
#define XB_SPIN(cond, bar) do { unsigned _sp = 0; while (cond) { __builtin_amdgcn_s_sleep(1); \
    if ((++_sp & 255u) == 0u) { if (xb_ld(&(bar)[XB_TMO])) break; if (_sp > XB_SPIN_CAP) { atomicAdd(&(bar)[XB_TMO], 1u); break; } } } } while (0)

struct XcdBarrier {
    unsigned* bar; unsigned x;
    volatile LAS unsigned* st;
};

__device__ __forceinline__ XcdBarrier xcd_barrier_post(unsigned* bar, volatile LAS unsigned* st) {
    XcdBarrier b; b.bar = bar; b.x = xb_xcc_id(); b.st = st;
    if (threadIdx.x == 0) (void)xb_add(&bar[XB_XCNT(b.x)], 1u);
    return b;
}
__device__ __forceinline__ void xcd_barrier_complete(unsigned* bar, unsigned x, unsigned& nloc, unsigned& nx) {
    const unsigned G = gridDim.x * gridDim.y * gridDim.z;
    unsigned sum, cnt, mine, sp = 0u;
    for (;;) {
        sum = 0u; cnt = 0u; mine = 0u;
#pragma unroll
        for (unsigned j = 0; j < 16; ++j) { const unsigned c = xb_ld(&bar[XB_XCNT(j)]); sum += c; cnt += (c > 0u) ? 1u : 0u; mine = (j == x) ? c : mine; }
        if (sum == G) break;
        __builtin_amdgcn_s_sleep(1);
        if ((++sp & 255u) == 0u) { if (xb_ld(&bar[XB_TMO])) break; if (sp > XB_SPIN_CAP) { atomicAdd(&bar[XB_TMO], 1u); break; } }
    }
    nloc = mine > 0u ? mine : 1u; nx = cnt > 0u ? cnt : 1u;
}

__device__ __forceinline__ void xcd_barrier(const XcdBarrier& b) {
    asm volatile("s_waitcnt vmcnt(0)" ::: "memory");
    __syncthreads();
    if (threadIdx.x == 0) {
        unsigned* bar = b.bar;
        __builtin_amdgcn_s_waitcnt(0);
        unsigned nloc = b.st[0], nx = b.st[1];
        if (nloc == 0u) { xcd_barrier_complete(bar, b.x, nloc, nx); b.st[0] = nloc; b.st[1] = nx; }
        const unsigned old = xb_add(&bar[XB_XSUB(b.x)], 1u);
        const unsigned gen = old / nloc;
        if (old + 1u == (gen + 1u) * nloc) {
            __builtin_amdgcn_fence(__ATOMIC_RELEASE, "agent");
            asm volatile("s_waitcnt vmcnt(0)" ::: "memory");
            const unsigned og = xb_add(&bar[XB_TOP], 1u);
            const unsigned tg = og / nx;
            if (og + 1u == (tg + 1u) * nx) xb_add(&bar[XB_TOPGEN], 1u);
            else XB_SPIN(xb_ld(&bar[XB_TOPGEN]) == tg, bar);
            __builtin_amdgcn_fence(__ATOMIC_ACQUIRE, "agent");
            xb_add(&bar[XB_XGEN(b.x)], 1u);
            asm volatile("s_waitcnt vmcnt(0)" ::: "memory");
        } else {
            XB_SPIN(xb_ld(&bar[XB_XGEN(b.x)]) == gen, bar);
            __builtin_amdgcn_fence(__ATOMIC_ACQUIRE, "agent");
            asm volatile("s_waitcnt vmcnt(0)" ::: "memory");
        }
    }
    __syncthreads();
}


__global__ __launch_bounds__(512) void mega_k(P pg) {
  const int tile = blockIdx.x;
  volatile LAS unsigned* xbw = (volatile LAS unsigned*)((LAS char*)smem_raw + XB_LDS_OFF);
  if (threadIdx.x < 4) xbw[threadIdx.x] = 0u;
  __syncthreads();
  XcdBarrier xb = xcd_barrier_post(pg.bar, xbw);
  const P p = tile_view(pg, tile);
  phase_prep(pg);
  phase_xcvt(p, tile);
  xcd_barrier(xb);
  phase_inproj(p, tile);
  wg_sync_mem();
  phase_halo(p, tile);
  phase_kv(p, tile);
  if (tile < 64) phase_mt(p, tile);
  xcd_barrier(xb);
  phase_gh(p, tile);
  wg_sync_mem();
  phase_mixer(p, tile);
  wg_sync_mem();
  phase_outproj(p, tile);
  wg_sync_mem();
  xcd_barrier(xb);
  phase_gquant(pg);
  xcd_barrier(xb);
  phase_scores(p, tile);
  wg_sync_mem();
  phase_oproj(p, tile);
  wg_sync_mem();
  phase_pq(p, tile);
  wg_sync_mem();
  phase_route(p, tile);
  xcd_barrier(xb);
  phase_gdown(pg);
  xcd_barrier(xb);
  phase_gcomb(p, tile);
  xcd_barrier(xb);
  phase_gup(pg);
  xcd_barrier(xb);
  phase_ln3(p, tile);
}

extern "C" void kernel_launch(void* const* d_in, const int* in_sizes, int n_in, void* d_out, int out_size, void* d_ws, size_t ws_size, hipStream_t stream) {
  static int grid_blocks = 0;
  if (grid_blocks == 0) {
    int dev = 0, cus = 0, per_cu = 0;
    (void)hipGetDevice(&dev);
    (void)hipDeviceGetAttribute(&cus, hipDeviceAttributeMultiprocessorCount, dev);
    if (hipFuncSetAttribute((const void*)mega_k, hipFuncAttributeMaxDynamicSharedMemorySize, LDS_BYTES) != hipSuccess) fprintf(stderr, "kernel_launch: hipFuncSetAttribute failed\n");
    if (hipOccupancyMaxActiveBlocksPerMultiprocessor(&per_cu, (const void*)mega_k, 512, LDS_BYTES) != hipSuccess || per_cu < 1) { fprintf(stderr, "kernel_launch: occupancy query says %d blocks/CU\n", per_cu); per_cu = 1; }
    (void)hipGetLastError();
    grid_blocks = NTOK / 128;
    if (cus * per_cu < grid_blocks) fprintf(stderr, "kernel_launch: device holds only %d x %d resident blocks, need %d\n", cus, per_cu, grid_blocks);
  }
  char* w8 = (char*)d_ws;
  const size_t MiB = (size_t)1 << 20;
  P p{};
  p.x = (const float*)d_in[0]; p.mem = (const float*)d_in[1]; p.w_in = (const float*)d_in[2]; p.b_in = (const float*)d_in[3];
  p.sgu_g = (const float*)d_in[4]; p.sgu_b = (const float*)d_in[5]; p.w_sp = (const float*)d_in[6]; p.b_sp = (const float*)d_in[7];
  p.conv_w = (const float*)d_in[8]; p.w_mo = (const float*)d_in[9]; p.ln1_g = (const float*)d_in[10]; p.ln1_b = (const float*)d_in[11];
  p.w_xq = (const float*)d_in[12]; p.w_xkv = (const float*)d_in[13]; p.w_xo = (const float*)d_in[14]; p.ln2_g = (const float*)d_in[15]; p.ln2_b = (const float*)d_in[16];
  p.w_pq = (const float*)d_in[17]; p.sub_keys = (const float*)d_in[18]; p.w_down = (const float*)d_in[19]; p.w_up = (const float*)d_in[20];
  p.ln3_g = (const float*)d_in[21]; p.ln3_b = (const float*)d_in[22];
  p.out = (float*)d_out;
  p.slabs = w8;
  bf16_t* wb = (bf16_t*)(w8 + 384 * MiB);
  p.w_inT = wb; p.w_inQ = (signed char*)wb; wb += (size_t)INW * DM / 2; p.sw_in = (float*)wb; wb += 2 * INW; p.w_moT = wb; wb += (size_t)DM * DM; p.wsb = wb; wb += 4 * 128 * 128;
  p.w_xqT = wb; p.GTq = (signed char*)wb; wb += (size_t)4 * 1024 * DM / 2; p.sG = (float*)wb; wb += 2 * 4096; p.w_xkvT = wb; wb += (size_t)2048 * DM; p.w_xoT = wb; wb += (size_t)DM * DM;
  p.memB = wb; wb += (size_t)1024 * DM; p.Kc = wb; wb += (size_t)1024 * DM; p.Vc = wb; wb += (size_t)1024 * DM; p.wxqB = wb; wb += (size_t)DM * DM; p.GTb = wb; wb += (size_t)4 * 1024 * DM; p.HT = wb; wb += (size_t)4 * 1024 * DM;
  p.w_pqT = wb; wb += (size_t)2048 * DM; p.wpqB = wb; wb += (size_t)2048 * DM; p.skb = wb; wb += (size_t)8 * 2 * 128 * 128;
  p.WDq = (const unsigned char*)wb; wb += (size_t)16384 * DM / 2; p.WUq = (const unsigned char*)wb; wb += (size_t)16384 * DM / 2;
  p.sd = (const float*)wb; wb += 2 * 16384; p.su = (const float*)wb; wb += 2 * 16384;
  p.HALO = wb; wb += (size_t)256 * 2 * 512;
  p.SX = (float*)wb; wb += 2 * NTOK; p.SX1 = (float*)wb; wb += 2 * NTOK;
  p.bar = (unsigned*)wb; wb += 2 * 4096;
  if ((size_t)((char*)wb - w8) > ws_size) fprintf(stderr, "kernel_launch: workspace too small\n");
  (void)hipMemsetAsync(p.bar, 0, XCD_BAR_WORDS * 4, stream);
  void* args[] = {&p};
  hipError_t e = hipLaunchCooperativeKernel((const void*)mega_k, dim3(grid_blocks), dim3(512), args, LDS_BYTES, stream);
  if (e != hipSuccess) fprintf(stderr, "cooperative launch failed: %s (grid %d)\n", hipGetErrorString(e), grid_blocks);
}
```

```cpp
#include <hip/hip_runtime.h>
#include <stdint.h>
#include <cstdio>

#define DM 1024
#define NTOK 32768
#define SEQ 8192
#define INW 2560
#define ALPHA 1.189207115002721f
#define LN_EPS 1e-5f

__device__ __forceinline__ float gelu_f(float v) {
  const float t = __builtin_amdgcn_rcpf(fabsf(v) * 0.2316418882f + 1.0f);
  float q = t * 0.5307027145f + (-0.7265760135f); q = q * t + 0.7107068705f; q = q * t + (-0.142248368f); q = q * t + 0.127414796f; q = q * t;
  const float e = __builtin_amdgcn_exp2f((v * v) * (-0.72134752044f));
  const float m = v * (q * e);
  return v < 0.f ? m : v - m;
}

typedef unsigned short bf16_t;
typedef short bf16x8 __attribute__((ext_vector_type(8)));
typedef float f32x4 __attribute__((ext_vector_type(4)));
typedef unsigned u32x4 __attribute__((ext_vector_type(4)));
typedef unsigned u32x2 __attribute__((ext_vector_type(2)));
#define LAS __attribute__((address_space(3)))
extern __shared__ __attribute__((aligned(16))) char smem_raw[];

typedef float f32x2_t __attribute__((ext_vector_type(2)));
typedef __bf16 bf16x2_t __attribute__((ext_vector_type(2)));
typedef _Float16 f16x2_t __attribute__((ext_vector_type(2)));
__device__ __forceinline__ unsigned pk_f16(float lo, float hi) { const f32x2_t v = {lo, hi}; return __builtin_bit_cast(unsigned, __builtin_convertvector(v, f16x2_t)); }
__device__ __forceinline__ float f16_lo(unsigned u) { return (float)__builtin_bit_cast(f16x2_t, u)[0]; }
__device__ __forceinline__ float f16_hi(unsigned u) { return (float)__builtin_bit_cast(f16x2_t, u)[1]; }
__device__ __forceinline__ unsigned pk_bf16(float lo, float hi) { const f32x2_t v = {lo, hi}; return __builtin_bit_cast(unsigned, __builtin_convertvector(v, bf16x2_t)); }
__device__ __forceinline__ int otid() { int t = threadIdx.x; asm volatile("" : "+v"(t)); return t; }
__device__ __forceinline__ unsigned pack4_i8(float a, float b, float c, float d) {
  const int ia = __float2int_rn(a), ib = __float2int_rn(b), ic = __float2int_rn(c), id = __float2int_rn(d);
  return ((unsigned)ia & 0xffu) | (((unsigned)ib & 0xffu) << 8) | (((unsigned)ic & 0xffu) << 16) | ((unsigned)id << 24);
}
__device__ __forceinline__ float bf_lo(unsigned u) { return __uint_as_float(u << 16); }
__device__ __forceinline__ float bf_hi(unsigned u) { return __uint_as_float(u & 0xffff0000u); }

template <int BN, class Epi>
__device__ __forceinline__ void wg_gemm(const bf16_t* __restrict__ A, int lda, const bf16_t* __restrict__ Bt, int ldb, int K, Epi&& epi) {
  constexpr int NT = BN / 64;
  constexpr int STAGE_BYTES = (128 + BN) * 128;
  constexpr int LA = 2, LB = BN / 64;
  LAS char* lds = (LAS char*)smem_raw;
  const int tid = otid(), lane = tid & 63, wid = tid >> 6, wr = wid >> 2, wc = wid & 3, fr = lane & 15, fq = lane >> 4;
  f32x4 acc[4][NT];
#pragma unroll
  for (int m = 0; m < 4; ++m)
#pragma unroll
    for (int n = 0; n < NT; ++n) acc[m][n] = (f32x4){0.f, 0.f, 0.f, 0.f};
  const int nk = K / 64;
  auto piece = [&](int buf, int kt, int i) {
    LAS char* base = lds + buf * STAGE_BYTES;
    if (i < LA) {
      const int q = tid + i * 512, row = q >> 3, c = (q & 7) ^ (row & 7);
      __builtin_amdgcn_global_load_lds((const unsigned*)(A + (long)row * lda + kt * 64 + c * 8), (LAS unsigned*)(base + q * 16), 16, 0, 2);
    } else {
      const int q = tid + (i - LA) * 512, row = q >> 3, c = (q & 7) ^ (row & 7);
      __builtin_amdgcn_global_load_lds((const unsigned*)(Bt + (long)row * ldb + kt * 64 + c * 8), (LAS unsigned*)(base + 16384 + q * 16), 16, 0, 0);
    }
  };
  auto stage = [&](int buf, int kt) {
#pragma unroll
    for (int i = 0; i < LA + LB; ++i) piece(buf, kt, i);
  };
  asm volatile("s_waitcnt vmcnt(0)" ::: "memory");
  __builtin_amdgcn_s_barrier();
  asm volatile("" ::: "memory");
  stage(0, 0);
  if (nk > 1) stage(1, 1);
  for (int kt = 0; kt < nk; ++kt) {
    if (kt + 1 < nk) asm volatile("s_waitcnt vmcnt(%0)" ::"n"(LA + LB) : "memory");
    else asm volatile("s_waitcnt vmcnt(0)" ::: "memory");
    __builtin_amdgcn_s_barrier();
    asm volatile("" ::: "memory");
    LAS const char* base = lds + (kt % 3) * STAGE_BYTES;
    bf16x8 af[4][2], bfr[NT][2];
#pragma unroll
    for (int m = 0; m < 4; ++m)
#pragma unroll
      for (int kk = 0; kk < 2; ++kk) {
        const int row = wr * 64 + m * 16 + fr, c = (kk * 4 + fq) ^ (fr & 7);
        af[m][kk] = *(LAS const bf16x8*)(base + row * 128 + c * 16);
      }
#pragma unroll
    for (int n = 0; n < NT; ++n)
#pragma unroll
      for (int kk = 0; kk < 2; ++kk) {
        const int row = wc * (BN / 4) + n * 16 + fr, c = (kk * 4 + fq) ^ (fr & 7);
        bfr[n][kk] = *(LAS const bf16x8*)(base + 16384 + row * 128 + c * 16);
      }
#pragma unroll
    for (int kk = 0; kk < 2; ++kk)
#pragma unroll
      for (int m = 0; m < 4; ++m) {
        if (kk * 4 + m < LA + LB) {
          __builtin_amdgcn_sched_barrier(0);
          if (kt + 2 < nk) piece((kt + 2) % 3, kt + 2, kk * 4 + m);
          __builtin_amdgcn_sched_barrier(0);
        }
#pragma unroll
        for (int n = 0; n < NT; ++n) acc[m][n] = __builtin_amdgcn_mfma_f32_16x16x32_bf16(bfr[n][kk], af[m][kk], acc[m][n], 0, 0, 0);
      }
  }
  epi(acc, wr, wc, fr, fq);
}

typedef int v4i_t __attribute__((ext_vector_type(4)));
template <int BN, class Epi>
__device__ __forceinline__ void wg_gemm_i8(const signed char* __restrict__ A, int lda, const signed char* __restrict__ Bt, int ldb, int K, Epi&& epi) {
  constexpr int NT = BN / 64;
  constexpr int STAGE_BYTES = (128 + BN) * 128;
  constexpr int LA = 2, LB = BN / 64;
  LAS char* lds = (LAS char*)smem_raw;
  const int tid = otid(), lane = tid & 63, wid = tid >> 6, wr = wid >> 2, wc = wid & 3, fr = lane & 15, fq = lane >> 4;
  v4i_t acc[4][NT];
#pragma unroll
  for (int m = 0; m < 4; ++m)
#pragma unroll
    for (int n = 0; n < NT; ++n) acc[m][n] = (v4i_t){0, 0, 0, 0};
  const int nk = K / 128;
  auto piece = [&](int buf, int kt, int i) {
    LAS char* base = lds + buf * STAGE_BYTES;
    if (i < LA) {
      const int q = tid + i * 512, row = q >> 3, c = (q & 7) ^ (row & 7);
      __builtin_amdgcn_global_load_lds((const unsigned*)(A + (long)row * lda + kt * 128 + c * 16), (LAS unsigned*)(base + q * 16), 16, 0, 2);
    } else {
      const int q = tid + (i - LA) * 512, row = q >> 3, c = (q & 7) ^ (row & 7);
      __builtin_amdgcn_global_load_lds((const unsigned*)(Bt + (long)row * ldb + kt * 128 + c * 16), (LAS unsigned*)(base + 16384 + q * 16), 16, 0, 0);
    }
  };
  auto stage = [&](int buf, int kt) {
#pragma unroll
    for (int i = 0; i < LA + LB; ++i) piece(buf, kt, i);
  };
  asm volatile("s_waitcnt vmcnt(0)" ::: "memory");
  __builtin_amdgcn_s_barrier();
  asm volatile("" ::: "memory");
  stage(0, 0);
  if (nk > 1) stage(1, 1);
  for (int kt = 0; kt < nk; ++kt) {
    if (kt + 1 < nk) asm volatile("s_waitcnt vmcnt(%0)" ::"n"(LA + LB) : "memory");
    else asm volatile("s_waitcnt vmcnt(0)" ::: "memory");
    __builtin_amdgcn_s_barrier();
    asm volatile("" ::: "memory");
    LAS const char* base = lds + (kt % 3) * STAGE_BYTES;
    v4i_t af[4][2], bfr[NT][2];
#pragma unroll
    for (int m = 0; m < 4; ++m)
#pragma unroll
      for (int kk = 0; kk < 2; ++kk) {
        const int row = wr * 64 + m * 16 + fr, c = (kk * 4 + fq) ^ (fr & 7);
        af[m][kk] = *(LAS const v4i_t*)(base + row * 128 + c * 16);
      }
#pragma unroll
    for (int n = 0; n < NT; ++n)
#pragma unroll
      for (int kk = 0; kk < 2; ++kk) {
        const int row = wc * (BN / 4) + n * 16 + fr, c = (kk * 4 + fq) ^ (fr & 7);
        bfr[n][kk] = *(LAS const v4i_t*)(base + 16384 + row * 128 + c * 16);
      }
#pragma unroll
    for (int kk = 0; kk < 2; ++kk)
#pragma unroll
      for (int m = 0; m < 4; ++m) {
        if (kk * 4 + m < LA + LB) {
          __builtin_amdgcn_sched_barrier(0);
          if (kt + 2 < nk) piece((kt + 2) % 3, kt + 2, kk * 4 + m);
          __builtin_amdgcn_sched_barrier(0);
        }
#pragma unroll
        for (int n = 0; n < NT; ++n) acc[m][n] = __builtin_amdgcn_mfma_i32_16x16x64_i8(bfr[n][kk], af[m][kk], acc[m][n], 0, 0, 0);
      }
  }
  epi(acc, wr, wc, fr, fq);
}

#define GEMM_LDS_BYTES (3 * (128 + 256) * 128)
#define RED_OFF GEMM_LDS_BYTES
#define XB_LDS_OFF (GEMM_LDS_BYTES + 4096)
#define LDS_BYTES (GEMM_LDS_BYTES + 4096 + 16)

struct P {
  const float* x; const float* mem; const float* b_in; const float* sgu_g; const float* sgu_b; const float* b_sp; const float* conv_w;
  const float* ln1_g; const float* ln1_b; const float* ln2_g; const float* ln2_b; const float* ln3_g; const float* ln3_b;
  const bf16_t* XB; const bf16_t* w_inT; const bf16_t* w_moT; const bf16_t* wsb;
  bf16_t* ZB; bf16_t* VT; bf16_t* Y; float* PRE; bf16_t* X1;
  const bf16_t* w_xqT; const bf16_t* w_xkvT; const bf16_t* w_xoT; const bf16_t* memB;
  bf16_t* Kc; bf16_t* Vc; bf16_t* Q; bf16_t* Pb; bf16_t* X2;
  const bf16_t* wxqB; bf16_t* GTb; bf16_t* HT;
  const bf16_t* w_pqT;
  const bf16_t* wpqB;
  const bf16_t* skb; unsigned* KEYS; unsigned char* X1Q; int* experts; float* gates;
  const unsigned char* WDq; const unsigned char* WUq; const float* sd; const float* su; float* out;
  signed char* w_inQ; float* sw_in; signed char* GTq; float* sG; float* SX1;
  char* slabs;
  unsigned* bar; unsigned char* XQ; float* SX; int* PD; float* H3;
  bf16_t* HALO;
  const float* w_in; const float* w_mo; const float* w_sp; const float* w_xq; const float* w_xkv; const float* w_xo; const float* w_pq; const float* sub_keys; const float* w_down; const float* w_up;
};

#define SLAB_BYTES (1536 * 1024)
#define OFF_XB 0
#define OFF_EXP 0
#define OFF_GATE (64 * 1024)
#define OFF_CQ (128 * 1024)
#define OFF_SC (144 * 1024)
#define OFF_X2Q (128 * 1024)
#define OFF_ZB (256 * 1024)
#define OFF_VT (896 * 1024)
#define OFF_Y (1024 * 1024)
#define OFF_Q (1280 * 1024)
__device__ __forceinline__ void wg_sync_mem() { asm volatile("s_waitcnt vmcnt(0) lgkmcnt(0)" ::: "memory"); __syncthreads(); }

#define OFF_SXB (128 * 1024)
__device__ __forceinline__ void phase_inproj(const P& p, int tile) {
  const signed char* xq = (const signed char*)(p.slabs + (size_t)tile * SLAB_BYTES + OFF_XB);
  const float* sxr = (const float*)(p.slabs + (size_t)tile * SLAB_BYTES + OFF_SXB);
  for (int nt = 0; nt < INW / 256; ++nt) {
    wg_gemm_i8<256>(xq, DM, p.w_inQ + (long)nt * 256 * DM, DM, DM, [&](v4i_t (&acc)[4][4], int wr, int wc, int fr, int fq) {
#pragma unroll
      for (int m = 0; m < 4; ++m) {
        const int rl = wr * 64 + m * 16 + fr;
        const float sr = sxr[rl];
#pragma unroll
        for (int n = 0; n < 4; ++n) {
          const int row = tile * 128 + rl, col = nt * 256 + wc * 64 + n * 16 + fq * 4;
          const float4 bv = *(const float4*)(p.b_in + col), sw = *(const float4*)(p.sw_in + col);
          float o0 = (float)acc[m][n][0] * (sr * sw.x) + bv.x, o1 = (float)acc[m][n][1] * (sr * sw.y) + bv.y, o2 = (float)acc[m][n][2] * (sr * sw.z) + bv.z, o3 = (float)acc[m][n][3] * (sr * sw.w) + bv.w;
          if (nt < 4) { o0 = gelu_f(o0); o1 = gelu_f(o1); o2 = gelu_f(o2); o3 = gelu_f(o3); }
          u32x2 w; w.x = pk_bf16(o0, o1); w.y = pk_bf16(o2, o3);
          *(u32x2*)(p.ZB + (long)row * INW + col) = w;
        }
      }
    });
  }
}

__device__ __forceinline__ void phase_mixer(const P& p, int tile) {
  const int tid = otid(), lane = tid & 63, wid = tid >> 6;
  const long t0 = (long)tile * 128;
  const bool seq_start = ((tile & 63) == 0);
#pragma unroll 2
  for (int it = tid; it < 128 * 64; it += 512) {
    const int tl = it >> 6, c = (it & 63) * 8;
    const long t = t0 + tl;
    float conv[8];
#pragma unroll
    for (int j = 0; j < 8; ++j) conv[j] = 0.f;
#pragma unroll
    for (int k = 0; k < 3; ++k) {
      const int rl = tl - 2 + k;
      const float4 w0 = *(const float4*)(p.conv_w + k * 512 + c), w1 = *(const float4*)(p.conv_w + k * 512 + c + 4);
      if (rl >= 0) {
        const bf16_t* zr = p.ZB + (t0 + rl) * INW;
        const u32x4 hb = *(const u32x4*)(zr + 1024 + c), gc = *(const u32x4*)(zr + 2048 + c);
        conv[0] += w0.x * (bf_lo(hb.x) * bf_lo(gc.x)); conv[1] += w0.y * (bf_hi(hb.x) * bf_hi(gc.x));
        conv[2] += w0.z * (bf_lo(hb.y) * bf_lo(gc.y)); conv[3] += w0.w * (bf_hi(hb.y) * bf_hi(gc.y));
        conv[4] += w1.x * (bf_lo(hb.z) * bf_lo(gc.z)); conv[5] += w1.y * (bf_hi(hb.z) * bf_hi(gc.z));
        conv[6] += w1.z * (bf_lo(hb.w) * bf_lo(gc.w)); conv[7] += w1.w * (bf_hi(hb.w) * bf_hi(gc.w));
      } else if (!seq_start) {
        const u32x4 zc = *(const u32x4*)(p.HALO + ((long)(tile - 1) * 2 + (rl + 2)) * 512 + c);
        conv[0] += w0.x * bf_lo(zc.x); conv[1] += w0.y * bf_hi(zc.x); conv[2] += w0.z * bf_lo(zc.y); conv[3] += w0.w * bf_hi(zc.y);
        conv[4] += w1.x * bf_lo(zc.z); conv[5] += w1.y * bf_hi(zc.z); conv[6] += w1.z * bf_lo(zc.w); conv[7] += w1.w * bf_hi(zc.w);
      }
    }
    const u32x4 gb = *(const u32x4*)(p.ZB + t * INW + 1536 + c);
    u32x4 o;
    o.x = pk_bf16(bf_lo(gb.x) * conv[0], bf_hi(gb.x) * conv[1]); o.y = pk_bf16(bf_lo(gb.y) * conv[2], bf_hi(gb.y) * conv[3]);
    o.z = pk_bf16(bf_lo(gb.z) * conv[4], bf_hi(gb.z) * conv[5]); o.w = pk_bf16(bf_lo(gb.w) * conv[6], bf_hi(gb.w) * conv[7]);
    *(u32x4*)(p.Y + t * DM + 512 + c) = o;
  }
  for (int h = 0; h < 4; ++h) {
    float a0[16], a1[16];
    const float g0 = p.sgu_g[h * 128 + 2 * lane], g1 = p.sgu_g[h * 128 + 2 * lane + 1], b0 = p.sgu_b[h * 128 + 2 * lane], b1 = p.sgu_b[h * 128 + 2 * lane + 1];
#pragma unroll
    for (int i = 0; i < 16; ++i) {
      const unsigned v = *(const unsigned*)(p.ZB + (t0 + wid * 16 + i) * INW + 512 + h * 128 + 2 * lane);
      const float x0 = bf_lo(v), x1 = bf_hi(v);
      float sum = x0 + x1;
#pragma unroll
      for (int o = 32; o > 0; o >>= 1) sum += __shfl_xor(sum, o);
      const float mu = sum * (1.f / 128.f);
      const float d0 = x0 - mu, d1 = x1 - mu;
      float q = d0 * d0 + d1 * d1;
#pragma unroll
      for (int o = 32; o > 0; o >>= 1) q += __shfl_xor(q, o);
      const float rstd = rsqrtf(q * (1.f / 128.f) + LN_EPS);
      a0[i] = d0 * rstd * g0 + b0; a1[i] = d1 * rstd * g1 + b1;
    }
    bf16_t* vt = p.VT + ((long)tile * 4 + h) * 128 * 128;
    u32x4 o;
    o.x = pk_bf16(a0[0], a0[1]); o.y = pk_bf16(a0[2], a0[3]); o.z = pk_bf16(a0[4], a0[5]); o.w = pk_bf16(a0[6], a0[7]);
    *(u32x4*)(vt + (2 * lane) * 128 + wid * 16) = o;
    o.x = pk_bf16(a0[8], a0[9]); o.y = pk_bf16(a0[10], a0[11]); o.z = pk_bf16(a0[12], a0[13]); o.w = pk_bf16(a0[14], a0[15]);
    *(u32x4*)(vt + (2 * lane) * 128 + wid * 16 + 8) = o;
    o.x = pk_bf16(a1[0], a1[1]); o.y = pk_bf16(a1[2], a1[3]); o.z = pk_bf16(a1[4], a1[5]); o.w = pk_bf16(a1[6], a1[7]);
    *(u32x4*)(vt + (2 * lane + 1) * 128 + wid * 16) = o;
    o.x = pk_bf16(a1[8], a1[9]); o.y = pk_bf16(a1[10], a1[11]); o.z = pk_bf16(a1[12], a1[13]); o.w = pk_bf16(a1[14], a1[15]);
    *(u32x4*)(vt + (2 * lane + 1) * 128 + wid * 16 + 8) = o;
  }
  wg_sync_mem();
  for (int h = 0; h < 4; ++h) {
    wg_gemm<128>(p.wsb + h * 128 * 128, 128, p.VT + ((long)tile * 4 + h) * 128 * 128, 128, 128, [&](f32x4 (&acc)[4][2], int wr, int wc, int fr, int fq) {
#pragma unroll
      for (int m = 0; m < 4; ++m)
#pragma unroll
        for (int n = 0; n < 2; ++n) {
          const int rl = wr * 64 + m * 16 + fr, col = wc * 32 + n * 16 + fq * 4;
          const float bs = p.b_sp[h * 128 + rl];
          const u32x2 uv = *(const u32x2*)(p.ZB + (t0 + rl) * INW + h * 128 + col);
          u32x2 w;
          w.x = pk_bf16(bf_lo(uv.x) * (acc[m][n][0] + bs), bf_hi(uv.x) * (acc[m][n][1] + bs));
          w.y = pk_bf16(bf_lo(uv.y) * (acc[m][n][2] + bs), bf_hi(uv.y) * (acc[m][n][3] + bs));
          *(u32x2*)(p.Y + (t0 + rl) * DM + h * 128 + col) = w;
        }
    });
  }
}

__device__ __forceinline__ void ln_rows16(const float* __restrict__ PRE, long r0, const float* __restrict__ g, const float* __restrict__ b, bf16_t* __restrict__ Out, int lane) {
#pragma unroll 2
  for (int i = 0; i < 16; ++i) {
    const bf16_t* pr = (const bf16_t*)PRE + (r0 + i) * DM;
    float4 v[4];
    float sum = 0.f;
#pragma unroll
    for (int j = 0; j < 4; ++j) { const u32x2 pv = *(const u32x2*)(pr + j * 256 + lane * 4); v[j].x = bf_lo(pv.x); v[j].y = bf_hi(pv.x); v[j].z = bf_lo(pv.y); v[j].w = bf_hi(pv.y); sum += (v[j].x + v[j].y) + (v[j].z + v[j].w); }
#pragma unroll
    for (int o = 32; o > 0; o >>= 1) sum += __shfl_xor(sum, o);
    const float mu = sum * (1.f / DM);
    float q = 0.f;
#pragma unroll
    for (int j = 0; j < 4; ++j) { v[j].x -= mu; v[j].y -= mu; v[j].z -= mu; v[j].w -= mu; q += (v[j].x * v[j].x + v[j].y * v[j].y) + (v[j].z * v[j].z + v[j].w * v[j].w); }
#pragma unroll
    for (int o = 32; o > 0; o >>= 1) q += __shfl_xor(q, o);
    const float rstd = rsqrtf(q * (1.f / DM) + LN_EPS);
#pragma unroll
    for (int j = 0; j < 4; ++j) {
      const int c0 = j * 256 + lane * 4;
      const float4 gg = *(const float4*)(g + c0), bb = *(const float4*)(b + c0);
      u32x2 w; w.x = pk_bf16(v[j].x * rstd * gg.x + bb.x, v[j].y * rstd * gg.y + bb.y); w.y = pk_bf16(v[j].z * rstd * gg.z + bb.z, v[j].w * rstd * gg.w + bb.w);
      *(u32x2*)(Out + (r0 + i) * DM + c0) = w;
    }
  }
}

__device__ __forceinline__ void ln_rows16_q(const float* __restrict__ PRE, long r0, const float* __restrict__ g, const float* __restrict__ b, bf16_t* __restrict__ Out,
                                            unsigned char* __restrict__ XQ, float* __restrict__ SX, int lane) {
#pragma unroll 2
  for (int i = 0; i < 16; ++i) {
    const bf16_t* pr = (const bf16_t*)PRE + (r0 + i) * DM;
    float4 v[4];
    float sum = 0.f;
#pragma unroll
    for (int j = 0; j < 4; ++j) { const u32x2 pv = *(const u32x2*)(pr + j * 256 + lane * 4); v[j].x = bf_lo(pv.x); v[j].y = bf_hi(pv.x); v[j].z = bf_lo(pv.y); v[j].w = bf_hi(pv.y); sum += (v[j].x + v[j].y) + (v[j].z + v[j].w); }
#pragma unroll
    for (int o = 32; o > 0; o >>= 1) sum += __shfl_xor(sum, o);
    const float mu = sum * (1.f / DM);
    float q = 0.f;
#pragma unroll
    for (int j = 0; j < 4; ++j) { v[j].x -= mu; v[j].y -= mu; v[j].z -= mu; v[j].w -= mu; q += (v[j].x * v[j].x + v[j].y * v[j].y) + (v[j].z * v[j].z + v[j].w * v[j].w); }
#pragma unroll
    for (int o = 32; o > 0; o >>= 1) q += __shfl_xor(q, o);
    const float rstd = rsqrtf(q * (1.f / DM) + LN_EPS);
    float amax = 0.f;
#pragma unroll
    for (int j = 0; j < 4; ++j) {
      const int c0 = j * 256 + lane * 4;
      const float4 gg = *(const float4*)(g + c0), bb = *(const float4*)(b + c0);
      v[j].x = v[j].x * rstd * gg.x + bb.x; v[j].y = v[j].y * rstd * gg.y + bb.y; v[j].z = v[j].z * rstd * gg.z + bb.z; v[j].w = v[j].w * rstd * gg.w + bb.w;
      u32x2 w; w.x = pk_bf16(v[j].x, v[j].y); w.y = pk_bf16(v[j].z, v[j].w);
      *(u32x2*)(Out + (r0 + i) * DM + c0) = w;
      amax = fmaxf(amax, fmaxf(fmaxf(fabsf(v[j].x), fabsf(v[j].y)), fmaxf(fabsf(v[j].z), fabsf(v[j].w))));
    }
#pragma unroll
    for (int o = 32; o > 0; o >>= 1) amax = fmaxf(amax, __shfl_xor(amax, o));
    const float inv = amax > 0.f ? 127.f / amax : 0.f;
#pragma unroll
    for (int j = 0; j < 4; ++j) *(unsigned*)(XQ + (r0 + i) * DM + j * 256 + lane * 4) = pack4_i8(v[j].x * inv, v[j].y * inv, v[j].z * inv, v[j].w * inv);
    if (lane == 0) SX[r0 + i] = amax * (1.f / 127.f);
  }
}

__device__ __forceinline__ void phase_outproj(const P& p, int tile) {
  const long t0 = (long)tile * 128;
  for (int nt = 0; nt < 4; ++nt) {
    wg_gemm<256>(p.Y + t0 * DM, DM, p.w_moT + (long)nt * 256 * DM, DM, DM, [&](f32x4 (&acc)[4][4], int wr, int wc, int fr, int fq) {
#pragma unroll
      for (int m = 0; m < 4; ++m)
#pragma unroll
        for (int n = 0; n < 4; ++n) {
          const long row = t0 + wr * 64 + m * 16 + fr; const int col = nt * 256 + wc * 64 + n * 16 + fq * 4;
          const float4 xv = *(const float4*)(p.x + row * DM + col);
          u32x2 o; o.x = pk_bf16(ALPHA * xv.x + acc[m][n][0], ALPHA * xv.y + acc[m][n][1]); o.y = pk_bf16(ALPHA * xv.z + acc[m][n][2], ALPHA * xv.w + acc[m][n][3]);
          *(u32x2*)((bf16_t*)p.PRE + row * DM + col) = o;
        }
    });
  }
  wg_sync_mem();
  ln_rows16_q(p.PRE, t0 + (threadIdx.x >> 6) * 16, p.ln1_g, p.ln1_b, p.X1, p.X1Q, p.SX1, threadIdx.x & 63);
}

__device__ __forceinline__ void phase_kv(const P& p, int unit) {
  const int rt = unit >> 5, nc = unit & 31;
  wg_gemm<64>(p.memB + (long)rt * 128 * DM, DM, p.w_xkvT + (long)nc * 64 * DM, DM, DM, [&](f32x4 (&acc)[4][1], int wr, int wc, int fr, int fq) {
    const int b = rt >> 1, col = nc * 64 + wc * 16 + fq * 4, hh = (col >> 8) & 3, d = col & 255;
#pragma unroll
    for (int m = 0; m < 4; ++m) {
      const int mm = (rt & 1) * 128 + wr * 64 + m * 16 + fr;
      u32x2 w; w.x = pk_bf16(acc[m][0][0], acc[m][0][1]); w.y = pk_bf16(acc[m][0][2], acc[m][0][3]);
      *(u32x2*)((col < 1024 ? p.Kc : p.Vc) + ((long)(b * 4 + hh) * 256 + mm) * 256 + d) = w;
    }
  });
}

__device__ __forceinline__ void phase_gh(const P& p, int unit) {
  if (unit < 128) {
    const int bh = unit >> 3, rt = (unit >> 2) & 1, nt = unit & 3, h = bh & 3, b = bh >> 2;
    wg_gemm<256>(p.Kc + ((long)bh * 256 + rt * 128) * 256, 256, p.wxqB + (long)nt * 256 * DM + h * 256, DM, 256, [&](f32x4 (&acc)[4][4], int wr, int wc, int fr, int fq) {
#pragma unroll
      for (int m = 0; m < 4; ++m)
#pragma unroll
        for (int n = 0; n < 4; ++n) {
          const long row = (long)b * 1024 + h * 256 + rt * 128 + wr * 64 + m * 16 + fr; const int col = nt * 256 + wc * 64 + n * 16 + fq * 4;
          u32x2 w; w.x = pk_bf16(acc[m][n][0], acc[m][n][1]); w.y = pk_bf16(acc[m][n][2], acc[m][n][3]);
          *(u32x2*)(p.GTb + row * DM + col) = w;
        }
    });
  } else {
    const int u = unit - 128, bh = u >> 3, rt = u & 7, h = bh & 3, b = bh >> 2;
    wg_gemm<256>(p.w_xoT + (long)rt * 128 * DM + h * 256, DM, p.Vc + (long)bh * 256 * 256, 256, 256, [&](f32x4 (&acc)[4][4], int wr, int wc, int fr, int fq) {
#pragma unroll
      for (int m = 0; m < 4; ++m)
#pragma unroll
        for (int n = 0; n < 4; ++n) {
          const long row = (long)b * 1024 + rt * 128 + wr * 64 + m * 16 + fr; const int col = h * 256 + wc * 64 + n * 16 + fq * 4;
          u32x2 w; w.x = pk_bf16(acc[m][n][0], acc[m][n][1]); w.y = pk_bf16(acc[m][n][2], acc[m][n][3]);
          *(u32x2*)(p.HT + row * DM + col) = w;
        }
    });
  }
}

__device__ __forceinline__ void phase_gquant(const P& p) {
  const int lane = threadIdx.x & 63, wid = threadIdx.x >> 6;
#pragma unroll
  for (int i = 0; i < 2; ++i) {
    const long row = (long)blockIdx.x * 16 + wid * 2 + i;
    u32x2 v[4];
    float amax = 0.f;
#pragma unroll
    for (int j = 0; j < 4; ++j) {
      v[j] = *(const u32x2*)(p.GTb + row * DM + 256 * j + lane * 4);
      amax = fmaxf(amax, fmaxf(fmaxf(fabsf(bf_lo(v[j].x)), fabsf(bf_hi(v[j].x))), fmaxf(fabsf(bf_lo(v[j].y)), fabsf(bf_hi(v[j].y)))));
    }
#pragma unroll
    for (int o = 32; o > 0; o >>= 1) amax = fmaxf(amax, __shfl_xor(amax, o));
    const float inv = amax > 0.f ? 127.f / amax : 0.f;
#pragma unroll
    for (int j = 0; j < 4; ++j) *(unsigned*)(p.GTq + row * DM + 256 * j + lane * 4) = pack4_i8(bf_lo(v[j].x) * inv, bf_hi(v[j].x) * inv, bf_lo(v[j].y) * inv, bf_hi(v[j].y) * inv);
    if (lane == 0) p.sG[row] = amax * (1.f / 127.f);
  }
}

__device__ __forceinline__ void phase_scores(const P& p, int tile) {
  const long t0 = (long)tile * 128;
  const int b = tile >> 6;
  LAS float* red = (LAS float*)((LAS char*)smem_raw + RED_OFF);
  for (int h = 0; h < 4; ++h) {
    bf16_t* Pw = p.Pb + t0 * DM + h * 256;
    wg_gemm_i8<256>((const signed char*)p.X1Q + t0 * DM, DM, p.GTq + ((long)b * 1024 + h * 256) * DM, DM, DM, [&](v4i_t (&iacc)[4][4], int wr, int wc, int fr, int fq) {
      f32x4 acc[4][4];
      float rmax[4];
#pragma unroll
      for (int m = 0; m < 4; ++m) {
        const float sr = p.SX1[t0 + wr * 64 + m * 16 + fr] * 0.0625f;
#pragma unroll
        for (int n = 0; n < 4; ++n) {
          const float4 sw = *(const float4*)(p.sG + b * 1024 + h * 256 + wc * 64 + n * 16 + fq * 4);
          acc[m][n][0] = (float)iacc[m][n][0] * (sr * sw.x); acc[m][n][1] = (float)iacc[m][n][1] * (sr * sw.y);
          acc[m][n][2] = (float)iacc[m][n][2] * (sr * sw.z); acc[m][n][3] = (float)iacc[m][n][3] * (sr * sw.w);
        }
      }
#pragma unroll
      for (int m = 0; m < 4; ++m) {
        float mx = -3.0e38f;
#pragma unroll
        for (int n = 0; n < 4; ++n) mx = fmaxf(mx, fmaxf(fmaxf(acc[m][n][0], acc[m][n][1]), fmaxf(acc[m][n][2], acc[m][n][3])));
        mx = fmaxf(mx, __shfl_xor(mx, 16)); mx = fmaxf(mx, __shfl_xor(mx, 32));
        if (fq == 0) red[(wr * 64 + m * 16 + fr) * 4 + wc] = mx;
      }
      __syncthreads();
#pragma unroll
      for (int m = 0; m < 4; ++m) {
        const f32x4 r = *(LAS const f32x4*)(red + (wr * 64 + m * 16 + fr) * 4);
        rmax[m] = fmaxf(fmaxf(r[0], r[1]), fmaxf(r[2], r[3]));
      }
#pragma unroll
      for (int m = 0; m < 4; ++m) {
        float sm = 0.f;
#pragma unroll
        for (int n = 0; n < 4; ++n)
#pragma unroll
          for (int j = 0; j < 4; ++j) { const float e = __expf(acc[m][n][j] - rmax[m]); acc[m][n][j] = e; sm += e; }
        sm += __shfl_xor(sm, 16); sm += __shfl_xor(sm, 32);
        if (fq == 0) red[512 + (wr * 64 + m * 16 + fr) * 4 + wc] = sm;
      }
      __syncthreads();
#pragma unroll
      for (int m = 0; m < 4; ++m) {
        const f32x4 r = *(LAS const f32x4*)(red + 512 + (wr * 64 + m * 16 + fr) * 4);
        const float inv = 1.f / ((r[0] + r[1]) + (r[2] + r[3]));
        const int rl = wr * 64 + m * 16 + fr;
#pragma unroll
        for (int n = 0; n < 4; ++n) {
          u32x2 w; w.x = pk_bf16(acc[m][n][0] * inv, acc[m][n][1] * inv); w.y = pk_bf16(acc[m][n][2] * inv, acc[m][n][3] * inv);
          *(u32x2*)(Pw + rl * DM + wc * 64 + n * 16 + fq * 4) = w;
        }
      }
    });
  }
}

__device__ __forceinline__ void phase_oproj(const P& p, int tile) {
  const long t0 = (long)tile * 128;
  for (int nt = 0; nt < 4; ++nt) {
    wg_gemm<256>(p.Pb + t0 * DM, DM, p.HT + ((long)(tile >> 6) * 1024 + nt * 256) * DM, DM, DM, [&](f32x4 (&acc)[4][4], int wr, int wc, int fr, int fq) {
#pragma unroll
      for (int m = 0; m < 4; ++m)
#pragma unroll
        for (int n = 0; n < 4; ++n) {
          const long row = t0 + wr * 64 + m * 16 + fr; const int col = nt * 256 + wc * 64 + n * 16 + fq * 4;
          const u32x2 xv = *(const u32x2*)(p.X1 + row * DM + col);
          u32x2 o; o.x = pk_bf16(ALPHA * bf_lo(xv.x) + acc[m][n][0], ALPHA * bf_hi(xv.x) + acc[m][n][1]); o.y = pk_bf16(ALPHA * bf_lo(xv.y) + acc[m][n][2], ALPHA * bf_hi(xv.y) + acc[m][n][3]);
          *(u32x2*)((bf16_t*)p.PRE + row * DM + col) = o;
        }
    });
  }
  wg_sync_mem();
  ln_rows16_q(p.PRE, t0 + (threadIdx.x >> 6) * 16, p.ln2_g, p.ln2_b, p.X2, p.XQ, p.SX, threadIdx.x & 63);
}

__device__ __forceinline__ unsigned f2key(float f) { const unsigned b = __float_as_uint(f); return b ^ ((unsigned)((int)b >> 31) | 0x80000000u); }
__device__ __forceinline__ float key2f(unsigned k) { return __uint_as_float(k ^ ((k & 0x80000000u) ? 0x80000000u : 0xffffffffu)); }
__device__ __forceinline__ void phase_pq(const P& p, int tile) {
  const long t0 = (long)tile * 128;
  for (int nt = 0; nt < 8; ++nt) {
    wg_gemm<256>(p.X2 + t0 * DM, DM, p.w_pqT + (long)nt * 256 * DM, DM, DM, [&](f32x4 (&acc)[4][4], int wr, int wc, int fr, int fq) {
#pragma unroll
      for (int m = 0; m < 4; ++m)
#pragma unroll
        for (int n = 0; n < 4; ++n) {
          const long row = t0 + wr * 64 + m * 16 + fr; const int col = nt * 256 + wc * 64 + n * 16 + fq * 4;
          u32x2 w; w.x = pk_f16(acc[m][n][0], acc[m][n][1]); w.y = pk_f16(acc[m][n][2], acc[m][n][3]);
          *(u32x2*)((unsigned short*)p.KEYS + row * 2048 + col) = w;
        }
    });
  }
}

__device__ __forceinline__ void phase_mt(const P& p, int unit) {
  const int hp = unit >> 2, nt = unit & 3;
  wg_gemm<256>(p.skb + (long)hp * 128 * 128, 128, p.wpqB + (long)nt * 256 * 2048 + hp * 128, 2048, 128, [&](f32x4 (&acc)[4][4], int wr, int wc, int fr, int fq) {
#pragma unroll
    for (int m = 0; m < 4; ++m)
#pragma unroll
      for (int n = 0; n < 4; ++n) {
        const int row = hp * 128 + wr * 64 + m * 16 + fr, col = nt * 256 + wc * 64 + n * 16 + fq * 4;
        u32x2 w; w.x = pk_bf16(acc[m][n][0], acc[m][n][1]); w.y = pk_bf16(acc[m][n][2], acc[m][n][3]);
        *(u32x2*)((bf16_t*)p.w_pqT + (long)row * DM + col) = w;
      }
  });
}

__device__ __forceinline__ unsigned cand_entry(int s) {
  unsigned e = 255u; int base = 0;
#pragma unroll
  for (int i = 0; i < 16; ++i) { const int cnt = 16 / (i + 1); if (s >= base && s < base + cnt) e = (unsigned)i | ((unsigned)(s - base) << 4); base += cnt; }
  return e;
}
template <int CTRL> __device__ __forceinline__ unsigned dpp_u(unsigned x) { return (unsigned)__builtin_amdgcn_mov_dpp((int)x, CTRL, 0xf, 0xf, true); }
template <int CTRL> __device__ __forceinline__ float dpp_f(float x) { return __int_as_float(__builtin_amdgcn_mov_dpp(__float_as_int(x), CTRL, 0xf, 0xf, true)); }
__device__ __forceinline__ unsigned umin_(unsigned a, unsigned b) { return a < b ? a : b; }
__device__ __forceinline__ unsigned row_min_u(unsigned x) {
  x = umin_(x, dpp_u<0x128>(x)); x = umin_(x, dpp_u<0x124>(x)); x = umin_(x, dpp_u<0x122>(x)); x = umin_(x, dpp_u<0x121>(x)); return x;
}
__device__ __forceinline__ float row_max_f(float x) { x = fmaxf(x, dpp_f<0x128>(x)); x = fmaxf(x, dpp_f<0x124>(x)); x = fmaxf(x, dpp_f<0x122>(x)); x = fmaxf(x, dpp_f<0x121>(x)); return x; }
__device__ __forceinline__ float row_sum_f(float x) { x += dpp_f<0x128>(x); x += dpp_f<0x124>(x); x += dpp_f<0x122>(x); x += dpp_f<0x121>(x); return x; }

#define KEYS_OFF 65536
#define KEY_STRIDE 528
template <int N> __device__ __forceinline__ unsigned top16_row(const unsigned (&k)[N], int r) {
  unsigned pm1 = 0xFFFFFFFEu, mine = 0;
#pragma unroll
  for (int rd = 0; rd < 16; ++rd) {
    unsigned d = pm1 - k[0];
#pragma unroll
    for (int i = 1; i < N; ++i) d = umin_(d, pm1 - k[i]);
    d = row_min_u(d);
    const unsigned nxt = pm1 - d;
    mine = (r == rd) ? nxt : mine;
    pm1 = nxt - 1;
  }
  return mine;
}

__device__ __forceinline__ void phase_route(const P& p, int tile) {
  const long t0 = (long)tile * 128;
  const int tid = otid(), lane = tid & 63, wid = tid >> 6, r = lane & 15, g = lane >> 4;
  LAS char* lds = (LAS char*)smem_raw;
  LAS unsigned char* tab = (LAS unsigned char*)(lds + RED_OFF);
  if (tid < 64) tab[tid] = (unsigned char)cand_entry(tid);
  unsigned ci[4], cj[4]; bool cval[4];
#pragma unroll
  for (int q = 0; q < 4; ++q) { const unsigned e = cand_entry(r * 4 + q); cval[q] = (e != 255u); ci[q] = ((unsigned)(g * 16) + (e & 15u)) * 4u; cj[q] = ((unsigned)(g * 16) + ((e >> 4) & 15u)) * 4u; }
  __syncthreads();
  auto load_keys = [&](int hp, u32x4 (&kb)[4]) {
#pragma unroll
    for (int ps = 0; ps < 4; ++ps) kb[ps] = *(const u32x4*)((const unsigned short*)p.KEYS + (t0 + wid * 16 + ps * 4 + g) * 2048 + hp * 128 + r * 8);
  };
  auto top_keys = [&](const u32x4 (&kb)[4], unsigned (&tp)[4]) {
#pragma unroll
    for (int ps = 0; ps < 4; ++ps) {
      const unsigned w[4] = {kb[ps].x, kb[ps].y, kb[ps].z, kb[ps].w};
      unsigned k[8];
#pragma unroll
      for (int i = 0; i < 4; ++i) {
        k[2 * i] = (f2key(f16_lo(w[i])) & ~127u) | (unsigned)(127 - (r * 8 + 2 * i));
        k[2 * i + 1] = (f2key(f16_hi(w[i])) & ~127u) | (unsigned)(126 - (r * 8 + 2 * i));
      }
      tp[ps] = top16_row<8>(k, r);
    }
  };
  u32x4 kA[4], kB[4];
  load_keys(0, kA);
  for (int h = 0; h < 8; ++h) {
    unsigned top[2][4];
    load_keys(h * 2 + 1, kB);
    top_keys(kA, top[0]);
    load_keys(h < 7 ? h * 2 + 2 : 15, kA);
    top_keys(kB, top[1]);
#pragma unroll
    for (int ps = 0; ps < 4; ++ps) {
      const int tk = wid * 16 + ps * 4 + g;
      const unsigned A = top[0][ps], B = top[1][ps];
      const float fa = key2f(A & ~127u), fb = key2f(B & ~127u);
      unsigned k2[4];
#pragma unroll
      for (int q = 0; q < 4; ++q) {
        const float va = __int_as_float(__builtin_amdgcn_ds_bpermute((int)ci[q], __float_as_int(fa)));
        const float vb = __int_as_float(__builtin_amdgcn_ds_bpermute((int)cj[q], __float_as_int(fb)));
        const unsigned kk = (f2key(va + vb) & ~63u) | (unsigned)(63 - (r * 4 + q));
        k2[q] = cval[q] ? kk : 0u;
      }
      const unsigned mine = top16_row<4>(k2, r);
      const unsigned slot = 63u - (mine & 63u);
      const unsigned e = tab[slot];
      const unsigned ka = (unsigned)__builtin_amdgcn_ds_bpermute((int)(((unsigned)(g * 16) + (e & 15u)) * 4u), (int)A);
      const unsigned kb = (unsigned)__builtin_amdgcn_ds_bpermute((int)(((unsigned)(g * 16) + ((e >> 4) & 15u)) * 4u), (int)B);
      const int expert = (int)((127u - (ka & 127u)) * 128u + (127u - (kb & 127u)));
      const float c = key2f(mine & ~63u);
      const float mx = row_max_f(c);
      const float ex = __expf(c - mx);
      const float sm = row_sum_f(ex);
      p.experts[(t0 + tk) * 128 + h * 16 + r] = expert;
      p.gates[(t0 + tk) * 128 + h * 16 + r] = ex / sm;
    }
  }
}

__device__ __forceinline__ f32x2_t ub01(unsigned w) { return (f32x2_t){(float)(w & 0xffu), (float)((w >> 8) & 0xffu)}; }
__device__ __forceinline__ f32x2_t ub23(unsigned w) { return (f32x2_t){(float)((w >> 16) & 0xffu), (float)(w >> 24)}; }
__device__ __forceinline__ int sum8_i(int x) {
  x += (int)dpp_u<0xB1>((unsigned)x); x += (int)dpp_u<0x4E>((unsigned)x); x += (int)dpp_u<0x141>((unsigned)x); return x;
}
struct GMeta { u32x4 xq; int er0, er1; };
__device__ __forceinline__ void phase_gdown(const P& p) {
  const int tid = otid(), lane = tid & 63, wid = tid >> 6, grp = lane >> 3, r8 = lane & 7;
  const int slice = blockIdx.x & 7, chunk = blockIdx.x >> 3;
  const unsigned char* tab = p.WDq + slice * 128 + r8 * 16;
  const char* sl = p.slabs + (size_t)(chunk * 8 + wid) * SLAB_BYTES;
  int* pd = (int*)(sl + OFF_ZB) + slice * 128 * 128;
  const unsigned char* xqb = (const unsigned char*)(sl + OFF_X2Q);
  const int* exb = (const int*)(sl + OFF_EXP);
  auto meta = [&](int ti, GMeta& m) {
    const int t = (ti < 127 ? ti : 127);
    m.xq = *(const u32x4*)(xqb + t * DM + slice * 128 + r8 * 16);
    m.er0 = exb[t * 128 + lane]; m.er1 = exb[t * 128 + 64 + lane];
  };
  auto issue = [&](const GMeta& m, u32x4 (&w)[16]) {
#pragma unroll
    for (int it = 0; it < 16; ++it) {
      const int e = __builtin_amdgcn_ds_bpermute(((it & 7) * 8 + grp) * 4, (it < 8) ? m.er0 : m.er1);
      w[it] = *(const u32x4*)(tab + (long)e * DM);
    }
  };
  auto consume = [&](int ti, const GMeta& m, const u32x4 (&w)[16]) {
    int c0 = 0, c1 = 0;
#pragma unroll
    for (int it = 0; it < 16; ++it) {
      int acc = __builtin_amdgcn_sdot4((int)w[it].x, (int)m.xq.x, 0, false);
      acc = __builtin_amdgcn_sdot4((int)w[it].y, (int)m.xq.y, acc, false); acc = __builtin_amdgcn_sdot4((int)w[it].z, (int)m.xq.z, acc, false); acc = __builtin_amdgcn_sdot4((int)w[it].w, (int)m.xq.w, acc, false);
      acc = sum8_i(acc);
      const bool mine = ((it & 7) == r8);
      c0 = (mine && it < 8) ? acc : c0;
      c1 = (mine && it >= 8) ? acc : c1;
    }
    pd[ti * 128 + r8 * 8 + grp] = c0; pd[ti * 128 + 64 + r8 * 8 + grp] = c1;
  };
  GMeta mA, mB; u32x4 wA[16], wB[16];
  meta(0, mA); issue(mA, wA); meta(1, mB);
  for (int ti = 0; ti < 128; ti += 2) {
    issue(mB, wB);
    consume(ti, mA, wA);
    meta(ti + 2, mA);
    issue(mA, wA);
    consume(ti + 1, mB, wB);
    meta(ti + 3, mB);
  }
}
__device__ __forceinline__ int cq_index(int k) { return ((k >> 5) * 8 + (k & 7)) * 4 + ((k >> 3) & 3); }
__device__ __forceinline__ void phase_gcomb(const P& p, int tile) {
  const int tid = otid(), lane = tid & 63, wid = tid >> 6;
  signed char* cq = (signed char*)(p.slabs + (size_t)tile * SLAB_BYTES + OFF_CQ);
  float* sc = (float*)(p.slabs + (size_t)tile * SLAB_BYTES + OFF_SC);
#pragma unroll 4
  for (int ti = 0; ti < 16; ++ti) {
    const int tl = wid * 16 + ti;
    const long t = (long)tile * 128 + tl;
    int s0 = 0, s1 = 0;
#pragma unroll
    for (int j = 0; j < 8; ++j) { s0 += p.PD[(j * 128 + tl) * 128 + lane]; s1 += p.PD[(j * 128 + tl) * 128 + 64 + lane]; }
    const int e0 = p.experts[t * 128 + lane], e1 = p.experts[t * 128 + 64 + lane];
    const float sx = p.SX[t];
    const float c0 = p.gates[t * 128 + lane] * gelu_f((float)s0 * p.sd[e0] * sx) * p.su[e0];
    const float c1 = p.gates[t * 128 + 64 + lane] * gelu_f((float)s1 * p.sd[e1] * sx) * p.su[e1];
    float amax = fmaxf(fabsf(c0), fabsf(c1));
#pragma unroll
    for (int o = 32; o > 0; o >>= 1) amax = fmaxf(amax, __shfl_xor(amax, o));
    const float inv = amax > 0.f ? 127.f / amax : 0.f;
    cq[tl * 128 + cq_index(lane)] = (signed char)__float2int_rn(c0 * inv);
    cq[tl * 128 + cq_index(lane + 64)] = (signed char)__float2int_rn(c1 * inv);
    if (lane == 0) sc[tl] = amax * (1.f / 127.f);
  }
}
struct UMeta { int er0, er1; unsigned cq[4]; };
__device__ __forceinline__ void phase_gup(const P& p) {
  const int tid = otid(), lane = tid & 63, wid = tid >> 6, grp = lane >> 3, r8 = lane & 7;
  const int slice = blockIdx.x & 7, chunk = blockIdx.x >> 3;
  const unsigned char* tab = p.WUq + slice * 128 + r8 * 16;
  char* sl = p.slabs + (size_t)(chunk * 8 + wid) * SLAB_BYTES;
  const int* exb = (const int*)(sl + OFF_EXP);
  const unsigned* cqb = (const unsigned*)(sl + OFF_CQ);
  const float* scb = (const float*)(sl + OFF_SC);
  bf16_t* h3b = (bf16_t*)(sl + OFF_ZB);
  auto meta = [&](int ti, UMeta& m) {
    const int t = (ti < 127 ? ti : 127);
    m.er0 = exb[t * 128 + lane]; m.er1 = exb[t * 128 + 64 + lane];
#pragma unroll
    for (int j = 0; j < 4; ++j) m.cq[j] = cqb[t * 32 + j * 8 + grp];
  };
  auto issue = [&](const UMeta& m, u32x4 (&w)[16]) {
#pragma unroll
    for (int it = 0; it < 16; ++it) {
      const int e = __builtin_amdgcn_ds_bpermute(((it & 7) * 8 + grp) * 4, (it < 8) ? m.er0 : m.er1);
      w[it] = *(const u32x4*)(tab + (long)e * DM);
    }
  };
  auto consume = [&](int ti, const UMeta& m, const u32x4 (&w)[16]) {
    int o[16];
#pragma unroll
    for (int i = 0; i < 16; ++i) o[i] = 0;
#pragma unroll
    for (int j = 0; j < 4; ++j) {
      const unsigned x0[4] = {w[4 * j].x, w[4 * j].y, w[4 * j].z, w[4 * j].w}, x1[4] = {w[4 * j + 1].x, w[4 * j + 1].y, w[4 * j + 1].z, w[4 * j + 1].w};
      const unsigned x2[4] = {w[4 * j + 2].x, w[4 * j + 2].y, w[4 * j + 2].z, w[4 * j + 2].w}, x3[4] = {w[4 * j + 3].x, w[4 * j + 3].y, w[4 * j + 3].z, w[4 * j + 3].w};
#pragma unroll
      for (int d = 0; d < 4; ++d) {
        const unsigned t0 = __builtin_amdgcn_perm(x1[d], x0[d], 0x05010400u), t1 = __builtin_amdgcn_perm(x1[d], x0[d], 0x07030602u);
        const unsigned u0 = __builtin_amdgcn_perm(x3[d], x2[d], 0x05010400u), u1 = __builtin_amdgcn_perm(x3[d], x2[d], 0x07030602u);
        o[d * 4 + 0] = __builtin_amdgcn_sdot4((int)__builtin_amdgcn_perm(u0, t0, 0x05040100u), (int)m.cq[j], o[d * 4 + 0], false);
        o[d * 4 + 1] = __builtin_amdgcn_sdot4((int)__builtin_amdgcn_perm(u0, t0, 0x07060302u), (int)m.cq[j], o[d * 4 + 1], false);
        o[d * 4 + 2] = __builtin_amdgcn_sdot4((int)__builtin_amdgcn_perm(u1, t1, 0x05040100u), (int)m.cq[j], o[d * 4 + 2], false);
        o[d * 4 + 3] = __builtin_amdgcn_sdot4((int)__builtin_amdgcn_perm(u1, t1, 0x07060302u), (int)m.cq[j], o[d * 4 + 3], false);
      }
    }
    const float sct = scb[ti];
    float f[16];
#pragma unroll
    for (int i = 0; i < 16; ++i) {
      int a = o[i];
      a += (int)dpp_u<0x128>((unsigned)a);
      a += __shfl_xor(a, 16);
      a += __shfl_xor(a, 32);
      f[i] = (float)a * sct;
    }
    if (grp == 0) {
      bf16_t* dst = h3b + ti * DM + slice * 128 + r8 * 16;
      u32x4 q0, q1;
      q0.x = pk_bf16(f[0], f[1]); q0.y = pk_bf16(f[2], f[3]); q0.z = pk_bf16(f[4], f[5]); q0.w = pk_bf16(f[6], f[7]);
      q1.x = pk_bf16(f[8], f[9]); q1.y = pk_bf16(f[10], f[11]); q1.z = pk_bf16(f[12], f[13]); q1.w = pk_bf16(f[14], f[15]);
      *(u32x4*)dst = q0; *(u32x4*)(dst + 8) = q1;
    }
  };
  UMeta mA, mB; u32x4 wA[16], wB[16];
  meta(0, mA); issue(mA, wA); meta(1, mB);
  for (int ti = 0; ti < 128; ti += 2) {
    issue(mB, wB);
    consume(ti, mA, wA);
    meta(ti + 2, mA);
    issue(mA, wA);
    consume(ti + 1, mB, wB);
    meta(ti + 3, mB);
  }
}
__device__ __forceinline__ void phase_ln3(const P& p, int tile) {
  const int tid = otid(), lane = tid & 63, wid = tid >> 6;
#pragma unroll 2
  for (int ti = 0; ti < 16; ++ti) {
    const long t = (long)tile * 128 + wid * 16 + ti;
    float4 v[4];
    float sum = 0.f;
#pragma unroll
    for (int j = 0; j < 4; ++j) {
      const int c0 = j * 256 + lane * 4;
      const u32x2 hv = *(const u32x2*)((const bf16_t*)p.H3 + t * DM + c0);
      const u32x2 xv = *(const u32x2*)(p.X2 + t * DM + c0);
      v[j].x = bf_lo(hv.x) + ALPHA * bf_lo(xv.x); v[j].y = bf_hi(hv.x) + ALPHA * bf_hi(xv.x); v[j].z = bf_lo(hv.y) + ALPHA * bf_lo(xv.y); v[j].w = bf_hi(hv.y) + ALPHA * bf_hi(xv.y);
      sum += (v[j].x + v[j].y) + (v[j].z + v[j].w);
    }
#pragma unroll
    for (int o = 32; o > 0; o >>= 1) sum += __shfl_xor(sum, o);
    const float mu = sum * (1.f / DM);
    float q = 0.f;
#pragma unroll
    for (int j = 0; j < 4; ++j) { v[j].x -= mu; v[j].y -= mu; v[j].z -= mu; v[j].w -= mu; q += (v[j].x * v[j].x + v[j].y * v[j].y) + (v[j].z * v[j].z + v[j].w * v[j].w); }
#pragma unroll
    for (int o = 32; o > 0; o >>= 1) q += __shfl_xor(q, o);
    const float rstd = rsqrtf(q * (1.f / DM) + LN_EPS);
#pragma unroll
    for (int j = 0; j < 4; ++j) {
      const int c0 = j * 256 + lane * 4;
      const float4 gg = *(const float4*)(p.ln3_g + c0), bb = *(const float4*)(p.ln3_b + c0);
      float4 o; o.x = v[j].x * rstd * gg.x + bb.x; o.y = v[j].y * rstd * gg.y + bb.y; o.z = v[j].z * rstd * gg.z + bb.z; o.w = v[j].w * rstd * gg.w + bb.w;
      *(float4*)(p.out + t * DM + c0) = o;
    }
  }
}

__device__ __forceinline__ void prep_transpose_tile(const float* __restrict__ W, bf16_t* __restrict__ WT, int K, int N, int tileidx) {
  LAS float* scr = (LAS float*)smem_raw;
  const int ntn = N / 64, k0 = (tileidx / ntn) * 64, n0 = (tileidx % ntn) * 64, tid = threadIdx.x;
#pragma unroll
  for (int i = 0; i < 8; ++i) { const int e = tid + i * 512, kk = e >> 6, nn = e & 63; scr[kk * 65 + nn] = W[(long)(k0 + kk) * N + n0 + nn]; }
  __syncthreads();
#pragma unroll
  for (int i = 0; i < 4; ++i) { const int e = tid + i * 512, nn = e >> 5, kp = (e & 31) * 2; *(unsigned*)(WT + (long)(n0 + nn) * K + k0 + kp) = pk_bf16(scr[kp * 65 + nn], scr[(kp + 1) * 65 + nn]); }
  __syncthreads();
}
__device__ __forceinline__ void prep_quant_strip(const float* __restrict__ W, signed char* __restrict__ Q, float* __restrict__ sc, int K, int N, int strip) {
  LAS float* scr = (LAS float*)smem_raw;
  LAS float* pmax = scr + 64 * 65;
  LAS float* inv = pmax + 8 * 64;
  const int n0 = strip * 64, tid = threadIdx.x, nn = tid & 63, kg = tid >> 6;
  float amax = 0.f;
  for (int k0 = 0; k0 < K; k0 += 64)
#pragma unroll
    for (int i = 0; i < 8; ++i) amax = fmaxf(amax, fabsf(W[(long)(k0 + kg + 8 * i) * N + n0 + nn]));
  pmax[kg * 64 + nn] = amax;
  __syncthreads();
  if (tid < 64) {
    float m = 0.f;
#pragma unroll
    for (int j = 0; j < 8; ++j) m = fmaxf(m, pmax[j * 64 + tid]);
    inv[tid] = m > 0.f ? 127.f / m : 0.f;
    sc[n0 + tid] = m * (1.f / 127.f);
  }
  __syncthreads();
  const float iv = inv[nn];
  for (int k0 = 0; k0 < K; k0 += 64) {
#pragma unroll
    for (int i = 0; i < 8; ++i) { const int kk = kg + 8 * i; scr[kk * 65 + nn] = W[(long)(k0 + kk) * N + n0 + nn] * iv; }
    __syncthreads();
#pragma unroll
    for (int i = 0; i < 2; ++i) {
      const int dd = tid + i * 512, n = dd >> 4, k4 = (dd & 15) * 4;
      *(unsigned*)(Q + (long)(n0 + n) * K + k0 + k4) = pack4_i8(scr[k4 * 65 + n], scr[(k4 + 1) * 65 + n], scr[(k4 + 2) * 65 + n], scr[(k4 + 3) * 65 + n]);
    }
    __syncthreads();
  }
}
__device__ __forceinline__ void prep_cvt(const float* __restrict__ in, bf16_t* __restrict__ out, long n8) {
  for (long i = (long)blockIdx.x * 512 + threadIdx.x; i < n8; i += (long)gridDim.x * 512) {
    const float4 a = *(const float4*)(in + i * 8), b = *(const float4*)(in + i * 8 + 4);
    u32x4 o; o.x = pk_bf16(a.x, a.y); o.y = pk_bf16(a.z, a.w); o.z = pk_bf16(b.x, b.y); o.w = pk_bf16(b.z, b.w);
    *(u32x4*)(out + i * 8) = o;
  }
}
__device__ __forceinline__ void phase_prep(const P& p) {
  const int T_IN = 16 * 40, T_SQ = 16 * 16, T_W2 = 16 * 32;
  const int total = T_IN + T_SQ + T_SQ + T_W2 + T_SQ + T_W2;
  for (int it = blockIdx.x; it < total; it += gridDim.x) {
    int r = it;
    if (r < T_IN) { if (r < 40) prep_quant_strip(p.w_in, p.w_inQ, p.sw_in, DM, INW, r); continue; } r -= T_IN;
    if (r < T_SQ) { prep_transpose_tile(p.w_mo, (bf16_t*)p.w_moT, DM, DM, r); continue; } r -= T_SQ;
    if (r < T_SQ) { continue; } r -= T_SQ;
    if (r < T_W2) { prep_transpose_tile(p.w_xkv, (bf16_t*)p.w_xkvT, DM, 2048, r); continue; } r -= T_W2;
    if (r < T_SQ) { prep_transpose_tile(p.w_xo, (bf16_t*)p.w_xoT, DM, DM, r); continue; } r -= T_SQ;
    (void)r;
  }
  prep_cvt(p.mem, (bf16_t*)p.memB, (long)1024 * DM / 8);
  prep_cvt(p.sub_keys, (bf16_t*)p.skb, (long)8 * 2 * 128 * 128 / 8);
  prep_cvt(p.w_pq, (bf16_t*)p.wpqB, (long)DM * 2048 / 8);
  prep_cvt(p.w_xq, (bf16_t*)p.wxqB, (long)DM * DM / 8);
  {
    const int lane = threadIdx.x & 63, gw = blockIdx.x * 8 + (threadIdx.x >> 6), ngw = gridDim.x * 8;
    for (int row = gw; row < 2 * 16384; row += ngw) {
      const int tb = row >> 14, e = row & 16383;
      const float* src = (tb ? p.w_up : p.w_down) + (long)e * DM;
      float4 v[4];
      float amax = 0.f;
#pragma unroll
      for (int i = 0; i < 4; ++i) { v[i] = *(const float4*)(src + 256 * i + lane * 4); amax = fmaxf(amax, fmaxf(fmaxf(fabsf(v[i].x), fabsf(v[i].y)), fmaxf(fabsf(v[i].z), fabsf(v[i].w)))); }
#pragma unroll
      for (int s = 32; s > 0; s >>= 1) amax = fmaxf(amax, __shfl_xor(amax, s));
      const float inv = amax > 0.f ? 127.f / amax : 0.f;
      unsigned char* dst = (unsigned char*)(tb ? p.WUq : p.WDq) + (long)e * DM;
      const float off = 0.f;
#pragma unroll
      for (int i = 0; i < 4; ++i) *(unsigned*)(dst + 256 * i + lane * 4) = pack4_i8(v[i].x * inv + off, v[i].y * inv + off, v[i].z * inv + off, v[i].w * inv + off);
      if (lane == 0) { float* sc = (float*)(tb ? p.su : p.sd); sc[e] = amax * (1.f / 127.f); }
    }
  }
  for (int i = blockIdx.x * 512 + threadIdx.x; i < 4 * 128 * 128 / 2; i += gridDim.x * 512) {
    const int e = i * 2, t = (e >> 7) & 127, sidx = e & 127;
    const float2 v = *(const float2*)(p.w_sp + e);
    *(unsigned*)((bf16_t*)p.wsb + e) = pk_bf16(sidx <= t ? v.x : 0.f, (sidx + 1) <= t ? v.y : 0.f);
  }
}
__device__ __forceinline__ void phase_xcvt(const P& p, int tile) {
  const int lane = threadIdx.x & 63, wid = threadIdx.x >> 6;
  signed char* xq = (signed char*)(p.slabs + (size_t)tile * SLAB_BYTES + OFF_XB);
  float* sxr = (float*)(p.slabs + (size_t)tile * SLAB_BYTES + OFF_SXB);
#pragma unroll 2
  for (int i = 0; i < 16; ++i) {
    const int rl = wid * 16 + i;
    const float* src = p.x + ((long)tile * 128 + rl) * DM;
    float4 v[4];
    float amax = 0.f;
#pragma unroll
    for (int j = 0; j < 4; ++j) { v[j] = *(const float4*)(src + 256 * j + lane * 4); amax = fmaxf(amax, fmaxf(fmaxf(fabsf(v[j].x), fabsf(v[j].y)), fmaxf(fabsf(v[j].z), fabsf(v[j].w)))); }
#pragma unroll
    for (int o = 32; o > 0; o >>= 1) amax = fmaxf(amax, __shfl_xor(amax, o));
    const float inv = amax > 0.f ? 127.f / amax : 0.f;
#pragma unroll
    for (int j = 0; j < 4; ++j) *(unsigned*)(xq + rl * DM + 256 * j + lane * 4) = pack4_i8(v[j].x * inv, v[j].y * inv, v[j].z * inv, v[j].w * inv);
    if (lane == 0) sxr[rl] = amax * (1.f / 127.f);
  }
}
__device__ __forceinline__ void phase_halo(const P& p, int tile) {
  const int tid = otid();
  if (tid < 128) {
    const int rr = tid >> 6, c = (tid & 63) * 8;
    const bf16_t* zr = p.ZB + ((long)tile * 128 + 126 + rr) * INW;
    const u32x4 hb = *(const u32x4*)(zr + 1024 + c), gc = *(const u32x4*)(zr + 2048 + c);
    u32x4 o;
    o.x = pk_bf16(bf_lo(hb.x) * bf_lo(gc.x), bf_hi(hb.x) * bf_hi(gc.x)); o.y = pk_bf16(bf_lo(hb.y) * bf_lo(gc.y), bf_hi(hb.y) * bf_hi(gc.y));
    o.z = pk_bf16(bf_lo(hb.z) * bf_lo(gc.z), bf_hi(hb.z) * bf_hi(gc.z)); o.w = pk_bf16(bf_lo(hb.w) * bf_lo(gc.w), bf_hi(hb.w) * bf_hi(gc.w));
    *(u32x4*)(p.HALO + ((long)tile * 2 + rr) * 512 + c) = o;
  }
}

__device__ __forceinline__ P tile_view(const P& p, int tile) {
  P q = p;
  char* sl = p.slabs + (size_t)tile * SLAB_BYTES;
  const long t0 = (long)tile * 128;
  q.XB = (bf16_t*)(sl + OFF_XB) - t0 * DM; q.X1 = (bf16_t*)(sl + OFF_XB) - t0 * DM;
  q.experts = (int*)(sl + OFF_EXP) - t0 * 128; q.gates = (float*)(sl + OFF_GATE) - t0 * 128;
  q.ZB = (bf16_t*)(sl + OFF_ZB) - t0 * INW; q.PRE = (float*)((bf16_t*)(sl + OFF_ZB) - t0 * DM); q.KEYS = (unsigned*)((unsigned short*)(sl + OFF_ZB) - t0 * 2048);
  q.PD = (int*)(sl + OFF_ZB); q.H3 = (float*)((bf16_t*)(sl + OFF_ZB) - t0 * DM);
  q.VT = (bf16_t*)(sl + OFF_VT) - (long)tile * 4 * 128 * 128; q.X1Q = (unsigned char*)(sl + OFF_VT) - t0 * DM; q.XQ = (unsigned char*)(sl + OFF_X2Q) - t0 * DM;
  q.Y = (bf16_t*)(sl + OFF_Y) - t0 * DM; q.Pb = (bf16_t*)(sl + OFF_Y) - t0 * DM;
  q.Q = (bf16_t*)(sl + OFF_Q) - t0 * DM; q.X2 = (bf16_t*)(sl + OFF_Q) - t0 * DM;
  return q;
}

#define XB_TMO      128
#define XB_XCNT(j)  (256  + 64 * (j))
#define XB_XSUB(j)  (1280 + 64 * (j))
#define XB_XGEN(j)  (2304 + 64 * (j))
#define XB_TOP      3328
#define XB_TOPGEN   3392
#define XCD_BAR_WORDS 3456
#define XB_SPIN_CAP (1u << 18)

__device__ __forceinline__ unsigned xb_ld(unsigned* p)              { return __hip_atomic_load(p, __ATOMIC_RELAXED, __HIP_MEMORY_SCOPE_AGENT); }
__device__ __forceinline__ unsigned xb_add(unsigned* p, unsigned v) { return __hip_atomic_fetch_add(p, v, __ATOMIC_RELAXED, __HIP_MEMORY_SCOPE_AGENT); }
__device__ __forceinline__ unsigned xb_xcc_id() { return (unsigned)__builtin_amdgcn_s_getreg((3 << 11) | 20) & 0xFu; }
#define XB_SPIN(cond, bar) do { unsigned _sp = 0; while (cond) { __builtin_amdgcn_s_sleep(1); \
    if ((++_sp & 255u) == 0u) { if (xb_ld(&(bar)[XB_TMO])) break; if (_sp > XB_SPIN_CAP) { atomicAdd(&(bar)[XB_TMO], 1u); break; } } } } while (0)

struct XcdBarrier {
    unsigned* bar; unsigned x;
    volatile LAS unsigned* st;
};

__device__ __forceinline__ XcdBarrier xcd_barrier_post(unsigned* bar, volatile LAS unsigned* st) {
    XcdBarrier b; b.bar = bar; b.x = xb_xcc_id(); b.st = st;
    if (threadIdx.x == 0) (void)xb_add(&bar[XB_XCNT(b.x)], 1u);
    return b;
}
__device__ __forceinline__ void xcd_barrier_complete(unsigned* bar, unsigned x, unsigned& nloc, unsigned& nx) {
    const unsigned G = gridDim.x * gridDim.y * gridDim.z;
    unsigned sum, cnt, mine, sp = 0u;
    for (;;) {
        sum = 0u; cnt = 0u; mine = 0u;
#pragma unroll
        for (unsigned j = 0; j < 16; ++j) { const unsigned c = xb_ld(&bar[XB_XCNT(j)]); sum += c; cnt += (c > 0u) ? 1u : 0u; mine = (j == x) ? c : mine; }
        if (sum == G) break;
        __builtin_amdgcn_s_sleep(1);
        if ((++sp & 255u) == 0u) { if (xb_ld(&bar[XB_TMO])) break; if (sp > XB_SPIN_CAP) { atomicAdd(&bar[XB_TMO], 1u); break; } }
    }
    nloc = mine > 0u ? mine : 1u; nx = cnt > 0u ? cnt : 1u;
}

__device__ __forceinline__ void xcd_barrier(const XcdBarrier& b) {
    asm volatile("s_waitcnt vmcnt(0)" ::: "memory");
    __syncthreads();
    if (threadIdx.x == 0) {
        unsigned* bar = b.bar;
        __builtin_amdgcn_s_waitcnt(0);
        unsigned nloc = b.st[0], nx = b.st[1];
        if (nloc == 0u) { xcd_barrier_complete(bar, b.x, nloc, nx); b.st[0] = nloc; b.st[1] = nx; }
        const unsigned old = xb_add(&bar[XB_XSUB(b.x)], 1u);
        const unsigned gen = old / nloc;
        if (old + 1u == (gen + 1u) * nloc) {
            __builtin_amdgcn_fence(__ATOMIC_RELEASE, "agent");
            asm volatile("s_waitcnt vmcnt(0)" ::: "memory");
            const unsigned og = xb_add(&bar[XB_TOP], 1u);
            const unsigned tg = og / nx;
            if (og + 1u == (tg + 1u) * nx) xb_add(&bar[XB_TOPGEN], 1u);
            else XB_SPIN(xb_ld(&bar[XB_TOPGEN]) == tg, bar);
            __builtin_amdgcn_fence(__ATOMIC_ACQUIRE, "agent");
            xb_add(&bar[XB_XGEN(b.x)], 1u);
            asm volatile("s_waitcnt vmcnt(0)" ::: "memory");
        } else {
            XB_SPIN(xb_ld(&bar[XB_XGEN(b.x)]) == gen, bar);
            __builtin_amdgcn_fence(__ATOMIC_ACQUIRE, "agent");
            asm volatile("s_waitcnt vmcnt(0)" ::: "memory");
        }
    }
    __syncthreads();
}


__global__ __launch_bounds__(512) void mega_k(P pg) {
  const int tile = blockIdx.x;
  volatile LAS unsigned* xbw = (volatile LAS unsigned*)((LAS char*)smem_raw + XB_LDS_OFF);
  if (threadIdx.x < 4) xbw[threadIdx.x] = 0u;
  __syncthreads();
  XcdBarrier xb = xcd_barrier_post(pg.bar, xbw);
  const P p = tile_view(pg, tile);
  phase_prep(pg);
  phase_xcvt(p, tile);
  xcd_barrier(xb);
  phase_inproj(p, tile);
  wg_sync_mem();
  phase_halo(p, tile);
  phase_kv(p, tile);
  if (tile < 64) phase_mt(p, tile);
  xcd_barrier(xb);
  phase_gh(p, tile);
  wg_sync_mem();
  phase_mixer(p, tile);
  wg_sync_mem();
  phase_outproj(p, tile);
  wg_sync_mem();
  xcd_barrier(xb);
  phase_gquant(pg);
  xcd_barrier(xb);
  phase_scores(p, tile);
  wg_sync_mem();
  phase_oproj(p, tile);
  wg_sync_mem();
  phase_pq(p, tile);
  wg_sync_mem();
  phase_route(p, tile);
  xcd_barrier(xb);
  phase_gdown(pg);
  xcd_barrier(xb);
  phase_gcomb(p, tile);
  xcd_barrier(xb);
  phase_gup(pg);
  xcd_barrier(xb);
  phase_ln3(p, tile);
}

extern "C" void kernel_launch(void* const* d_in, const int* in_sizes, int n_in, void* d_out, int out_size, void* d_ws, size_t ws_size, hipStream_t stream) {
  static int grid_blocks = 0;
  if (grid_blocks == 0) {
    int dev = 0, cus = 0, per_cu = 0;
    (void)hipGetDevice(&dev);
    (void)hipDeviceGetAttribute(&cus, hipDeviceAttributeMultiprocessorCount, dev);
    if (hipFuncSetAttribute((const void*)mega_k, hipFuncAttributeMaxDynamicSharedMemorySize, LDS_BYTES) != hipSuccess) fprintf(stderr, "kernel_launch: hipFuncSetAttribute failed\n");
    if (hipOccupancyMaxActiveBlocksPerMultiprocessor(&per_cu, (const void*)mega_k, 512, LDS_BYTES) != hipSuccess || per_cu < 1) { fprintf(stderr, "kernel_launch: occupancy query says %d blocks/CU\n", per_cu); per_cu = 1; }
    (void)hipGetLastError();
    grid_blocks = NTOK / 128;
    if (cus * per_cu < grid_blocks) fprintf(stderr, "kernel_launch: device holds only %d x %d resident blocks, need %d\n", cus, per_cu, grid_blocks);
  }
  char* w8 = (char*)d_ws;
  const size_t MiB = (size_t)1 << 20;
  P p{};
  p.x = (const float*)d_in[0]; p.mem = (const float*)d_in[1]; p.w_in = (const float*)d_in[2]; p.b_in = (const float*)d_in[3];
  p.sgu_g = (const float*)d_in[4]; p.sgu_b = (const float*)d_in[5]; p.w_sp = (const float*)d_in[6]; p.b_sp = (const float*)d_in[7];
  p.conv_w = (const float*)d_in[8]; p.w_mo = (const float*)d_in[9]; p.ln1_g = (const float*)d_in[10]; p.ln1_b = (const float*)d_in[11];
  p.w_xq = (const float*)d_in[12]; p.w_xkv = (const float*)d_in[13]; p.w_xo = (const float*)d_in[14]; p.ln2_g = (const float*)d_in[15]; p.ln2_b = (const float*)d_in[16];
  p.w_pq = (const float*)d_in[17]; p.sub_keys = (const float*)d_in[18]; p.w_down = (const float*)d_in[19]; p.w_up = (const float*)d_in[20];
  p.ln3_g = (const float*)d_in[21]; p.ln3_b = (const float*)d_in[22];
  p.out = (float*)d_out;
  p.slabs = w8;
  bf16_t* wb = (bf16_t*)(w8 + 384 * MiB);
  p.w_inT = wb; p.w_inQ = (signed char*)wb; wb += (size_t)INW * DM / 2; p.sw_in = (float*)wb; wb += 2 * INW; p.w_moT = wb; wb += (size_t)DM * DM; p.wsb = wb; wb += 4 * 128 * 128;
  p.w_xqT = wb; p.GTq = (signed char*)wb; wb += (size_t)4 * 1024 * DM / 2; p.sG = (float*)wb; wb += 2 * 4096; p.w_xkvT = wb; wb += (size_t)2048 * DM; p.w_xoT = wb; wb += (size_t)DM * DM;
  p.memB = wb; wb += (size_t)1024 * DM; p.Kc = wb; wb += (size_t)1024 * DM; p.Vc = wb; wb += (size_t)1024 * DM; p.wxqB = wb; wb += (size_t)DM * DM; p.GTb = wb; wb += (size_t)4 * 1024 * DM; p.HT = wb; wb += (size_t)4 * 1024 * DM;
  p.w_pqT = wb; wb += (size_t)2048 * DM; p.wpqB = wb; wb += (size_t)2048 * DM; p.skb = wb; wb += (size_t)8 * 2 * 128 * 128;
  p.WDq = (const unsigned char*)wb; wb += (size_t)16384 * DM / 2; p.WUq = (const unsigned char*)wb; wb += (size_t)16384 * DM / 2;
  p.sd = (const float*)wb; wb += 2 * 16384; p.su = (const float*)wb; wb += 2 * 16384;
  p.HALO = wb; wb += (size_t)256 * 2 * 512;
  p.SX = (float*)wb; wb += 2 * NTOK; p.SX1 = (float*)wb; wb += 2 * NTOK;
  p.bar = (unsigned*)wb; wb += 2 * 4096;
  if ((size_t)((char*)wb - w8) > ws_size) fprintf(stderr, "kernel_launch: workspace too small\n");
  (void)hipMemsetAsync(p.bar, 0, XCD_BAR_WORDS * 4, stream);
  void* args[] = {&p};
  hipError_t e = hipLaunchCooperativeKernel((const void*)mega_k, dim3(grid_blocks), dim3(512), args, LDS_BYTES, stream);
  if (e != hipSuccess) fprintf(stderr, "cooperative launch failed: %s (grid %d)\n", hipGetErrorString(e), grid_blocks);
}
```

```cpp
#include <hip/hip_runtime.h>
#include <stdint.h>
#include <cstdio>

#define DM 1024
#define NTOK 32768
#define SEQ 8192
#define INW 2560
#define ALPHA 1.189207115002721f
#define LN_EPS 1e-5f

__device__ __forceinline__ float gelu_f(float v) {
  const float t = __builtin_amdgcn_rcpf(fabsf(v) * 0.2316418882f + 1.0f);
  float q = t * 0.5307027145f + (-0.7265760135f); q = q * t + 0.7107068705f; q = q * t + (-0.142248368f); q = q * t + 0.127414796f; q = q * t;
  const float e = __builtin_amdgcn_exp2f((v * v) * (-0.72134752044f));
  const float m = v * (q * e);
  return v < 0.f ? m : v - m;
}

typedef unsigned short bf16_t;
typedef short bf16x8 __attribute__((ext_vector_type(8)));
typedef float f32x4 __attribute__((ext_vector_type(4)));
typedef unsigned u32x4 __attribute__((ext_vector_type(4)));
typedef unsigned u32x2 __attribute__((ext_vector_type(2)));
#define LAS __attribute__((address_space(3)))
extern __shared__ __attribute__((aligned(16))) char smem_raw[];

typedef float f32x2_t __attribute__((ext_vector_type(2)));
typedef __bf16 bf16x2_t __attribute__((ext_vector_type(2)));
typedef _Float16 f16x2_t __attribute__((ext_vector_type(2)));
__device__ __forceinline__ unsigned pk_f16(float lo, float hi) { const f32x2_t v = {lo, hi}; return __builtin_bit_cast(unsigned, __builtin_convertvector(v, f16x2_t)); }
__device__ __forceinline__ float f16_lo(unsigned u) { return (float)__builtin_bit_cast(f16x2_t, u)[0]; }
__device__ __forceinline__ float f16_hi(unsigned u) { return (float)__builtin_bit_cast(f16x2_t, u)[1]; }
__device__ __forceinline__ unsigned pk_bf16(float lo, float hi) { const f32x2_t v = {lo, hi}; return __builtin_bit_cast(unsigned, __builtin_convertvector(v, bf16x2_t)); }
__device__ __forceinline__ int otid() { int t = threadIdx.x; asm volatile("" : "+v"(t)); return t; }
__device__ __forceinline__ unsigned pack4_i8(float a, float b, float c, float d) {
  const int ia = __float2int_rn(a), ib = __float2int_rn(b), ic = __float2int_rn(c), id = __float2int_rn(d);
  return ((unsigned)ia & 0xffu) | (((unsigned)ib & 0xffu) << 8) | (((unsigned)ic & 0xffu) << 16) | ((unsigned)id << 24);
}
__device__ __forceinline__ float bf_lo(unsigned u) { return __uint_as_float(u << 16); }
__device__ __forceinline__ float bf_hi(unsigned u) { return __uint_as_float(u & 0xffff0000u); }

__device__ __forceinline__ int swz(int row) { return (((row >> 1) & 1) << 2) | (((row >> 3) & 1) << 1); }
template <int BN, class Epi>
__device__ __forceinline__ void wg_gemm(const bf16_t* __restrict__ A, int lda, const bf16_t* __restrict__ Bt, int ldb, int K, Epi&& epi) {
  constexpr int NT = BN / 64;
  constexpr int STAGE_BYTES = (128 + BN) * 128;
  constexpr int LA = 2, LB = BN / 64;
  LAS char* lds = (LAS char*)smem_raw;
  const int tid = otid(), lane = tid & 63, wid = tid >> 6, wr = wid >> 2, wc = wid & 3, fr = lane & 15, fq = lane >> 4;
  f32x4 acc[4][NT];
#pragma unroll
  for (int m = 0; m < 4; ++m)
#pragma unroll
    for (int n = 0; n < NT; ++n) acc[m][n] = (f32x4){0.f, 0.f, 0.f, 0.f};
  const int nk = K / 64;
  auto piece = [&](int buf, int kt, int i) {
    LAS char* base = lds + buf * STAGE_BYTES;
    if (i < LA) {
      const int q = tid + i * 512, row = q >> 3, c = (q & 7) ^ swz(row);
      __builtin_amdgcn_global_load_lds((const unsigned*)(A + (long)row * lda + kt * 64 + c * 8), (LAS unsigned*)(base + q * 16), 16, 0, 2);
    } else {
      const int q = tid + (i - LA) * 512, row = q >> 3, c = (q & 7) ^ swz(row);
      __builtin_amdgcn_global_load_lds((const unsigned*)(Bt + (long)row * ldb + kt * 64 + c * 8), (LAS unsigned*)(base + 16384 + q * 16), 16, 0, 0);
    }
  };
  auto stage = [&](int buf, int kt) {
#pragma unroll
    for (int i = 0; i < LA + LB; ++i) piece(buf, kt, i);
  };
  asm volatile("s_waitcnt vmcnt(0)" ::: "memory");
  __builtin_amdgcn_s_barrier();
  asm volatile("" ::: "memory");
  stage(0, 0);
  if (nk > 1) stage(1, 1);
  for (int kt = 0; kt < nk; ++kt) {
    if (kt + 1 < nk) asm volatile("s_waitcnt vmcnt(%0)" ::"n"(LA + LB) : "memory");
    else asm volatile("s_waitcnt vmcnt(0)" ::: "memory");
    __builtin_amdgcn_s_barrier();
    asm volatile("" ::: "memory");
    LAS const char* base = lds + (kt % 3) * STAGE_BYTES;
    bf16x8 af[4][2], bfr[NT][2];
#pragma unroll
    for (int m = 0; m < 4; ++m)
#pragma unroll
      for (int kk = 0; kk < 2; ++kk) {
        const int row = wr * 64 + m * 16 + fr, c = (kk * 4 + fq) ^ swz(fr);
        af[m][kk] = *(LAS const bf16x8*)(base + row * 128 + c * 16);
      }
#pragma unroll
    for (int n = 0; n < NT; ++n)
#pragma unroll
      for (int kk = 0; kk < 2; ++kk) {
        const int row = wc * (BN / 4) + n * 16 + fr, c = (kk * 4 + fq) ^ swz(fr);
        bfr[n][kk] = *(LAS const bf16x8*)(base + 16384 + row * 128 + c * 16);
      }
#pragma unroll
    for (int kk = 0; kk < 2; ++kk)
#pragma unroll
      for (int m = 0; m < 4; ++m) {
        if (kk * 4 + m < LA + LB) {
          __builtin_amdgcn_sched_barrier(0);
          if (kt + 2 < nk) piece((kt + 2) % 3, kt + 2, kk * 4 + m);
          __builtin_amdgcn_sched_barrier(0);
        }
#pragma unroll
        for (int n = 0; n < NT; ++n) acc[m][n] = __builtin_amdgcn_mfma_f32_16x16x32_bf16(bfr[n][kk], af[m][kk], acc[m][n], 0, 0, 0);
      }
  }
  epi(acc, wr, wc, fr, fq);
}

typedef int v4i_t __attribute__((ext_vector_type(4)));
template <int BN, class Epi>
__device__ __forceinline__ void wg_gemm_i8(const signed char* __restrict__ A, int lda, const signed char* __restrict__ Bt, int ldb, int K, Epi&& epi) {
  constexpr int NT = BN / 64;
  constexpr int STAGE_BYTES = (128 + BN) * 128;
  constexpr int LA = 2, LB = BN / 64;
  LAS char* lds = (LAS char*)smem_raw;
  const int tid = otid(), lane = tid & 63, wid = tid >> 6, wr = wid >> 2, wc = wid & 3, fr = lane & 15, fq = lane >> 4;
  v4i_t acc[4][NT];
#pragma unroll
  for (int m = 0; m < 4; ++m)
#pragma unroll
    for (int n = 0; n < NT; ++n) acc[m][n] = (v4i_t){0, 0, 0, 0};
  const int nk = K / 128;
  auto piece = [&](int buf, int kt, int i) {
    LAS char* base = lds + buf * STAGE_BYTES;
    if (i < LA) {
      const int q = tid + i * 512, row = q >> 3, c = (q & 7) ^ swz(row);
      __builtin_amdgcn_global_load_lds((const unsigned*)(A + (long)row * lda + kt * 128 + c * 16), (LAS unsigned*)(base + q * 16), 16, 0, 2);
    } else {
      const int q = tid + (i - LA) * 512, row = q >> 3, c = (q & 7) ^ swz(row);
      __builtin_amdgcn_global_load_lds((const unsigned*)(Bt + (long)row * ldb + kt * 128 + c * 16), (LAS unsigned*)(base + 16384 + q * 16), 16, 0, 0);
    }
  };
  auto stage = [&](int buf, int kt) {
#pragma unroll
    for (int i = 0; i < LA + LB; ++i) piece(buf, kt, i);
  };
  asm volatile("s_waitcnt vmcnt(0)" ::: "memory");
  __builtin_amdgcn_s_barrier();
  asm volatile("" ::: "memory");
  stage(0, 0);
  if (nk > 1) stage(1, 1);
  for (int kt = 0; kt < nk; ++kt) {
    if (kt + 1 < nk) asm volatile("s_waitcnt vmcnt(%0)" ::"n"(LA + LB) : "memory");
    else asm volatile("s_waitcnt vmcnt(0)" ::: "memory");
    __builtin_amdgcn_s_barrier();
    asm volatile("" ::: "memory");
    LAS const char* base = lds + (kt % 3) * STAGE_BYTES;
    v4i_t af[4][2], bfr[NT][2];
#pragma unroll
    for (int m = 0; m < 4; ++m)
#pragma unroll
      for (int kk = 0; kk < 2; ++kk) {
        const int row = wr * 64 + m * 16 + fr, c = (kk * 4 + fq) ^ swz(fr);
        af[m][kk] = *(LAS const v4i_t*)(base + row * 128 + c * 16);
      }
#pragma unroll
    for (int n = 0; n < NT; ++n)
#pragma unroll
      for (int kk = 0; kk < 2; ++kk) {
        const int row = wc * (BN / 4) + n * 16 + fr, c = (kk * 4 + fq) ^ swz(fr);
        bfr[n][kk] = *(LAS const v4i_t*)(base + 16384 + row * 128 + c * 16);
      }
#pragma unroll
    for (int kk = 0; kk < 2; ++kk)
#pragma unroll
      for (int m = 0; m < 4; ++m) {
        if (kk * 4 + m < LA + LB) {
          __builtin_amdgcn_sched_barrier(0);
          if (kt + 2 < nk) piece((kt + 2) % 3, kt + 2, kk * 4 + m);
          __builtin_amdgcn_sched_barrier(0);
        }
#pragma unroll
        for (int n = 0; n < NT; ++n) acc[m][n] = __builtin_amdgcn_mfma_i32_16x16x64_i8(bfr[n][kk], af[m][kk], acc[m][n], 0, 0, 0);
      }
  }
  epi(acc, wr, wc, fr, fq);
}

#define GEMM_LDS_BYTES (3 * (128 + 256) * 128)
#define RED_OFF GEMM_LDS_BYTES
#define XB_LDS_OFF (GEMM_LDS_BYTES + 4096)
#define LDS_BYTES (GEMM_LDS_BYTES + 4096 + 16)

struct P {
  const float* x; const float* mem; const float* b_in; const float* sgu_g; const float* sgu_b; const float* b_sp; const float* conv_w;
  const float* ln1_g; const float* ln1_b; const float* ln2_g; const float* ln2_b; const float* ln3_g; const float* ln3_b;
  const bf16_t* XB; const bf16_t* w_inT; const bf16_t* w_moT; const bf16_t* wsb;
  bf16_t* ZB; bf16_t* VT; bf16_t* Y; float* PRE; bf16_t* X1;
  const bf16_t* w_xqT; const bf16_t* w_xkvT; const bf16_t* w_xoT; const bf16_t* memB;
  bf16_t* Kc; bf16_t* Vc; bf16_t* Q; bf16_t* Pb; bf16_t* X2;
  const bf16_t* wxqB; bf16_t* GTb; bf16_t* HT;
  const bf16_t* w_pqT;
  const bf16_t* wpqB;
  const bf16_t* skb; unsigned* KEYS; unsigned char* X1Q; int* experts; float* gates;
  const unsigned char* WDq; const unsigned char* WUq; const float* sd; const float* su; float* out;
  signed char* w_inQ; float* sw_in; signed char* GTq; float* sG; signed char* MTq; float* sMT; float* SX1;
  char* slabs;
  unsigned* bar; unsigned char* XQ; float* SX; int* PD; float* H3;
  bf16_t* HALO;
  const float* w_in; const float* w_mo; const float* w_sp; const float* w_xq; const float* w_xkv; const float* w_xo; const float* w_pq; const float* sub_keys; const float* w_down; const float* w_up;
};

#define SLAB_BYTES (1536 * 1024)
#define OFF_XB 0
#define OFF_EXP 0
#define OFF_GATE (64 * 1024)
#define OFF_CQ (128 * 1024)
#define OFF_SC (144 * 1024)
#define OFF_X2Q (128 * 1024)
#define OFF_ZB (256 * 1024)
#define OFF_VT (896 * 1024)
#define OFF_Y (1024 * 1024)
#define OFF_Q (1280 * 1024)
__device__ __forceinline__ void wg_sync_mem() { asm volatile("s_waitcnt vmcnt(0) lgkmcnt(0)" ::: "memory"); __syncthreads(); }

#define OFF_SXB (128 * 1024)
__device__ __forceinline__ void phase_inproj(const P& p, int tile) {
  const signed char* xq = (const signed char*)(p.slabs + (size_t)tile * SLAB_BYTES + OFF_XB);
  const float* sxr = (const float*)(p.slabs + (size_t)tile * SLAB_BYTES + OFF_SXB);
  for (int nt = 0; nt < INW / 256; ++nt) {
    wg_gemm_i8<256>(xq, DM, p.w_inQ + (long)nt * 256 * DM, DM, DM, [&](v4i_t (&acc)[4][4], int wr, int wc, int fr, int fq) {
#pragma unroll
      for (int m = 0; m < 4; ++m) {
        const int rl = wr * 64 + m * 16 + fr;
        const float sr = sxr[rl];
#pragma unroll
        for (int n = 0; n < 4; ++n) {
          const int row = tile * 128 + rl, col = nt * 256 + wc * 64 + n * 16 + fq * 4;
          const float4 bv = *(const float4*)(p.b_in + col), sw = *(const float4*)(p.sw_in + col);
          float o0 = (float)acc[m][n][0] * (sr * sw.x) + bv.x, o1 = (float)acc[m][n][1] * (sr * sw.y) + bv.y, o2 = (float)acc[m][n][2] * (sr * sw.z) + bv.z, o3 = (float)acc[m][n][3] * (sr * sw.w) + bv.w;
          if (nt < 4) { o0 = gelu_f(o0); o1 = gelu_f(o1); o2 = gelu_f(o2); o3 = gelu_f(o3); }
          u32x2 w; w.x = pk_bf16(o0, o1); w.y = pk_bf16(o2, o3);
          *(u32x2*)(p.ZB + (long)row * INW + col) = w;
        }
      }
    });
  }
}

__device__ __forceinline__ void phase_mixer(const P& p, int tile) {
  const int tid = otid(), lane = tid & 63, wid = tid >> 6;
  const long t0 = (long)tile * 128;
  const bool seq_start = ((tile & 63) == 0);
#pragma unroll 2
  for (int it = tid; it < 128 * 64; it += 512) {
    const int tl = it >> 6, c = (it & 63) * 8;
    const long t = t0 + tl;
    float conv[8];
#pragma unroll
    for (int j = 0; j < 8; ++j) conv[j] = 0.f;
#pragma unroll
    for (int k = 0; k < 3; ++k) {
      const int rl = tl - 2 + k;
      const float4 w0 = *(const float4*)(p.conv_w + k * 512 + c), w1 = *(const float4*)(p.conv_w + k * 512 + c + 4);
      if (rl >= 0) {
        const bf16_t* zr = p.ZB + (t0 + rl) * INW;
        const u32x4 hb = *(const u32x4*)(zr + 1024 + c), gc = *(const u32x4*)(zr + 2048 + c);
        conv[0] += w0.x * (bf_lo(hb.x) * bf_lo(gc.x)); conv[1] += w0.y * (bf_hi(hb.x) * bf_hi(gc.x));
        conv[2] += w0.z * (bf_lo(hb.y) * bf_lo(gc.y)); conv[3] += w0.w * (bf_hi(hb.y) * bf_hi(gc.y));
        conv[4] += w1.x * (bf_lo(hb.z) * bf_lo(gc.z)); conv[5] += w1.y * (bf_hi(hb.z) * bf_hi(gc.z));
        conv[6] += w1.z * (bf_lo(hb.w) * bf_lo(gc.w)); conv[7] += w1.w * (bf_hi(hb.w) * bf_hi(gc.w));
      } else if (!seq_start) {
        const u32x4 zc = *(const u32x4*)(p.HALO + ((long)(tile - 1) * 2 + (rl + 2)) * 512 + c);
        conv[0] += w0.x * bf_lo(zc.x); conv[1] += w0.y * bf_hi(zc.x); conv[2] += w0.z * bf_lo(zc.y); conv[3] += w0.w * bf_hi(zc.y);
        conv[4] += w1.x * bf_lo(zc.z); conv[5] += w1.y * bf_hi(zc.z); conv[6] += w1.z * bf_lo(zc.w); conv[7] += w1.w * bf_hi(zc.w);
      }
    }
    const u32x4 gb = *(const u32x4*)(p.ZB + t * INW + 1536 + c);
    u32x4 o;
    o.x = pk_bf16(bf_lo(gb.x) * conv[0], bf_hi(gb.x) * conv[1]); o.y = pk_bf16(bf_lo(gb.y) * conv[2], bf_hi(gb.y) * conv[3]);
    o.z = pk_bf16(bf_lo(gb.z) * conv[4], bf_hi(gb.z) * conv[5]); o.w = pk_bf16(bf_lo(gb.w) * conv[6], bf_hi(gb.w) * conv[7]);
    *(u32x4*)(p.Y + t * DM + 512 + c) = o;
  }
  for (int h = 0; h < 4; ++h) {
    float a0[16], a1[16];
    const float g0 = p.sgu_g[h * 128 + 2 * lane], g1 = p.sgu_g[h * 128 + 2 * lane + 1], b0 = p.sgu_b[h * 128 + 2 * lane], b1 = p.sgu_b[h * 128 + 2 * lane + 1];
#pragma unroll
    for (int i = 0; i < 16; ++i) {
      const unsigned v = *(const unsigned*)(p.ZB + (t0 + wid * 16 + i) * INW + 512 + h * 128 + 2 * lane);
      const float x0 = bf_lo(v), x1 = bf_hi(v);
      float sum = x0 + x1;
#pragma unroll
      for (int o = 32; o > 0; o >>= 1) sum += __shfl_xor(sum, o);
      const float mu = sum * (1.f / 128.f);
      const float d0 = x0 - mu, d1 = x1 - mu;
      float q = d0 * d0 + d1 * d1;
#pragma unroll
      for (int o = 32; o > 0; o >>= 1) q += __shfl_xor(q, o);
      const float rstd = rsqrtf(q * (1.f / 128.f) + LN_EPS);
      a0[i] = d0 * rstd * g0 + b0; a1[i] = d1 * rstd * g1 + b1;
    }
    bf16_t* vt = p.VT + ((long)tile * 4 + h) * 128 * 128;
    u32x4 o;
    o.x = pk_bf16(a0[0], a0[1]); o.y = pk_bf16(a0[2], a0[3]); o.z = pk_bf16(a0[4], a0[5]); o.w = pk_bf16(a0[6], a0[7]);
    *(u32x4*)(vt + (2 * lane) * 128 + wid * 16) = o;
    o.x = pk_bf16(a0[8], a0[9]); o.y = pk_bf16(a0[10], a0[11]); o.z = pk_bf16(a0[12], a0[13]); o.w = pk_bf16(a0[14], a0[15]);
    *(u32x4*)(vt + (2 * lane) * 128 + wid * 16 + 8) = o;
    o.x = pk_bf16(a1[0], a1[1]); o.y = pk_bf16(a1[2], a1[3]); o.z = pk_bf16(a1[4], a1[5]); o.w = pk_bf16(a1[6], a1[7]);
    *(u32x4*)(vt + (2 * lane + 1) * 128 + wid * 16) = o;
    o.x = pk_bf16(a1[8], a1[9]); o.y = pk_bf16(a1[10], a1[11]); o.z = pk_bf16(a1[12], a1[13]); o.w = pk_bf16(a1[14], a1[15]);
    *(u32x4*)(vt + (2 * lane + 1) * 128 + wid * 16 + 8) = o;
  }
  wg_sync_mem();
  for (int h = 0; h < 4; ++h) {
    wg_gemm<128>(p.wsb + h * 128 * 128, 128, p.VT + ((long)tile * 4 + h) * 128 * 128, 128, 128, [&](f32x4 (&acc)[4][2], int wr, int wc, int fr, int fq) {
#pragma unroll
      for (int m = 0; m < 4; ++m)
#pragma unroll
        for (int n = 0; n < 2; ++n) {
          const int rl = wr * 64 + m * 16 + fr, col = wc * 32 + n * 16 + fq * 4;
          const float bs = p.b_sp[h * 128 + rl];
          const u32x2 uv = *(const u32x2*)(p.ZB + (t0 + rl) * INW + h * 128 + col);
          u32x2 w;
          w.x = pk_bf16(bf_lo(uv.x) * (acc[m][n][0] + bs), bf_hi(uv.x) * (acc[m][n][1] + bs));
          w.y = pk_bf16(bf_lo(uv.y) * (acc[m][n][2] + bs), bf_hi(uv.y) * (acc[m][n][3] + bs));
          *(u32x2*)(p.Y + (t0 + rl) * DM + h * 128 + col) = w;
        }
    });
  }
}

__device__ __forceinline__ void ln_rows16(const float* __restrict__ PRE, long r0, const float* __restrict__ g, const float* __restrict__ b, bf16_t* __restrict__ Out, int lane) {
#pragma unroll 2
  for (int i = 0; i < 16; ++i) {
    const bf16_t* pr = (const bf16_t*)PRE + (r0 + i) * DM;
    float4 v[4];
    float sum = 0.f;
#pragma unroll
    for (int j = 0; j < 4; ++j) { const u32x2 pv = *(const u32x2*)(pr + j * 256 + lane * 4); v[j].x = bf_lo(pv.x); v[j].y = bf_hi(pv.x); v[j].z = bf_lo(pv.y); v[j].w = bf_hi(pv.y); sum += (v[j].x + v[j].y) + (v[j].z + v[j].w); }
#pragma unroll
    for (int o = 32; o > 0; o >>= 1) sum += __shfl_xor(sum, o);
    const float mu = sum * (1.f / DM);
    float q = 0.f;
#pragma unroll
    for (int j = 0; j < 4; ++j) { v[j].x -= mu; v[j].y -= mu; v[j].z -= mu; v[j].w -= mu; q += (v[j].x * v[j].x + v[j].y * v[j].y) + (v[j].z * v[j].z + v[j].w * v[j].w); }
#pragma unroll
    for (int o = 32; o > 0; o >>= 1) q += __shfl_xor(q, o);
    const float rstd = rsqrtf(q * (1.f / DM) + LN_EPS);
#pragma unroll
    for (int j = 0; j < 4; ++j) {
      const int c0 = j * 256 + lane * 4;
      const float4 gg = *(const float4*)(g + c0), bb = *(const float4*)(b + c0);
      u32x2 w; w.x = pk_bf16(v[j].x * rstd * gg.x + bb.x, v[j].y * rstd * gg.y + bb.y); w.y = pk_bf16(v[j].z * rstd * gg.z + bb.z, v[j].w * rstd * gg.w + bb.w);
      *(u32x2*)(Out + (r0 + i) * DM + c0) = w;
    }
  }
}

__device__ __forceinline__ void ln_rows16_q(const float* __restrict__ PRE, long r0, const float* __restrict__ g, const float* __restrict__ b, bf16_t* __restrict__ Out,
                                            unsigned char* __restrict__ XQ, float* __restrict__ SX, int lane) {
#pragma unroll 2
  for (int i = 0; i < 16; ++i) {
    const bf16_t* pr = (const bf16_t*)PRE + (r0 + i) * DM;
    float4 v[4];
    float sum = 0.f;
#pragma unroll
    for (int j = 0; j < 4; ++j) { const u32x2 pv = *(const u32x2*)(pr + j * 256 + lane * 4); v[j].x = bf_lo(pv.x); v[j].y = bf_hi(pv.x); v[j].z = bf_lo(pv.y); v[j].w = bf_hi(pv.y); sum += (v[j].x + v[j].y) + (v[j].z + v[j].w); }
#pragma unroll
    for (int o = 32; o > 0; o >>= 1) sum += __shfl_xor(sum, o);
    const float mu = sum * (1.f / DM);
    float q = 0.f;
#pragma unroll
    for (int j = 0; j < 4; ++j) { v[j].x -= mu; v[j].y -= mu; v[j].z -= mu; v[j].w -= mu; q += (v[j].x * v[j].x + v[j].y * v[j].y) + (v[j].z * v[j].z + v[j].w * v[j].w); }
#pragma unroll
    for (int o = 32; o > 0; o >>= 1) q += __shfl_xor(q, o);
    const float rstd = rsqrtf(q * (1.f / DM) + LN_EPS);
    float amax = 0.f;
#pragma unroll
    for (int j = 0; j < 4; ++j) {
      const int c0 = j * 256 + lane * 4;
      const float4 gg = *(const float4*)(g + c0), bb = *(const float4*)(b + c0);
      v[j].x = v[j].x * rstd * gg.x + bb.x; v[j].y = v[j].y * rstd * gg.y + bb.y; v[j].z = v[j].z * rstd * gg.z + bb.z; v[j].w = v[j].w * rstd * gg.w + bb.w;
      u32x2 w; w.x = pk_bf16(v[j].x, v[j].y); w.y = pk_bf16(v[j].z, v[j].w);
      *(u32x2*)(Out + (r0 + i) * DM + c0) = w;
      amax = fmaxf(amax, fmaxf(fmaxf(fabsf(v[j].x), fabsf(v[j].y)), fmaxf(fabsf(v[j].z), fabsf(v[j].w))));
    }
#pragma unroll
    for (int o = 32; o > 0; o >>= 1) amax = fmaxf(amax, __shfl_xor(amax, o));
    const float inv = amax > 0.f ? 127.f / amax : 0.f;
#pragma unroll
    for (int j = 0; j < 4; ++j) *(unsigned*)(XQ + (r0 + i) * DM + j * 256 + lane * 4) = pack4_i8(v[j].x * inv, v[j].y * inv, v[j].z * inv, v[j].w * inv);
    if (lane == 0) SX[r0 + i] = amax * (1.f / 127.f);
  }
}

__device__ __forceinline__ void phase_outproj(const P& p, int tile) {
  const long t0 = (long)tile * 128;
  for (int nt = 0; nt < 4; ++nt) {
    wg_gemm<256>(p.Y + t0 * DM, DM, p.w_moT + (long)nt * 256 * DM, DM, DM, [&](f32x4 (&acc)[4][4], int wr, int wc, int fr, int fq) {
#pragma unroll
      for (int m = 0; m < 4; ++m)
#pragma unroll
        for (int n = 0; n < 4; ++n) {
          const long row = t0 + wr * 64 + m * 16 + fr; const int col = nt * 256 + wc * 64 + n * 16 + fq * 4;
          const float4 xv = *(const float4*)(p.x + row * DM + col);
          u32x2 o; o.x = pk_bf16(ALPHA * xv.x + acc[m][n][0], ALPHA * xv.y + acc[m][n][1]); o.y = pk_bf16(ALPHA * xv.z + acc[m][n][2], ALPHA * xv.w + acc[m][n][3]);
          *(u32x2*)((bf16_t*)p.PRE + row * DM + col) = o;
        }
    });
  }
  wg_sync_mem();
  ln_rows16_q(p.PRE, t0 + (threadIdx.x >> 6) * 16, p.ln1_g, p.ln1_b, p.X1, p.X1Q, p.SX1, threadIdx.x & 63);
}

__device__ __forceinline__ void phase_kv(const P& p, int unit) {
  const int rt = unit >> 5, nc = unit & 31;
  wg_gemm<64>(p.memB + (long)rt * 128 * DM, DM, p.w_xkvT + (long)nc * 64 * DM, DM, DM, [&](f32x4 (&acc)[4][1], int wr, int wc, int fr, int fq) {
    const int b = rt >> 1, col = nc * 64 + wc * 16 + fq * 4, hh = (col >> 8) & 3, d = col & 255;
#pragma unroll
    for (int m = 0; m < 4; ++m) {
      const int mm = (rt & 1) * 128 + wr * 64 + m * 16 + fr;
      u32x2 w; w.x = pk_bf16(acc[m][0][0], acc[m][0][1]); w.y = pk_bf16(acc[m][0][2], acc[m][0][3]);
      *(u32x2*)((col < 1024 ? p.Kc : p.Vc) + ((long)(b * 4 + hh) * 256 + mm) * 256 + d) = w;
    }
  });
}

__device__ __forceinline__ void phase_gh(const P& p, int unit) {
  if (unit < 128) {
    const int bh = unit >> 3, rt = (unit >> 2) & 1, nt = unit & 3, h = bh & 3, b = bh >> 2;
    wg_gemm<256>(p.Kc + ((long)bh * 256 + rt * 128) * 256, 256, p.wxqB + (long)nt * 256 * DM + h * 256, DM, 256, [&](f32x4 (&acc)[4][4], int wr, int wc, int fr, int fq) {
#pragma unroll
      for (int m = 0; m < 4; ++m)
#pragma unroll
        for (int n = 0; n < 4; ++n) {
          const long row = (long)b * 1024 + h * 256 + rt * 128 + wr * 64 + m * 16 + fr; const int col = nt * 256 + wc * 64 + n * 16 + fq * 4;
          u32x2 w; w.x = pk_bf16(acc[m][n][0], acc[m][n][1]); w.y = pk_bf16(acc[m][n][2], acc[m][n][3]);
          *(u32x2*)(p.GTb + row * DM + col) = w;
        }
    });
  } else {
    const int u = unit - 128, bh = u >> 3, rt = u & 7, h = bh & 3, b = bh >> 2;
    wg_gemm<256>(p.w_xoT + (long)rt * 128 * DM + h * 256, DM, p.Vc + (long)bh * 256 * 256, 256, 256, [&](f32x4 (&acc)[4][4], int wr, int wc, int fr, int fq) {
#pragma unroll
      for (int m = 0; m < 4; ++m)
#pragma unroll
        for (int n = 0; n < 4; ++n) {
          const long row = (long)b * 1024 + rt * 128 + wr * 64 + m * 16 + fr; const int col = h * 256 + wc * 64 + n * 16 + fq * 4;
          u32x2 w; w.x = pk_bf16(acc[m][n][0], acc[m][n][1]); w.y = pk_bf16(acc[m][n][2], acc[m][n][3]);
          *(u32x2*)(p.HT + row * DM + col) = w;
        }
    });
  }
}

__device__ __forceinline__ void phase_gquant(const P& p) {
  const int lane = threadIdx.x & 63, wid = threadIdx.x >> 6;
#pragma unroll
  for (int i = 0; i < 2; ++i) {
    const long row = (long)blockIdx.x * 16 + wid * 2 + i;
    u32x2 v[4];
    float amax = 0.f;
#pragma unroll
    for (int j = 0; j < 4; ++j) {
      v[j] = *(const u32x2*)(p.GTb + row * DM + 256 * j + lane * 4);
      amax = fmaxf(amax, fmaxf(fmaxf(fabsf(bf_lo(v[j].x)), fabsf(bf_hi(v[j].x))), fmaxf(fabsf(bf_lo(v[j].y)), fabsf(bf_hi(v[j].y)))));
    }
#pragma unroll
    for (int o = 32; o > 0; o >>= 1) amax = fmaxf(amax, __shfl_xor(amax, o));
    const float inv = amax > 0.f ? 127.f / amax : 0.f;
#pragma unroll
    for (int j = 0; j < 4; ++j) *(unsigned*)(p.GTq + row * DM + 256 * j + lane * 4) = pack4_i8(bf_lo(v[j].x) * inv, bf_hi(v[j].x) * inv, bf_lo(v[j].y) * inv, bf_hi(v[j].y) * inv);
    if (lane == 0) p.sG[row] = amax * (1.f / 127.f);
  }
  {
    const long row = (long)blockIdx.x * 8 + wid;
    u32x2 v[4];
    float amax = 0.f;
#pragma unroll
    for (int j = 0; j < 4; ++j) {
      v[j] = *(const u32x2*)(p.w_pqT + row * DM + 256 * j + lane * 4);
      amax = fmaxf(amax, fmaxf(fmaxf(fabsf(bf_lo(v[j].x)), fabsf(bf_hi(v[j].x))), fmaxf(fabsf(bf_lo(v[j].y)), fabsf(bf_hi(v[j].y)))));
    }
#pragma unroll
    for (int o = 32; o > 0; o >>= 1) amax = fmaxf(amax, __shfl_xor(amax, o));
    const float inv = amax > 0.f ? 127.f / amax : 0.f;
#pragma unroll
    for (int j = 0; j < 4; ++j) *(unsigned*)(p.MTq + row * DM + 256 * j + lane * 4) = pack4_i8(bf_lo(v[j].x) * inv, bf_hi(v[j].x) * inv, bf_lo(v[j].y) * inv, bf_hi(v[j].y) * inv);
    if (lane == 0) p.sMT[row] = amax * (1.f / 127.f);
  }
}

__device__ __forceinline__ void phase_scores(const P& p, int tile) {
  const long t0 = (long)tile * 128;
  const int b = tile >> 6;
  LAS float* red = (LAS float*)((LAS char*)smem_raw + RED_OFF);
  for (int h = 0; h < 4; ++h) {
    bf16_t* Pw = p.Pb + t0 * DM + h * 256;
    wg_gemm_i8<256>((const signed char*)p.X1Q + t0 * DM, DM, p.GTq + ((long)b * 1024 + h * 256) * DM, DM, DM, [&](v4i_t (&iacc)[4][4], int wr, int wc, int fr, int fq) {
      f32x4 acc[4][4];
      float rmax[4];
#pragma unroll
      for (int m = 0; m < 4; ++m) {
        const float sr = p.SX1[t0 + wr * 64 + m * 16 + fr] * 0.0625f;
#pragma unroll
        for (int n = 0; n < 4; ++n) {
          const float4 sw = *(const float4*)(p.sG + b * 1024 + h * 256 + wc * 64 + n * 16 + fq * 4);
          acc[m][n][0] = (float)iacc[m][n][0] * (sr * sw.x); acc[m][n][1] = (float)iacc[m][n][1] * (sr * sw.y);
          acc[m][n][2] = (float)iacc[m][n][2] * (sr * sw.z); acc[m][n][3] = (float)iacc[m][n][3] * (sr * sw.w);
        }
      }
#pragma unroll
      for (int m = 0; m < 4; ++m) {
        float mx = -3.0e38f;
#pragma unroll
        for (int n = 0; n < 4; ++n) mx = fmaxf(mx, fmaxf(fmaxf(acc[m][n][0], acc[m][n][1]), fmaxf(acc[m][n][2], acc[m][n][3])));
        mx = fmaxf(mx, __shfl_xor(mx, 16)); mx = fmaxf(mx, __shfl_xor(mx, 32));
        if (fq == 0) red[(wr * 64 + m * 16 + fr) * 4 + wc] = mx;
      }
      __syncthreads();
#pragma unroll
      for (int m = 0; m < 4; ++m) {
        const f32x4 r = *(LAS const f32x4*)(red + (wr * 64 + m * 16 + fr) * 4);
        rmax[m] = fmaxf(fmaxf(r[0], r[1]), fmaxf(r[2], r[3]));
      }
#pragma unroll
      for (int m = 0; m < 4; ++m) {
        float sm = 0.f;
#pragma unroll
        for (int n = 0; n < 4; ++n)
#pragma unroll
          for (int j = 0; j < 4; ++j) { const float e = __expf(acc[m][n][j] - rmax[m]); acc[m][n][j] = e; sm += e; }
        sm += __shfl_xor(sm, 16); sm += __shfl_xor(sm, 32);
        if (fq == 0) red[512 + (wr * 64 + m * 16 + fr) * 4 + wc] = sm;
      }
      __syncthreads();
#pragma unroll
      for (int m = 0; m < 4; ++m) {
        const f32x4 r = *(LAS const f32x4*)(red + 512 + (wr * 64 + m * 16 + fr) * 4);
        const float inv = 1.f / ((r[0] + r[1]) + (r[2] + r[3]));
        const int rl = wr * 64 + m * 16 + fr;
#pragma unroll
        for (int n = 0; n < 4; ++n) {
          u32x2 w; w.x = pk_bf16(acc[m][n][0] * inv, acc[m][n][1] * inv); w.y = pk_bf16(acc[m][n][2] * inv, acc[m][n][3] * inv);
          *(u32x2*)(Pw + rl * DM + wc * 64 + n * 16 + fq * 4) = w;
        }
      }
    });
  }
}

__device__ __forceinline__ void phase_oproj(const P& p, int tile) {
  const long t0 = (long)tile * 128;
  for (int nt = 0; nt < 4; ++nt) {
    wg_gemm<256>(p.Pb + t0 * DM, DM, p.HT + ((long)(tile >> 6) * 1024 + nt * 256) * DM, DM, DM, [&](f32x4 (&acc)[4][4], int wr, int wc, int fr, int fq) {
#pragma unroll
      for (int m = 0; m < 4; ++m)
#pragma unroll
        for (int n = 0; n < 4; ++n) {
          const long row = t0 + wr * 64 + m * 16 + fr; const int col = nt * 256 + wc * 64 + n * 16 + fq * 4;
          const u32x2 xv = *(const u32x2*)(p.X1 + row * DM + col);
          u32x2 o; o.x = pk_bf16(ALPHA * bf_lo(xv.x) + acc[m][n][0], ALPHA * bf_hi(xv.x) + acc[m][n][1]); o.y = pk_bf16(ALPHA * bf_lo(xv.y) + acc[m][n][2], ALPHA * bf_hi(xv.y) + acc[m][n][3]);
          *(u32x2*)((bf16_t*)p.PRE + row * DM + col) = o;
        }
    });
  }
  wg_sync_mem();
  ln_rows16_q(p.PRE, t0 + (threadIdx.x >> 6) * 16, p.ln2_g, p.ln2_b, p.X2, p.XQ, p.SX, threadIdx.x & 63);
}

__device__ __forceinline__ unsigned f2key(float f) { const unsigned b = __float_as_uint(f); return b ^ ((unsigned)((int)b >> 31) | 0x80000000u); }
__device__ __forceinline__ float key2f(unsigned k) { return __uint_as_float(k ^ ((k & 0x80000000u) ? 0x80000000u : 0xffffffffu)); }
__device__ __forceinline__ void phase_pq(const P& p, int tile) {
  const long t0 = (long)tile * 128;
  for (int nt = 0; nt < 8; ++nt) {
    wg_gemm_i8<256>((const signed char*)p.XQ + t0 * DM, DM, p.MTq + (long)nt * 256 * DM, DM, DM, [&](v4i_t (&acc)[4][4], int wr, int wc, int fr, int fq) {
#pragma unroll
      for (int m = 0; m < 4; ++m) {
        const long row = t0 + wr * 64 + m * 16 + fr;
        const float sr = p.SX[row];
#pragma unroll
        for (int n = 0; n < 4; ++n) {
          const int col = nt * 256 + wc * 64 + n * 16 + fq * 4;
          const float4 sw = *(const float4*)(p.sMT + col);
          u32x2 w; w.x = pk_f16((float)acc[m][n][0] * (sr * sw.x), (float)acc[m][n][1] * (sr * sw.y)); w.y = pk_f16((float)acc[m][n][2] * (sr * sw.z), (float)acc[m][n][3] * (sr * sw.w));
          *(u32x2*)((unsigned short*)p.KEYS + row * 2048 + col) = w;
        }
      }
    });
  }
}

__device__ __forceinline__ void phase_mt(const P& p, int unit) {
  const int hp = unit >> 2, nt = unit & 3;
  wg_gemm<256>(p.skb + (long)hp * 128 * 128, 128, p.wpqB + (long)nt * 256 * 2048 + hp * 128, 2048, 128, [&](f32x4 (&acc)[4][4], int wr, int wc, int fr, int fq) {
#pragma unroll
    for (int m = 0; m < 4; ++m)
#pragma unroll
      for (int n = 0; n < 4; ++n) {
        const int row = hp * 128 + wr * 64 + m * 16 + fr, col = nt * 256 + wc * 64 + n * 16 + fq * 4;
        u32x2 w; w.x = pk_bf16(acc[m][n][0], acc[m][n][1]); w.y = pk_bf16(acc[m][n][2], acc[m][n][3]);
        *(u32x2*)((bf16_t*)p.w_pqT + (long)row * DM + col) = w;
      }
  });
}

__device__ __forceinline__ unsigned cand_entry(int s) {
  unsigned e = 255u; int base = 0;
#pragma unroll
  for (int i = 0; i < 16; ++i) { const int cnt = 16 / (i + 1); if (s >= base && s < base + cnt) e = (unsigned)i | ((unsigned)(s - base) << 4); base += cnt; }
  return e;
}
template <int CTRL> __device__ __forceinline__ unsigned dpp_u(unsigned x) { return (unsigned)__builtin_amdgcn_mov_dpp((int)x, CTRL, 0xf, 0xf, true); }
template <int CTRL> __device__ __forceinline__ float dpp_f(float x) { return __int_as_float(__builtin_amdgcn_mov_dpp(__float_as_int(x), CTRL, 0xf, 0xf, true)); }
__device__ __forceinline__ unsigned umin_(unsigned a, unsigned b) { return a < b ? a : b; }
__device__ __forceinline__ unsigned row_min_u(unsigned x) {
  x = umin_(x, dpp_u<0x128>(x)); x = umin_(x, dpp_u<0x124>(x)); x = umin_(x, dpp_u<0x122>(x)); x = umin_(x, dpp_u<0x121>(x)); return x;
}
__device__ __forceinline__ float row_max_f(float x) { x = fmaxf(x, dpp_f<0x128>(x)); x = fmaxf(x, dpp_f<0x124>(x)); x = fmaxf(x, dpp_f<0x122>(x)); x = fmaxf(x, dpp_f<0x121>(x)); return x; }
__device__ __forceinline__ float row_sum_f(float x) { x += dpp_f<0x128>(x); x += dpp_f<0x124>(x); x += dpp_f<0x122>(x); x += dpp_f<0x121>(x); return x; }

#define KEYS_OFF 65536
#define KEY_STRIDE 528
template <int N> __device__ __forceinline__ unsigned top16_row(const unsigned (&k)[N], int r) {
  unsigned pm1 = 0xFFFFFFFEu, mine = 0;
#pragma unroll
  for (int rd = 0; rd < 16; ++rd) {
    unsigned d = pm1 - k[0];
#pragma unroll
    for (int i = 1; i < N; ++i) d = umin_(d, pm1 - k[i]);
    d = row_min_u(d);
    const unsigned nxt = pm1 - d;
    mine = (r == rd) ? nxt : mine;
    pm1 = nxt - 1;
  }
  return mine;
}

__device__ __forceinline__ void phase_route(const P& p, int tile) {
  const long t0 = (long)tile * 128;
  const int tid = otid(), lane = tid & 63, wid = tid >> 6, r = lane & 15, g = lane >> 4;
  LAS char* lds = (LAS char*)smem_raw;
  LAS unsigned char* tab = (LAS unsigned char*)(lds + RED_OFF);
  if (tid < 64) tab[tid] = (unsigned char)cand_entry(tid);
  unsigned ci[4], cj[4]; bool cval[4];
#pragma unroll
  for (int q = 0; q < 4; ++q) { const unsigned e = cand_entry(r * 4 + q); cval[q] = (e != 255u); ci[q] = ((unsigned)(g * 16) + (e & 15u)) * 4u; cj[q] = ((unsigned)(g * 16) + ((e >> 4) & 15u)) * 4u; }
  __syncthreads();
  auto load_keys = [&](int hp, u32x4 (&kb)[4]) {
#pragma unroll
    for (int ps = 0; ps < 4; ++ps) kb[ps] = *(const u32x4*)((const unsigned short*)p.KEYS + (t0 + wid * 16 + ps * 4 + g) * 2048 + hp * 128 + r * 8);
  };
  auto top_keys = [&](const u32x4 (&kb)[4], unsigned (&tp)[4]) {
#pragma unroll
    for (int ps = 0; ps < 4; ++ps) {
      const unsigned w[4] = {kb[ps].x, kb[ps].y, kb[ps].z, kb[ps].w};
      unsigned k[8];
#pragma unroll
      for (int i = 0; i < 4; ++i) {
        k[2 * i] = (f2key(f16_lo(w[i])) & ~127u) | (unsigned)(127 - (r * 8 + 2 * i));
        k[2 * i + 1] = (f2key(f16_hi(w[i])) & ~127u) | (unsigned)(126 - (r * 8 + 2 * i));
      }
      tp[ps] = top16_row<8>(k, r);
    }
  };
  u32x4 kA[4], kB[4];
  load_keys(0, kA);
  for (int h = 0; h < 8; ++h) {
    unsigned top[2][4];
    load_keys(h * 2 + 1, kB);
    top_keys(kA, top[0]);
    load_keys(h < 7 ? h * 2 + 2 : 15, kA);
    top_keys(kB, top[1]);
#pragma unroll
    for (int ps = 0; ps < 4; ++ps) {
      const int tk = wid * 16 + ps * 4 + g;
      const unsigned A = top[0][ps], B = top[1][ps];
      const float fa = key2f(A & ~127u), fb = key2f(B & ~127u);
      unsigned k2[4];
#pragma unroll
      for (int q = 0; q < 4; ++q) {
        const float va = __int_as_float(__builtin_amdgcn_ds_bpermute((int)ci[q], __float_as_int(fa)));
        const float vb = __int_as_float(__builtin_amdgcn_ds_bpermute((int)cj[q], __float_as_int(fb)));
        const unsigned kk = (f2key(va + vb) & ~63u) | (unsigned)(63 - (r * 4 + q));
        k2[q] = cval[q] ? kk : 0u;
      }
      const unsigned mine = top16_row<4>(k2, r);
      const unsigned slot = 63u - (mine & 63u);
      const unsigned e = tab[slot];
      const unsigned ka = (unsigned)__builtin_amdgcn_ds_bpermute((int)(((unsigned)(g * 16) + (e & 15u)) * 4u), (int)A);
      const unsigned kb = (unsigned)__builtin_amdgcn_ds_bpermute((int)(((unsigned)(g * 16) + ((e >> 4) & 15u)) * 4u), (int)B);
      const int expert = (int)((127u - (ka & 127u)) * 128u + (127u - (kb & 127u)));
      const float c = key2f(mine & ~63u);
      const float mx = row_max_f(c);
      const float ex = __expf(c - mx);
      const float sm = row_sum_f(ex);
      p.experts[(t0 + tk) * 128 + h * 16 + r] = expert;
      p.gates[(t0 + tk) * 128 + h * 16 + r] = ex / sm;
    }
  }
}

__device__ __forceinline__ f32x2_t ub01(unsigned w) { return (f32x2_t){(float)(w & 0xffu), (float)((w >> 8) & 0xffu)}; }
__device__ __forceinline__ f32x2_t ub23(unsigned w) { return (f32x2_t){(float)((w >> 16) & 0xffu), (float)(w >> 24)}; }
__device__ __forceinline__ int sum8_i(int x) {
  x += (int)dpp_u<0xB1>((unsigned)x); x += (int)dpp_u<0x4E>((unsigned)x); x += (int)dpp_u<0x141>((unsigned)x); return x;
}
struct GMeta { u32x4 xq; int er0, er1; };
__device__ __forceinline__ void phase_gdown(const P& p) {
  const int tid = otid(), lane = tid & 63, wid = tid >> 6, grp = lane >> 3, r8 = lane & 7;
  const int slice = blockIdx.x & 7, chunk = blockIdx.x >> 3;
  const unsigned char* tab = p.WDq + slice * 128 + r8 * 16;
  const char* sl = p.slabs + (size_t)(chunk * 8 + wid) * SLAB_BYTES;
  int* pd = (int*)(sl + OFF_ZB) + slice * 128 * 128;
  const unsigned char* xqb = (const unsigned char*)(sl + OFF_X2Q);
  const int* exb = (const int*)(sl + OFF_EXP);
  auto meta = [&](int ti, GMeta& m) {
    const int t = (ti < 127 ? ti : 127);
    m.xq = *(const u32x4*)(xqb + t * DM + slice * 128 + r8 * 16);
    m.er0 = exb[t * 128 + lane]; m.er1 = exb[t * 128 + 64 + lane];
  };
  auto issue = [&](const GMeta& m, u32x4 (&w)[16]) {
#pragma unroll
    for (int it = 0; it < 16; ++it) {
      const int e = __builtin_amdgcn_ds_bpermute(((it & 7) * 8 + grp) * 4, (it < 8) ? m.er0 : m.er1);
      w[it] = *(const u32x4*)(tab + (long)e * DM);
    }
  };
  auto consume = [&](int ti, const GMeta& m, const u32x4 (&w)[16]) {
    int c0 = 0, c1 = 0;
#pragma unroll
    for (int it = 0; it < 16; ++it) {
      int acc = __builtin_amdgcn_sdot4((int)w[it].x, (int)m.xq.x, 0, false);
      acc = __builtin_amdgcn_sdot4((int)w[it].y, (int)m.xq.y, acc, false); acc = __builtin_amdgcn_sdot4((int)w[it].z, (int)m.xq.z, acc, false); acc = __builtin_amdgcn_sdot4((int)w[it].w, (int)m.xq.w, acc, false);
      acc = sum8_i(acc);
      const bool mine = ((it & 7) == r8);
      c0 = (mine && it < 8) ? acc : c0;
      c1 = (mine && it >= 8) ? acc : c1;
    }
    pd[ti * 128 + r8 * 8 + grp] = c0; pd[ti * 128 + 64 + r8 * 8 + grp] = c1;
  };
  GMeta mA, mB; u32x4 wA[16], wB[16];
  meta(0, mA); issue(mA, wA); meta(1, mB);
  for (int ti = 0; ti < 128; ti += 2) {
    issue(mB, wB);
    consume(ti, mA, wA);
    meta(ti + 2, mA);
    issue(mA, wA);
    consume(ti + 1, mB, wB);
    meta(ti + 3, mB);
  }
}
__device__ __forceinline__ int cq_index(int k) { return ((k >> 5) * 8 + (k & 7)) * 4 + ((k >> 3) & 3); }
__device__ __forceinline__ void phase_gcomb(const P& p, int tile) {
  const int tid = otid(), lane = tid & 63, wid = tid >> 6;
  signed char* cq = (signed char*)(p.slabs + (size_t)tile * SLAB_BYTES + OFF_CQ);
  float* sc = (float*)(p.slabs + (size_t)tile * SLAB_BYTES + OFF_SC);
#pragma unroll 4
  for (int ti = 0; ti < 16; ++ti) {
    const int tl = wid * 16 + ti;
    const long t = (long)tile * 128 + tl;
    int s0 = 0, s1 = 0;
#pragma unroll
    for (int j = 0; j < 8; ++j) { s0 += p.PD[(j * 128 + tl) * 128 + lane]; s1 += p.PD[(j * 128 + tl) * 128 + 64 + lane]; }
    const int e0 = p.experts[t * 128 + lane], e1 = p.experts[t * 128 + 64 + lane];
    const float sx = p.SX[t];
    const float c0 = p.gates[t * 128 + lane] * gelu_f((float)s0 * p.sd[e0] * sx) * p.su[e0];
    const float c1 = p.gates[t * 128 + 64 + lane] * gelu_f((float)s1 * p.sd[e1] * sx) * p.su[e1];
    float amax = fmaxf(fabsf(c0), fabsf(c1));
#pragma unroll
    for (int o = 32; o > 0; o >>= 1) amax = fmaxf(amax, __shfl_xor(amax, o));
    const float inv = amax > 0.f ? 127.f / amax : 0.f;
    cq[tl * 128 + cq_index(lane)] = (signed char)__float2int_rn(c0 * inv);
    cq[tl * 128 + cq_index(lane + 64)] = (signed char)__float2int_rn(c1 * inv);
    if (lane == 0) sc[tl] = amax * (1.f / 127.f);
  }
}
struct UMeta { int er0, er1; unsigned cq[4]; };
__device__ __forceinline__ void phase_gup(const P& p) {
  const int tid = otid(), lane = tid & 63, wid = tid >> 6, grp = lane >> 3, r8 = lane & 7;
  const int slice = blockIdx.x & 7, chunk = blockIdx.x >> 3;
  const unsigned char* tab = p.WUq + slice * 128 + r8 * 16;
  char* sl = p.slabs + (size_t)(chunk * 8 + wid) * SLAB_BYTES;
  const int* exb = (const int*)(sl + OFF_EXP);
  const unsigned* cqb = (const unsigned*)(sl + OFF_CQ);
  const float* scb = (const float*)(sl + OFF_SC);
  bf16_t* h3b = (bf16_t*)(sl + OFF_ZB);
  auto meta = [&](int ti, UMeta& m) {
    const int t = (ti < 127 ? ti : 127);
    m.er0 = exb[t * 128 + lane]; m.er1 = exb[t * 128 + 64 + lane];
#pragma unroll
    for (int j = 0; j < 4; ++j) m.cq[j] = cqb[t * 32 + j * 8 + grp];
  };
  auto issue = [&](const UMeta& m, u32x4 (&w)[16]) {
#pragma unroll
    for (int it = 0; it < 16; ++it) {
      const int e = __builtin_amdgcn_ds_bpermute(((it & 7) * 8 + grp) * 4, (it < 8) ? m.er0 : m.er1);
      w[it] = *(const u32x4*)(tab + (long)e * DM);
    }
  };
  auto consume = [&](int ti, const UMeta& m, const u32x4 (&w)[16]) {
    int o[16];
#pragma unroll
    for (int i = 0; i < 16; ++i) o[i] = 0;
#pragma unroll
    for (int j = 0; j < 4; ++j) {
      const unsigned x0[4] = {w[4 * j].x, w[4 * j].y, w[4 * j].z, w[4 * j].w}, x1[4] = {w[4 * j + 1].x, w[4 * j + 1].y, w[4 * j + 1].z, w[4 * j + 1].w};
      const unsigned x2[4] = {w[4 * j + 2].x, w[4 * j + 2].y, w[4 * j + 2].z, w[4 * j + 2].w}, x3[4] = {w[4 * j + 3].x, w[4 * j + 3].y, w[4 * j + 3].z, w[4 * j + 3].w};
#pragma unroll
      for (int d = 0; d < 4; ++d) {
        const unsigned t0 = __builtin_amdgcn_perm(x1[d], x0[d], 0x05010400u), t1 = __builtin_amdgcn_perm(x1[d], x0[d], 0x07030602u);
        const unsigned u0 = __builtin_amdgcn_perm(x3[d], x2[d], 0x05010400u), u1 = __builtin_amdgcn_perm(x3[d], x2[d], 0x07030602u);
        o[d * 4 + 0] = __builtin_amdgcn_sdot4((int)__builtin_amdgcn_perm(u0, t0, 0x05040100u), (int)m.cq[j], o[d * 4 + 0], false);
        o[d * 4 + 1] = __builtin_amdgcn_sdot4((int)__builtin_amdgcn_perm(u0, t0, 0x07060302u), (int)m.cq[j], o[d * 4 + 1], false);
        o[d * 4 + 2] = __builtin_amdgcn_sdot4((int)__builtin_amdgcn_perm(u1, t1, 0x05040100u), (int)m.cq[j], o[d * 4 + 2], false);
        o[d * 4 + 3] = __builtin_amdgcn_sdot4((int)__builtin_amdgcn_perm(u1, t1, 0x07060302u), (int)m.cq[j], o[d * 4 + 3], false);
      }
    }
    const float sct = scb[ti];
    float f[16];
#pragma unroll
    for (int i = 0; i < 16; ++i) {
      int a = o[i];
      a += (int)dpp_u<0x128>((unsigned)a);
      a += __shfl_xor(a, 16);
      a += __shfl_xor(a, 32);
      f[i] = (float)a * sct;
    }
    if (grp == 0) {
      bf16_t* dst = h3b + ti * DM + slice * 128 + r8 * 16;
      u32x4 q0, q1;
      q0.x = pk_bf16(f[0], f[1]); q0.y = pk_bf16(f[2], f[3]); q0.z = pk_bf16(f[4], f[5]); q0.w = pk_bf16(f[6], f[7]);
      q1.x = pk_bf16(f[8], f[9]); q1.y = pk_bf16(f[10], f[11]); q1.z = pk_bf16(f[12], f[13]); q1.w = pk_bf16(f[14], f[15]);
      *(u32x4*)dst = q0; *(u32x4*)(dst + 8) = q1;
    }
  };
  UMeta mA, mB; u32x4 wA[16], wB[16];
  meta(0, mA); issue(mA, wA); meta(1, mB);
  for (int ti = 0; ti < 128; ti += 2) {
    issue(mB, wB);
    consume(ti, mA, wA);
    meta(ti + 2, mA);
    issue(mA, wA);
    consume(ti + 1, mB, wB);
    meta(ti + 3, mB);
  }
}
__device__ __forceinline__ void phase_ln3(const P& p, int tile) {
  const int tid = otid(), lane = tid & 63, wid = tid >> 6;
#pragma unroll 2
  for (int ti = 0; ti < 16; ++ti) {
    const long t = (long)tile * 128 + wid * 16 + ti;
    float4 v[4];
    float sum = 0.f;
#pragma unroll
    for (int j = 0; j < 4; ++j) {
      const int c0 = j * 256 + lane * 4;
      const u32x2 hv = *(const u32x2*)((const bf16_t*)p.H3 + t * DM + c0);
      const u32x2 xv = *(const u32x2*)(p.X2 + t * DM + c0);
      v[j].x = bf_lo(hv.x) + ALPHA * bf_lo(xv.x); v[j].y = bf_hi(hv.x) + ALPHA * bf_hi(xv.x); v[j].z = bf_lo(hv.y) + ALPHA * bf_lo(xv.y); v[j].w = bf_hi(hv.y) + ALPHA * bf_hi(xv.y);
      sum += (v[j].x + v[j].y) + (v[j].z + v[j].w);
    }
#pragma unroll
    for (int o = 32; o > 0; o >>= 1) sum += __shfl_xor(sum, o);
    const float mu = sum * (1.f / DM);
    float q = 0.f;
#pragma unroll
    for (int j = 0; j < 4; ++j) { v[j].x -= mu; v[j].y -= mu; v[j].z -= mu; v[j].w -= mu; q += (v[j].x * v[j].x + v[j].y * v[j].y) + (v[j].z * v[j].z + v[j].w * v[j].w); }
#pragma unroll
    for (int o = 32; o > 0; o >>= 1) q += __shfl_xor(q, o);
    const float rstd = rsqrtf(q * (1.f / DM) + LN_EPS);
#pragma unroll
    for (int j = 0; j < 4; ++j) {
      const int c0 = j * 256 + lane * 4;
      const float4 gg = *(const float4*)(p.ln3_g + c0), bb = *(const float4*)(p.ln3_b + c0);
      float4 o; o.x = v[j].x * rstd * gg.x + bb.x; o.y = v[j].y * rstd * gg.y + bb.y; o.z = v[j].z * rstd * gg.z + bb.z; o.w = v[j].w * rstd * gg.w + bb.w;
      *(float4*)(p.out + t * DM + c0) = o;
    }
  }
}

__device__ __forceinline__ void prep_transpose_tile(const float* __restrict__ W, bf16_t* __restrict__ WT, int K, int N, int tileidx) {
  LAS float* scr = (LAS float*)smem_raw;
  const int ntn = N / 64, k0 = (tileidx / ntn) * 64, n0 = (tileidx % ntn) * 64, tid = threadIdx.x;
#pragma unroll
  for (int i = 0; i < 8; ++i) { const int e = tid + i * 512, kk = e >> 6, nn = e & 63; scr[kk * 65 + nn] = W[(long)(k0 + kk) * N + n0 + nn]; }
  __syncthreads();
#pragma unroll
  for (int i = 0; i < 4; ++i) { const int e = tid + i * 512, nn = e >> 5, kp = (e & 31) * 2; *(unsigned*)(WT + (long)(n0 + nn) * K + k0 + kp) = pk_bf16(scr[kp * 65 + nn], scr[(kp + 1) * 65 + nn]); }
  __syncthreads();
}
__device__ __forceinline__ void prep_quant_strip(const float* __restrict__ W, signed char* __restrict__ Q, float* __restrict__ sc, int K, int N, int strip) {
  LAS float* scr = (LAS float*)smem_raw;
  LAS float* pmax = scr + 64 * 65;
  LAS float* inv = pmax + 8 * 64;
  const int n0 = strip * 64, tid = threadIdx.x, nn = tid & 63, kg = tid >> 6;
  float amax = 0.f;
  for (int k0 = 0; k0 < K; k0 += 64)
#pragma unroll
    for (int i = 0; i < 8; ++i) amax = fmaxf(amax, fabsf(W[(long)(k0 + kg + 8 * i) * N + n0 + nn]));
  pmax[kg * 64 + nn] = amax;
  __syncthreads();
  if (tid < 64) {
    float m = 0.f;
#pragma unroll
    for (int j = 0; j < 8; ++j) m = fmaxf(m, pmax[j * 64 + tid]);
    inv[tid] = m > 0.f ? 127.f / m : 0.f;
    sc[n0 + tid] = m * (1.f / 127.f);
  }
  __syncthreads();
  const float iv = inv[nn];
  for (int k0 = 0; k0 < K; k0 += 64) {
#pragma unroll
    for (int i = 0; i < 8; ++i) { const int kk = kg + 8 * i; scr[kk * 65 + nn] = W[(long)(k0 + kk) * N + n0 + nn] * iv; }
    __syncthreads();
#pragma unroll
    for (int i = 0; i < 2; ++i) {
      const int dd = tid + i * 512, n = dd >> 4, k4 = (dd & 15) * 4;
      *(unsigned*)(Q + (long)(n0 + n) * K + k0 + k4) = pack4_i8(scr[k4 * 65 + n], scr[(k4 + 1) * 65 + n], scr[(k4 + 2) * 65 + n], scr[(k4 + 3) * 65 + n]);
    }
    __syncthreads();
  }
}
__device__ __forceinline__ void prep_cvt(const float* __restrict__ in, bf16_t* __restrict__ out, long n8) {
  for (long i = (long)blockIdx.x * 512 + threadIdx.x; i < n8; i += (long)gridDim.x * 512) {
    const float4 a = *(const float4*)(in + i * 8), b = *(const float4*)(in + i * 8 + 4);
    u32x4 o; o.x = pk_bf16(a.x, a.y); o.y = pk_bf16(a.z, a.w); o.z = pk_bf16(b.x, b.y); o.w = pk_bf16(b.z, b.w);
    *(u32x4*)(out + i * 8) = o;
  }
}
__device__ __forceinline__ void phase_prep(const P& p) {
  const int T_IN = 16 * 40, T_SQ = 16 * 16, T_W2 = 16 * 32;
  const int total = T_IN + T_SQ + T_SQ + T_W2 + T_SQ + T_W2;
  for (int it = blockIdx.x; it < total; it += gridDim.x) {
    int r = it;
    if (r < T_IN) { if (r < 40) prep_quant_strip(p.w_in, p.w_inQ, p.sw_in, DM, INW, r); continue; } r -= T_IN;
    if (r < T_SQ) { prep_transpose_tile(p.w_mo, (bf16_t*)p.w_moT, DM, DM, r); continue; } r -= T_SQ;
    if (r < T_SQ) { continue; } r -= T_SQ;
    if (r < T_W2) { prep_transpose_tile(p.w_xkv, (bf16_t*)p.w_xkvT, DM, 2048, r); continue; } r -= T_W2;
    if (r < T_SQ) { prep_transpose_tile(p.w_xo, (bf16_t*)p.w_xoT, DM, DM, r); continue; } r -= T_SQ;
    (void)r;
  }
  prep_cvt(p.mem, (bf16_t*)p.memB, (long)1024 * DM / 8);
  prep_cvt(p.sub_keys, (bf16_t*)p.skb, (long)8 * 2 * 128 * 128 / 8);
  prep_cvt(p.w_pq, (bf16_t*)p.wpqB, (long)DM * 2048 / 8);
  prep_cvt(p.w_xq, (bf16_t*)p.wxqB, (long)DM * DM / 8);
  {
    const int lane = threadIdx.x & 63, gw = blockIdx.x * 8 + (threadIdx.x >> 6), ngw = gridDim.x * 8;
    for (int row = gw; row < 2 * 16384; row += ngw) {
      const int tb = row >> 14, e = row & 16383;
      const float* src = (tb ? p.w_up : p.w_down) + (long)e * DM;
      float4 v[4];
      float amax = 0.f;
#pragma unroll
      for (int i = 0; i < 4; ++i) { v[i] = *(const float4*)(src + 256 * i + lane * 4); amax = fmaxf(amax, fmaxf(fmaxf(fabsf(v[i].x), fabsf(v[i].y)), fmaxf(fabsf(v[i].z), fabsf(v[i].w)))); }
#pragma unroll
      for (int s = 32; s > 0; s >>= 1) amax = fmaxf(amax, __shfl_xor(amax, s));
      const float inv = amax > 0.f ? 127.f / amax : 0.f;
      unsigned char* dst = (unsigned char*)(tb ? p.WUq : p.WDq) + (long)e * DM;
      const float off = 0.f;
#pragma unroll
      for (int i = 0; i < 4; ++i) *(unsigned*)(dst + 256 * i + lane * 4) = pack4_i8(v[i].x * inv + off, v[i].y * inv + off, v[i].z * inv + off, v[i].w * inv + off);
      if (lane == 0) { float* sc = (float*)(tb ? p.su : p.sd); sc[e] = amax * (1.f / 127.f); }
    }
  }
  for (int i = blockIdx.x * 512 + threadIdx.x; i < 4 * 128 * 128 / 2; i += gridDim.x * 512) {
    const int e = i * 2, t = (e >> 7) & 127, sidx = e & 127;
    const float2 v = *(const float2*)(p.w_sp + e);
    *(unsigned*)((bf16_t*)p.wsb + e) = pk_bf16(sidx <= t ? v.x : 0.f, (sidx + 1) <= t ? v.y : 0.f);
  }
}
__device__ __forceinline__ void phase_xcvt(const P& p, int tile) {
  const int lane = threadIdx.x & 63, wid = threadIdx.x >> 6;
  signed char* xq = (signed char*)(p.slabs + (size_t)tile * SLAB_BYTES + OFF_XB);
  float* sxr = (float*)(p.slabs + (size_t)tile * SLAB_BYTES + OFF_SXB);
#pragma unroll 2
  for (int i = 0; i < 16; ++i) {
    const int rl = wid * 16 + i;
    const float* src = p.x + ((long)tile * 128 + rl) * DM;
    float4 v[4];
    float amax = 0.f;
#pragma unroll
    for (int j = 0; j < 4; ++j) { v[j] = *(const float4*)(src + 256 * j + lane * 4); amax = fmaxf(amax, fmaxf(fmaxf(fabsf(v[j].x), fabsf(v[j].y)), fmaxf(fabsf(v[j].z), fabsf(v[j].w)))); }
#pragma unroll
    for (int o = 32; o > 0; o >>= 1) amax = fmaxf(amax, __shfl_xor(amax, o));
    const float inv = amax > 0.f ? 127.f / amax : 0.f;
#pragma unroll
    for (int j = 0; j < 4; ++j) *(unsigned*)(xq + rl * DM + 256 * j + lane * 4) = pack4_i8(v[j].x * inv, v[j].y * inv, v[j].z * inv, v[j].w * inv);
    if (lane == 0) sxr[rl] = amax * (1.f / 127.f);
  }
}
__device__ __forceinline__ void phase_halo(const P& p, int tile) {
  const int tid = otid();
  if (tid < 128) {
    const int rr = tid >> 6, c = (tid & 63) * 8;
    const bf16_t* zr = p.ZB + ((long)tile * 128 + 126 + rr) * INW;
    const u32x4 hb = *(const u32x4*)(zr + 1024 + c), gc = *(const u32x4*)(zr + 2048 + c);
    u32x4 o;
    o.x = pk_bf16(bf_lo(hb.x) * bf_lo(gc.x), bf_hi(hb.x) * bf_hi(gc.x)); o.y = pk_bf16(bf_lo(hb.y) * bf_lo(gc.y), bf_hi(hb.y) * bf_hi(gc.y));
    o.z = pk_bf16(bf_lo(hb.z) * bf_lo(gc.z), bf_hi(hb.z) * bf_hi(gc.z)); o.w = pk_bf16(bf_lo(hb.w) * bf_lo(gc.w), bf_hi(hb.w) * bf_hi(gc.w));
    *(u32x4*)(p.HALO + ((long)tile * 2 + rr) * 512 + c) = o;
  }
}

__device__ __forceinline__ P tile_view(const P& p, int tile) {
  P q = p;
  char* sl = p.slabs + (size_t)tile * SLAB_BYTES;
  const long t0 = (long)tile * 128;
  q.XB = (bf16_t*)(sl + OFF_XB) - t0 * DM; q.X1 = (bf16_t*)(sl + OFF_XB) - t0 * DM;
  q.experts = (int*)(sl + OFF_EXP) - t0 * 128; q.gates = (float*)(sl + OFF_GATE) - t0 * 128;
  q.ZB = (bf16_t*)(sl + OFF_ZB) - t0 * INW; q.PRE = (float*)((bf16_t*)(sl + OFF_ZB) - t0 * DM); q.KEYS = (unsigned*)((unsigned short*)(sl + OFF_ZB) - t0 * 2048);
  q.PD = (int*)(sl + OFF_ZB); q.H3 = (float*)((bf16_t*)(sl + OFF_ZB) - t0 * DM);
  q.VT = (bf16_t*)(sl + OFF_VT) - (long)tile * 4 * 128 * 128; q.X1Q = (unsigned char*)(sl + OFF_VT) - t0 * DM; q.XQ = (unsigned char*)(sl + OFF_X2Q) - t0 * DM;
  q.Y = (bf16_t*)(sl + OFF_Y) - t0 * DM; q.Pb = (bf16_t*)(sl + OFF_Y) - t0 * DM;
  q.Q = (bf16_t*)(sl + OFF_Q) - t0 * DM; q.X2 = (bf16_t*)(sl + OFF_Q) - t0 * DM;
  return q;
}

#define XB_TMO      128
#define XB_XCNT(j)  (256  + 64 * (j))
#define XB_XSUB(j)  (1280 + 64 * (j))
#define XB_XGEN(j)  (2304 + 64 * (j))
#define XB_TOP      3328
#define XB_TOPGEN   3392
#define XCD_BAR_WORDS 3456
#define XB_SPIN_CAP (1u << 18)

__device__ __forceinline__ unsigned xb_ld(unsigned* p)              { return __hip_atomic_load(p, __ATOMIC_RELAXED, __HIP_MEMORY_SCOPE_AGENT); }
__device__ __forceinline__ unsigned xb_add(unsigned* p, unsigned v) { return __hip_atomic_fetch_add(p, v, __ATOMIC_RELAXED, __HIP_MEMORY_SCOPE_AGENT); }
__device__ __forceinline__ unsigned xb_xcc_id() { return (unsigned)__builtin_amdgcn_s_getreg((3 << 11) | 20) & 0xFu; }
#define XB_SPIN(cond, bar) do { unsigned _sp = 0; while (cond) { __builtin_amdgcn_s_sleep(1); \
    if ((++_sp & 255u) == 0u) { if (xb_ld(&(bar)[XB_TMO])) break; if (_sp > XB_SPIN_CAP) { atomicAdd(&(bar)[XB_TMO], 1u); break; } } } } while (0)

struct XcdBarrier {
    unsigned* bar; unsigned x;
    volatile LAS unsigned* st;
};

__device__ __forceinline__ XcdBarrier xcd_barrier_post(unsigned* bar, volatile LAS unsigned* st) {
    XcdBarrier b; b.bar = bar; b.x = xb_xcc_id(); b.st = st;
    if (threadIdx.x == 0) (void)xb_add(&bar[XB_XCNT(b.x)], 1u);
    return b;
}
__device__ __forceinline__ void xcd_barrier_complete(unsigned* bar, unsigned x, unsigned& nloc, unsigned& nx) {
    const unsigned G = gridDim.x * gridDim.y * gridDim.z;
    unsigned sum, cnt, mine, sp = 0u;
    for (;;) {
        sum = 0u; cnt = 0u; mine = 0u;
#pragma unroll
        for (unsigned j = 0; j < 16; ++j) { const unsigned c = xb_ld(&bar[XB_XCNT(j)]); sum += c; cnt += (c > 0u) ? 1u : 0u; mine = (j == x) ? c : mine; }
        if (sum == G) break;
        __builtin_amdgcn_s_sleep(1);
        if ((++sp & 255u) == 0u) { if (xb_ld(&bar[XB_TMO])) break; if (sp > XB_SPIN_CAP) { atomicAdd(&bar[XB_TMO], 1u); break; } }
    }
    nloc = mine > 0u ? mine : 1u; nx = cnt > 0u ? cnt : 1u;
}

__device__ __forceinline__ void xcd_barrier(const XcdBarrier& b) {
    asm volatile("s_waitcnt vmcnt(0)" ::: "memory");
    __syncthreads();
    if (threadIdx.x == 0) {
        unsigned* bar = b.bar;
        __builtin_amdgcn_s_waitcnt(0);
        unsigned nloc = b.st[0], nx = b.st[1];
        if (nloc == 0u) { xcd_barrier_complete(bar, b.x, nloc, nx); b.st[0] = nloc; b.st[1] = nx; }
        const unsigned old = xb_add(&bar[XB_XSUB(b.x)], 1u);
        const unsigned gen = old / nloc;
        if (old + 1u == (gen + 1u) * nloc) {
            __builtin_amdgcn_fence(__ATOMIC_RELEASE, "agent");
            asm volatile("s_waitcnt vmcnt(0)" ::: "memory");
            const unsigned og = xb_add(&bar[XB_TOP], 1u);
            const unsigned tg = og / nx;
            if (og + 1u == (tg + 1u) * nx) xb_add(&bar[XB_TOPGEN], 1u);
            else XB_SPIN(xb_ld(&bar[XB_TOPGEN]) == tg, bar);
            __builtin_amdgcn_fence(__ATOMIC_ACQUIRE, "agent");
            xb_add(&bar[XB_XGEN(b.x)], 1u);
            asm volatile("s_waitcnt vmcnt(0)" ::: "memory");
        } else {
            XB_SPIN(xb_ld(&bar[XB_XGEN(b.x)]) == gen, bar);
            __builtin_amdgcn_fence(__ATOMIC_ACQUIRE, "agent");
            asm volatile("s_waitcnt vmcnt(0)" ::: "memory");
        }
    }
    __syncthreads();
}


__global__ __launch_bounds__(512) void mega_k(P pg) {
  const int tile = blockIdx.x;
  volatile LAS unsigned* xbw = (volatile LAS unsigned*)((LAS char*)smem_raw + XB_LDS_OFF);
  if (threadIdx.x < 4) xbw[threadIdx.x] = 0u;
  __syncthreads();
  XcdBarrier xb = xcd_barrier_post(pg.bar, xbw);
  const P p = tile_view(pg, tile);
  phase_prep(pg);
  phase_xcvt(p, tile);
  xcd_barrier(xb);
  phase_inproj(p, tile);
  wg_sync_mem();
  phase_halo(p, tile);
  phase_kv(p, tile);
  if (tile < 64) phase_mt(p, tile);
  xcd_barrier(xb);
  phase_gh(p, tile);
  wg_sync_mem();
  phase_mixer(p, tile);
  wg_sync_mem();
  phase_outproj(p, tile);
  wg_sync_mem();
  xcd_barrier(xb);
  phase_gquant(pg);
  xcd_barrier(xb);
  phase_scores(p, tile);
  wg_sync_mem();
  phase_oproj(p, tile);
  wg_sync_mem();
  phase_pq(p, tile);
  wg_sync_mem();
  phase_route(p, tile);
  xcd_barrier(xb);
  phase_gdown(pg);
  xcd_barrier(xb);
  phase_gcomb(p, tile);
  xcd_barrier(xb);
  phase_gup(pg);
  xcd_barrier(xb);
  phase_ln3(p, tile);
}

extern "C" void kernel_launch(void* const* d_in, const int* in_sizes, int n_in, void* d_out, int out_size, void* d_ws, size_t ws_size, hipStream_t stream) {
  static int grid_blocks = 0;
  if (grid_blocks == 0) {
    int dev = 0, cus = 0, per_cu = 0;
    (void)hipGetDevice(&dev);
    (void)hipDeviceGetAttribute(&cus, hipDeviceAttributeMultiprocessorCount, dev);
    if (hipFuncSetAttribute((const void*)mega_k, hipFuncAttributeMaxDynamicSharedMemorySize, LDS_BYTES) != hipSuccess) fprintf(stderr, "kernel_launch: hipFuncSetAttribute failed\n");
    if (hipOccupancyMaxActiveBlocksPerMultiprocessor(&per_cu, (const void*)mega_k, 512, LDS_BYTES) != hipSuccess || per_cu < 1) { fprintf(stderr, "kernel_launch: occupancy query says %d blocks/CU\n", per_cu); per_cu = 1; }
    (void)hipGetLastError();
    grid_blocks = NTOK / 128;
    if (cus * per_cu < grid_blocks) fprintf(stderr, "kernel_launch: device holds only %d x %d resident blocks, need %d\n", cus, per_cu, grid_blocks);
  }
  char* w8 = (char*)d_ws;
  const size_t MiB = (size_t)1 << 20;
  P p{};
  p.x = (const float*)d_in[0]; p.mem = (const float*)d_in[1]; p.w_in = (const float*)d_in[2]; p.b_in = (const float*)d_in[3];
  p.sgu_g = (const float*)d_in[4]; p.sgu_b = (const float*)d_in[5]; p.w_sp = (const float*)d_in[6]; p.b_sp = (const float*)d_in[7];
  p.conv_w = (const float*)d_in[8]; p.w_mo = (const float*)d_in[9]; p.ln1_g = (const float*)d_in[10]; p.ln1_b = (const float*)d_in[11];
  p.w_xq = (const float*)d_in[12]; p.w_xkv = (const float*)d_in[13]; p.w_xo = (const float*)d_in[14]; p.ln2_g = (const float*)d_in[15]; p.ln2_b = (const float*)d_in[16];
  p.w_pq = (const float*)d_in[17]; p.sub_keys = (const float*)d_in[18]; p.w_down = (const float*)d_in[19]; p.w_up = (const float*)d_in[20];
  p.ln3_g = (const float*)d_in[21]; p.ln3_b = (const float*)d_in[22];
  p.out = (float*)d_out;
  p.slabs = w8;
  bf16_t* wb = (bf16_t*)(w8 + 384 * MiB);
  p.w_inT = wb; p.w_inQ = (signed char*)wb; wb += (size_t)INW * DM / 2; p.sw_in = (float*)wb; wb += 2 * INW; p.w_moT = wb; wb += (size_t)DM * DM; p.wsb = wb; wb += 4 * 128 * 128;
  p.w_xqT = wb; p.GTq = (signed char*)wb; wb += (size_t)4 * 1024 * DM / 2; p.sG = (float*)wb; wb += 2 * 4096; p.w_xkvT = wb; wb += (size_t)2048 * DM; p.w_xoT = wb; wb += (size_t)DM * DM;
  p.memB = wb; wb += (size_t)1024 * DM; p.Kc = wb; wb += (size_t)1024 * DM; p.Vc = wb; wb += (size_t)1024 * DM; p.wxqB = wb; wb += (size_t)DM * DM; p.GTb = wb; wb += (size_t)4 * 1024 * DM; p.HT = wb; wb += (size_t)4 * 1024 * DM;
  p.w_pqT = wb; wb += (size_t)2048 * DM; p.MTq = (signed char*)wb; wb += (size_t)2048 * DM / 2; p.sMT = (float*)wb; wb += 2 * 2048; p.wpqB = wb; wb += (size_t)2048 * DM; p.skb = wb; wb += (size_t)8 * 2 * 128 * 128;
  p.WDq = (const unsigned char*)wb; wb += (size_t)16384 * DM / 2; p.WUq = (const unsigned char*)wb; wb += (size_t)16384 * DM / 2;
  p.sd = (const float*)wb; wb += 2 * 16384; p.su = (const float*)wb; wb += 2 * 16384;
  p.HALO = wb; wb += (size_t)256 * 2 * 512;
  p.SX = (float*)wb; wb += 2 * NTOK; p.SX1 = (float*)wb; wb += 2 * NTOK;
  p.bar = (unsigned*)wb; wb += 2 * 4096;
  if ((size_t)((char*)wb - w8) > ws_size) fprintf(stderr, "kernel_launch: workspace too small\n");
  (void)hipMemsetAsync(p.bar, 0, XCD_BAR_WORDS * 4, stream);
  void* args[] = {&p};
  hipError_t e = hipLaunchCooperativeKernel((const void*)mega_k, dim3(grid_blocks), dim3(512), args, LDS_BYTES, stream);
  if (e != hipSuccess) fprintf(stderr, "cooperative launch failed: %s (grid %d)\n", hipGetErrorString(e), grid_blocks);
}
```

```cpp
#include <hip/hip_runtime.h>
#include <stdint.h>
#include <cstdio>

#define DM 1024
#define NTOK 32768
#define SEQ 8192
#define INW 2560
#define ALPHA 1.189207115002721f
#define LN_EPS 1e-5f

__device__ __forceinline__ float gelu_f(float v) {
  const float t = __builtin_amdgcn_rcpf(fabsf(v) * 0.2316418882f + 1.0f);
  float q = t * 0.5307027145f + (-0.7265760135f); q = q * t + 0.7107068705f; q = q * t + (-0.142248368f); q = q * t + 0.127414796f; q = q * t;
  const float e = __builtin_amdgcn_exp2f((v * v) * (-0.72134752044f));
  const float m = v * (q * e);
  return v < 0.f ? m : v - m;
}

typedef unsigned short bf16_t;
typedef short bf16x8 __attribute__((ext_vector_type(8)));
typedef float f32x4 __attribute__((ext_vector_type(4)));
typedef unsigned u32x4 __attribute__((ext_vector_type(4)));
typedef unsigned u32x2 __attribute__((ext_vector_type(2)));
#define LAS __attribute__((address_space(3)))
extern __shared__ __attribute__((aligned(16))) char smem_raw[];

typedef float f32x2_t __attribute__((ext_vector_type(2)));
typedef __bf16 bf16x2_t __attribute__((ext_vector_type(2)));
typedef _Float16 f16x2_t __attribute__((ext_vector_type(2)));
__device__ __forceinline__ unsigned pk_f16(float lo, float hi) { const f32x2_t v = {lo, hi}; return __builtin_bit_cast(unsigned, __builtin_convertvector(v, f16x2_t)); }
__device__ __forceinline__ float f16_lo(unsigned u) { return (float)__builtin_bit_cast(f16x2_t, u)[0]; }
__device__ __forceinline__ float f16_hi(unsigned u) { return (float)__builtin_bit_cast(f16x2_t, u)[1]; }
__device__ __forceinline__ unsigned pk_bf16(float lo, float hi) { const f32x2_t v = {lo, hi}; return __builtin_bit_cast(unsigned, __builtin_convertvector(v, bf16x2_t)); }
__device__ __forceinline__ int otid() { int t = threadIdx.x; asm volatile("" : "+v"(t)); return t; }
__device__ __forceinline__ unsigned pack4_i8(float a, float b, float c, float d) {
  const int ia = __float2int_rn(a), ib = __float2int_rn(b), ic = __float2int_rn(c), id = __float2int_rn(d);
  return ((unsigned)ia & 0xffu) | (((unsigned)ib & 0xffu) << 8) | (((unsigned)ic & 0xffu) << 16) | ((unsigned)id << 24);
}
__device__ __forceinline__ float bf_lo(unsigned u) { return __uint_as_float(u << 16); }
__device__ __forceinline__ float bf_hi(unsigned u) { return __uint_as_float(u & 0xffff0000u); }

__device__ __forceinline__ int swz(int row) { return (((row >> 1) & 1) << 2) | (((row >> 3) & 1) << 1); }
template <int BN, class Epi>
__device__ __forceinline__ void wg_gemm(const bf16_t* __restrict__ A, int lda, const bf16_t* __restrict__ Bt, int ldb, int K, Epi&& epi) {
  constexpr int NT = BN / 64;
  constexpr int STAGE_BYTES = (128 + BN) * 128;
  constexpr int LA = 2, LB = BN / 64;
  LAS char* lds = (LAS char*)smem_raw;
  const int tid = otid(), lane = tid & 63, wid = tid >> 6, wr = wid >> 2, wc = wid & 3, fr = lane & 15, fq = lane >> 4;
  f32x4 acc[4][NT];
#pragma unroll
  for (int m = 0; m < 4; ++m)
#pragma unroll
    for (int n = 0; n < NT; ++n) acc[m][n] = (f32x4){0.f, 0.f, 0.f, 0.f};
  const int nk = K / 64;
  auto piece = [&](int buf, int kt, int i) {
    LAS char* base = lds + buf * STAGE_BYTES;
    if (i < LA) {
      const int q = tid + i * 512, row = q >> 3, c = (q & 7) ^ swz(row);
      __builtin_amdgcn_global_load_lds((const unsigned*)(A + (long)row * lda + kt * 64 + c * 8), (LAS unsigned*)(base + q * 16), 16, 0, 2);
    } else {
      const int q = tid + (i - LA) * 512, row = q >> 3, c = (q & 7) ^ swz(row);
      __builtin_amdgcn_global_load_lds((const unsigned*)(Bt + (long)row * ldb + kt * 64 + c * 8), (LAS unsigned*)(base + 16384 + q * 16), 16, 0, 0);
    }
  };
  auto stage = [&](int buf, int kt) {
#pragma unroll
    for (int i = 0; i < LA + LB; ++i) piece(buf, kt, i);
  };
  asm volatile("s_waitcnt vmcnt(0)" ::: "memory");
  __builtin_amdgcn_s_barrier();
  asm volatile("" ::: "memory");
  stage(0, 0);
  if (nk > 1) stage(1, 1);
  for (int kt = 0; kt < nk; ++kt) {
    if (kt + 1 < nk) asm volatile("s_waitcnt vmcnt(%0)" ::"n"(LA + LB) : "memory");
    else asm volatile("s_waitcnt vmcnt(0)" ::: "memory");
    __builtin_amdgcn_s_barrier();
    asm volatile("" ::: "memory");
    LAS const char* base = lds + (kt % 3) * STAGE_BYTES;
    bf16x8 af[4][2], bfr[NT][2];
#pragma unroll
    for (int m = 0; m < 4; ++m)
#pragma unroll
      for (int kk = 0; kk < 2; ++kk) {
        const int row = wr * 64 + m * 16 + fr, c = (kk * 4 + fq) ^ swz(fr);
        af[m][kk] = *(LAS const bf16x8*)(base + row * 128 + c * 16);
      }
#pragma unroll
    for (int n = 0; n < NT; ++n)
#pragma unroll
      for (int kk = 0; kk < 2; ++kk) {
        const int row = wc * (BN / 4) + n * 16 + fr, c = (kk * 4 + fq) ^ swz(fr);
        bfr[n][kk] = *(LAS const bf16x8*)(base + 16384 + row * 128 + c * 16);
      }
#pragma unroll
    for (int kk = 0; kk < 2; ++kk)
#pragma unroll
      for (int m = 0; m < 4; ++m) {
        if (kk * 4 + m < LA + LB) {
          __builtin_amdgcn_sched_barrier(0);
          if (kt + 2 < nk) piece((kt + 2) % 3, kt + 2, kk * 4 + m);
          __builtin_amdgcn_sched_barrier(0);
        }
#pragma unroll
        for (int n = 0; n < NT; ++n) acc[m][n] = __builtin_amdgcn_mfma_f32_16x16x32_bf16(bfr[n][kk], af[m][kk], acc[m][n], 0, 0, 0);
      }
  }
  epi(acc, wr, wc, fr, fq);
}

typedef int v4i_t __attribute__((ext_vector_type(4)));
template <int BN, class Epi>
__device__ __forceinline__ void wg_gemm_i8(const signed char* __restrict__ A, int lda, const signed char* __restrict__ Bt, int ldb, int K, Epi&& epi) {
  constexpr int NT = BN / 64;
  constexpr int STAGE_BYTES = (128 + BN) * 128;
  constexpr int LA = 2, LB = BN / 64;
  LAS char* lds = (LAS char*)smem_raw;
  const int tid = otid(), lane = tid & 63, wid = tid >> 6, wr = wid >> 2, wc = wid & 3, fr = lane & 15, fq = lane >> 4;
  v4i_t acc[4][NT];
#pragma unroll
  for (int m = 0; m < 4; ++m)
#pragma unroll
    for (int n = 0; n < NT; ++n) acc[m][n] = (v4i_t){0, 0, 0, 0};
  const int nk = K / 128;
  auto piece = [&](int buf, int kt, int i) {
    LAS char* base = lds + buf * STAGE_BYTES;
    if (i < LA) {
      const int q = tid + i * 512, row = q >> 3, c = (q & 7) ^ swz(row);
      __builtin_amdgcn_global_load_lds((const unsigned*)(A + (long)row * lda + kt * 128 + c * 16), (LAS unsigned*)(base + q * 16), 16, 0, 2);
    } else {
      const int q = tid + (i - LA) * 512, row = q >> 3, c = (q & 7) ^ swz(row);
      __builtin_amdgcn_global_load_lds((const unsigned*)(Bt + (long)row * ldb + kt * 128 + c * 16), (LAS unsigned*)(base + 16384 + q * 16), 16, 0, 0);
    }
  };
  auto stage = [&](int buf, int kt) {
#pragma unroll
    for (int i = 0; i < LA + LB; ++i) piece(buf, kt, i);
  };
  asm volatile("s_waitcnt vmcnt(0)" ::: "memory");
  __builtin_amdgcn_s_barrier();
  asm volatile("" ::: "memory");
  stage(0, 0);
  if (nk > 1) stage(1, 1);
  for (int kt = 0; kt < nk; ++kt) {
    if (kt + 1 < nk) asm volatile("s_waitcnt vmcnt(%0)" ::"n"(LA + LB) : "memory");
    else asm volatile("s_waitcnt vmcnt(0)" ::: "memory");
    __builtin_amdgcn_s_barrier();
    asm volatile("" ::: "memory");
    LAS const char* base = lds + (kt % 3) * STAGE_BYTES;
    v4i_t af[4][2], bfr[NT][2];
#pragma unroll
    for (int m = 0; m < 4; ++m)
#pragma unroll
      for (int kk = 0; kk < 2; ++kk) {
        const int row = wr * 64 + m * 16 + fr, c = (kk * 4 + fq) ^ swz(fr);
        af[m][kk] = *(LAS const v4i_t*)(base + row * 128 + c * 16);
      }
#pragma unroll
    for (int n = 0; n < NT; ++n)
#pragma unroll
      for (int kk = 0; kk < 2; ++kk) {
        const int row = wc * (BN / 4) + n * 16 + fr, c = (kk * 4 + fq) ^ swz(fr);
        bfr[n][kk] = *(LAS const v4i_t*)(base + 16384 + row * 128 + c * 16);
      }
#pragma unroll
    for (int kk = 0; kk < 2; ++kk)
#pragma unroll
      for (int m = 0; m < 4; ++m) {
        if (kk * 4 + m < LA + LB) {
          __builtin_amdgcn_sched_barrier(0);
          if (kt + 2 < nk) piece((kt + 2) % 3, kt + 2, kk * 4 + m);
          __builtin_amdgcn_sched_barrier(0);
        }
#pragma unroll
        for (int n = 0; n < NT; ++n) acc[m][n] = __builtin_amdgcn_mfma_i32_16x16x64_i8(bfr[n][kk], af[m][kk], acc[m][n], 0, 0, 0);
      }
  }
  epi(acc, wr, wc, fr, fq);
}

#define GEMM_LDS_BYTES (3 * (128 + 256) * 128)
#define RED_OFF GEMM_LDS_BYTES
#define XB_LDS_OFF (GEMM_LDS_BYTES + 4096)
#define LDS_BYTES (GEMM_LDS_BYTES + 4096 + 16)

struct P {
  const float* x; const float* mem; const float* b_in; const float* sgu_g; const float* sgu_b; const float* b_sp; const float* conv_w;
  const float* ln1_g; const float* ln1_b; const float* ln2_g; const float* ln2_b; const float* ln3_g; const float* ln3_b;
  const bf16_t* XB; const bf16_t* w_inT; const bf16_t* w_moT; const bf16_t* wsb;
  bf16_t* ZB; bf16_t* VT; bf16_t* Y; float* PRE; bf16_t* X1;
  const bf16_t* w_xqT; const bf16_t* w_xkvT; const bf16_t* w_xoT; const bf16_t* memB;
  bf16_t* Kc; bf16_t* Vc; bf16_t* Q; bf16_t* Pb; bf16_t* X2;
  const bf16_t* wxqB; bf16_t* GTb; bf16_t* HT;
  const bf16_t* w_pqT;
  const bf16_t* wpqB;
  const bf16_t* skb; unsigned* KEYS; unsigned char* X1Q; int* experts; float* gates;
  const unsigned char* WDq; const unsigned char* WUq; const float* sd; const float* su; float* out;
  signed char* w_inQ; float* sw_in; signed char* GTq; float* sG; signed char* MTq; float* sMT; signed char* w_moQ; float* sw_mo; signed char* YQ; float* SY; float* SX1;
  char* slabs;
  unsigned* bar; unsigned char* XQ; float* SX; int* PD; float* H3;
  bf16_t* HALO;
  const float* w_in; const float* w_mo; const float* w_sp; const float* w_xq; const float* w_xkv; const float* w_xo; const float* w_pq; const float* sub_keys; const float* w_down; const float* w_up;
};

#define SLAB_BYTES (1536 * 1024)
#define OFF_XB 0
#define OFF_EXP 0
#define OFF_GATE (64 * 1024)
#define OFF_CQ (128 * 1024)
#define OFF_SC (144 * 1024)
#define OFF_X2Q (128 * 1024)
#define OFF_ZB (256 * 1024)
#define OFF_VT (896 * 1024)
#define OFF_Y (1024 * 1024)
#define OFF_Q (1280 * 1024)
__device__ __forceinline__ void wg_sync_mem() { asm volatile("s_waitcnt vmcnt(0) lgkmcnt(0)" ::: "memory"); __syncthreads(); }

#define OFF_SXB (128 * 1024)
__device__ __forceinline__ void phase_inproj(const P& p, int tile) {
  const signed char* xq = (const signed char*)(p.slabs + (size_t)tile * SLAB_BYTES + OFF_XB);
  const float* sxr = (const float*)(p.slabs + (size_t)tile * SLAB_BYTES + OFF_SXB);
  for (int nt = 0; nt < INW / 256; ++nt) {
    wg_gemm_i8<256>(xq, DM, p.w_inQ + (long)nt * 256 * DM, DM, DM, [&](v4i_t (&acc)[4][4], int wr, int wc, int fr, int fq) {
#pragma unroll
      for (int m = 0; m < 4; ++m) {
        const int rl = wr * 64 + m * 16 + fr;
        const float sr = sxr[rl];
#pragma unroll
        for (int n = 0; n < 4; ++n) {
          const int row = tile * 128 + rl, col = nt * 256 + wc * 64 + n * 16 + fq * 4;
          const float4 bv = *(const float4*)(p.b_in + col), sw = *(const float4*)(p.sw_in + col);
          float o0 = (float)acc[m][n][0] * (sr * sw.x) + bv.x, o1 = (float)acc[m][n][1] * (sr * sw.y) + bv.y, o2 = (float)acc[m][n][2] * (sr * sw.z) + bv.z, o3 = (float)acc[m][n][3] * (sr * sw.w) + bv.w;
          if (nt < 4) { o0 = gelu_f(o0); o1 = gelu_f(o1); o2 = gelu_f(o2); o3 = gelu_f(o3); }
          u32x2 w; w.x = pk_bf16(o0, o1); w.y = pk_bf16(o2, o3);
          *(u32x2*)(p.ZB + (long)row * INW + col) = w;
        }
      }
    });
  }
}

__device__ __forceinline__ void phase_mixer(const P& p, int tile) {
  const int tid = otid(), lane = tid & 63, wid = tid >> 6;
  const long t0 = (long)tile * 128;
  const bool seq_start = ((tile & 63) == 0);
#pragma unroll 2
  for (int it = tid; it < 128 * 64; it += 512) {
    const int tl = it >> 6, c = (it & 63) * 8;
    const long t = t0 + tl;
    float conv[8];
#pragma unroll
    for (int j = 0; j < 8; ++j) conv[j] = 0.f;
#pragma unroll
    for (int k = 0; k < 3; ++k) {
      const int rl = tl - 2 + k;
      const float4 w0 = *(const float4*)(p.conv_w + k * 512 + c), w1 = *(const float4*)(p.conv_w + k * 512 + c + 4);
      if (rl >= 0) {
        const bf16_t* zr = p.ZB + (t0 + rl) * INW;
        const u32x4 hb = *(const u32x4*)(zr + 1024 + c), gc = *(const u32x4*)(zr + 2048 + c);
        conv[0] += w0.x * (bf_lo(hb.x) * bf_lo(gc.x)); conv[1] += w0.y * (bf_hi(hb.x) * bf_hi(gc.x));
        conv[2] += w0.z * (bf_lo(hb.y) * bf_lo(gc.y)); conv[3] += w0.w * (bf_hi(hb.y) * bf_hi(gc.y));
        conv[4] += w1.x * (bf_lo(hb.z) * bf_lo(gc.z)); conv[5] += w1.y * (bf_hi(hb.z) * bf_hi(gc.z));
        conv[6] += w1.z * (bf_lo(hb.w) * bf_lo(gc.w)); conv[7] += w1.w * (bf_hi(hb.w) * bf_hi(gc.w));
      } else if (!seq_start) {
        const u32x4 zc = *(const u32x4*)(p.HALO + ((long)(tile - 1) * 2 + (rl + 2)) * 512 + c);
        conv[0] += w0.x * bf_lo(zc.x); conv[1] += w0.y * bf_hi(zc.x); conv[2] += w0.z * bf_lo(zc.y); conv[3] += w0.w * bf_hi(zc.y);
        conv[4] += w1.x * bf_lo(zc.z); conv[5] += w1.y * bf_hi(zc.z); conv[6] += w1.z * bf_lo(zc.w); conv[7] += w1.w * bf_hi(zc.w);
      }
    }
    const u32x4 gb = *(const u32x4*)(p.ZB + t * INW + 1536 + c);
    u32x4 o;
    o.x = pk_bf16(bf_lo(gb.x) * conv[0], bf_hi(gb.x) * conv[1]); o.y = pk_bf16(bf_lo(gb.y) * conv[2], bf_hi(gb.y) * conv[3]);
    o.z = pk_bf16(bf_lo(gb.z) * conv[4], bf_hi(gb.z) * conv[5]); o.w = pk_bf16(bf_lo(gb.w) * conv[6], bf_hi(gb.w) * conv[7]);
    *(u32x4*)(p.Y + t * DM + 512 + c) = o;
  }
  for (int h = 0; h < 4; ++h) {
    float a0[16], a1[16];
    const float g0 = p.sgu_g[h * 128 + 2 * lane], g1 = p.sgu_g[h * 128 + 2 * lane + 1], b0 = p.sgu_b[h * 128 + 2 * lane], b1 = p.sgu_b[h * 128 + 2 * lane + 1];
#pragma unroll
    for (int i = 0; i < 16; ++i) {
      const unsigned v = *(const unsigned*)(p.ZB + (t0 + wid * 16 + i) * INW + 512 + h * 128 + 2 * lane);
      const float x0 = bf_lo(v), x1 = bf_hi(v);
      float sum = x0 + x1;
#pragma unroll
      for (int o = 32; o > 0; o >>= 1) sum += __shfl_xor(sum, o);
      const float mu = sum * (1.f / 128.f);
      const float d0 = x0 - mu, d1 = x1 - mu;
      float q = d0 * d0 + d1 * d1;
#pragma unroll
      for (int o = 32; o > 0; o >>= 1) q += __shfl_xor(q, o);
      const float rstd = rsqrtf(q * (1.f / 128.f) + LN_EPS);
      a0[i] = d0 * rstd * g0 + b0; a1[i] = d1 * rstd * g1 + b1;
    }
    bf16_t* vt = p.VT + ((long)tile * 4 + h) * 128 * 128;
    u32x4 o;
    o.x = pk_bf16(a0[0], a0[1]); o.y = pk_bf16(a0[2], a0[3]); o.z = pk_bf16(a0[4], a0[5]); o.w = pk_bf16(a0[6], a0[7]);
    *(u32x4*)(vt + (2 * lane) * 128 + wid * 16) = o;
    o.x = pk_bf16(a0[8], a0[9]); o.y = pk_bf16(a0[10], a0[11]); o.z = pk_bf16(a0[12], a0[13]); o.w = pk_bf16(a0[14], a0[15]);
    *(u32x4*)(vt + (2 * lane) * 128 + wid * 16 + 8) = o;
    o.x = pk_bf16(a1[0], a1[1]); o.y = pk_bf16(a1[2], a1[3]); o.z = pk_bf16(a1[4], a1[5]); o.w = pk_bf16(a1[6], a1[7]);
    *(u32x4*)(vt + (2 * lane + 1) * 128 + wid * 16) = o;
    o.x = pk_bf16(a1[8], a1[9]); o.y = pk_bf16(a1[10], a1[11]); o.z = pk_bf16(a1[12], a1[13]); o.w = pk_bf16(a1[14], a1[15]);
    *(u32x4*)(vt + (2 * lane + 1) * 128 + wid * 16 + 8) = o;
  }
  wg_sync_mem();
  for (int h = 0; h < 4; ++h) {
    wg_gemm<128>(p.wsb + h * 128 * 128, 128, p.VT + ((long)tile * 4 + h) * 128 * 128, 128, 128, [&](f32x4 (&acc)[4][2], int wr, int wc, int fr, int fq) {
#pragma unroll
      for (int m = 0; m < 4; ++m)
#pragma unroll
        for (int n = 0; n < 2; ++n) {
          const int rl = wr * 64 + m * 16 + fr, col = wc * 32 + n * 16 + fq * 4;
          const float bs = p.b_sp[h * 128 + rl];
          const u32x2 uv = *(const u32x2*)(p.ZB + (t0 + rl) * INW + h * 128 + col);
          u32x2 w;
          w.x = pk_bf16(bf_lo(uv.x) * (acc[m][n][0] + bs), bf_hi(uv.x) * (acc[m][n][1] + bs));
          w.y = pk_bf16(bf_lo(uv.y) * (acc[m][n][2] + bs), bf_hi(uv.y) * (acc[m][n][3] + bs));
          *(u32x2*)(p.Y + (t0 + rl) * DM + h * 128 + col) = w;
        }
    });
  }
}

__device__ __forceinline__ void ln_rows16(const float* __restrict__ PRE, long r0, const float* __restrict__ g, const float* __restrict__ b, bf16_t* __restrict__ Out, int lane) {
#pragma unroll 2
  for (int i = 0; i < 16; ++i) {
    const bf16_t* pr = (const bf16_t*)PRE + (r0 + i) * DM;
    float4 v[4];
    float sum = 0.f;
#pragma unroll
    for (int j = 0; j < 4; ++j) { const u32x2 pv = *(const u32x2*)(pr + j * 256 + lane * 4); v[j].x = bf_lo(pv.x); v[j].y = bf_hi(pv.x); v[j].z = bf_lo(pv.y); v[j].w = bf_hi(pv.y); sum += (v[j].x + v[j].y) + (v[j].z + v[j].w); }
#pragma unroll
    for (int o = 32; o > 0; o >>= 1) sum += __shfl_xor(sum, o);
    const float mu = sum * (1.f / DM);
    float q = 0.f;
#pragma unroll
    for (int j = 0; j < 4; ++j) { v[j].x -= mu; v[j].y -= mu; v[j].z -= mu; v[j].w -= mu; q += (v[j].x * v[j].x + v[j].y * v[j].y) + (v[j].z * v[j].z + v[j].w * v[j].w); }
#pragma unroll
    for (int o = 32; o > 0; o >>= 1) q += __shfl_xor(q, o);
    const float rstd = rsqrtf(q * (1.f / DM) + LN_EPS);
#pragma unroll
    for (int j = 0; j < 4; ++j) {
      const int c0 = j * 256 + lane * 4;
      const float4 gg = *(const float4*)(g + c0), bb = *(const float4*)(b + c0);
      u32x2 w; w.x = pk_bf16(v[j].x * rstd * gg.x + bb.x, v[j].y * rstd * gg.y + bb.y); w.y = pk_bf16(v[j].z * rstd * gg.z + bb.z, v[j].w * rstd * gg.w + bb.w);
      *(u32x2*)(Out + (r0 + i) * DM + c0) = w;
    }
  }
}

__device__ __forceinline__ void ln_rows16_q(const float* __restrict__ PRE, long r0, const float* __restrict__ g, const float* __restrict__ b, bf16_t* __restrict__ Out,
                                            unsigned char* __restrict__ XQ, float* __restrict__ SX, int lane) {
#pragma unroll 2
  for (int i = 0; i < 16; ++i) {
    const bf16_t* pr = (const bf16_t*)PRE + (r0 + i) * DM;
    float4 v[4];
    float sum = 0.f;
#pragma unroll
    for (int j = 0; j < 4; ++j) { const u32x2 pv = *(const u32x2*)(pr + j * 256 + lane * 4); v[j].x = bf_lo(pv.x); v[j].y = bf_hi(pv.x); v[j].z = bf_lo(pv.y); v[j].w = bf_hi(pv.y); sum += (v[j].x + v[j].y) + (v[j].z + v[j].w); }
#pragma unroll
    for (int o = 32; o > 0; o >>= 1) sum += __shfl_xor(sum, o);
    const float mu = sum * (1.f / DM);
    float q = 0.f;
#pragma unroll
    for (int j = 0; j < 4; ++j) { v[j].x -= mu; v[j].y -= mu; v[j].z -= mu; v[j].w -= mu; q += (v[j].x * v[j].x + v[j].y * v[j].y) + (v[j].z * v[j].z + v[j].w * v[j].w); }
#pragma unroll
    for (int o = 32; o > 0; o >>= 1) q += __shfl_xor(q, o);
    const float rstd = rsqrtf(q * (1.f / DM) + LN_EPS);
    float amax = 0.f;
#pragma unroll
    for (int j = 0; j < 4; ++j) {
      const int c0 = j * 256 + lane * 4;
      const float4 gg = *(const float4*)(g + c0), bb = *(const float4*)(b + c0);
      v[j].x = v[j].x * rstd * gg.x + bb.x; v[j].y = v[j].y * rstd * gg.y + bb.y; v[j].z = v[j].z * rstd * gg.z + bb.z; v[j].w = v[j].w * rstd * gg.w + bb.w;
      u32x2 w; w.x = pk_bf16(v[j].x, v[j].y); w.y = pk_bf16(v[j].z, v[j].w);
      *(u32x2*)(Out + (r0 + i) * DM + c0) = w;
      amax = fmaxf(amax, fmaxf(fmaxf(fabsf(v[j].x), fabsf(v[j].y)), fmaxf(fabsf(v[j].z), fabsf(v[j].w))));
    }
#pragma unroll
    for (int o = 32; o > 0; o >>= 1) amax = fmaxf(amax, __shfl_xor(amax, o));
    const float inv = amax > 0.f ? 127.f / amax : 0.f;
#pragma unroll
    for (int j = 0; j < 4; ++j) *(unsigned*)(XQ + (r0 + i) * DM + j * 256 + lane * 4) = pack4_i8(v[j].x * inv, v[j].y * inv, v[j].z * inv, v[j].w * inv);
    if (lane == 0) SX[r0 + i] = amax * (1.f / 127.f);
  }
}

__device__ __forceinline__ void phase_outproj(const P& p, int tile) {
  const long t0 = (long)tile * 128;
  {
    const int lane = threadIdx.x & 63, wid = threadIdx.x >> 6;
#pragma unroll 2
    for (int i = 0; i < 16; ++i) {
      const long row = t0 + wid * 16 + i;
      u32x2 v[4];
      float amax = 0.f;
#pragma unroll
      for (int j = 0; j < 4; ++j) {
        v[j] = *(const u32x2*)(p.Y + row * DM + 256 * j + lane * 4);
        amax = fmaxf(amax, fmaxf(fmaxf(fabsf(bf_lo(v[j].x)), fabsf(bf_hi(v[j].x))), fmaxf(fabsf(bf_lo(v[j].y)), fabsf(bf_hi(v[j].y)))));
      }
#pragma unroll
      for (int o = 32; o > 0; o >>= 1) amax = fmaxf(amax, __shfl_xor(amax, o));
      const float inv = amax > 0.f ? 127.f / amax : 0.f;
#pragma unroll
      for (int j = 0; j < 4; ++j) *(unsigned*)(p.YQ + row * DM + 256 * j + lane * 4) = pack4_i8(bf_lo(v[j].x) * inv, bf_hi(v[j].x) * inv, bf_lo(v[j].y) * inv, bf_hi(v[j].y) * inv);
      if (lane == 0) p.SY[row] = amax * (1.f / 127.f);
    }
  }
  wg_sync_mem();
  for (int nt = 0; nt < 4; ++nt) {
    wg_gemm_i8<256>(p.YQ + t0 * DM, DM, p.w_moQ + (long)nt * 256 * DM, DM, DM, [&](v4i_t (&acc)[4][4], int wr, int wc, int fr, int fq) {
#pragma unroll
      for (int m = 0; m < 4; ++m) {
        const long row = t0 + wr * 64 + m * 16 + fr;
        const float sr = p.SY[row];
#pragma unroll
        for (int n = 0; n < 4; ++n) {
          const int col = nt * 256 + wc * 64 + n * 16 + fq * 4;
          const float4 xv = *(const float4*)(p.x + row * DM + col);
          const float4 sw = *(const float4*)(p.sw_mo + col);
          u32x2 o; o.x = pk_bf16(ALPHA * xv.x + (float)acc[m][n][0] * (sr * sw.x), ALPHA * xv.y + (float)acc[m][n][1] * (sr * sw.y));
          o.y = pk_bf16(ALPHA * xv.z + (float)acc[m][n][2] * (sr * sw.z), ALPHA * xv.w + (float)acc[m][n][3] * (sr * sw.w));
          *(u32x2*)((bf16_t*)p.PRE + row * DM + col) = o;
        }
      }
    });
  }
  wg_sync_mem();
  ln_rows16_q(p.PRE, t0 + (threadIdx.x >> 6) * 16, p.ln1_g, p.ln1_b, p.X1, p.X1Q, p.SX1, threadIdx.x & 63);
}

__device__ __forceinline__ void phase_kv(const P& p, int unit) {
  const int rt = unit >> 5, nc = unit & 31;
  wg_gemm<64>(p.memB + (long)rt * 128 * DM, DM, p.w_xkvT + (long)nc * 64 * DM, DM, DM, [&](f32x4 (&acc)[4][1], int wr, int wc, int fr, int fq) {
    const int b = rt >> 1, col = nc * 64 + wc * 16 + fq * 4, hh = (col >> 8) & 3, d = col & 255;
#pragma unroll
    for (int m = 0; m < 4; ++m) {
      const int mm = (rt & 1) * 128 + wr * 64 + m * 16 + fr;
      u32x2 w; w.x = pk_bf16(acc[m][0][0], acc[m][0][1]); w.y = pk_bf16(acc[m][0][2], acc[m][0][3]);
      *(u32x2*)((col < 1024 ? p.Kc : p.Vc) + ((long)(b * 4 + hh) * 256 + mm) * 256 + d) = w;
    }
  });
}

__device__ __forceinline__ void phase_gh(const P& p, int unit) {
  if (unit < 128) {
    const int bh = unit >> 3, rt = (unit >> 2) & 1, nt = unit & 3, h = bh & 3, b = bh >> 2;
    wg_gemm<256>(p.Kc + ((long)bh * 256 + rt * 128) * 256, 256, p.wxqB + (long)nt * 256 * DM + h * 256, DM, 256, [&](f32x4 (&acc)[4][4], int wr, int wc, int fr, int fq) {
#pragma unroll
      for (int m = 0; m < 4; ++m)
#pragma unroll
        for (int n = 0; n < 4; ++n) {
          const long row = (long)b * 1024 + h * 256 + rt * 128 + wr * 64 + m * 16 + fr; const int col = nt * 256 + wc * 64 + n * 16 + fq * 4;
          u32x2 w; w.x = pk_bf16(acc[m][n][0], acc[m][n][1]); w.y = pk_bf16(acc[m][n][2], acc[m][n][3]);
          *(u32x2*)(p.GTb + row * DM + col) = w;
        }
    });
  } else {
    const int u = unit - 128, bh = u >> 3, rt = u & 7, h = bh & 3, b = bh >> 2;
    wg_gemm<256>(p.w_xoT + (long)rt * 128 * DM + h * 256, DM, p.Vc + (long)bh * 256 * 256, 256, 256, [&](f32x4 (&acc)[4][4], int wr, int wc, int fr, int fq) {
#pragma unroll
      for (int m = 0; m < 4; ++m)
#pragma unroll
        for (int n = 0; n < 4; ++n) {
          const long row = (long)b * 1024 + rt * 128 + wr * 64 + m * 16 + fr; const int col = h * 256 + wc * 64 + n * 16 + fq * 4;
          u32x2 w; w.x = pk_bf16(acc[m][n][0], acc[m][n][1]); w.y = pk_bf16(acc[m][n][2], acc[m][n][3]);
          *(u32x2*)(p.HT + row * DM + col) = w;
        }
    });
  }
}

__device__ __forceinline__ void phase_gquant(const P& p) {
  const int lane = threadIdx.x & 63, wid = threadIdx.x >> 6;
#pragma unroll
  for (int i = 0; i < 2; ++i) {
    const long row = (long)blockIdx.x * 16 + wid * 2 + i;
    u32x2 v[4];
    float amax = 0.f;
#pragma unroll
    for (int j = 0; j < 4; ++j) {
      v[j] = *(const u32x2*)(p.GTb + row * DM + 256 * j + lane * 4);
      amax = fmaxf(amax, fmaxf(fmaxf(fabsf(bf_lo(v[j].x)), fabsf(bf_hi(v[j].x))), fmaxf(fabsf(bf_lo(v[j].y)), fabsf(bf_hi(v[j].y)))));
    }
#pragma unroll
    for (int o = 32; o > 0; o >>= 1) amax = fmaxf(amax, __shfl_xor(amax, o));
    const float inv = amax > 0.f ? 127.f / amax : 0.f;
#pragma unroll
    for (int j = 0; j < 4; ++j) *(unsigned*)(p.GTq + row * DM + 256 * j + lane * 4) = pack4_i8(bf_lo(v[j].x) * inv, bf_hi(v[j].x) * inv, bf_lo(v[j].y) * inv, bf_hi(v[j].y) * inv);
    if (lane == 0) p.sG[row] = amax * (1.f / 127.f);
  }
  {
    const long row = (long)blockIdx.x * 8 + wid;
    u32x2 v[4];
    float amax = 0.f;
#pragma unroll
    for (int j = 0; j < 4; ++j) {
      v[j] = *(const u32x2*)(p.w_pqT + row * DM + 256 * j + lane * 4);
      amax = fmaxf(amax, fmaxf(fmaxf(fabsf(bf_lo(v[j].x)), fabsf(bf_hi(v[j].x))), fmaxf(fabsf(bf_lo(v[j].y)), fabsf(bf_hi(v[j].y)))));
    }
#pragma unroll
    for (int o = 32; o > 0; o >>= 1) amax = fmaxf(amax, __shfl_xor(amax, o));
    const float inv = amax > 0.f ? 127.f / amax : 0.f;
#pragma unroll
    for (int j = 0; j < 4; ++j) *(unsigned*)(p.MTq + row * DM + 256 * j + lane * 4) = pack4_i8(bf_lo(v[j].x) * inv, bf_hi(v[j].x) * inv, bf_lo(v[j].y) * inv, bf_hi(v[j].y) * inv);
    if (lane == 0) p.sMT[row] = amax * (1.f / 127.f);
  }
}

__device__ __forceinline__ void phase_scores(const P& p, int tile) {
  const long t0 = (long)tile * 128;
  const int b = tile >> 6;
  LAS float* red = (LAS float*)((LAS char*)smem_raw + RED_OFF);
  for (int h = 0; h < 4; ++h) {
    bf16_t* Pw = p.Pb + t0 * DM + h * 256;
    wg_gemm_i8<256>((const signed char*)p.X1Q + t0 * DM, DM, p.GTq + ((long)b * 1024 + h * 256) * DM, DM, DM, [&](v4i_t (&iacc)[4][4], int wr, int wc, int fr, int fq) {
      f32x4 acc[4][4];
      float rmax[4];
#pragma unroll
      for (int m = 0; m < 4; ++m) {
        const float sr = p.SX1[t0 + wr * 64 + m * 16 + fr] * 0.0625f;
#pragma unroll
        for (int n = 0; n < 4; ++n) {
          const float4 sw = *(const float4*)(p.sG + b * 1024 + h * 256 + wc * 64 + n * 16 + fq * 4);
          acc[m][n][0] = (float)iacc[m][n][0] * (sr * sw.x); acc[m][n][1] = (float)iacc[m][n][1] * (sr * sw.y);
          acc[m][n][2] = (float)iacc[m][n][2] * (sr * sw.z); acc[m][n][3] = (float)iacc[m][n][3] * (sr * sw.w);
        }
      }
#pragma unroll
      for (int m = 0; m < 4; ++m) {
        float mx = -3.0e38f;
#pragma unroll
        for (int n = 0; n < 4; ++n) mx = fmaxf(mx, fmaxf(fmaxf(acc[m][n][0], acc[m][n][1]), fmaxf(acc[m][n][2], acc[m][n][3])));
        mx = fmaxf(mx, __shfl_xor(mx, 16)); mx = fmaxf(mx, __shfl_xor(mx, 32));
        if (fq == 0) red[(wr * 64 + m * 16 + fr) * 4 + wc] = mx;
      }
      __syncthreads();
#pragma unroll
      for (int m = 0; m < 4; ++m) {
        const f32x4 r = *(LAS const f32x4*)(red + (wr * 64 + m * 16 + fr) * 4);
        rmax[m] = fmaxf(fmaxf(r[0], r[1]), fmaxf(r[2], r[3]));
      }
#pragma unroll
      for (int m = 0; m < 4; ++m) {
        float sm = 0.f;
#pragma unroll
        for (int n = 0; n < 4; ++n)
#pragma unroll
          for (int j = 0; j < 4; ++j) { const float e = __expf(acc[m][n][j] - rmax[m]); acc[m][n][j] = e; sm += e; }
        sm += __shfl_xor(sm, 16); sm += __shfl_xor(sm, 32);
        if (fq == 0) red[512 + (wr * 64 + m * 16 + fr) * 4 + wc] = sm;
      }
      __syncthreads();
#pragma unroll
      for (int m = 0; m < 4; ++m) {
        const f32x4 r = *(LAS const f32x4*)(red + 512 + (wr * 64 + m * 16 + fr) * 4);
        const float inv = 1.f / ((r[0] + r[1]) + (r[2] + r[3]));
        const int rl = wr * 64 + m * 16 + fr;
#pragma unroll
        for (int n = 0; n < 4; ++n) {
          u32x2 w; w.x = pk_bf16(acc[m][n][0] * inv, acc[m][n][1] * inv); w.y = pk_bf16(acc[m][n][2] * inv, acc[m][n][3] * inv);
          *(u32x2*)(Pw + rl * DM + wc * 64 + n * 16 + fq * 4) = w;
        }
      }
    });
  }
}

__device__ __forceinline__ void phase_oproj(const P& p, int tile) {
  const long t0 = (long)tile * 128;
  for (int nt = 0; nt < 4; ++nt) {
    wg_gemm<256>(p.Pb + t0 * DM, DM, p.HT + ((long)(tile >> 6) * 1024 + nt * 256) * DM, DM, DM, [&](f32x4 (&acc)[4][4], int wr, int wc, int fr, int fq) {
#pragma unroll
      for (int m = 0; m < 4; ++m)
#pragma unroll
        for (int n = 0; n < 4; ++n) {
          const long row = t0 + wr * 64 + m * 16 + fr; const int col = nt * 256 + wc * 64 + n * 16 + fq * 4;
          const u32x2 xv = *(const u32x2*)(p.X1 + row * DM + col);
          u32x2 o; o.x = pk_bf16(ALPHA * bf_lo(xv.x) + acc[m][n][0], ALPHA * bf_hi(xv.x) + acc[m][n][1]); o.y = pk_bf16(ALPHA * bf_lo(xv.y) + acc[m][n][2], ALPHA * bf_hi(xv.y) + acc[m][n][3]);
          *(u32x2*)((bf16_t*)p.PRE + row * DM + col) = o;
        }
    });
  }
  wg_sync_mem();
  ln_rows16_q(p.PRE, t0 + (threadIdx.x >> 6) * 16, p.ln2_g, p.ln2_b, p.X2, p.XQ, p.SX, threadIdx.x & 63);
}

__device__ __forceinline__ unsigned f2key(float f) { const unsigned b = __float_as_uint(f); return b ^ ((unsigned)((int)b >> 31) | 0x80000000u); }
__device__ __forceinline__ float key2f(unsigned k) { return __uint_as_float(k ^ ((k & 0x80000000u) ? 0x80000000u : 0xffffffffu)); }
__device__ __forceinline__ void phase_pq(const P& p, int tile) {
  const long t0 = (long)tile * 128;
  for (int nt = 0; nt < 8; ++nt) {
    wg_gemm_i8<256>((const signed char*)p.XQ + t0 * DM, DM, p.MTq + (long)nt * 256 * DM, DM, DM, [&](v4i_t (&acc)[4][4], int wr, int wc, int fr, int fq) {
#pragma unroll
      for (int m = 0; m < 4; ++m) {
        const long row = t0 + wr * 64 + m * 16 + fr;
        const float sr = p.SX[row];
#pragma unroll
        for (int n = 0; n < 4; ++n) {
          const int col = nt * 256 + wc * 64 + n * 16 + fq * 4;
          const float4 sw = *(const float4*)(p.sMT + col);
          u32x2 w; w.x = pk_f16((float)acc[m][n][0] * (sr * sw.x), (float)acc[m][n][1] * (sr * sw.y)); w.y = pk_f16((float)acc[m][n][2] * (sr * sw.z), (float)acc[m][n][3] * (sr * sw.w));
          *(u32x2*)((unsigned short*)p.KEYS + row * 2048 + col) = w;
        }
      }
    });
  }
}

__device__ __forceinline__ void phase_mt(const P& p, int unit) {
  const int hp = unit >> 2, nt = unit & 3;
  wg_gemm<256>(p.skb + (long)hp * 128 * 128, 128, p.wpqB + (long)nt * 256 * 2048 + hp * 128, 2048, 128, [&](f32x4 (&acc)[4][4], int wr, int wc, int fr, int fq) {
#pragma unroll
    for (int m = 0; m < 4; ++m)
#pragma unroll
      for (int n = 0; n < 4; ++n) {
        const int row = hp * 128 + wr * 64 + m * 16 + fr, col = nt * 256 + wc * 64 + n * 16 + fq * 4;
        u32x2 w; w.x = pk_bf16(acc[m][n][0], acc[m][n][1]); w.y = pk_bf16(acc[m][n][2], acc[m][n][3]);
        *(u32x2*)((bf16_t*)p.w_pqT + (long)row * DM + col) = w;
      }
  });
}

__device__ __forceinline__ unsigned cand_entry(int s) {
  unsigned e = 255u; int base = 0;
#pragma unroll
  for (int i = 0; i < 16; ++i) { const int cnt = 16 / (i + 1); if (s >= base && s < base + cnt) e = (unsigned)i | ((unsigned)(s - base) << 4); base += cnt; }
  return e;
}
template <int CTRL> __device__ __forceinline__ unsigned dpp_u(unsigned x) { return (unsigned)__builtin_amdgcn_mov_dpp((int)x, CTRL, 0xf, 0xf, true); }
template <int CTRL> __device__ __forceinline__ float dpp_f(float x) { return __int_as_float(__builtin_amdgcn_mov_dpp(__float_as_int(x), CTRL, 0xf, 0xf, true)); }
__device__ __forceinline__ unsigned umin_(unsigned a, unsigned b) { return a < b ? a : b; }
__device__ __forceinline__ unsigned row_min_u(unsigned x) {
  x = umin_(x, dpp_u<0x128>(x)); x = umin_(x, dpp_u<0x124>(x)); x = umin_(x, dpp_u<0x122>(x)); x = umin_(x, dpp_u<0x121>(x)); return x;
}
__device__ __forceinline__ float row_max_f(float x) { x = fmaxf(x, dpp_f<0x128>(x)); x = fmaxf(x, dpp_f<0x124>(x)); x = fmaxf(x, dpp_f<0x122>(x)); x = fmaxf(x, dpp_f<0x121>(x)); return x; }
__device__ __forceinline__ float row_sum_f(float x) { x += dpp_f<0x128>(x); x += dpp_f<0x124>(x); x += dpp_f<0x122>(x); x += dpp_f<0x121>(x); return x; }

#define KEYS_OFF 65536
#define KEY_STRIDE 528
template <int N> __device__ __forceinline__ unsigned top16_row(const unsigned (&k)[N], int r) {
  unsigned pm1 = 0xFFFFFFFEu, mine = 0;
#pragma unroll
  for (int rd = 0; rd < 16; ++rd) {
    unsigned d = pm1 - k[0];
#pragma unroll
    for (int i = 1; i < N; ++i) d = umin_(d, pm1 - k[i]);
    d = row_min_u(d);
    const unsigned nxt = pm1 - d;
    mine = (r == rd) ? nxt : mine;
    pm1 = nxt - 1;
  }
  return mine;
}

__device__ __forceinline__ void phase_route(const P& p, int tile) {
  const long t0 = (long)tile * 128;
  const int tid = otid(), lane = tid & 63, wid = tid >> 6, r = lane & 15, g = lane >> 4;
  LAS char* lds = (LAS char*)smem_raw;
  LAS unsigned char* tab = (LAS unsigned char*)(lds + RED_OFF);
  if (tid < 64) tab[tid] = (unsigned char)cand_entry(tid);
  unsigned ci[4], cj[4]; bool cval[4];
#pragma unroll
  for (int q = 0; q < 4; ++q) { const unsigned e = cand_entry(r * 4 + q); cval[q] = (e != 255u); ci[q] = ((unsigned)(g * 16) + (e & 15u)) * 4u; cj[q] = ((unsigned)(g * 16) + ((e >> 4) & 15u)) * 4u; }
  __syncthreads();
  auto load_keys = [&](int hp, u32x4 (&kb)[4]) {
#pragma unroll
    for (int ps = 0; ps < 4; ++ps) kb[ps] = *(const u32x4*)((const unsigned short*)p.KEYS + (t0 + wid * 16 + ps * 4 + g) * 2048 + hp * 128 + r * 8);
  };
  auto top_keys = [&](const u32x4 (&kb)[4], unsigned (&tp)[4]) {
#pragma unroll
    for (int ps = 0; ps < 4; ++ps) {
      const unsigned w[4] = {kb[ps].x, kb[ps].y, kb[ps].z, kb[ps].w};
      unsigned k[8];
#pragma unroll
      for (int i = 0; i < 4; ++i) {
        k[2 * i] = (f2key(f16_lo(w[i])) & ~127u) | (unsigned)(127 - (r * 8 + 2 * i));
        k[2 * i + 1] = (f2key(f16_hi(w[i])) & ~127u) | (unsigned)(126 - (r * 8 + 2 * i));
      }
      tp[ps] = top16_row<8>(k, r);
    }
  };
  u32x4 kA[4], kB[4];
  load_keys(0, kA);
  for (int h = 0; h < 8; ++h) {
    unsigned top[2][4];
    load_keys(h * 2 + 1, kB);
    top_keys(kA, top[0]);
    load_keys(h < 7 ? h * 2 + 2 : 15, kA);
    top_keys(kB, top[1]);
#pragma unroll
    for (int ps = 0; ps < 4; ++ps) {
      const int tk = wid * 16 + ps * 4 + g;
      const unsigned A = top[0][ps], B = top[1][ps];
      const float fa = key2f(A & ~127u), fb = key2f(B & ~127u);
      unsigned k2[4];
#pragma unroll
      for (int q = 0; q < 4; ++q) {
        const float va = __int_as_float(__builtin_amdgcn_ds_bpermute((int)ci[q], __float_as_int(fa)));
        const float vb = __int_as_float(__builtin_amdgcn_ds_bpermute((int)cj[q], __float_as_int(fb)));
        const unsigned kk = (f2key(va + vb) & ~63u) | (unsigned)(63 - (r * 4 + q));
        k2[q] = cval[q] ? kk : 0u;
      }
      const unsigned mine = top16_row<4>(k2, r);
      const unsigned slot = 63u - (mine & 63u);
      const unsigned e = tab[slot];
      const unsigned ka = (unsigned)__builtin_amdgcn_ds_bpermute((int)(((unsigned)(g * 16) + (e & 15u)) * 4u), (int)A);
      const unsigned kb = (unsigned)__builtin_amdgcn_ds_bpermute((int)(((unsigned)(g * 16) + ((e >> 4) & 15u)) * 4u), (int)B);
      const int expert = (int)((127u - (ka & 127u)) * 128u + (127u - (kb & 127u)));
      const float c = key2f(mine & ~63u);
      const float mx = row_max_f(c);
      const float ex = __expf(c - mx);
      const float sm = row_sum_f(ex);
      p.experts[(t0 + tk) * 128 + h * 16 + r] = expert;
      p.gates[(t0 + tk) * 128 + h * 16 + r] = ex / sm;
    }
  }
}

__device__ __forceinline__ f32x2_t ub01(unsigned w) { return (f32x2_t){(float)(w & 0xffu), (float)((w >> 8) & 0xffu)}; }
__device__ __forceinline__ f32x2_t ub23(unsigned w) { return (f32x2_t){(float)((w >> 16) & 0xffu), (float)(w >> 24)}; }
__device__ __forceinline__ int sum8_i(int x) {
  x += (int)dpp_u<0xB1>((unsigned)x); x += (int)dpp_u<0x4E>((unsigned)x); x += (int)dpp_u<0x141>((unsigned)x); return x;
}
struct GMeta { u32x4 xq; int er0, er1; };
__device__ __forceinline__ void phase_gdown(const P& p) {
  const int tid = otid(), lane = tid & 63, wid = tid >> 6, grp = lane >> 3, r8 = lane & 7;
  const int slice = blockIdx.x & 7, chunk = blockIdx.x >> 3;
  const unsigned char* tab = p.WDq + slice * 128 + r8 * 16;
  const char* sl = p.slabs + (size_t)(chunk * 8 + wid) * SLAB_BYTES;
  int* pd = (int*)(sl + OFF_ZB) + slice * 128 * 128;
  const unsigned char* xqb = (const unsigned char*)(sl + OFF_X2Q);
  const int* exb = (const int*)(sl + OFF_EXP);
  auto meta = [&](int ti, GMeta& m) {
    const int t = (ti < 127 ? ti : 127);
    m.xq = *(const u32x4*)(xqb + t * DM + slice * 128 + r8 * 16);
    m.er0 = exb[t * 128 + lane]; m.er1 = exb[t * 128 + 64 + lane];
  };
  auto issue = [&](const GMeta& m, u32x4 (&w)[16]) {
#pragma unroll
    for (int it = 0; it < 16; ++it) {
      const int e = __builtin_amdgcn_ds_bpermute(((it & 7) * 8 + grp) * 4, (it < 8) ? m.er0 : m.er1);
      w[it] = *(const u32x4*)(tab + (long)e * DM);
    }
  };
  auto consume = [&](int ti, const GMeta& m, const u32x4 (&w)[16]) {
    int c0 = 0, c1 = 0;
#pragma unroll
    for (int it = 0; it < 16; ++it) {
      int acc = __builtin_amdgcn_sdot4((int)w[it].x, (int)m.xq.x, 0, false);
      acc = __builtin_amdgcn_sdot4((int)w[it].y, (int)m.xq.y, acc, false); acc = __builtin_amdgcn_sdot4((int)w[it].z, (int)m.xq.z, acc, false); acc = __builtin_amdgcn_sdot4((int)w[it].w, (int)m.xq.w, acc, false);
      acc = sum8_i(acc);
      const bool mine = ((it & 7) == r8);
      c0 = (mine && it < 8) ? acc : c0;
      c1 = (mine && it >= 8) ? acc : c1;
    }
    pd[ti * 128 + r8 * 8 + grp] = c0; pd[ti * 128 + 64 + r8 * 8 + grp] = c1;
  };
  GMeta mA, mB; u32x4 wA[16], wB[16];
  meta(0, mA); issue(mA, wA); meta(1, mB);
  for (int ti = 0; ti < 128; ti += 2) {
    issue(mB, wB);
    consume(ti, mA, wA);
    meta(ti + 2, mA);
    issue(mA, wA);
    consume(ti + 1, mB, wB);
    meta(ti + 3, mB);
  }
}
__device__ __forceinline__ int cq_index(int k) { return ((k >> 5) * 8 + (k & 7)) * 4 + ((k >> 3) & 3); }
__device__ __forceinline__ void phase_gcomb(const P& p, int tile) {
  const int tid = otid(), lane = tid & 63, wid = tid >> 6;
  signed char* cq = (signed char*)(p.slabs + (size_t)tile * SLAB_BYTES + OFF_CQ);
  float* sc = (float*)(p.slabs + (size_t)tile * SLAB_BYTES + OFF_SC);
#pragma unroll 4
  for (int ti = 0; ti < 16; ++ti) {
    const int tl = wid * 16 + ti;
    const long t = (long)tile * 128 + tl;
    int s0 = 0, s1 = 0;
#pragma unroll
    for (int j = 0; j < 8; ++j) { s0 += p.PD[(j * 128 + tl) * 128 + lane]; s1 += p.PD[(j * 128 + tl) * 128 + 64 + lane]; }
    const int e0 = p.experts[t * 128 + lane], e1 = p.experts[t * 128 + 64 + lane];
    const float sx = p.SX[t];
    const float c0 = p.gates[t * 128 + lane] * gelu_f((float)s0 * p.sd[e0] * sx) * p.su[e0];
    const float c1 = p.gates[t * 128 + 64 + lane] * gelu_f((float)s1 * p.sd[e1] * sx) * p.su[e1];
    float amax = fmaxf(fabsf(c0), fabsf(c1));
#pragma unroll
    for (int o = 32; o > 0; o >>= 1) amax = fmaxf(amax, __shfl_xor(amax, o));
    const float inv = amax > 0.f ? 127.f / amax : 0.f;
    cq[tl * 128 + cq_index(lane)] = (signed char)__float2int_rn(c0 * inv);
    cq[tl * 128 + cq_index(lane + 64)] = (signed char)__float2int_rn(c1 * inv);
    if (lane == 0) sc[tl] = amax * (1.f / 127.f);
  }
}
struct UMeta { int er0, er1; unsigned cq[4]; };
__device__ __forceinline__ void phase_gup(const P& p) {
  const int tid = otid(), lane = tid & 63, wid = tid >> 6, grp = lane >> 3, r8 = lane & 7;
  const int slice = blockIdx.x & 7, chunk = blockIdx.x >> 3;
  const unsigned char* tab = p.WUq + slice * 128 + r8 * 16;
  char* sl = p.slabs + (size_t)(chunk * 8 + wid) * SLAB_BYTES;
  const int* exb = (const int*)(sl + OFF_EXP);
  const unsigned* cqb = (const unsigned*)(sl + OFF_CQ);
  const float* scb = (const float*)(sl + OFF_SC);
  bf16_t* h3b = (bf16_t*)(sl + OFF_ZB);
  auto meta = [&](int ti, UMeta& m) {
    const int t = (ti < 127 ? ti : 127);
    m.er0 = exb[t * 128 + lane]; m.er1 = exb[t * 128 + 64 + lane];
#pragma unroll
    for (int j = 0; j < 4; ++j) m.cq[j] = cqb[t * 32 + j * 8 + grp];
  };
  auto issue = [&](const UMeta& m, u32x4 (&w)[16]) {
#pragma unroll
    for (int it = 0; it < 16; ++it) {
      const int e = __builtin_amdgcn_ds_bpermute(((it & 7) * 8 + grp) * 4, (it < 8) ? m.er0 : m.er1);
      w[it] = *(const u32x4*)(tab + (long)e * DM);
    }
  };
  auto consume = [&](int ti, const UMeta& m, const u32x4 (&w)[16]) {
    int o[16];
#pragma unroll
    for (int i = 0; i < 16; ++i) o[i] = 0;
#pragma unroll
    for (int j = 0; j < 4; ++j) {
      const unsigned x0[4] = {w[4 * j].x, w[4 * j].y, w[4 * j].z, w[4 * j].w}, x1[4] = {w[4 * j + 1].x, w[4 * j + 1].y, w[4 * j + 1].z, w[4 * j + 1].w};
      const unsigned x2[4] = {w[4 * j + 2].x, w[4 * j + 2].y, w[4 * j + 2].z, w[4 * j + 2].w}, x3[4] = {w[4 * j + 3].x, w[4 * j + 3].y, w[4 * j + 3].z, w[4 * j + 3].w};
#pragma unroll
      for (int d = 0; d < 4; ++d) {
        const unsigned t0 = __builtin_amdgcn_perm(x1[d], x0[d], 0x05010400u), t1 = __builtin_amdgcn_perm(x1[d], x0[d], 0x07030602u);
        const unsigned u0 = __builtin_amdgcn_perm(x3[d], x2[d], 0x05010400u), u1 = __builtin_amdgcn_perm(x3[d], x2[d], 0x07030602u);
        o[d * 4 + 0] = __builtin_amdgcn_sdot4((int)__builtin_amdgcn_perm(u0, t0, 0x05040100u), (int)m.cq[j], o[d * 4 + 0], false);
        o[d * 4 + 1] = __builtin_amdgcn_sdot4((int)__builtin_amdgcn_perm(u0, t0, 0x07060302u), (int)m.cq[j], o[d * 4 + 1], false);
        o[d * 4 + 2] = __builtin_amdgcn_sdot4((int)__builtin_amdgcn_perm(u1, t1, 0x05040100u), (int)m.cq[j], o[d * 4 + 2], false);
        o[d * 4 + 3] = __builtin_amdgcn_sdot4((int)__builtin_amdgcn_perm(u1, t1, 0x07060302u), (int)m.cq[j], o[d * 4 + 3], false);
      }
    }
    const float sct = scb[ti];
    float f[16];
#pragma unroll
    for (int i = 0; i < 16; ++i) {
      int a = o[i];
      a += (int)dpp_u<0x128>((unsigned)a);
      a += __shfl_xor(a, 16);
      a += __shfl_xor(a, 32);
      f[i] = (float)a * sct;
    }
    if (grp == 0) {
      bf16_t* dst = h3b + ti * DM + slice * 128 + r8 * 16;
      u32x4 q0, q1;
      q0.x = pk_bf16(f[0], f[1]); q0.y = pk_bf16(f[2], f[3]); q0.z = pk_bf16(f[4], f[5]); q0.w = pk_bf16(f[6], f[7]);
      q1.x = pk_bf16(f[8], f[9]); q1.y = pk_bf16(f[10], f[11]); q1.z = pk_bf16(f[12], f[13]); q1.w = pk_bf16(f[14], f[15]);
      *(u32x4*)dst = q0; *(u32x4*)(dst + 8) = q1;
    }
  };
  UMeta mA, mB; u32x4 wA[16], wB[16];
  meta(0, mA); issue(mA, wA); meta(1, mB);
  for (int ti = 0; ti < 128; ti += 2) {
    issue(mB, wB);
    consume(ti, mA, wA);
    meta(ti + 2, mA);
    issue(mA, wA);
    consume(ti + 1, mB, wB);
    meta(ti + 3, mB);
  }
}
__device__ __forceinline__ void phase_ln3(const P& p, int tile) {
  const int tid = otid(), lane = tid & 63, wid = tid >> 6;
#pragma unroll 2
  for (int ti = 0; ti < 16; ++ti) {
    const long t = (long)tile * 128 + wid * 16 + ti;
    float4 v[4];
    float sum = 0.f;
#pragma unroll
    for (int j = 0; j < 4; ++j) {
      const int c0 = j * 256 + lane * 4;
      const u32x2 hv = *(const u32x2*)((const bf16_t*)p.H3 + t * DM + c0);
      const u32x2 xv = *(const u32x2*)(p.X2 + t * DM + c0);
      v[j].x = bf_lo(hv.x) + ALPHA * bf_lo(xv.x); v[j].y = bf_hi(hv.x) + ALPHA * bf_hi(xv.x); v[j].z = bf_lo(hv.y) + ALPHA * bf_lo(xv.y); v[j].w = bf_hi(hv.y) + ALPHA * bf_hi(xv.y);
      sum += (v[j].x + v[j].y) + (v[j].z + v[j].w);
    }
#pragma unroll
    for (int o = 32; o > 0; o >>= 1) sum += __shfl_xor(sum, o);
    const float mu = sum * (1.f / DM);
    float q = 0.f;
#pragma unroll
    for (int j = 0; j < 4; ++j) { v[j].x -= mu; v[j].y -= mu; v[j].z -= mu; v[j].w -= mu; q += (v[j].x * v[j].x + v[j].y * v[j].y) + (v[j].z * v[j].z + v[j].w * v[j].w); }
#pragma unroll
    for (int o = 32; o > 0; o >>= 1) q += __shfl_xor(q, o);
    const float rstd = rsqrtf(q * (1.f / DM) + LN_EPS);
#pragma unroll
    for (int j = 0; j < 4; ++j) {
      const int c0 = j * 256 + lane * 4;
      const float4 gg = *(const float4*)(p.ln3_g + c0), bb = *(const float4*)(p.ln3_b + c0);
      float4 o; o.x = v[j].x * rstd * gg.x + bb.x; o.y = v[j].y * rstd * gg.y + bb.y; o.z = v[j].z * rstd * gg.z + bb.z; o.w = v[j].w * rstd * gg.w + bb.w;
      *(float4*)(p.out + t * DM + c0) = o;
    }
  }
}

__device__ __forceinline__ void prep_transpose_tile(const float* __restrict__ W, bf16_t* __restrict__ WT, int K, int N, int tileidx) {
  LAS float* scr = (LAS float*)smem_raw;
  const int ntn = N / 64, k0 = (tileidx / ntn) * 64, n0 = (tileidx % ntn) * 64, tid = threadIdx.x;
#pragma unroll
  for (int i = 0; i < 8; ++i) { const int e = tid + i * 512, kk = e >> 6, nn = e & 63; scr[kk * 65 + nn] = W[(long)(k0 + kk) * N + n0 + nn]; }
  __syncthreads();
#pragma unroll
  for (int i = 0; i < 4; ++i) { const int e = tid + i * 512, nn = e >> 5, kp = (e & 31) * 2; *(unsigned*)(WT + (long)(n0 + nn) * K + k0 + kp) = pk_bf16(scr[kp * 65 + nn], scr[(kp + 1) * 65 + nn]); }
  __syncthreads();
}
__device__ __forceinline__ void prep_quant_strip(const float* __restrict__ W, signed char* __restrict__ Q, float* __restrict__ sc, int K, int N, int strip) {
  LAS float* scr = (LAS float*)smem_raw;
  LAS float* pmax = scr + 64 * 65;
  LAS float* inv = pmax + 8 * 64;
  const int n0 = strip * 64, tid = threadIdx.x, nn = tid & 63, kg = tid >> 6;
  float amax = 0.f;
  for (int k0 = 0; k0 < K; k0 += 64)
#pragma unroll
    for (int i = 0; i < 8; ++i) amax = fmaxf(amax, fabsf(W[(long)(k0 + kg + 8 * i) * N + n0 + nn]));
  pmax[kg * 64 + nn] = amax;
  __syncthreads();
  if (tid < 64) {
    float m = 0.f;
#pragma unroll
    for (int j = 0; j < 8; ++j) m = fmaxf(m, pmax[j * 64 + tid]);
    inv[tid] = m > 0.f ? 127.f / m : 0.f;
    sc[n0 + tid] = m * (1.f / 127.f);
  }
  __syncthreads();
  const float iv = inv[nn];
  for (int k0 = 0; k0 < K; k0 += 64) {
#pragma unroll
    for (int i = 0; i < 8; ++i) { const int kk = kg + 8 * i; scr[kk * 65 + nn] = W[(long)(k0 + kk) * N + n0 + nn] * iv; }
    __syncthreads();
#pragma unroll
    for (int i = 0; i < 2; ++i) {
      const int dd = tid + i * 512, n = dd >> 4, k4 = (dd & 15) * 4;
      *(unsigned*)(Q + (long)(n0 + n) * K + k0 + k4) = pack4_i8(scr[k4 * 65 + n], scr[(k4 + 1) * 65 + n], scr[(k4 + 2) * 65 + n], scr[(k4 + 3) * 65 + n]);
    }
    __syncthreads();
  }
}
__device__ __forceinline__ void prep_cvt(const float* __restrict__ in, bf16_t* __restrict__ out, long n8) {
  for (long i = (long)blockIdx.x * 512 + threadIdx.x; i < n8; i += (long)gridDim.x * 512) {
    const float4 a = *(const float4*)(in + i * 8), b = *(const float4*)(in + i * 8 + 4);
    u32x4 o; o.x = pk_bf16(a.x, a.y); o.y = pk_bf16(a.z, a.w); o.z = pk_bf16(b.x, b.y); o.w = pk_bf16(b.z, b.w);
    *(u32x4*)(out + i * 8) = o;
  }
}
__device__ __forceinline__ void phase_prep(const P& p) {
  const int T_IN = 16 * 40, T_SQ = 16 * 16, T_W2 = 16 * 32;
  const int total = T_IN + T_SQ + T_SQ + T_W2 + T_SQ + T_W2;
  for (int it = blockIdx.x; it < total; it += gridDim.x) {
    int r = it;
    if (r < T_IN) { if (r < 40) prep_quant_strip(p.w_in, p.w_inQ, p.sw_in, DM, INW, r); continue; } r -= T_IN;
    if (r < T_SQ) { if (r < 16) prep_quant_strip(p.w_mo, p.w_moQ, p.sw_mo, DM, DM, r); continue; } r -= T_SQ;
    if (r < T_SQ) { continue; } r -= T_SQ;
    if (r < T_W2) { prep_transpose_tile(p.w_xkv, (bf16_t*)p.w_xkvT, DM, 2048, r); continue; } r -= T_W2;
    if (r < T_SQ) { prep_transpose_tile(p.w_xo, (bf16_t*)p.w_xoT, DM, DM, r); continue; } r -= T_SQ;
    (void)r;
  }
  prep_cvt(p.mem, (bf16_t*)p.memB, (long)1024 * DM / 8);
  prep_cvt(p.sub_keys, (bf16_t*)p.skb, (long)8 * 2 * 128 * 128 / 8);
  prep_cvt(p.w_pq, (bf16_t*)p.wpqB, (long)DM * 2048 / 8);
  prep_cvt(p.w_xq, (bf16_t*)p.wxqB, (long)DM * DM / 8);
  {
    const int lane = threadIdx.x & 63, gw = blockIdx.x * 8 + (threadIdx.x >> 6), ngw = gridDim.x * 8;
    for (int row = gw; row < 2 * 16384; row += ngw) {
      const int tb = row >> 14, e = row & 16383;
      const float* src = (tb ? p.w_up : p.w_down) + (long)e * DM;
      float4 v[4];
      float amax = 0.f;
#pragma unroll
      for (int i = 0; i < 4; ++i) { v[i] = *(const float4*)(src + 256 * i + lane * 4); amax = fmaxf(amax, fmaxf(fmaxf(fabsf(v[i].x), fabsf(v[i].y)), fmaxf(fabsf(v[i].z), fabsf(v[i].w)))); }
#pragma unroll
      for (int s = 32; s > 0; s >>= 1) amax = fmaxf(amax, __shfl_xor(amax, s));
      const float inv = amax > 0.f ? 127.f / amax : 0.f;
      unsigned char* dst = (unsigned char*)(tb ? p.WUq : p.WDq) + (long)e * DM;
      const float off = 0.f;
#pragma unroll
      for (int i = 0; i < 4; ++i) *(unsigned*)(dst + 256 * i + lane * 4) = pack4_i8(v[i].x * inv + off, v[i].y * inv + off, v[i].z * inv + off, v[i].w * inv + off);
      if (lane == 0) { float* sc = (float*)(tb ? p.su : p.sd); sc[e] = amax * (1.f / 127.f); }
    }
  }
  for (int i = blockIdx.x * 512 + threadIdx.x; i < 4 * 128 * 128 / 2; i += gridDim.x * 512) {
    const int e = i * 2, t = (e >> 7) & 127, sidx = e & 127;
    const float2 v = *(const float2*)(p.w_sp + e);
    *(unsigned*)((bf16_t*)p.wsb + e) = pk_bf16(sidx <= t ? v.x : 0.f, (sidx + 1) <= t ? v.y : 0.f);
  }
}
__device__ __forceinline__ void phase_xcvt(const P& p, int tile) {
  const int lane = threadIdx.x & 63, wid = threadIdx.x >> 6;
  signed char* xq = (signed char*)(p.slabs + (size_t)tile * SLAB_BYTES + OFF_XB);
  float* sxr = (float*)(p.slabs + (size_t)tile * SLAB_BYTES + OFF_SXB);
#pragma unroll 2
  for (int i = 0; i < 16; ++i) {
    const int rl = wid * 16 + i;
    const float* src = p.x + ((long)tile * 128 + rl) * DM;
    float4 v[4];
    float amax = 0.f;
#pragma unroll
    for (int j = 0; j < 4; ++j) { v[j] = *(const float4*)(src + 256 * j + lane * 4); amax = fmaxf(amax, fmaxf(fmaxf(fabsf(v[j].x), fabsf(v[j].y)), fmaxf(fabsf(v[j].z), fabsf(v[j].w)))); }
#pragma unroll
    for (int o = 32; o > 0; o >>= 1) amax = fmaxf(amax, __shfl_xor(amax, o));
    const float inv = amax > 0.f ? 127.f / amax : 0.f;
#pragma unroll
    for (int j = 0; j < 4; ++j) *(unsigned*)(xq + rl * DM + 256 * j + lane * 4) = pack4_i8(v[j].x * inv, v[j].y * inv, v[j].z * inv, v[j].w * inv);
    if (lane == 0) sxr[rl] = amax * (1.f / 127.f);
  }
}
__device__ __forceinline__ void phase_halo(const P& p, int tile) {
  const int tid = otid();
  if (tid < 128) {
    const int rr = tid >> 6, c = (tid & 63) * 8;
    const bf16_t* zr = p.ZB + ((long)tile * 128 + 126 + rr) * INW;
    const u32x4 hb = *(const u32x4*)(zr + 1024 + c), gc = *(const u32x4*)(zr + 2048 + c);
    u32x4 o;
    o.x = pk_bf16(bf_lo(hb.x) * bf_lo(gc.x), bf_hi(hb.x) * bf_hi(gc.x)); o.y = pk_bf16(bf_lo(hb.y) * bf_lo(gc.y), bf_hi(hb.y) * bf_hi(gc.y));
    o.z = pk_bf16(bf_lo(hb.z) * bf_lo(gc.z), bf_hi(hb.z) * bf_hi(gc.z)); o.w = pk_bf16(bf_lo(hb.w) * bf_lo(gc.w), bf_hi(hb.w) * bf_hi(gc.w));
    *(u32x4*)(p.HALO + ((long)tile * 2 + rr) * 512 + c) = o;
  }
}

__device__ __forceinline__ P tile_view(const P& p, int tile) {
  P q = p;
  char* sl = p.slabs + (size_t)tile * SLAB_BYTES;
  const long t0 = (long)tile * 128;
  q.XB = (bf16_t*)(sl + OFF_XB) - t0 * DM; q.X1 = (bf16_t*)(sl + OFF_XB) - t0 * DM;
  q.experts = (int*)(sl + OFF_EXP) - t0 * 128; q.gates = (float*)(sl + OFF_GATE) - t0 * 128;
  q.ZB = (bf16_t*)(sl + OFF_ZB) - t0 * INW; q.PRE = (float*)((bf16_t*)(sl + OFF_ZB) - t0 * DM); q.KEYS = (unsigned*)((unsigned short*)(sl + OFF_ZB) - t0 * 2048);
  q.PD = (int*)(sl + OFF_ZB); q.H3 = (float*)((bf16_t*)(sl + OFF_ZB) - t0 * DM);
  q.VT = (bf16_t*)(sl + OFF_VT) - (long)tile * 4 * 128 * 128; q.X1Q = (unsigned char*)(sl + OFF_VT) - t0 * DM; q.XQ = (unsigned char*)(sl + OFF_X2Q) - t0 * DM;
  q.Y = (bf16_t*)(sl + OFF_Y) - t0 * DM; q.Pb = (bf16_t*)(sl + OFF_Y) - t0 * DM;
  q.Q = (bf16_t*)(sl + OFF_Q) - t0 * DM; q.X2 = (bf16_t*)(sl + OFF_Q) - t0 * DM; q.YQ = (signed char*)(sl + OFF_Q) - t0 * DM;
  return q;
}

#define XB_TMO      128
#define XB_XCNT(j)  (256  + 64 * (j))
#define XB_XSUB(j)  (1280 + 64 * (j))
#define XB_XGEN(j)  (2304 + 64 * (j))
#define XB_TOP      3328
#define XB_TOPGEN   3392
#define XCD_BAR_WORDS 3456
#define XB_SPIN_CAP (1u << 18)

__device__ __forceinline__ unsigned xb_ld(unsigned* p)              { return __hip_atomic_load(p, __ATOMIC_RELAXED, __HIP_MEMORY_SCOPE_AGENT); }
__device__ __forceinline__ unsigned xb_add(unsigned* p, unsigned v) { return __hip_atomic_fetch_add(p, v, __ATOMIC_RELAXED, __HIP_MEMORY_SCOPE_AGENT); }
__device__ __forceinline__ unsigned xb_xcc_id() { return (unsigned)__builtin_amdgcn_s_getreg((3 << 11) | 20) & 0xFu; }
#define XB_SPIN(cond, bar) do { unsigned _sp = 0; while (cond) { __builtin_amdgcn_s_sleep(1); \
    if ((++_sp & 255u) == 0u) { if (xb_ld(&(bar)[XB_TMO])) break; if (_sp > XB_SPIN_CAP) { atomicAdd(&(bar)[XB_TMO], 1u); break; } } } } while (0)

struct XcdBarrier {
    unsigned* bar; unsigned x;
    volatile LAS unsigned* st;
};

__device__ __forceinline__ XcdBarrier xcd_barrier_post(unsigned* bar, volatile LAS unsigned* st) {
    XcdBarrier b; b.bar = bar; b.x = xb_xcc_id(); b.st = st;
    if (threadIdx.x == 0) (void)xb_add(&bar[XB_XCNT(b.x)], 1u);
    return b;
}
__device__ __forceinline__ void xcd_barrier_complete(unsigned* bar, unsigned x, unsigned& nloc, unsigned& nx) {
    const unsigned G = gridDim.x * gridDim.y * gridDim.z;
    unsigned sum, cnt, mine, sp = 0u;
    for (;;) {
        sum = 0u; cnt = 0u; mine = 0u;
#pragma unroll
        for (unsigned j = 0; j < 16; ++j) { const unsigned c = xb_ld(&bar[XB_XCNT(j)]); sum += c; cnt += (c > 0u) ? 1u : 0u; mine = (j == x) ? c : mine; }
        if (sum == G) break;
        __builtin_amdgcn_s_sleep(1);
        if ((++sp & 255u) == 0u) { if (xb_ld(&bar[XB_TMO])) break; if (sp > XB_SPIN_CAP) { atomicAdd(&bar[XB_TMO], 1u); break; } }
    }
    nloc = mine > 0u ? mine : 1u; nx = cnt > 0u ? cnt : 1u;
}

__device__ __forceinline__ void xcd_barrier(const XcdBarrier& b) {
    asm volatile("s_waitcnt vmcnt(0)" ::: "memory");
    __syncthreads();
    if (threadIdx.x == 0) {
        unsigned* bar = b.bar;
        __builtin_amdgcn_s_waitcnt(0);
        unsigned nloc = b.st[0], nx = b.st[1];
        if (nloc == 0u) { xcd_barrier_complete(bar, b.x, nloc, nx); b.st[0] = nloc; b.st[1] = nx; }
        const unsigned old = xb_add(&bar[XB_XSUB(b.x)], 1u);
        const unsigned gen = old / nloc;
        if (old + 1u == (gen + 1u) * nloc) {
            __builtin_amdgcn_fence(__ATOMIC_RELEASE, "agent");
            asm volatile("s_waitcnt vmcnt(0)" ::: "memory");
            const unsigned og = xb_add(&bar[XB_TOP], 1u);
            const unsigned tg = og / nx;
            if (og + 1u == (tg + 1u) * nx) xb_add(&bar[XB_TOPGEN], 1u);
            else XB_SPIN(xb_ld(&bar[XB_TOPGEN]) == tg, bar);
            __builtin_amdgcn_fence(__ATOMIC_ACQUIRE, "agent");
            xb_add(&bar[XB_XGEN(b.x)], 1u);
            asm volatile("s_waitcnt vmcnt(0)" ::: "memory");
        } else {
            XB_SPIN(xb_ld(&bar[XB_XGEN(b.x)]) == gen, bar);
            __builtin_amdgcn_fence(__ATOMIC_ACQUIRE, "agent");
            asm volatile("s_waitcnt vmcnt(0)" ::: "memory");
        }
    }
    __syncthreads();
}


__global__ __launch_bounds__(512) void mega_k(P pg) {
  const int tile = blockIdx.x;
  volatile LAS unsigned* xbw = (volatile LAS unsigned*)((LAS char*)smem_raw + XB_LDS_OFF);
  if (threadIdx.x < 4) xbw[threadIdx.x] = 0u;
  __syncthreads();
  XcdBarrier xb = xcd_barrier_post(pg.bar, xbw);
  const P p = tile_view(pg, tile);
  phase_prep(pg);
  phase_xcvt(p, tile);
  xcd_barrier(xb);
  phase_inproj(p, tile);
  wg_sync_mem();
  phase_halo(p, tile);
  phase_kv(p, tile);
  if (tile < 64) phase_mt(p, tile);
  xcd_barrier(xb);
  phase_gh(p, tile);
  wg_sync_mem();
  phase_mixer(p, tile);
  wg_sync_mem();
  phase_outproj(p, tile);
  wg_sync_mem();
  xcd_barrier(xb);
  phase_gquant(pg);
  xcd_barrier(xb);
  phase_scores(p, tile);
  wg_sync_mem();
  phase_oproj(p, tile);
  wg_sync_mem();
  phase_pq(p, tile);
  wg_sync_mem();
  phase_route(p, tile);
  xcd_barrier(xb);
  phase_gdown(pg);
  xcd_barrier(xb);
  phase_gcomb(p, tile);
  xcd_barrier(xb);
  phase_gup(pg);
  xcd_barrier(xb);
  phase_ln3(p, tile);
}

extern "C" void kernel_launch(void* const* d_in, const int* in_sizes, int n_in, void* d_out, int out_size, void* d_ws, size_t ws_size, hipStream_t stream) {
  static int grid_blocks = 0;
  if (grid_blocks == 0) {
    int dev = 0, cus = 0, per_cu = 0;
    (void)hipGetDevice(&dev);
    (void)hipDeviceGetAttribute(&cus, hipDeviceAttributeMultiprocessorCount, dev);
    if (hipFuncSetAttribute((const void*)mega_k, hipFuncAttributeMaxDynamicSharedMemorySize, LDS_BYTES) != hipSuccess) fprintf(stderr, "kernel_launch: hipFuncSetAttribute failed\n");
    if (hipOccupancyMaxActiveBlocksPerMultiprocessor(&per_cu, (const void*)mega_k, 512, LDS_BYTES) != hipSuccess || per_cu < 1) { fprintf(stderr, "kernel_launch: occupancy query says %d blocks/CU\n", per_cu); per_cu = 1; }
    (void)hipGetLastError();
    grid_blocks = NTOK / 128;
    if (cus * per_cu < grid_blocks) fprintf(stderr, "kernel_launch: device holds only %d x %d resident blocks, need %d\n", cus, per_cu, grid_blocks);
  }
  char* w8 = (char*)d_ws;
  const size_t MiB = (size_t)1 << 20;
  P p{};
  p.x = (const float*)d_in[0]; p.mem = (const float*)d_in[1]; p.w_in = (const float*)d_in[2]; p.b_in = (const float*)d_in[3];
  p.sgu_g = (const float*)d_in[4]; p.sgu_b = (const float*)d_in[5]; p.w_sp = (const float*)d_in[6]; p.b_sp = (const float*)d_in[7];
  p.conv_w = (const float*)d_in[8]; p.w_mo = (const float*)d_in[9]; p.ln1_g = (const float*)d_in[10]; p.ln1_b = (const float*)d_in[11];
  p.w_xq = (const float*)d_in[12]; p.w_xkv = (const float*)d_in[13]; p.w_xo = (const float*)d_in[14]; p.ln2_g = (const float*)d_in[15]; p.ln2_b = (const float*)d_in[16];
  p.w_pq = (const float*)d_in[17]; p.sub_keys = (const float*)d_in[18]; p.w_down = (const float*)d_in[19]; p.w_up = (const float*)d_in[20];
  p.ln3_g = (const float*)d_in[21]; p.ln3_b = (const float*)d_in[22];
  p.out = (float*)d_out;
  p.slabs = w8;
  bf16_t* wb = (bf16_t*)(w8 + 384 * MiB);
  p.w_inT = wb; p.w_inQ = (signed char*)wb; wb += (size_t)INW * DM / 2; p.sw_in = (float*)wb; wb += 2 * INW; p.w_moT = wb; p.w_moQ = (signed char*)wb; wb += (size_t)DM * DM / 2; p.sw_mo = (float*)wb; wb += 2 * DM; p.wsb = wb; wb += 4 * 128 * 128;
  p.w_xqT = wb; p.GTq = (signed char*)wb; wb += (size_t)4 * 1024 * DM / 2; p.sG = (float*)wb; wb += 2 * 4096; p.w_xkvT = wb; wb += (size_t)2048 * DM; p.w_xoT = wb; wb += (size_t)DM * DM;
  p.memB = wb; wb += (size_t)1024 * DM; p.Kc = wb; wb += (size_t)1024 * DM; p.Vc = wb; wb += (size_t)1024 * DM; p.wxqB = wb; wb += (size_t)DM * DM; p.GTb = wb; wb += (size_t)4 * 1024 * DM; p.HT = wb; wb += (size_t)4 * 1024 * DM;
  p.w_pqT = wb; wb += (size_t)2048 * DM; p.MTq = (signed char*)wb; wb += (size_t)2048 * DM / 2; p.sMT = (float*)wb; wb += 2 * 2048; p.wpqB = wb; wb += (size_t)2048 * DM; p.skb = wb; wb += (size_t)8 * 2 * 128 * 128;
  p.WDq = (const unsigned char*)wb; wb += (size_t)16384 * DM / 2; p.WUq = (const unsigned char*)wb; wb += (size_t)16384 * DM / 2;
  p.sd = (const float*)wb; wb += 2 * 16384; p.su = (const float*)wb; wb += 2 * 16384;
  p.HALO = wb; wb += (size_t)256 * 2 * 512;
  p.SX = (float*)wb; wb += 2 * NTOK; p.SY = (float*)wb; wb += 2 * NTOK; p.SX1 = (float*)wb; wb += 2 * NTOK;
  p.bar = (unsigned*)wb; wb += 2 * 4096;
  if ((size_t)((char*)wb - w8) > ws_size) fprintf(stderr, "kernel_launch: workspace too small\n");
  (void)hipMemsetAsync(p.bar, 0, XCD_BAR_WORDS * 4, stream);
  void* args[] = {&p};
  hipError_t e = hipLaunchCooperativeKernel((const void*)mega_k, dim3(grid_blocks), dim3(512), args, LDS_BYTES, stream);
  if (e != hipSuccess) fprintf(stderr, "cooperative launch failed: %s (grid %d)\n", hipGetErrorString(e), grid_blocks);
}
```

```cpp
#include <hip/hip_runtime.h>
#include <stdint.h>
#include <cstdio>

#define DM 1024
#define NTOK 32768
#define SEQ 8192
#define INW 2560
#define ALPHA 1.189207115002721f
#define LN_EPS 1e-5f

__device__ __forceinline__ float gelu_f(float v) {
  const float t = __builtin_amdgcn_rcpf(fabsf(v) * 0.2316418882f + 1.0f);
  float q = t * 0.5307027145f + (-0.7265760135f); q = q * t + 0.7107068705f; q = q * t + (-0.142248368f); q = q * t + 0.127414796f; q = q * t;
  const float e = __builtin_amdgcn_exp2f((v * v) * (-0.72134752044f));
  const float m = v * (q * e);
  return v < 0.f ? m : v - m;
}

typedef unsigned short bf16_t;
typedef short bf16x8 __attribute__((ext_vector_type(8)));
typedef float f32x4 __attribute__((ext_vector_type(4)));
typedef unsigned u32x4 __attribute__((ext_vector_type(4)));
typedef unsigned u32x2 __attribute__((ext_vector_type(2)));
#define LAS __attribute__((address_space(3)))
extern __shared__ __attribute__((aligned(16))) char smem_raw[];

typedef float f32x2_t __attribute__((ext_vector_type(2)));
typedef __bf16 bf16x2_t __attribute__((ext_vector_type(2)));
typedef _Float16 f16x2_t __attribute__((ext_vector_type(2)));
__device__ __forceinline__ unsigned pk_f16(float lo, float hi) { const f32x2_t v = {lo, hi}; return __builtin_bit_cast(unsigned, __builtin_convertvector(v, f16x2_t)); }
__device__ __forceinline__ float f16_lo(unsigned u) { return (float)__builtin_bit_cast(f16x2_t, u)[0]; }
__device__ __forceinline__ float f16_hi(unsigned u) { return (float)__builtin_bit_cast(f16x2_t, u)[1]; }
__device__ __forceinline__ unsigned pk_bf16(float lo, float hi) { const f32x2_t v = {lo, hi}; return __builtin_bit_cast(unsigned, __builtin_convertvector(v, bf16x2_t)); }
__device__ __forceinline__ int otid() { int t = threadIdx.x; asm volatile("" : "+v"(t)); return t; }
__device__ __forceinline__ unsigned pack4_i8(float a, float b, float c, float d) {
  const int ia = __float2int_rn(a), ib = __float2int_rn(b), ic = __float2int_rn(c), id = __float2int_rn(d);
  return ((unsigned)ia & 0xffu) | (((unsigned)ib & 0xffu) << 8) | (((unsigned)ic & 0xffu) << 16) | ((unsigned)id << 24);
}
__device__ __forceinline__ float bf_lo(unsigned u) { return __uint_as_float(u << 16); }
__device__ __forceinline__ float bf_hi(unsigned u) { return __uint_as_float(u & 0xffff0000u); }

__device__ __forceinline__ int swz(int row) { return (((row >> 1) & 1) << 2) | (((row >> 3) & 1) << 1); }
template <int BN, class Epi>
__device__ __forceinline__ void wg_gemm(const bf16_t* __restrict__ A, int lda, const bf16_t* __restrict__ Bt, int ldb, int K, Epi&& epi) {
  constexpr int NT = BN / 64;
  constexpr int STAGE_BYTES = (128 + BN) * 128;
  constexpr int LA = 2, LB = BN / 64;
  LAS char* lds = (LAS char*)smem_raw;
  const int tid = otid(), lane = tid & 63, wid = tid >> 6, wr = wid >> 2, wc = wid & 3, fr = lane & 15, fq = lane >> 4;
  f32x4 acc[4][NT];
#pragma unroll
  for (int m = 0; m < 4; ++m)
#pragma unroll
    for (int n = 0; n < NT; ++n) acc[m][n] = (f32x4){0.f, 0.f, 0.f, 0.f};
  const int nk = K / 64;
  auto piece = [&](int buf, int kt, int i) {
    LAS char* base = lds + buf * STAGE_BYTES;
    if (i < LA) {
      const int q = tid + i * 512, row = q >> 3, c = (q & 7) ^ swz(row);
      __builtin_amdgcn_global_load_lds((const unsigned*)(A + (long)row * lda + kt * 64 + c * 8), (LAS unsigned*)(base + q * 16), 16, 0, 2);
    } else {
      const int q = tid + (i - LA) * 512, row = q >> 3, c = (q & 7) ^ swz(row);
      __builtin_amdgcn_global_load_lds((const unsigned*)(Bt + (long)row * ldb + kt * 64 + c * 8), (LAS unsigned*)(base + 16384 + q * 16), 16, 0, 0);
    }
  };
  auto stage = [&](int buf, int kt) {
#pragma unroll
    for (int i = 0; i < LA + LB; ++i) piece(buf, kt, i);
  };
  __builtin_amdgcn_s_barrier();
  asm volatile("" ::: "memory");
  stage(0, 0);
  if (nk > 1) stage(1, 1);
  for (int kt = 0; kt < nk; ++kt) {
    if (kt + 1 < nk) asm volatile("s_waitcnt vmcnt(%0)" ::"n"(LA + LB) : "memory");
    else asm volatile("s_waitcnt vmcnt(0)" ::: "memory");
    __builtin_amdgcn_s_barrier();
    asm volatile("" ::: "memory");
    LAS const char* base = lds + (kt % 3) * STAGE_BYTES;
    bf16x8 af[4][2], bfr[NT][2];
#pragma unroll
    for (int m = 0; m < 4; ++m)
#pragma unroll
      for (int kk = 0; kk < 2; ++kk) {
        const int row = wr * 64 + m * 16 + fr, c = (kk * 4 + fq) ^ swz(fr);
        af[m][kk] = *(LAS const bf16x8*)(base + row * 128 + c * 16);
      }
#pragma unroll
    for (int n = 0; n < NT; ++n)
#pragma unroll
      for (int kk = 0; kk < 2; ++kk) {
        const int row = wc * (BN / 4) + n * 16 + fr, c = (kk * 4 + fq) ^ swz(fr);
        bfr[n][kk] = *(LAS const bf16x8*)(base + 16384 + row * 128 + c * 16);
      }
#pragma unroll
    for (int kk = 0; kk < 2; ++kk)
#pragma unroll
      for (int m = 0; m < 4; ++m) {
        if (kk * 4 + m < LA + LB) {
          __builtin_amdgcn_sched_barrier(0);
          if (kt + 2 < nk) piece((kt + 2) % 3, kt + 2, kk * 4 + m);
          __builtin_amdgcn_sched_barrier(0);
        }
#pragma unroll
        for (int n = 0; n < NT; ++n) acc[m][n] = __builtin_amdgcn_mfma_f32_16x16x32_bf16(bfr[n][kk], af[m][kk], acc[m][n], 0, 0, 0);
      }
  }
  epi(acc, wr, wc, fr, fq);
}

typedef int v4i_t __attribute__((ext_vector_type(4)));
template <int BN, class Epi>
__device__ __forceinline__ void wg_gemm_i8(const signed char* __restrict__ A, int lda, const signed char* __restrict__ Bt, int ldb, int K, Epi&& epi) {
  constexpr int NT = BN / 64;
  constexpr int STAGE_BYTES = (128 + BN) * 128;
  constexpr int LA = 2, LB = BN / 64;
  LAS char* lds = (LAS char*)smem_raw;
  const int tid = otid(), lane = tid & 63, wid = tid >> 6, wr = wid >> 2, wc = wid & 3, fr = lane & 15, fq = lane >> 4;
  v4i_t acc[4][NT];
#pragma unroll
  for (int m = 0; m < 4; ++m)
#pragma unroll
    for (int n = 0; n < NT; ++n) acc[m][n] = (v4i_t){0, 0, 0, 0};
  const int nk = K / 128;
  auto piece = [&](int buf, int kt, int i) {
    LAS char* base = lds + buf * STAGE_BYTES;
    if (i < LA) {
      const int q = tid + i * 512, row = q >> 3, c = (q & 7) ^ swz(row);
      __builtin_amdgcn_global_load_lds((const unsigned*)(A + (long)row * lda + kt * 128 + c * 16), (LAS unsigned*)(base + q * 16), 16, 0, 2);
    } else {
      const int q = tid + (i - LA) * 512, row = q >> 3, c = (q & 7) ^ swz(row);
      __builtin_amdgcn_global_load_lds((const unsigned*)(Bt + (long)row * ldb + kt * 128 + c * 16), (LAS unsigned*)(base + 16384 + q * 16), 16, 0, 0);
    }
  };
  auto stage = [&](int buf, int kt) {
#pragma unroll
    for (int i = 0; i < LA + LB; ++i) piece(buf, kt, i);
  };
  __builtin_amdgcn_s_barrier();
  asm volatile("" ::: "memory");
  stage(0, 0);
  if (nk > 1) stage(1, 1);
  for (int kt = 0; kt < nk; ++kt) {
    if (kt + 1 < nk) asm volatile("s_waitcnt vmcnt(%0)" ::"n"(LA + LB) : "memory");
    else asm volatile("s_waitcnt vmcnt(0)" ::: "memory");
    __builtin_amdgcn_s_barrier();
    asm volatile("" ::: "memory");
    LAS const char* base = lds + (kt % 3) * STAGE_BYTES;
    v4i_t af[4][2], bfr[NT][2];
#pragma unroll
    for (int m = 0; m < 4; ++m)
#pragma unroll
      for (int kk = 0; kk < 2; ++kk) {
        const int row = wr * 64 + m * 16 + fr, c = (kk * 4 + fq) ^ swz(fr);
        af[m][kk] = *(LAS const v4i_t*)(base + row * 128 + c * 16);
      }
#pragma unroll
    for (int n = 0; n < NT; ++n)
#pragma unroll
      for (int kk = 0; kk < 2; ++kk) {
        const int row = wc * (BN / 4) + n * 16 + fr, c = (kk * 4 + fq) ^ swz(fr);
        bfr[n][kk] = *(LAS const v4i_t*)(base + 16384 + row * 128 + c * 16);
      }
#pragma unroll
    for (int kk = 0; kk < 2; ++kk)
#pragma unroll
      for (int m = 0; m < 4; ++m) {
        if (kk * 4 + m < LA + LB) {
          __builtin_amdgcn_sched_barrier(0);
          if (kt + 2 < nk) piece((kt + 2) % 3, kt + 2, kk * 4 + m);
          __builtin_amdgcn_sched_barrier(0);
        }
#pragma unroll
        for (int n = 0; n < NT; ++n) acc[m][n] = __builtin_amdgcn_mfma_i32_16x16x64_i8(bfr[n][kk], af[m][kk], acc[m][n], 0, 0, 0);
      }
  }
  epi(acc, wr, wc, fr, fq);
}

#define XCD_BAR_WORDS 3456
#define GEMM_LDS_BYTES (3 * (128 + 256) * 128)
#define RED_OFF GEMM_LDS_BYTES
#define XB_LDS_OFF (GEMM_LDS_BYTES + 4096)
#define LDS_BYTES (GEMM_LDS_BYTES + 4096 + 16)

struct P {
  const float* x; const float* mem; const float* b_in; const float* sgu_g; const float* sgu_b; const float* b_sp; const float* conv_w;
  const float* ln1_g; const float* ln1_b; const float* ln2_g; const float* ln2_b; const float* ln3_g; const float* ln3_b;
  const bf16_t* XB; const bf16_t* w_inT; const bf16_t* w_moT; const bf16_t* wsb;
  bf16_t* ZB; bf16_t* VT; bf16_t* Y; float* PRE; bf16_t* X1;
  const bf16_t* w_xqT; const bf16_t* w_xkvT; const bf16_t* w_xoT; const bf16_t* memB;
  bf16_t* Kc; bf16_t* Vc; bf16_t* Q; bf16_t* Pb; bf16_t* X2;
  const bf16_t* wxqB; bf16_t* GTb; bf16_t* HT;
  const bf16_t* w_pqT;
  const bf16_t* wpqB;
  const bf16_t* skb; unsigned* KEYS; unsigned char* X1Q; int* experts; float* gates;
  const unsigned char* WDq; const unsigned char* WUq; const float* sd; const float* su; float* out;
  signed char* w_inQ; float* sw_in; signed char* GTq; float* sG; signed char* MTq; float* sMT; signed char* w_moQ; float* sw_mo; signed char* YQ; float* SY; float* SX1;
  char* slabs;
  unsigned* bar; unsigned char* XQ; float* SX; int* PD; float* H3;
  bf16_t* HALO;
  const float* w_in; const float* w_mo; const float* w_sp; const float* w_xq; const float* w_xkv; const float* w_xo; const float* w_pq; const float* sub_keys; const float* w_down; const float* w_up;
};

#define SLAB_BYTES (1536 * 1024)
#define OFF_XB 0
#define OFF_EXP 0
#define OFF_GATE (64 * 1024)
#define OFF_CQ (128 * 1024)
#define OFF_SC (144 * 1024)
#define OFF_X2Q (128 * 1024)
#define OFF_ZB (256 * 1024)
#define OFF_VT (896 * 1024)
#define OFF_Y (1024 * 1024)
#define OFF_Q (1280 * 1024)
__device__ __forceinline__ void wg_sync_mem() { asm volatile("s_waitcnt vmcnt(0) lgkmcnt(0)" ::: "memory"); __syncthreads(); }

#define OFF_SXB (128 * 1024)
__device__ __forceinline__ void phase_inproj(const P& p, int tile) {
  const signed char* xq = (const signed char*)(p.slabs + (size_t)tile * SLAB_BYTES + OFF_XB);
  const float* sxr = (const float*)(p.slabs + (size_t)tile * SLAB_BYTES + OFF_SXB);
  for (int nt = 0; nt < INW / 256; ++nt) {
    wg_gemm_i8<256>(xq, DM, p.w_inQ + (long)nt * 256 * DM, DM, DM, [&](v4i_t (&acc)[4][4], int wr, int wc, int fr, int fq) {
#pragma unroll
      for (int m = 0; m < 4; ++m) {
        const int rl = wr * 64 + m * 16 + fr;
        const float sr = sxr[rl];
#pragma unroll
        for (int n = 0; n < 4; ++n) {
          const int row = tile * 128 + rl, col = nt * 256 + wc * 64 + n * 16 + fq * 4;
          const float4 bv = *(const float4*)(p.b_in + col), sw = *(const float4*)(p.sw_in + col);
          float o0 = (float)acc[m][n][0] * (sr * sw.x) + bv.x, o1 = (float)acc[m][n][1] * (sr * sw.y) + bv.y, o2 = (float)acc[m][n][2] * (sr * sw.z) + bv.z, o3 = (float)acc[m][n][3] * (sr * sw.w) + bv.w;
          if (nt < 4) { o0 = gelu_f(o0); o1 = gelu_f(o1); o2 = gelu_f(o2); o3 = gelu_f(o3); }
          u32x2 w; w.x = pk_bf16(o0, o1); w.y = pk_bf16(o2, o3);
          *(u32x2*)(p.ZB + (long)row * INW + col) = w;
        }
      }
    });
  }
}

__device__ __forceinline__ void phase_mixer(const P& p, int tile) {
  const int tid = otid(), lane = tid & 63, wid = tid >> 6;
  const long t0 = (long)tile * 128;
  const bool seq_start = ((tile & 63) == 0);
#pragma unroll 2
  for (int it = tid; it < 128 * 64; it += 512) {
    const int tl = it >> 6, c = (it & 63) * 8;
    const long t = t0 + tl;
    float conv[8];
#pragma unroll
    for (int j = 0; j < 8; ++j) conv[j] = 0.f;
#pragma unroll
    for (int k = 0; k < 3; ++k) {
      const int rl = tl - 2 + k;
      const float4 w0 = *(const float4*)(p.conv_w + k * 512 + c), w1 = *(const float4*)(p.conv_w + k * 512 + c + 4);
      if (rl >= 0) {
        const bf16_t* zr = p.ZB + (t0 + rl) * INW;
        const u32x4 hb = *(const u32x4*)(zr + 1024 + c), gc = *(const u32x4*)(zr + 2048 + c);
        conv[0] += w0.x * (bf_lo(hb.x) * bf_lo(gc.x)); conv[1] += w0.y * (bf_hi(hb.x) * bf_hi(gc.x));
        conv[2] += w0.z * (bf_lo(hb.y) * bf_lo(gc.y)); conv[3] += w0.w * (bf_hi(hb.y) * bf_hi(gc.y));
        conv[4] += w1.x * (bf_lo(hb.z) * bf_lo(gc.z)); conv[5] += w1.y * (bf_hi(hb.z) * bf_hi(gc.z));
        conv[6] += w1.z * (bf_lo(hb.w) * bf_lo(gc.w)); conv[7] += w1.w * (bf_hi(hb.w) * bf_hi(gc.w));
      } else if (!seq_start) {
        const u32x4 zc = *(const u32x4*)(p.HALO + ((long)(tile - 1) * 2 + (rl + 2)) * 512 + c);
        conv[0] += w0.x * bf_lo(zc.x); conv[1] += w0.y * bf_hi(zc.x); conv[2] += w0.z * bf_lo(zc.y); conv[3] += w0.w * bf_hi(zc.y);
        conv[4] += w1.x * bf_lo(zc.z); conv[5] += w1.y * bf_hi(zc.z); conv[6] += w1.z * bf_lo(zc.w); conv[7] += w1.w * bf_hi(zc.w);
      }
    }
    const u32x4 gb = *(const u32x4*)(p.ZB + t * INW + 1536 + c);
    u32x4 o;
    o.x = pk_bf16(bf_lo(gb.x) * conv[0], bf_hi(gb.x) * conv[1]); o.y = pk_bf16(bf_lo(gb.y) * conv[2], bf_hi(gb.y) * conv[3]);
    o.z = pk_bf16(bf_lo(gb.z) * conv[4], bf_hi(gb.z) * conv[5]); o.w = pk_bf16(bf_lo(gb.w) * conv[6], bf_hi(gb.w) * conv[7]);
    *(u32x4*)(p.Y + t * DM + 512 + c) = o;
  }
  for (int h = 0; h < 4; ++h) {
    float a0[16], a1[16];
    const float g0 = p.sgu_g[h * 128 + 2 * lane], g1 = p.sgu_g[h * 128 + 2 * lane + 1], b0 = p.sgu_b[h * 128 + 2 * lane], b1 = p.sgu_b[h * 128 + 2 * lane + 1];
#pragma unroll
    for (int i = 0; i < 16; ++i) {
      const unsigned v = *(const unsigned*)(p.ZB + (t0 + wid * 16 + i) * INW + 512 + h * 128 + 2 * lane);
      const float x0 = bf_lo(v), x1 = bf_hi(v);
      float sum = x0 + x1;
#pragma unroll
      for (int o = 32; o > 0; o >>= 1) sum += __shfl_xor(sum, o);
      const float mu = sum * (1.f / 128.f);
      const float d0 = x0 - mu, d1 = x1 - mu;
      float q = d0 * d0 + d1 * d1;
#pragma unroll
      for (int o = 32; o > 0; o >>= 1) q += __shfl_xor(q, o);
      const float rstd = rsqrtf(q * (1.f / 128.f) + LN_EPS);
      a0[i] = d0 * rstd * g0 + b0; a1[i] = d1 * rstd * g1 + b1;
    }
    bf16_t* vt = p.VT + ((long)tile * 4 + h) * 128 * 128;
    u32x4 o;
    o.x = pk_bf16(a0[0], a0[1]); o.y = pk_bf16(a0[2], a0[3]); o.z = pk_bf16(a0[4], a0[5]); o.w = pk_bf16(a0[6], a0[7]);
    *(u32x4*)(vt + (2 * lane) * 128 + wid * 16) = o;
    o.x = pk_bf16(a0[8], a0[9]); o.y = pk_bf16(a0[10], a0[11]); o.z = pk_bf16(a0[12], a0[13]); o.w = pk_bf16(a0[14], a0[15]);
    *(u32x4*)(vt + (2 * lane) * 128 + wid * 16 + 8) = o;
    o.x = pk_bf16(a1[0], a1[1]); o.y = pk_bf16(a1[2], a1[3]); o.z = pk_bf16(a1[4], a1[5]); o.w = pk_bf16(a1[6], a1[7]);
    *(u32x4*)(vt + (2 * lane + 1) * 128 + wid * 16) = o;
    o.x = pk_bf16(a1[8], a1[9]); o.y = pk_bf16(a1[10], a1[11]); o.z = pk_bf16(a1[12], a1[13]); o.w = pk_bf16(a1[14], a1[15]);
    *(u32x4*)(vt + (2 * lane + 1) * 128 + wid * 16 + 8) = o;
  }
  wg_sync_mem();
  for (int h = 0; h < 4; ++h) {
    wg_gemm<128>(p.wsb + h * 128 * 128, 128, p.VT + ((long)tile * 4 + h) * 128 * 128, 128, 128, [&](f32x4 (&acc)[4][2], int wr, int wc, int fr, int fq) {
#pragma unroll
      for (int m = 0; m < 4; ++m)
#pragma unroll
        for (int n = 0; n < 2; ++n) {
          const int rl = wr * 64 + m * 16 + fr, col = wc * 32 + n * 16 + fq * 4;
          const float bs = p.b_sp[h * 128 + rl];
          const u32x2 uv = *(const u32x2*)(p.ZB + (t0 + rl) * INW + h * 128 + col);
          u32x2 w;
          w.x = pk_bf16(bf_lo(uv.x) * (acc[m][n][0] + bs), bf_hi(uv.x) * (acc[m][n][1] + bs));
          w.y = pk_bf16(bf_lo(uv.y) * (acc[m][n][2] + bs), bf_hi(uv.y) * (acc[m][n][3] + bs));
          *(u32x2*)(p.Y + (t0 + rl) * DM + h * 128 + col) = w;
        }
    });
  }
}

__device__ __forceinline__ void ln_rows16(const float* __restrict__ PRE, long r0, const float* __restrict__ g, const float* __restrict__ b, bf16_t* __restrict__ Out, int lane) {
#pragma unroll 2
  for (int i = 0; i < 16; ++i) {
    const bf16_t* pr = (const bf16_t*)PRE + (r0 + i) * DM;
    float4 v[4];
    float sum = 0.f;
#pragma unroll
    for (int j = 0; j < 4; ++j) { const u32x2 pv = *(const u32x2*)(pr + j * 256 + lane * 4); v[j].x = bf_lo(pv.x); v[j].y = bf_hi(pv.x); v[j].z = bf_lo(pv.y); v[j].w = bf_hi(pv.y); sum += (v[j].x + v[j].y) + (v[j].z + v[j].w); }
#pragma unroll
    for (int o = 32; o > 0; o >>= 1) sum += __shfl_xor(sum, o);
    const float mu = sum * (1.f / DM);
    float q = 0.f;
#pragma unroll
    for (int j = 0; j < 4; ++j) { v[j].x -= mu; v[j].y -= mu; v[j].z -= mu; v[j].w -= mu; q += (v[j].x * v[j].x + v[j].y * v[j].y) + (v[j].z * v[j].z + v[j].w * v[j].w); }
#pragma unroll
    for (int o = 32; o > 0; o >>= 1) q += __shfl_xor(q, o);
    const float rstd = rsqrtf(q * (1.f / DM) + LN_EPS);
#pragma unroll
    for (int j = 0; j < 4; ++j) {
      const int c0 = j * 256 + lane * 4;
      const float4 gg = *(const float4*)(g + c0), bb = *(const float4*)(b + c0);
      u32x2 w; w.x = pk_bf16(v[j].x * rstd * gg.x + bb.x, v[j].y * rstd * gg.y + bb.y); w.y = pk_bf16(v[j].z * rstd * gg.z + bb.z, v[j].w * rstd * gg.w + bb.w);
      *(u32x2*)(Out + (r0 + i) * DM + c0) = w;
    }
  }
}

__device__ __forceinline__ void ln_rows16_q(const float* __restrict__ PRE, long r0, const float* __restrict__ g, const float* __restrict__ b, bf16_t* __restrict__ Out,
                                            unsigned char* __restrict__ XQ, float* __restrict__ SX, int lane) {
#pragma unroll 2
  for (int i = 0; i < 16; ++i) {
    const bf16_t* pr = (const bf16_t*)PRE + (r0 + i) * DM;
    float4 v[4];
    float sum = 0.f;
#pragma unroll
    for (int j = 0; j < 4; ++j) { const u32x2 pv = *(const u32x2*)(pr + j * 256 + lane * 4); v[j].x = bf_lo(pv.x); v[j].y = bf_hi(pv.x); v[j].z = bf_lo(pv.y); v[j].w = bf_hi(pv.y); sum += (v[j].x + v[j].y) + (v[j].z + v[j].w); }
#pragma unroll
    for (int o = 32; o > 0; o >>= 1) sum += __shfl_xor(sum, o);
    const float mu = sum * (1.f / DM);
    float q = 0.f;
#pragma unroll
    for (int j = 0; j < 4; ++j) { v[j].x -= mu; v[j].y -= mu; v[j].z -= mu; v[j].w -= mu; q += (v[j].x * v[j].x + v[j].y * v[j].y) + (v[j].z * v[j].z + v[j].w * v[j].w); }
#pragma unroll
    for (int o = 32; o > 0; o >>= 1) q += __shfl_xor(q, o);
    const float rstd = rsqrtf(q * (1.f / DM) + LN_EPS);
    float amax = 0.f;
#pragma unroll
    for (int j = 0; j < 4; ++j) {
      const int c0 = j * 256 + lane * 4;
      const float4 gg = *(const float4*)(g + c0), bb = *(const float4*)(b + c0);
      v[j].x = v[j].x * rstd * gg.x + bb.x; v[j].y = v[j].y * rstd * gg.y + bb.y; v[j].z = v[j].z * rstd * gg.z + bb.z; v[j].w = v[j].w * rstd * gg.w + bb.w;
      u32x2 w; w.x = pk_bf16(v[j].x, v[j].y); w.y = pk_bf16(v[j].z, v[j].w);
      *(u32x2*)(Out + (r0 + i) * DM + c0) = w;
      amax = fmaxf(amax, fmaxf(fmaxf(fabsf(v[j].x), fabsf(v[j].y)), fmaxf(fabsf(v[j].z), fabsf(v[j].w))));
    }
#pragma unroll
    for (int o = 32; o > 0; o >>= 1) amax = fmaxf(amax, __shfl_xor(amax, o));
    const float inv = amax > 0.f ? 127.f / amax : 0.f;
#pragma unroll
    for (int j = 0; j < 4; ++j) *(unsigned*)(XQ + (r0 + i) * DM + j * 256 + lane * 4) = pack4_i8(v[j].x * inv, v[j].y * inv, v[j].z * inv, v[j].w * inv);
    if (lane == 0) SX[r0 + i] = amax * (1.f / 127.f);
  }
}

__device__ __forceinline__ void phase_outproj(const P& p, int tile) {
  const long t0 = (long)tile * 128;
  {
    const int lane = threadIdx.x & 63, wid = threadIdx.x >> 6;
#pragma unroll 2
    for (int i = 0; i < 16; ++i) {
      const long row = t0 + wid * 16 + i;
      u32x2 v[4];
      float amax = 0.f;
#pragma unroll
      for (int j = 0; j < 4; ++j) {
        v[j] = *(const u32x2*)(p.Y + row * DM + 256 * j + lane * 4);
        amax = fmaxf(amax, fmaxf(fmaxf(fabsf(bf_lo(v[j].x)), fabsf(bf_hi(v[j].x))), fmaxf(fabsf(bf_lo(v[j].y)), fabsf(bf_hi(v[j].y)))));
      }
#pragma unroll
      for (int o = 32; o > 0; o >>= 1) amax = fmaxf(amax, __shfl_xor(amax, o));
      const float inv = amax > 0.f ? 127.f / amax : 0.f;
#pragma unroll
      for (int j = 0; j < 4; ++j) *(unsigned*)(p.YQ + row * DM + 256 * j + lane * 4) = pack4_i8(bf_lo(v[j].x) * inv, bf_hi(v[j].x) * inv, bf_lo(v[j].y) * inv, bf_hi(v[j].y) * inv);
      if (lane == 0) p.SY[row] = amax * (1.f / 127.f);
    }
  }
  wg_sync_mem();
  for (int nt = 0; nt < 4; ++nt) {
    wg_gemm_i8<256>(p.YQ + t0 * DM, DM, p.w_moQ + (long)nt * 256 * DM, DM, DM, [&](v4i_t (&acc)[4][4], int wr, int wc, int fr, int fq) {
#pragma unroll
      for (int m = 0; m < 4; ++m) {
        const long row = t0 + wr * 64 + m * 16 + fr;
        const float sr = p.SY[row];
#pragma unroll
        for (int n = 0; n < 4; ++n) {
          const int col = nt * 256 + wc * 64 + n * 16 + fq * 4;
          const float4 xv = *(const float4*)(p.x + row * DM + col);
          const float4 sw = *(const float4*)(p.sw_mo + col);
          u32x2 o; o.x = pk_bf16(ALPHA * xv.x + (float)acc[m][n][0] * (sr * sw.x), ALPHA * xv.y + (float)acc[m][n][1] * (sr * sw.y));
          o.y = pk_bf16(ALPHA * xv.z + (float)acc[m][n][2] * (sr * sw.z), ALPHA * xv.w + (float)acc[m][n][3] * (sr * sw.w));
          *(u32x2*)((bf16_t*)p.PRE + row * DM + col) = o;
        }
      }
    });
  }
  wg_sync_mem();
  ln_rows16_q(p.PRE, t0 + (threadIdx.x >> 6) * 16, p.ln1_g, p.ln1_b, p.X1, p.X1Q, p.SX1, threadIdx.x & 63);
}

__device__ __forceinline__ void phase_kv(const P& p, int unit) {
  const int rt = unit >> 5, nc = unit & 31;
  wg_gemm<64>(p.memB + (long)rt * 128 * DM, DM, p.w_xkvT + (long)nc * 64 * DM, DM, DM, [&](f32x4 (&acc)[4][1], int wr, int wc, int fr, int fq) {
    const int b = rt >> 1, col = nc * 64 + wc * 16 + fq * 4, hh = (col >> 8) & 3, d = col & 255;
#pragma unroll
    for (int m = 0; m < 4; ++m) {
      const int mm = (rt & 1) * 128 + wr * 64 + m * 16 + fr;
      u32x2 w; w.x = pk_bf16(acc[m][0][0], acc[m][0][1]); w.y = pk_bf16(acc[m][0][2], acc[m][0][3]);
      *(u32x2*)((col < 1024 ? p.Kc : p.Vc) + ((long)(b * 4 + hh) * 256 + mm) * 256 + d) = w;
    }
  });
}

__device__ __forceinline__ void phase_gh(const P& p, int unit) {
  if (unit < 128) {
    const int bh = unit >> 3, rt = (unit >> 2) & 1, nt = unit & 3, h = bh & 3, b = bh >> 2;
    wg_gemm<256>(p.Kc + ((long)bh * 256 + rt * 128) * 256, 256, p.wxqB + (long)nt * 256 * DM + h * 256, DM, 256, [&](f32x4 (&acc)[4][4], int wr, int wc, int fr, int fq) {
#pragma unroll
      for (int m = 0; m < 4; ++m)
#pragma unroll
        for (int n = 0; n < 4; ++n) {
          const long row = (long)b * 1024 + h * 256 + rt * 128 + wr * 64 + m * 16 + fr; const int col = nt * 256 + wc * 64 + n * 16 + fq * 4;
          u32x2 w; w.x = pk_bf16(acc[m][n][0], acc[m][n][1]); w.y = pk_bf16(acc[m][n][2], acc[m][n][3]);
          *(u32x2*)(p.GTb + row * DM + col) = w;
        }
    });
  } else {
    const int u = unit - 128, bh = u >> 3, rt = u & 7, h = bh & 3, b = bh >> 2;
    wg_gemm<256>(p.w_xoT + (long)rt * 128 * DM + h * 256, DM, p.Vc + (long)bh * 256 * 256, 256, 256, [&](f32x4 (&acc)[4][4], int wr, int wc, int fr, int fq) {
#pragma unroll
      for (int m = 0; m < 4; ++m)
#pragma unroll
        for (int n = 0; n < 4; ++n) {
          const long row = (long)b * 1024 + rt * 128 + wr * 64 + m * 16 + fr; const int col = h * 256 + wc * 64 + n * 16 + fq * 4;
          u32x2 w; w.x = pk_bf16(acc[m][n][0], acc[m][n][1]); w.y = pk_bf16(acc[m][n][2], acc[m][n][3]);
          *(u32x2*)(p.HT + row * DM + col) = w;
        }
    });
  }
}

__device__ __forceinline__ void phase_gquant(const P& p) {
  const int lane = threadIdx.x & 63, wid = threadIdx.x >> 6;
#pragma unroll
  for (int i = 0; i < 2; ++i) {
    const long row = (long)blockIdx.x * 16 + wid * 2 + i;
    u32x2 v[4];
    float amax = 0.f;
#pragma unroll
    for (int j = 0; j < 4; ++j) {
      v[j] = *(const u32x2*)(p.GTb + row * DM + 256 * j + lane * 4);
      amax = fmaxf(amax, fmaxf(fmaxf(fabsf(bf_lo(v[j].x)), fabsf(bf_hi(v[j].x))), fmaxf(fabsf(bf_lo(v[j].y)), fabsf(bf_hi(v[j].y)))));
    }
#pragma unroll
    for (int o = 32; o > 0; o >>= 1) amax = fmaxf(amax, __shfl_xor(amax, o));
    const float inv = amax > 0.f ? 127.f / amax : 0.f;
#pragma unroll
    for (int j = 0; j < 4; ++j) *(unsigned*)(p.GTq + row * DM + 256 * j + lane * 4) = pack4_i8(bf_lo(v[j].x) * inv, bf_hi(v[j].x) * inv, bf_lo(v[j].y) * inv, bf_hi(v[j].y) * inv);
    if (lane == 0) p.sG[row] = amax * (1.f / 127.f);
  }
  {
    const long row = (long)blockIdx.x * 8 + wid;
    u32x2 v[4];
    float amax = 0.f;
#pragma unroll
    for (int j = 0; j < 4; ++j) {
      v[j] = *(const u32x2*)(p.w_pqT + row * DM + 256 * j + lane * 4);
      amax = fmaxf(amax, fmaxf(fmaxf(fabsf(bf_lo(v[j].x)), fabsf(bf_hi(v[j].x))), fmaxf(fabsf(bf_lo(v[j].y)), fabsf(bf_hi(v[j].y)))));
    }
#pragma unroll
    for (int o = 32; o > 0; o >>= 1) amax = fmaxf(amax, __shfl_xor(amax, o));
    const float inv = amax > 0.f ? 127.f / amax : 0.f;
#pragma unroll
    for (int j = 0; j < 4; ++j) *(unsigned*)(p.MTq + row * DM + 256 * j + lane * 4) = pack4_i8(bf_lo(v[j].x) * inv, bf_hi(v[j].x) * inv, bf_lo(v[j].y) * inv, bf_hi(v[j].y) * inv);
    if (lane == 0) p.sMT[row] = amax * (1.f / 127.f);
  }
}

__device__ __forceinline__ void phase_scores(const P& p, int tile) {
  const long t0 = (long)tile * 128;
  const int b = tile >> 6;
  LAS float* red = (LAS float*)((LAS char*)smem_raw + RED_OFF);
  for (int h = 0; h < 4; ++h) {
    bf16_t* Pw = p.Pb + t0 * DM + h * 256;
    wg_gemm_i8<256>((const signed char*)p.X1Q + t0 * DM, DM, p.GTq + ((long)b * 1024 + h * 256) * DM, DM, DM, [&](v4i_t (&iacc)[4][4], int wr, int wc, int fr, int fq) {
      f32x4 acc[4][4];
      float rmax[4];
#pragma unroll
      for (int m = 0; m < 4; ++m) {
        const float sr = p.SX1[t0 + wr * 64 + m * 16 + fr] * 0.0625f;
#pragma unroll
        for (int n = 0; n < 4; ++n) {
          const float4 sw = *(const float4*)(p.sG + b * 1024 + h * 256 + wc * 64 + n * 16 + fq * 4);
          acc[m][n][0] = (float)iacc[m][n][0] * (sr * sw.x); acc[m][n][1] = (float)iacc[m][n][1] * (sr * sw.y);
          acc[m][n][2] = (float)iacc[m][n][2] * (sr * sw.z); acc[m][n][3] = (float)iacc[m][n][3] * (sr * sw.w);
        }
      }
#pragma unroll
      for (int m = 0; m < 4; ++m) {
        float mx = -3.0e38f;
#pragma unroll
        for (int n = 0; n < 4; ++n) mx = fmaxf(mx, fmaxf(fmaxf(acc[m][n][0], acc[m][n][1]), fmaxf(acc[m][n][2], acc[m][n][3])));
        mx = fmaxf(mx, __shfl_xor(mx, 16)); mx = fmaxf(mx, __shfl_xor(mx, 32));
        if (fq == 0) red[(wr * 64 + m * 16 + fr) * 4 + wc] = mx;
      }
      __syncthreads();
#pragma unroll
      for (int m = 0; m < 4; ++m) {
        const f32x4 r = *(LAS const f32x4*)(red + (wr * 64 + m * 16 + fr) * 4);
        rmax[m] = fmaxf(fmaxf(r[0], r[1]), fmaxf(r[2], r[3]));
      }
#pragma unroll
      for (int m = 0; m < 4; ++m) {
        float sm = 0.f;
#pragma unroll
        for (int n = 0; n < 4; ++n)
#pragma unroll
          for (int j = 0; j < 4; ++j) { const float e = __expf(acc[m][n][j] - rmax[m]); acc[m][n][j] = e; sm += e; }
        sm += __shfl_xor(sm, 16); sm += __shfl_xor(sm, 32);
        if (fq == 0) red[512 + (wr * 64 + m * 16 + fr) * 4 + wc] = sm;
      }
      __syncthreads();
#pragma unroll
      for (int m = 0; m < 4; ++m) {
        const f32x4 r = *(LAS const f32x4*)(red + 512 + (wr * 64 + m * 16 + fr) * 4);
        const float inv = 1.f / ((r[0] + r[1]) + (r[2] + r[3]));
        const int rl = wr * 64 + m * 16 + fr;
#pragma unroll
        for (int n = 0; n < 4; ++n) {
          u32x2 w; w.x = pk_bf16(acc[m][n][0] * inv, acc[m][n][1] * inv); w.y = pk_bf16(acc[m][n][2] * inv, acc[m][n][3] * inv);
          *(u32x2*)(Pw + rl * DM + wc * 64 + n * 16 + fq * 4) = w;
        }
      }
    });
  }
}

__device__ __forceinline__ void phase_oproj(const P& p, int tile) {
  const long t0 = (long)tile * 128;
  for (int nt = 0; nt < 4; ++nt) {
    wg_gemm<256>(p.Pb + t0 * DM, DM, p.HT + ((long)(tile >> 6) * 1024 + nt * 256) * DM, DM, DM, [&](f32x4 (&acc)[4][4], int wr, int wc, int fr, int fq) {
#pragma unroll
      for (int m = 0; m < 4; ++m)
#pragma unroll
        for (int n = 0; n < 4; ++n) {
          const long row = t0 + wr * 64 + m * 16 + fr; const int col = nt * 256 + wc * 64 + n * 16 + fq * 4;
          const u32x2 xv = *(const u32x2*)(p.X1 + row * DM + col);
          u32x2 o; o.x = pk_bf16(ALPHA * bf_lo(xv.x) + acc[m][n][0], ALPHA * bf_hi(xv.x) + acc[m][n][1]); o.y = pk_bf16(ALPHA * bf_lo(xv.y) + acc[m][n][2], ALPHA * bf_hi(xv.y) + acc[m][n][3]);
          *(u32x2*)((bf16_t*)p.PRE + row * DM + col) = o;
        }
    });
  }
  wg_sync_mem();
  ln_rows16_q(p.PRE, t0 + (threadIdx.x >> 6) * 16, p.ln2_g, p.ln2_b, p.X2, p.XQ, p.SX, threadIdx.x & 63);
}

__device__ __forceinline__ unsigned f2key(float f) { const unsigned b = __float_as_uint(f); return b ^ ((unsigned)((int)b >> 31) | 0x80000000u); }
__device__ __forceinline__ float key2f(unsigned k) { return __uint_as_float(k ^ ((k & 0x80000000u) ? 0x80000000u : 0xffffffffu)); }
__device__ __forceinline__ void phase_pq(const P& p, int tile) {
  const long t0 = (long)tile * 128;
  for (int nt = 0; nt < 8; ++nt) {
    wg_gemm_i8<256>((const signed char*)p.XQ + t0 * DM, DM, p.MTq + (long)nt * 256 * DM, DM, DM, [&](v4i_t (&acc)[4][4], int wr, int wc, int fr, int fq) {
#pragma unroll
      for (int m = 0; m < 4; ++m) {
        const long row = t0 + wr * 64 + m * 16 + fr;
        const float sr = p.SX[row];
#pragma unroll
        for (int n = 0; n < 4; ++n) {
          const int col = nt * 256 + wc * 64 + n * 16 + fq * 4;
          const float4 sw = *(const float4*)(p.sMT + col);
          u32x2 w; w.x = pk_f16((float)acc[m][n][0] * (sr * sw.x), (float)acc[m][n][1] * (sr * sw.y)); w.y = pk_f16((float)acc[m][n][2] * (sr * sw.z), (float)acc[m][n][3] * (sr * sw.w));
          *(u32x2*)((unsigned short*)p.KEYS + row * 2048 + col) = w;
        }
      }
    });
  }
}

__device__ __forceinline__ void phase_mt(const P& p, int unit) {
  const int hp = unit >> 2, nt = unit & 3;
  wg_gemm<256>(p.skb + (long)hp * 128 * 128, 128, p.wpqB + (long)nt * 256 * 2048 + hp * 128, 2048, 128, [&](f32x4 (&acc)[4][4], int wr, int wc, int fr, int fq) {
#pragma unroll
    for (int m = 0; m < 4; ++m)
#pragma unroll
      for (int n = 0; n < 4; ++n) {
        const int row = hp * 128 + wr * 64 + m * 16 + fr, col = nt * 256 + wc * 64 + n * 16 + fq * 4;
        u32x2 w; w.x = pk_bf16(acc[m][n][0], acc[m][n][1]); w.y = pk_bf16(acc[m][n][2], acc[m][n][3]);
        *(u32x2*)((bf16_t*)p.w_pqT + (long)row * DM + col) = w;
      }
  });
}

__device__ __forceinline__ unsigned cand_entry(int s) {
  unsigned e = 255u; int base = 0;
#pragma unroll
  for (int i = 0; i < 16; ++i) { const int cnt = 16 / (i + 1); if (s >= base && s < base + cnt) e = (unsigned)i | ((unsigned)(s - base) << 4); base += cnt; }
  return e;
}
template <int CTRL> __device__ __forceinline__ unsigned dpp_u(unsigned x) { return (unsigned)__builtin_amdgcn_mov_dpp((int)x, CTRL, 0xf, 0xf, true); }
template <int CTRL> __device__ __forceinline__ float dpp_f(float x) { return __int_as_float(__builtin_amdgcn_mov_dpp(__float_as_int(x), CTRL, 0xf, 0xf, true)); }
__device__ __forceinline__ unsigned umin_(unsigned a, unsigned b) { return a < b ? a : b; }
__device__ __forceinline__ unsigned row_min_u(unsigned x) {
  x = umin_(x, dpp_u<0x128>(x)); x = umin_(x, dpp_u<0x124>(x)); x = umin_(x, dpp_u<0x122>(x)); x = umin_(x, dpp_u<0x121>(x)); return x;
}
__device__ __forceinline__ float row_max_f(float x) { x = fmaxf(x, dpp_f<0x128>(x)); x = fmaxf(x, dpp_f<0x124>(x)); x = fmaxf(x, dpp_f<0x122>(x)); x = fmaxf(x, dpp_f<0x121>(x)); return x; }
__device__ __forceinline__ float row_sum_f(float x) { x += dpp_f<0x128>(x); x += dpp_f<0x124>(x); x += dpp_f<0x122>(x); x += dpp_f<0x121>(x); return x; }

#define KEYS_OFF 65536
#define KEY_STRIDE 528
template <int N> __device__ __forceinline__ unsigned top16_row(const unsigned (&k)[N], int r) {
  unsigned pm1 = 0xFFFFFFFEu, mine = 0;
#pragma unroll
  for (int rd = 0; rd < 16; ++rd) {
    unsigned d = pm1 - k[0];
#pragma unroll
    for (int i = 1; i < N; ++i) d = umin_(d, pm1 - k[i]);
    d = row_min_u(d);
    const unsigned nxt = pm1 - d;
    mine = (r == rd) ? nxt : mine;
    pm1 = nxt - 1;
  }
  return mine;
}

__device__ __forceinline__ void phase_route(const P& p, int tile) {
  const long t0 = (long)tile * 128;
  const int tid = otid(), lane = tid & 63, wid = tid >> 6, r = lane & 15, g = lane >> 4;
  LAS char* lds = (LAS char*)smem_raw;
  LAS unsigned char* tab = (LAS unsigned char*)(lds + RED_OFF);
  if (tid < 64) tab[tid] = (unsigned char)cand_entry(tid);
  unsigned ci[4], cj[4]; bool cval[4];
#pragma unroll
  for (int q = 0; q < 4; ++q) { const unsigned e = cand_entry(r * 4 + q); cval[q] = (e != 255u); ci[q] = ((unsigned)(g * 16) + (e & 15u)) * 4u; cj[q] = ((unsigned)(g * 16) + ((e >> 4) & 15u)) * 4u; }
  __syncthreads();
  auto load_keys = [&](int hp, u32x4 (&kb)[4]) {
#pragma unroll
    for (int ps = 0; ps < 4; ++ps) kb[ps] = *(const u32x4*)((const unsigned short*)p.KEYS + (t0 + wid * 16 + ps * 4 + g) * 2048 + hp * 128 + r * 8);
  };
  auto top_keys = [&](const u32x4 (&kb)[4], unsigned (&tp)[4]) {
#pragma unroll
    for (int ps = 0; ps < 4; ++ps) {
      const unsigned w[4] = {kb[ps].x, kb[ps].y, kb[ps].z, kb[ps].w};
      unsigned k[8];
#pragma unroll
      for (int i = 0; i < 4; ++i) {
        k[2 * i] = (f2key(f16_lo(w[i])) & ~127u) | (unsigned)(127 - (r * 8 + 2 * i));
        k[2 * i + 1] = (f2key(f16_hi(w[i])) & ~127u) | (unsigned)(126 - (r * 8 + 2 * i));
      }
      tp[ps] = top16_row<8>(k, r);
    }
  };
  u32x4 kA[4], kB[4];
  load_keys(0, kA);
  for (int h = 0; h < 8; ++h) {
    unsigned top[2][4];
    load_keys(h * 2 + 1, kB);
    top_keys(kA, top[0]);
    load_keys(h < 7 ? h * 2 + 2 : 15, kA);
    top_keys(kB, top[1]);
#pragma unroll
    for (int ps = 0; ps < 4; ++ps) {
      const int tk = wid * 16 + ps * 4 + g;
      const unsigned A = top[0][ps], B = top[1][ps];
      const float fa = key2f(A & ~127u), fb = key2f(B & ~127u);
      unsigned k2[4];
#pragma unroll
      for (int q = 0; q < 4; ++q) {
        const float va = __int_as_float(__builtin_amdgcn_ds_bpermute((int)ci[q], __float_as_int(fa)));
        const float vb = __int_as_float(__builtin_amdgcn_ds_bpermute((int)cj[q], __float_as_int(fb)));
        const unsigned kk = (f2key(va + vb) & ~63u) | (unsigned)(63 - (r * 4 + q));
        k2[q] = cval[q] ? kk : 0u;
      }
      const unsigned mine = top16_row<4>(k2, r);
      const unsigned slot = 63u - (mine & 63u);
      const unsigned e = tab[slot];
      const unsigned ka = (unsigned)__builtin_amdgcn_ds_bpermute((int)(((unsigned)(g * 16) + (e & 15u)) * 4u), (int)A);
      const unsigned kb = (unsigned)__builtin_amdgcn_ds_bpermute((int)(((unsigned)(g * 16) + ((e >> 4) & 15u)) * 4u), (int)B);
      const int expert = (int)((127u - (ka & 127u)) * 128u + (127u - (kb & 127u)));
      const float c = key2f(mine & ~63u);
      const float mx = row_max_f(c);
      const float ex = __expf(c - mx);
      const float sm = row_sum_f(ex);
      p.experts[(t0 + tk) * 128 + h * 16 + r] = expert;
      p.gates[(t0 + tk) * 128 + h * 16 + r] = ex / sm;
    }
  }
}

__device__ __forceinline__ f32x2_t ub01(unsigned w) { return (f32x2_t){(float)(w & 0xffu), (float)((w >> 8) & 0xffu)}; }
__device__ __forceinline__ f32x2_t ub23(unsigned w) { return (f32x2_t){(float)((w >> 16) & 0xffu), (float)(w >> 24)}; }
__device__ __forceinline__ int sum8_i(int x) {
  x += (int)dpp_u<0xB1>((unsigned)x); x += (int)dpp_u<0x4E>((unsigned)x); x += (int)dpp_u<0x141>((unsigned)x); return x;
}
struct GMeta { u32x4 xq; int er0, er1; };
__device__ __forceinline__ void phase_gdown(const P& p) {
  const int tid = otid(), lane = tid & 63, wid = tid >> 6, grp = lane >> 3, r8 = lane & 7;
  const int slice = blockIdx.x & 7, chunk = blockIdx.x >> 3;
  const unsigned char* tab = p.WDq + slice * 128 + r8 * 16;
  const char* sl = p.slabs + (size_t)(chunk * 8 + wid) * SLAB_BYTES;
  int* pd = (int*)(sl + OFF_ZB) + slice * 128 * 128;
  const unsigned char* xqb = (const unsigned char*)(sl + OFF_X2Q);
  const int* exb = (const int*)(sl + OFF_EXP);
  auto meta = [&](int ti, GMeta& m) {
    const int t = (ti < 127 ? ti : 127);
    m.xq = *(const u32x4*)(xqb + t * DM + slice * 128 + r8 * 16);
    m.er0 = exb[t * 128 + lane]; m.er1 = exb[t * 128 + 64 + lane];
  };
  auto issue = [&](const GMeta& m, u32x4 (&w)[16]) {
#pragma unroll
    for (int it = 0; it < 16; ++it) {
      const int e = __builtin_amdgcn_ds_bpermute(((it & 7) * 8 + grp) * 4, (it < 8) ? m.er0 : m.er1);
      w[it] = *(const u32x4*)(tab + (long)e * DM);
    }
  };
  auto consume = [&](int ti, const GMeta& m, const u32x4 (&w)[16]) {
    int c0 = 0, c1 = 0;
#pragma unroll
    for (int it = 0; it < 16; ++it) {
      int acc = __builtin_amdgcn_sdot4((int)w[it].x, (int)m.xq.x, 0, false);
      acc = __builtin_amdgcn_sdot4((int)w[it].y, (int)m.xq.y, acc, false); acc = __builtin_amdgcn_sdot4((int)w[it].z, (int)m.xq.z, acc, false); acc = __builtin_amdgcn_sdot4((int)w[it].w, (int)m.xq.w, acc, false);
      acc = sum8_i(acc);
      const bool mine = ((it & 7) == r8);
      c0 = (mine && it < 8) ? acc : c0;
      c1 = (mine && it >= 8) ? acc : c1;
    }
    pd[ti * 128 + r8 * 8 + grp] = c0; pd[ti * 128 + 64 + r8 * 8 + grp] = c1;
  };
  GMeta mA, mB; u32x4 wA[16], wB[16];
  meta(0, mA); issue(mA, wA); meta(1, mB);
  for (int ti = 0; ti < 128; ti += 2) {
    issue(mB, wB);
    consume(ti, mA, wA);
    meta(ti + 2, mA);
    issue(mA, wA);
    consume(ti + 1, mB, wB);
    meta(ti + 3, mB);
  }
}
__device__ __forceinline__ int cq_index(int k) { return ((k >> 5) * 8 + (k & 7)) * 4 + ((k >> 3) & 3); }
__device__ __forceinline__ void phase_gcomb(const P& p, int tile) {
  const int tid = otid(), lane = tid & 63, wid = tid >> 6;
  signed char* cq = (signed char*)(p.slabs + (size_t)tile * SLAB_BYTES + OFF_CQ);
  float* sc = (float*)(p.slabs + (size_t)tile * SLAB_BYTES + OFF_SC);
#pragma unroll 4
  for (int ti = 0; ti < 16; ++ti) {
    const int tl = wid * 16 + ti;
    const long t = (long)tile * 128 + tl;
    int s0 = 0, s1 = 0;
#pragma unroll
    for (int j = 0; j < 8; ++j) { s0 += p.PD[(j * 128 + tl) * 128 + lane]; s1 += p.PD[(j * 128 + tl) * 128 + 64 + lane]; }
    const int e0 = p.experts[t * 128 + lane], e1 = p.experts[t * 128 + 64 + lane];
    const float sx = p.SX[t];
    const float c0 = p.gates[t * 128 + lane] * gelu_f((float)s0 * p.sd[e0] * sx) * p.su[e0];
    const float c1 = p.gates[t * 128 + 64 + lane] * gelu_f((float)s1 * p.sd[e1] * sx) * p.su[e1];
    float amax = fmaxf(fabsf(c0), fabsf(c1));
#pragma unroll
    for (int o = 32; o > 0; o >>= 1) amax = fmaxf(amax, __shfl_xor(amax, o));
    const float inv = amax > 0.f ? 127.f / amax : 0.f;
    cq[tl * 128 + cq_index(lane)] = (signed char)__float2int_rn(c0 * inv);
    cq[tl * 128 + cq_index(lane + 64)] = (signed char)__float2int_rn(c1 * inv);
    if (lane == 0) sc[tl] = amax * (1.f / 127.f);
  }
}
struct UMeta { int er0, er1; unsigned cq[4]; };
__device__ __forceinline__ void phase_gup(const P& p) {
  const int tid = otid(), lane = tid & 63, wid = tid >> 6, grp = lane >> 3, r8 = lane & 7;
  const int slice = blockIdx.x & 7, chunk = blockIdx.x >> 3;
  const unsigned char* tab = p.WUq + slice * 128 + r8 * 16;
  char* sl = p.slabs + (size_t)(chunk * 8 + wid) * SLAB_BYTES;
  const int* exb = (const int*)(sl + OFF_EXP);
  const unsigned* cqb = (const unsigned*)(sl + OFF_CQ);
  const float* scb = (const float*)(sl + OFF_SC);
  bf16_t* h3b = (bf16_t*)(sl + OFF_ZB);
  auto meta = [&](int ti, UMeta& m) {
    const int t = (ti < 127 ? ti : 127);
    m.er0 = exb[t * 128 + lane]; m.er1 = exb[t * 128 + 64 + lane];
#pragma unroll
    for (int j = 0; j < 4; ++j) m.cq[j] = cqb[t * 32 + j * 8 + grp];
  };
  auto issue = [&](const UMeta& m, u32x4 (&w)[16]) {
#pragma unroll
    for (int it = 0; it < 16; ++it) {
      const int e = __builtin_amdgcn_ds_bpermute(((it & 7) * 8 + grp) * 4, (it < 8) ? m.er0 : m.er1);
      w[it] = *(const u32x4*)(tab + (long)e * DM);
    }
  };
  auto consume = [&](int ti, const UMeta& m, const u32x4 (&w)[16]) {
    int o[16];
#pragma unroll
    for (int i = 0; i < 16; ++i) o[i] = 0;
#pragma unroll
    for (int j = 0; j < 4; ++j) {
      const unsigned x0[4] = {w[4 * j].x, w[4 * j].y, w[4 * j].z, w[4 * j].w}, x1[4] = {w[4 * j + 1].x, w[4 * j + 1].y, w[4 * j + 1].z, w[4 * j + 1].w};
      const unsigned x2[4] = {w[4 * j + 2].x, w[4 * j + 2].y, w[4 * j + 2].z, w[4 * j + 2].w}, x3[4] = {w[4 * j + 3].x, w[4 * j + 3].y, w[4 * j + 3].z, w[4 * j + 3].w};
#pragma unroll
      for (int d = 0; d < 4; ++d) {
        const unsigned t0 = __builtin_amdgcn_perm(x1[d], x0[d], 0x05010400u), t1 = __builtin_amdgcn_perm(x1[d], x0[d], 0x07030602u);
        const unsigned u0 = __builtin_amdgcn_perm(x3[d], x2[d], 0x05010400u), u1 = __builtin_amdgcn_perm(x3[d], x2[d], 0x07030602u);
        o[d * 4 + 0] = __builtin_amdgcn_sdot4((int)__builtin_amdgcn_perm(u0, t0, 0x05040100u), (int)m.cq[j], o[d * 4 + 0], false);
        o[d * 4 + 1] = __builtin_amdgcn_sdot4((int)__builtin_amdgcn_perm(u0, t0, 0x07060302u), (int)m.cq[j], o[d * 4 + 1], false);
        o[d * 4 + 2] = __builtin_amdgcn_sdot4((int)__builtin_amdgcn_perm(u1, t1, 0x05040100u), (int)m.cq[j], o[d * 4 + 2], false);
        o[d * 4 + 3] = __builtin_amdgcn_sdot4((int)__builtin_amdgcn_perm(u1, t1, 0x07060302u), (int)m.cq[j], o[d * 4 + 3], false);
      }
    }
    const float sct = scb[ti];
    float f[16];
#pragma unroll
    for (int i = 0; i < 16; ++i) {
      int a = o[i];
      a += (int)dpp_u<0x128>((unsigned)a);
      a += __shfl_xor(a, 16);
      a += __shfl_xor(a, 32);
      f[i] = (float)a * sct;
    }
    if (grp == 0) {
      bf16_t* dst = h3b + ti * DM + slice * 128 + r8 * 16;
      u32x4 q0, q1;
      q0.x = pk_bf16(f[0], f[1]); q0.y = pk_bf16(f[2], f[3]); q0.z = pk_bf16(f[4], f[5]); q0.w = pk_bf16(f[6], f[7]);
      q1.x = pk_bf16(f[8], f[9]); q1.y = pk_bf16(f[10], f[11]); q1.z = pk_bf16(f[12], f[13]); q1.w = pk_bf16(f[14], f[15]);
      *(u32x4*)dst = q0; *(u32x4*)(dst + 8) = q1;
    }
  };
  UMeta mA, mB; u32x4 wA[16], wB[16];
  meta(0, mA); issue(mA, wA); meta(1, mB);
  for (int ti = 0; ti < 128; ti += 2) {
    issue(mB, wB);
    consume(ti, mA, wA);
    meta(ti + 2, mA);
    issue(mA, wA);
    consume(ti + 1, mB, wB);
    meta(ti + 3, mB);
  }
}
__device__ __forceinline__ void phase_ln3(const P& p, int tile) {
  const int tid = otid(), lane = tid & 63, wid = tid >> 6;
#pragma unroll 2
  for (int ti = 0; ti < 16; ++ti) {
    const long t = (long)tile * 128 + wid * 16 + ti;
    float4 v[4];
    float sum = 0.f;
#pragma unroll
    for (int j = 0; j < 4; ++j) {
      const int c0 = j * 256 + lane * 4;
      const u32x2 hv = *(const u32x2*)((const bf16_t*)p.H3 + t * DM + c0);
      const u32x2 xv = *(const u32x2*)(p.X2 + t * DM + c0);
      v[j].x = bf_lo(hv.x) + ALPHA * bf_lo(xv.x); v[j].y = bf_hi(hv.x) + ALPHA * bf_hi(xv.x); v[j].z = bf_lo(hv.y) + ALPHA * bf_lo(xv.y); v[j].w = bf_hi(hv.y) + ALPHA * bf_hi(xv.y);
      sum += (v[j].x + v[j].y) + (v[j].z + v[j].w);
    }
#pragma unroll
    for (int o = 32; o > 0; o >>= 1) sum += __shfl_xor(sum, o);
    const float mu = sum * (1.f / DM);
    float q = 0.f;
#pragma unroll
    for (int j = 0; j < 4; ++j) { v[j].x -= mu; v[j].y -= mu; v[j].z -= mu; v[j].w -= mu; q += (v[j].x * v[j].x + v[j].y * v[j].y) + (v[j].z * v[j].z + v[j].w * v[j].w); }
#pragma unroll
    for (int o = 32; o > 0; o >>= 1) q += __shfl_xor(q, o);
    const float rstd = rsqrtf(q * (1.f / DM) + LN_EPS);
#pragma unroll
    for (int j = 0; j < 4; ++j) {
      const int c0 = j * 256 + lane * 4;
      const float4 gg = *(const float4*)(p.ln3_g + c0), bb = *(const float4*)(p.ln3_b + c0);
      float4 o; o.x = v[j].x * rstd * gg.x + bb.x; o.y = v[j].y * rstd * gg.y + bb.y; o.z = v[j].z * rstd * gg.z + bb.z; o.w = v[j].w * rstd * gg.w + bb.w;
      *(float4*)(p.out + t * DM + c0) = o;
    }
  }
}

__device__ __forceinline__ void prep_transpose_tile(const float* __restrict__ W, bf16_t* __restrict__ WT, int K, int N, int tileidx) {
  LAS float* scr = (LAS float*)smem_raw;
  const int ntn = N / 64, k0 = (tileidx / ntn) * 64, n0 = (tileidx % ntn) * 64, tid = threadIdx.x;
#pragma unroll
  for (int i = 0; i < 8; ++i) { const int e = tid + i * 512, kk = e >> 6, nn = e & 63; scr[kk * 65 + nn] = W[(long)(k0 + kk) * N + n0 + nn]; }
  __syncthreads();
#pragma unroll
  for (int i = 0; i < 4; ++i) { const int e = tid + i * 512, nn = e >> 5, kp = (e & 31) * 2; *(unsigned*)(WT + (long)(n0 + nn) * K + k0 + kp) = pk_bf16(scr[kp * 65 + nn], scr[(kp + 1) * 65 + nn]); }
  __syncthreads();
}
__device__ __forceinline__ void prep_quant_strip(const float* __restrict__ W, signed char* __restrict__ Q, float* __restrict__ sc, int K, int N, int strip) {
  LAS float* scr = (LAS float*)smem_raw;
  LAS float* pmax = scr + 64 * 65;
  LAS float* inv = pmax + 8 * 64;
  const int n0 = strip * 64, tid = threadIdx.x, nn = tid & 63, kg = tid >> 6;
  float amax = 0.f;
#pragma unroll 4
  for (int k0 = 0; k0 < K; k0 += 64)
#pragma unroll
    for (int i = 0; i < 8; ++i) amax = fmaxf(amax, fabsf(W[(long)(k0 + kg + 8 * i) * N + n0 + nn]));
  pmax[kg * 64 + nn] = amax;
  __syncthreads();
  if (tid < 64) {
    float m = 0.f;
#pragma unroll
    for (int j = 0; j < 8; ++j) m = fmaxf(m, pmax[j * 64 + tid]);
    inv[tid] = m > 0.f ? 127.f / m : 0.f;
    sc[n0 + tid] = m * (1.f / 127.f);
  }
  __syncthreads();
  const float iv = inv[nn];
  float cur[8];
#pragma unroll
  for (int i = 0; i < 8; ++i) cur[i] = W[(long)(kg + 8 * i) * N + n0 + nn];
  for (int k0 = 0; k0 < K; k0 += 64) {
    float nxt[8];
    const int k1 = k0 + 64 < K ? k0 + 64 : k0;
#pragma unroll
    for (int i = 0; i < 8; ++i) nxt[i] = W[(long)(k1 + kg + 8 * i) * N + n0 + nn];
#pragma unroll
    for (int i = 0; i < 8; ++i) { const int kk = kg + 8 * i; scr[kk * 65 + nn] = cur[i] * iv; }
#pragma unroll
    for (int i = 0; i < 8; ++i) cur[i] = nxt[i];
    __syncthreads();
#pragma unroll
    for (int i = 0; i < 2; ++i) {
      const int dd = tid + i * 512, n = dd >> 4, k4 = (dd & 15) * 4;
      *(unsigned*)(Q + (long)(n0 + n) * K + k0 + k4) = pack4_i8(scr[k4 * 65 + n], scr[(k4 + 1) * 65 + n], scr[(k4 + 2) * 65 + n], scr[(k4 + 3) * 65 + n]);
    }
    __syncthreads();
  }
}
__device__ __forceinline__ void prep_cvt(const float* __restrict__ in, bf16_t* __restrict__ out, long n8) {
  for (long i = (long)blockIdx.x * 512 + threadIdx.x; i < n8; i += (long)gridDim.x * 512) {
    const float4 a = *(const float4*)(in + i * 8), b = *(const float4*)(in + i * 8 + 4);
    u32x4 o; o.x = pk_bf16(a.x, a.y); o.y = pk_bf16(a.z, a.w); o.z = pk_bf16(b.x, b.y); o.w = pk_bf16(b.z, b.w);
    *(u32x4*)(out + i * 8) = o;
  }
}
__device__ __forceinline__ void phase_prep(const P& p) {
  const int T_IN = 16 * 40, T_SQ = 16 * 16, T_W2 = 16 * 32;
  const int total = T_IN + T_SQ + T_SQ + T_W2 + T_SQ + T_W2;
  for (int it = blockIdx.x; it < total; it += gridDim.x) {
    int r = it;
    if (r < T_IN) { if (r < 40) prep_quant_strip(p.w_in, p.w_inQ, p.sw_in, DM, INW, r); continue; } r -= T_IN;
    if (r < T_SQ) { if (r < 16) prep_quant_strip(p.w_mo, p.w_moQ, p.sw_mo, DM, DM, r); continue; } r -= T_SQ;
    if (r < T_SQ) { continue; } r -= T_SQ;
    if (r < T_W2) { prep_transpose_tile(p.w_xkv, (bf16_t*)p.w_xkvT, DM, 2048, r); continue; } r -= T_W2;
    if (r < T_SQ) { prep_transpose_tile(p.w_xo, (bf16_t*)p.w_xoT, DM, DM, r); continue; } r -= T_SQ;
    (void)r;
  }
  prep_cvt(p.mem, (bf16_t*)p.memB, (long)1024 * DM / 8);
  prep_cvt(p.sub_keys, (bf16_t*)p.skb, (long)8 * 2 * 128 * 128 / 8);
  prep_cvt(p.w_pq, (bf16_t*)p.wpqB, (long)DM * 2048 / 8);
  prep_cvt(p.w_xq, (bf16_t*)p.wxqB, (long)DM * DM / 8);
  {
    const int lane = threadIdx.x & 63, b = blockIdx.x;
    const bool strip_wg = b < 40 || (b >= 128 && b < 144);
    const int rank = b < 128 ? b - 40 : b - 144 + 88;
    {
    for (int row = strip_wg ? 2 * 16384 : rank * 8 + (threadIdx.x >> 6); row < 2 * 16384; row += 1600) {
      const int tb = row >> 14, e = row & 16383;
      const float* src = (tb ? p.w_up : p.w_down) + (long)e * DM;
      float4 v[4];
      float amax = 0.f;
#pragma unroll
      for (int i = 0; i < 4; ++i) { v[i] = *(const float4*)(src + 256 * i + lane * 4); amax = fmaxf(amax, fmaxf(fmaxf(fabsf(v[i].x), fabsf(v[i].y)), fmaxf(fabsf(v[i].z), fabsf(v[i].w)))); }
#pragma unroll
      for (int s = 32; s > 0; s >>= 1) amax = fmaxf(amax, __shfl_xor(amax, s));
      const float inv = amax > 0.f ? 127.f / amax : 0.f;
      unsigned char* dst = (unsigned char*)(tb ? p.WUq : p.WDq) + (long)e * DM;
      const float off = 0.f;
#pragma unroll
      for (int i = 0; i < 4; ++i) *(unsigned*)(dst + 256 * i + lane * 4) = pack4_i8(v[i].x * inv + off, v[i].y * inv + off, v[i].z * inv + off, v[i].w * inv + off);
      if (lane == 0) { float* sc = (float*)(tb ? p.su : p.sd); sc[e] = amax * (1.f / 127.f); }
    }
    }
  }
  for (int i = blockIdx.x * 512 + threadIdx.x; i < 4 * 128 * 128 / 2; i += gridDim.x * 512) {
    const int e = i * 2, t = (e >> 7) & 127, sidx = e & 127;
    const float2 v = *(const float2*)(p.w_sp + e);
    *(unsigned*)((bf16_t*)p.wsb + e) = pk_bf16(sidx <= t ? v.x : 0.f, (sidx + 1) <= t ? v.y : 0.f);
  }
}
__device__ __forceinline__ void phase_xcvt(const P& p, int tile) {
  const int lane = threadIdx.x & 63, wid = threadIdx.x >> 6;
  signed char* xq = (signed char*)(p.slabs + (size_t)tile * SLAB_BYTES + OFF_XB);
  float* sxr = (float*)(p.slabs + (size_t)tile * SLAB_BYTES + OFF_SXB);
#pragma unroll 2
  for (int i = 0; i < 16; ++i) {
    const int rl = wid * 16 + i;
    const float* src = p.x + ((long)tile * 128 + rl) * DM;
    float4 v[4];
    float amax = 0.f;
#pragma unroll
    for (int j = 0; j < 4; ++j) { v[j] = *(const float4*)(src + 256 * j + lane * 4); amax = fmaxf(amax, fmaxf(fmaxf(fabsf(v[j].x), fabsf(v[j].y)), fmaxf(fabsf(v[j].z), fabsf(v[j].w)))); }
#pragma unroll
    for (int o = 32; o > 0; o >>= 1) amax = fmaxf(amax, __shfl_xor(amax, o));
    const float inv = amax > 0.f ? 127.f / amax : 0.f;
#pragma unroll
    for (int j = 0; j < 4; ++j) *(unsigned*)(xq + rl * DM + 256 * j + lane * 4) = pack4_i8(v[j].x * inv, v[j].y * inv, v[j].z * inv, v[j].w * inv);
    if (lane == 0) sxr[rl] = amax * (1.f / 127.f);
  }
}
__device__ __forceinline__ void phase_halo(const P& p, int tile) {
  const int tid = otid();
  if (tid < 128) {
    const int rr = tid >> 6, c = (tid & 63) * 8;
    const bf16_t* zr = p.ZB + ((long)tile * 128 + 126 + rr) * INW;
    const u32x4 hb = *(const u32x4*)(zr + 1024 + c), gc = *(const u32x4*)(zr + 2048 + c);
    u32x4 o;
    o.x = pk_bf16(bf_lo(hb.x) * bf_lo(gc.x), bf_hi(hb.x) * bf_hi(gc.x)); o.y = pk_bf16(bf_lo(hb.y) * bf_lo(gc.y), bf_hi(hb.y) * bf_hi(gc.y));
    o.z = pk_bf16(bf_lo(hb.z) * bf_lo(gc.z), bf_hi(hb.z) * bf_hi(gc.z)); o.w = pk_bf16(bf_lo(hb.w) * bf_lo(gc.w), bf_hi(hb.w) * bf_hi(gc.w));
    *(u32x4*)(p.HALO + ((long)tile * 2 + rr) * 512 + c) = o;
  }
}

__device__ __forceinline__ P tile_view(const P& p, int tile) {
  P q = p;
  char* sl = p.slabs + (size_t)tile * SLAB_BYTES;
  const long t0 = (long)tile * 128;
  q.XB = (bf16_t*)(sl + OFF_XB) - t0 * DM; q.X1 = (bf16_t*)(sl + OFF_XB) - t0 * DM;
  q.experts = (int*)(sl + OFF_EXP) - t0 * 128; q.gates = (float*)(sl + OFF_GATE) - t0 * 128;
  q.ZB = (bf16_t*)(sl + OFF_ZB) - t0 * INW; q.PRE = (float*)((bf16_t*)(sl + OFF_ZB) - t0 * DM); q.KEYS = (unsigned*)((unsigned short*)(sl + OFF_ZB) - t0 * 2048);
  q.PD = (int*)(sl + OFF_ZB); q.H3 = (float*)((bf16_t*)(sl + OFF_ZB) - t0 * DM);
  q.VT = (bf16_t*)(sl + OFF_VT) - (long)tile * 4 * 128 * 128; q.X1Q = (unsigned char*)(sl + OFF_VT) - t0 * DM; q.XQ = (unsigned char*)(sl + OFF_X2Q) - t0 * DM;
  q.Y = (bf16_t*)(sl + OFF_Y) - t0 * DM; q.Pb = (bf16_t*)(sl + OFF_Y) - t0 * DM;
  q.Q = (bf16_t*)(sl + OFF_Q) - t0 * DM; q.X2 = (bf16_t*)(sl + OFF_Q) - t0 * DM; q.YQ = (signed char*)(sl + OFF_Q) - t0 * DM;
  return q;
}

#define XB_TMO      128
#define XB_XCNT(j)  (256  + 64 * (j))
#define XB_XSUB(j)  (1280 + 64 * (j))
#define XB_XGEN(j)  (2304 + 64 * (j))
#define XB_TOP      3328
#define XB_TOPGEN   3392
#define XB_SPIN_CAP (1u << 18)

__device__ __forceinline__ unsigned xb_ld(unsigned* p)              { return __hip_atomic_load(p, __ATOMIC_RELAXED, __HIP_MEMORY_SCOPE_AGENT); }
__device__ __forceinline__ unsigned xb_add(unsigned* p, unsigned v) { return __hip_atomic_fetch_add(p, v, __ATOMIC_RELAXED, __HIP_MEMORY_SCOPE_AGENT); }
__device__ __forceinline__ unsigned xb_xcc_id() { return (unsigned)__builtin_amdgcn_s_getreg((3 << 11) | 20) & 0xFu; }
#define XB_SPIN(cond, bar) do { unsigned _sp = 0; while (cond) { __builtin_amdgcn_s_sleep(1); \
    if ((++_sp & 255u) == 0u) { if (xb_ld(&(bar)[XB_TMO])) break; if (_sp > XB_SPIN_CAP) { atomicAdd(&(bar)[XB_TMO], 1u); break; } } } } while (0)

struct XcdBarrier {
    unsigned* bar; unsigned x;
    volatile LAS unsigned* st;
};

__device__ __forceinline__ XcdBarrier xcd_barrier_post(unsigned* bar, volatile LAS unsigned* st) {
    XcdBarrier b; b.bar = bar; b.x = xb_xcc_id(); b.st = st;
    if (threadIdx.x == 0) (void)xb_add(&bar[XB_XCNT(b.x)], 1u);
    return b;
}
__device__ __forceinline__ void xcd_barrier_complete(unsigned* bar, unsigned x, unsigned& nloc, unsigned& nx) {
    const unsigned G = gridDim.x * gridDim.y * gridDim.z;
    unsigned sum, cnt, mine, sp = 0u;
    for (;;) {
        sum = 0u; cnt = 0u; mine = 0u;
#pragma unroll
        for (unsigned j = 0; j < 16; ++j) { const unsigned c = xb_ld(&bar[XB_XCNT(j)]); sum += c; cnt += (c > 0u) ? 1u : 0u; mine = (j == x) ? c : mine; }
        if (sum == G) break;
        __builtin_amdgcn_s_sleep(1);
        if ((++sp & 255u) == 0u) { if (xb_ld(&bar[XB_TMO])) break; if (sp > XB_SPIN_CAP) { atomicAdd(&bar[XB_TMO], 1u); break; } }
    }
    nloc = mine > 0u ? mine : 1u; nx = cnt > 0u ? cnt : 1u;
}

__device__ __forceinline__ void xcd_barrier(const XcdBarrier& b) {
    asm volatile("s_waitcnt vmcnt(0)" ::: "memory");
    __syncthreads();
    if (threadIdx.x == 0) {
        unsigned* bar = b.bar;
        __builtin_amdgcn_s_waitcnt(0);
        unsigned nloc = b.st[0], nx = b.st[1];
        if (nloc == 0u) { xcd_barrier_complete(bar, b.x, nloc, nx); b.st[0] = nloc; b.st[1] = nx; }
        const unsigned old = xb_add(&bar[XB_XSUB(b.x)], 1u);
        const unsigned gen = old / nloc;
        if (old + 1u == (gen + 1u) * nloc) {
            __builtin_amdgcn_fence(__ATOMIC_RELEASE, "agent");
            asm volatile("s_waitcnt vmcnt(0)" ::: "memory");
            const unsigned og = xb_add(&bar[XB_TOP], 1u);
            const unsigned tg = og / nx;
            if (og + 1u == (tg + 1u) * nx) xb_add(&bar[XB_TOPGEN], 1u);
            else XB_SPIN(xb_ld(&bar[XB_TOPGEN]) == tg, bar);
            __builtin_amdgcn_fence(__ATOMIC_ACQUIRE, "agent");
            xb_add(&bar[XB_XGEN(b.x)], 1u);
            asm volatile("s_waitcnt vmcnt(0)" ::: "memory");
        } else {
            XB_SPIN(xb_ld(&bar[XB_XGEN(b.x)]) == gen, bar);
            __builtin_amdgcn_fence(__ATOMIC_ACQUIRE, "agent");
            asm volatile("s_waitcnt vmcnt(0)" ::: "memory");
        }
    }
    __syncthreads();
}


__global__ __launch_bounds__(512) void mega_k(P pg) {
  const int tile = blockIdx.x;
  volatile LAS unsigned* xbw = (volatile LAS unsigned*)((LAS char*)smem_raw + XB_LDS_OFF);
  if (threadIdx.x < 4) xbw[threadIdx.x] = 0u;
  __syncthreads();
  XcdBarrier xb = xcd_barrier_post(pg.bar, xbw);
  const P p = tile_view(pg, tile);
  phase_prep(pg);
  phase_xcvt(p, tile);
  xcd_barrier(xb);
  phase_inproj(p, tile);
  wg_sync_mem();
  phase_halo(p, tile);
  phase_kv(p, tile);
  if (tile < 64) phase_mt(p, tile);
  xcd_barrier(xb);
  phase_gh(p, tile);
  wg_sync_mem();
  phase_mixer(p, tile);
  wg_sync_mem();
  phase_outproj(p, tile);
  wg_sync_mem();
  xcd_barrier(xb);
  phase_gquant(pg);
  xcd_barrier(xb);
  phase_scores(p, tile);
  wg_sync_mem();
  phase_oproj(p, tile);
  wg_sync_mem();
  phase_pq(p, tile);
  wg_sync_mem();
  phase_route(p, tile);
  xcd_barrier(xb);
  phase_gdown(pg);
  xcd_barrier(xb);
  phase_gcomb(p, tile);
  xcd_barrier(xb);
  phase_gup(pg);
  xcd_barrier(xb);
  phase_ln3(p, tile);
}

extern "C" void kernel_launch(void* const* d_in, const int* in_sizes, int n_in, void* d_out, int out_size, void* d_ws, size_t ws_size, hipStream_t stream) {
  static int grid_blocks = 0;
  if (grid_blocks == 0) {
    int dev = 0, cus = 0, per_cu = 0;
    (void)hipGetDevice(&dev);
    (void)hipDeviceGetAttribute(&cus, hipDeviceAttributeMultiprocessorCount, dev);
    if (hipFuncSetAttribute((const void*)mega_k, hipFuncAttributeMaxDynamicSharedMemorySize, LDS_BYTES) != hipSuccess) fprintf(stderr, "kernel_launch: hipFuncSetAttribute failed\n");
    if (hipOccupancyMaxActiveBlocksPerMultiprocessor(&per_cu, (const void*)mega_k, 512, LDS_BYTES) != hipSuccess || per_cu < 1) { fprintf(stderr, "kernel_launch: occupancy query says %d blocks/CU\n", per_cu); per_cu = 1; }
    (void)hipGetLastError();
    grid_blocks = NTOK / 128;
    if (cus * per_cu < grid_blocks) fprintf(stderr, "kernel_launch: device holds only %d x %d resident blocks, need %d\n", cus, per_cu, grid_blocks);
  }
  char* w8 = (char*)d_ws;
  const size_t MiB = (size_t)1 << 20;
  P p{};
  p.x = (const float*)d_in[0]; p.mem = (const float*)d_in[1]; p.w_in = (const float*)d_in[2]; p.b_in = (const float*)d_in[3];
  p.sgu_g = (const float*)d_in[4]; p.sgu_b = (const float*)d_in[5]; p.w_sp = (const float*)d_in[6]; p.b_sp = (const float*)d_in[7];
  p.conv_w = (const float*)d_in[8]; p.w_mo = (const float*)d_in[9]; p.ln1_g = (const float*)d_in[10]; p.ln1_b = (const float*)d_in[11];
  p.w_xq = (const float*)d_in[12]; p.w_xkv = (const float*)d_in[13]; p.w_xo = (const float*)d_in[14]; p.ln2_g = (const float*)d_in[15]; p.ln2_b = (const float*)d_in[16];
  p.w_pq = (const float*)d_in[17]; p.sub_keys = (const float*)d_in[18]; p.w_down = (const float*)d_in[19]; p.w_up = (const float*)d_in[20];
  p.ln3_g = (const float*)d_in[21]; p.ln3_b = (const float*)d_in[22];
  p.out = (float*)d_out;
  p.slabs = w8;
  bf16_t* wb = (bf16_t*)(w8 + 384 * MiB);
  p.w_inT = wb; p.w_inQ = (signed char*)wb; wb += (size_t)INW * DM / 2; p.sw_in = (float*)wb; wb += 2 * INW; p.w_moT = wb; p.w_moQ = (signed char*)wb; wb += (size_t)DM * DM / 2; p.sw_mo = (float*)wb; wb += 2 * DM; p.wsb = wb; wb += 4 * 128 * 128;
  p.w_xqT = wb; p.GTq = (signed char*)wb; wb += (size_t)4 * 1024 * DM / 2; p.sG = (float*)wb; wb += 2 * 4096; p.w_xkvT = wb; wb += (size_t)2048 * DM; p.w_xoT = wb; wb += (size_t)DM * DM;
  p.memB = wb; wb += (size_t)1024 * DM; p.Kc = wb; wb += (size_t)1024 * DM; p.Vc = wb; wb += (size_t)1024 * DM; p.wxqB = wb; wb += (size_t)DM * DM; p.GTb = wb; wb += (size_t)4 * 1024 * DM; p.HT = wb; wb += (size_t)4 * 1024 * DM;
  p.w_pqT = wb; wb += (size_t)2048 * DM; p.MTq = (signed char*)wb; wb += (size_t)2048 * DM / 2; p.sMT = (float*)wb; wb += 2 * 2048; p.wpqB = wb; wb += (size_t)2048 * DM; p.skb = wb; wb += (size_t)8 * 2 * 128 * 128;
  p.WDq = (const unsigned char*)wb; wb += (size_t)16384 * DM / 2; p.WUq = (const unsigned char*)wb; wb += (size_t)16384 * DM / 2;
  p.sd = (const float*)wb; wb += 2 * 16384; p.su = (const float*)wb; wb += 2 * 16384;
  p.HALO = wb; wb += (size_t)256 * 2 * 512;
  p.SX = (float*)wb; wb += 2 * NTOK; p.SY = (float*)wb; wb += 2 * NTOK; p.SX1 = (float*)wb; wb += 2 * NTOK;
  p.bar = (unsigned*)wb; wb += 2 * 4096;
  if ((size_t)((char*)wb - w8) > ws_size) fprintf(stderr, "kernel_launch: workspace too small\n");
  (void)hipMemsetAsync(p.bar, 0, (XCD_BAR_WORDS + 128) * 4, stream);
  void* args[] = {&p};
  hipError_t e = hipLaunchCooperativeKernel((const void*)mega_k, dim3(grid_blocks), dim3(512), args, LDS_BYTES, stream);
  if (e != hipSuccess) fprintf(stderr, "cooperative launch failed: %s (grid %d)\n", hipGetErrorString(e), grid_blocks);
}
```

```cpp
#include <hip/hip_runtime.h>
#include <stdint.h>
#include <cstdio>

#define DM 1024
#define NTOK 32768
#define SEQ 8192
#define INW 2560
#define ALPHA 1.189207115002721f
#define LN_EPS 1e-5f

__device__ __forceinline__ float gelu_f(float v) {
  const float t = __builtin_amdgcn_rcpf(fabsf(v) * 0.2316418882f + 1.0f);
  float q = t * 0.5307027145f + (-0.7265760135f); q = q * t + 0.7107068705f; q = q * t + (-0.142248368f); q = q * t + 0.127414796f; q = q * t;
  const float e = __builtin_amdgcn_exp2f((v * v) * (-0.72134752044f));
  const float m = v * (q * e);
  return v < 0.f ? m : v - m;
}

typedef unsigned short bf16_t;
typedef short bf16x8 __attribute__((ext_vector_type(8)));
typedef float f32x4 __attribute__((ext_vector_type(4)));
typedef unsigned u32x4 __attribute__((ext_vector_type(4)));
typedef unsigned u32x2 __attribute__((ext_vector_type(2)));
#define LAS __attribute__((address_space(3)))
extern __shared__ __attribute__((aligned(16))) char smem_raw[];

typedef float f32x2_t __attribute__((ext_vector_type(2)));
typedef __bf16 bf16x2_t __attribute__((ext_vector_type(2)));
typedef _Float16 f16x2_t __attribute__((ext_vector_type(2)));
__device__ __forceinline__ unsigned pk_f16(float lo, float hi) { const f32x2_t v = {lo, hi}; return __builtin_bit_cast(unsigned, __builtin_convertvector(v, f16x2_t)); }
__device__ __forceinline__ float f16_lo(unsigned u) { return (float)__builtin_bit_cast(f16x2_t, u)[0]; }
__device__ __forceinline__ float f16_hi(unsigned u) { return (float)__builtin_bit_cast(f16x2_t, u)[1]; }
__device__ __forceinline__ unsigned pk_bf16(float lo, float hi) { const f32x2_t v = {lo, hi}; return __builtin_bit_cast(unsigned, __builtin_convertvector(v, bf16x2_t)); }
__device__ __forceinline__ int otid() { int t = threadIdx.x; asm volatile("" : "+v"(t)); return t; }
template <int CTRL> __device__ __forceinline__ float dppf_(float x) { return __int_as_float(__builtin_amdgcn_mov_dpp(__float_as_int(x), CTRL, 0xf, 0xf, true)); }
__device__ __forceinline__ float wave_sum_f(float x) {
  x += dppf_<0x128>(x); x += dppf_<0x124>(x); x += dppf_<0x122>(x); x += dppf_<0x121>(x);
  x += __shfl_xor(x, 16); x += __shfl_xor(x, 32); return x;
}
__device__ __forceinline__ float wave_max_f(float x) {
  x = fmaxf(x, dppf_<0x128>(x)); x = fmaxf(x, dppf_<0x124>(x)); x = fmaxf(x, dppf_<0x122>(x)); x = fmaxf(x, dppf_<0x121>(x));
  x = fmaxf(x, __shfl_xor(x, 16)); x = fmaxf(x, __shfl_xor(x, 32)); return x;
}
__device__ __forceinline__ unsigned pack4_i8(float a, float b, float c, float d) {
  const int ia = __float2int_rn(a), ib = __float2int_rn(b), ic = __float2int_rn(c), id = __float2int_rn(d);
  return ((unsigned)ia & 0xffu) | (((unsigned)ib & 0xffu) << 8) | (((unsigned)ic & 0xffu) << 16) | ((unsigned)id << 24);
}
__device__ __forceinline__ float bf_lo(unsigned u) { return __uint_as_float(u << 16); }
__device__ __forceinline__ float bf_hi(unsigned u) { return __uint_as_float(u & 0xffff0000u); }

__device__ __forceinline__ int swz(int row) { return (((row >> 1) & 1) << 2) | (((row >> 3) & 1) << 1); }
template <int BN, class Epi>
__device__ __forceinline__ void wg_gemm(const bf16_t* __restrict__ A, int lda, const bf16_t* __restrict__ Bt, int ldb, int K, Epi&& epi) {
  constexpr int NT = BN / 64;
  constexpr int STAGE_BYTES = (128 + BN) * 128;
  constexpr int LA = 2, LB = BN / 64;
  LAS char* lds = (LAS char*)smem_raw;
  const int tid = otid(), lane = tid & 63, wid = tid >> 6, wr = wid >> 2, wc = wid & 3, fr = lane & 15, fq = lane >> 4;
  f32x4 acc[4][NT];
#pragma unroll
  for (int m = 0; m < 4; ++m)
#pragma unroll
    for (int n = 0; n < NT; ++n) acc[m][n] = (f32x4){0.f, 0.f, 0.f, 0.f};
  const int nk = K / 64;
  auto piece = [&](int buf, int kt, int i) {
    LAS char* base = lds + buf * STAGE_BYTES;
    if (i < LA) {
      const int q = tid + i * 512, row = q >> 3, c = (q & 7) ^ swz(row);
      __builtin_amdgcn_global_load_lds((const unsigned*)(A + (long)row * lda + kt * 64 + c * 8), (LAS unsigned*)(base + q * 16), 16, 0, 2);
    } else {
      const int q = tid + (i - LA) * 512, row = q >> 3, c = (q & 7) ^ swz(row);
      __builtin_amdgcn_global_load_lds((const unsigned*)(Bt + (long)row * ldb + kt * 64 + c * 8), (LAS unsigned*)(base + 16384 + q * 16), 16, 0, 0);
    }
  };
  auto stage = [&](int buf, int kt) {
#pragma unroll
    for (int i = 0; i < LA + LB; ++i) piece(buf, kt, i);
  };
  __builtin_amdgcn_s_barrier();
  asm volatile("" ::: "memory");
  stage(0, 0);
  if (nk > 1) stage(1, 1);
  for (int kt = 0; kt < nk; ++kt) {
    if (kt + 1 < nk) asm volatile("s_waitcnt vmcnt(%0)" ::"n"(LA + LB) : "memory");
    else asm volatile("s_waitcnt vmcnt(0)" ::: "memory");
    __builtin_amdgcn_s_barrier();
    asm volatile("" ::: "memory");
    LAS const char* base = lds + (kt % 3) * STAGE_BYTES;
    bf16x8 af[4][2], bfr[NT][2];
#pragma unroll
    for (int m = 0; m < 4; ++m)
#pragma unroll
      for (int kk = 0; kk < 2; ++kk) {
        const int row = wr * 64 + m * 16 + fr, c = (kk * 4 + fq) ^ swz(fr);
        af[m][kk] = *(LAS const bf16x8*)(base + row * 128 + c * 16);
      }
#pragma unroll
    for (int n = 0; n < NT; ++n)
#pragma unroll
      for (int kk = 0; kk < 2; ++kk) {
        const int row = wc * (BN / 4) + n * 16 + fr, c = (kk * 4 + fq) ^ swz(fr);
        bfr[n][kk] = *(LAS const bf16x8*)(base + 16384 + row * 128 + c * 16);
      }
#pragma unroll
    for (int kk = 0; kk < 2; ++kk)
#pragma unroll
      for (int m = 0; m < 4; ++m) {
        if (kk * 4 + m < LA + LB) {
          __builtin_amdgcn_sched_barrier(0);
          if (kt + 2 < nk) piece((kt + 2) % 3, kt + 2, kk * 4 + m);
          __builtin_amdgcn_sched_barrier(0);
        }
#pragma unroll
        for (int n = 0; n < NT; ++n) acc[m][n] = __builtin_amdgcn_mfma_f32_16x16x32_bf16(bfr[n][kk], af[m][kk], acc[m][n], 0, 0, 0);
      }
  }
  epi(acc, wr, wc, fr, fq);
}

typedef int v4i_t __attribute__((ext_vector_type(4)));
template <int BN, class Epi>
__device__ __forceinline__ void wg_gemm_i8(const signed char* __restrict__ A, int lda, const signed char* __restrict__ Bt, int ldb, int K, Epi&& epi) {
  constexpr int NT = BN / 64;
  constexpr int STAGE_BYTES = (128 + BN) * 128;
  constexpr int LA = 2, LB = BN / 64;
  LAS char* lds = (LAS char*)smem_raw;
  const int tid = otid(), lane = tid & 63, wid = tid >> 6, wr = wid >> 2, wc = wid & 3, fr = lane & 15, fq = lane >> 4;
  v4i_t acc[4][NT];
#pragma unroll
  for (int m = 0; m < 4; ++m)
#pragma unroll
    for (int n = 0; n < NT; ++n) acc[m][n] = (v4i_t){0, 0, 0, 0};
  const int nk = K / 128;
  auto piece = [&](int buf, int kt, int i) {
    LAS char* base = lds + buf * STAGE_BYTES;
    if (i < LA) {
      const int q = tid + i * 512, row = q >> 3, c = (q & 7) ^ swz(row);
      __builtin_amdgcn_global_load_lds((const unsigned*)(A + (long)row * lda + kt * 128 + c * 16), (LAS unsigned*)(base + q * 16), 16, 0, 2);
    } else {
      const int q = tid + (i - LA) * 512, row = q >> 3, c = (q & 7) ^ swz(row);
      __builtin_amdgcn_global_load_lds((const unsigned*)(Bt + (long)row * ldb + kt * 128 + c * 16), (LAS unsigned*)(base + 16384 + q * 16), 16, 0, 0);
    }
  };
  auto stage = [&](int buf, int kt) {
#pragma unroll
    for (int i = 0; i < LA + LB; ++i) piece(buf, kt, i);
  };
  __builtin_amdgcn_s_barrier();
  asm volatile("" ::: "memory");
  stage(0, 0);
  if (nk > 1) stage(1, 1);
  for (int kt = 0; kt < nk; ++kt) {
    if (kt + 1 < nk) asm volatile("s_waitcnt vmcnt(%0)" ::"n"(LA + LB) : "memory");
    else asm volatile("s_waitcnt vmcnt(0)" ::: "memory");
    __builtin_amdgcn_s_barrier();
    asm volatile("" ::: "memory");
    LAS const char* base = lds + (kt % 3) * STAGE_BYTES;
    v4i_t af[4][2], bfr[NT][2];
#pragma unroll
    for (int m = 0; m < 4; ++m)
#pragma unroll
      for (int kk = 0; kk < 2; ++kk) {
        const int row = wr * 64 + m * 16 + fr, c = (kk * 4 + fq) ^ swz(fr);
        af[m][kk] = *(LAS const v4i_t*)(base + row * 128 + c * 16);
      }
#pragma unroll
    for (int n = 0; n < NT; ++n)
#pragma unroll
      for (int kk = 0; kk < 2; ++kk) {
        const int row = wc * (BN / 4) + n * 16 + fr, c = (kk * 4 + fq) ^ swz(fr);
        bfr[n][kk] = *(LAS const v4i_t*)(base + 16384 + row * 128 + c * 16);
      }
#pragma unroll
    for (int kk = 0; kk < 2; ++kk)
#pragma unroll
      for (int m = 0; m < 4; ++m) {
        if (kk * 4 + m < LA + LB) {
          __builtin_amdgcn_sched_barrier(0);
          if (kt + 2 < nk) piece((kt + 2) % 3, kt + 2, kk * 4 + m);
          __builtin_amdgcn_sched_barrier(0);
        }
#pragma unroll
        for (int n = 0; n < NT; ++n) acc[m][n] = __builtin_amdgcn_mfma_i32_16x16x64_i8(bfr[n][kk], af[m][kk], acc[m][n], 0, 0, 0);
      }
  }
  epi(acc, wr, wc, fr, fq);
}

#define XCD_BAR_WORDS 3456
#define GEMM_LDS_BYTES (3 * (128 + 256) * 128)
#define RED_OFF GEMM_LDS_BYTES
#define XB_LDS_OFF (GEMM_LDS_BYTES + 4096)
#define LDS_BYTES (GEMM_LDS_BYTES + 4096 + 16)

struct P {
  const float* x; const float* mem; const float* b_in; const float* sgu_g; const float* sgu_b; const float* b_sp; const float* conv_w;
  const float* ln1_g; const float* ln1_b; const float* ln2_g; const float* ln2_b; const float* ln3_g; const float* ln3_b;
  const bf16_t* XB; const bf16_t* w_inT; const bf16_t* w_moT; const bf16_t* wsb;
  bf16_t* ZB; bf16_t* VT; bf16_t* Y; float* PRE; bf16_t* X1;
  const bf16_t* w_xqT; const bf16_t* w_xkvT; const bf16_t* w_xoT; const bf16_t* memB;
  bf16_t* Kc; bf16_t* Vc; bf16_t* Q; bf16_t* Pb; bf16_t* X2;
  const bf16_t* wxqB; bf16_t* GTb; bf16_t* HT;
  const bf16_t* w_pqT;
  const bf16_t* wpqB;
  const bf16_t* skb; unsigned* KEYS; unsigned char* X1Q; int* experts; float* gates;
  const unsigned char* WDq; const unsigned char* WUq; const float* sd; const float* su; float* out;
  signed char* w_inQ; float* sw_in; signed char* GTq; float* sG; signed char* MTq; float* sMT; signed char* w_moQ; float* sw_mo; signed char* YQ; float* SY; float* SX1;
  char* slabs;
  unsigned* bar; unsigned char* XQ; float* SX; int* PD; float* H3;
  bf16_t* HALO;
  const float* w_in; const float* w_mo; const float* w_sp; const float* w_xq; const float* w_xkv; const float* w_xo; const float* w_pq; const float* sub_keys; const float* w_down; const float* w_up;
};

#define SLAB_BYTES (1536 * 1024)
#define OFF_XB 0
#define OFF_EXP 0
#define OFF_GATE (64 * 1024)
#define OFF_CQ (128 * 1024)
#define OFF_SC (144 * 1024)
#define OFF_X2Q (128 * 1024)
#define OFF_ZB (256 * 1024)
#define OFF_VT (896 * 1024)
#define OFF_Y (1024 * 1024)
#define OFF_Q (1280 * 1024)
__device__ __forceinline__ void wg_sync_mem() { asm volatile("s_waitcnt vmcnt(0) lgkmcnt(0)" ::: "memory"); __syncthreads(); }

#define OFF_SXB (128 * 1024)
__device__ __forceinline__ void phase_inproj(const P& p, int tile) {
  const signed char* xq = (const signed char*)(p.slabs + (size_t)tile * SLAB_BYTES + OFF_XB);
  const float* sxr = (const float*)(p.slabs + (size_t)tile * SLAB_BYTES + OFF_SXB);
  for (int nt = 0; nt < INW / 256; ++nt) {
    wg_gemm_i8<256>(xq, DM, p.w_inQ + (long)nt * 256 * DM, DM, DM, [&](v4i_t (&acc)[4][4], int wr, int wc, int fr, int fq) {
#pragma unroll
      for (int m = 0; m < 4; ++m) {
        const int rl = wr * 64 + m * 16 + fr;
        const float sr = sxr[rl];
#pragma unroll
        for (int n = 0; n < 4; ++n) {
          const int row = tile * 128 + rl, col = nt * 256 + wc * 64 + n * 16 + fq * 4;
          const float4 bv = *(const float4*)(p.b_in + col), sw = *(const float4*)(p.sw_in + col);
          float o0 = (float)acc[m][n][0] * (sr * sw.x) + bv.x, o1 = (float)acc[m][n][1] * (sr * sw.y) + bv.y, o2 = (float)acc[m][n][2] * (sr * sw.z) + bv.z, o3 = (float)acc[m][n][3] * (sr * sw.w) + bv.w;
          if (nt < 4) { o0 = gelu_f(o0); o1 = gelu_f(o1); o2 = gelu_f(o2); o3 = gelu_f(o3); }
          u32x2 w; w.x = pk_bf16(o0, o1); w.y = pk_bf16(o2, o3);
          *(u32x2*)(p.ZB + (long)row * INW + col) = w;
        }
      }
    });
  }
}

__device__ __forceinline__ void phase_mixer(const P& p, int tile) {
  const int tid = otid(), lane = tid & 63, wid = tid >> 6;
  const long t0 = (long)tile * 128;
  const bool seq_start = ((tile & 63) == 0);
  {
    const int c = (tid & 63) * 8, s0 = (tid >> 6) * 16;
    float w[3][8];
#pragma unroll
    for (int k = 0; k < 3; ++k) {
      const float4 w0 = *(const float4*)(p.conv_w + k * 512 + c), w1 = *(const float4*)(p.conv_w + k * 512 + c + 4);
      w[k][0] = w0.x; w[k][1] = w0.y; w[k][2] = w0.z; w[k][3] = w0.w; w[k][4] = w1.x; w[k][5] = w1.y; w[k][6] = w1.z; w[k][7] = w1.w;
    }
    float p2[8], p1[8];
    auto prod_row = [&](int rl, float (&pr)[8]) {
      if (rl >= 0) {
        const bf16_t* zr = p.ZB + (t0 + rl) * INW;
        const u32x4 hb = *(const u32x4*)(zr + 1024 + c), gc = *(const u32x4*)(zr + 2048 + c);
        pr[0] = bf_lo(hb.x) * bf_lo(gc.x); pr[1] = bf_hi(hb.x) * bf_hi(gc.x); pr[2] = bf_lo(hb.y) * bf_lo(gc.y); pr[3] = bf_hi(hb.y) * bf_hi(gc.y);
        pr[4] = bf_lo(hb.z) * bf_lo(gc.z); pr[5] = bf_hi(hb.z) * bf_hi(gc.z); pr[6] = bf_lo(hb.w) * bf_lo(gc.w); pr[7] = bf_hi(hb.w) * bf_hi(gc.w);
      } else if (!seq_start) {
        const u32x4 zc = *(const u32x4*)(p.HALO + ((long)(tile - 1) * 2 + (rl + 2)) * 512 + c);
        pr[0] = bf_lo(zc.x); pr[1] = bf_hi(zc.x); pr[2] = bf_lo(zc.y); pr[3] = bf_hi(zc.y); pr[4] = bf_lo(zc.z); pr[5] = bf_hi(zc.z); pr[6] = bf_lo(zc.w); pr[7] = bf_hi(zc.w);
      } else {
#pragma unroll
        for (int j = 0; j < 8; ++j) pr[j] = 0.f;
      }
    };
    prod_row(s0 - 2, p2);
    prod_row(s0 - 1, p1);
#pragma unroll 4
    for (int i = 0; i < 16; ++i) {
      const long t = t0 + s0 + i;
      float p0[8];
      prod_row(s0 + i, p0);
      const u32x4 gb = *(const u32x4*)(p.ZB + t * INW + 1536 + c);
      float conv[8];
#pragma unroll
      for (int j = 0; j < 8; ++j) conv[j] = w[0][j] * p2[j] + w[1][j] * p1[j] + w[2][j] * p0[j];
      u32x4 o;
      o.x = pk_bf16(bf_lo(gb.x) * conv[0], bf_hi(gb.x) * conv[1]); o.y = pk_bf16(bf_lo(gb.y) * conv[2], bf_hi(gb.y) * conv[3]);
      o.z = pk_bf16(bf_lo(gb.z) * conv[4], bf_hi(gb.z) * conv[5]); o.w = pk_bf16(bf_lo(gb.w) * conv[6], bf_hi(gb.w) * conv[7]);
      *(u32x4*)(p.Y + t * DM + 512 + c) = o;
#pragma unroll
      for (int j = 0; j < 8; ++j) { p2[j] = p1[j]; p1[j] = p0[j]; }
    }
  }
  for (int h = 0; h < 4; ++h) {
    float a0[16], a1[16];
    const float g0 = p.sgu_g[h * 128 + 2 * lane], g1 = p.sgu_g[h * 128 + 2 * lane + 1], b0 = p.sgu_b[h * 128 + 2 * lane], b1 = p.sgu_b[h * 128 + 2 * lane + 1];
#pragma unroll
    for (int i = 0; i < 16; ++i) {
      const unsigned v = *(const unsigned*)(p.ZB + (t0 + wid * 16 + i) * INW + 512 + h * 128 + 2 * lane);
      const float x0 = bf_lo(v), x1 = bf_hi(v);
      float sum = x0 + x1;
      sum = wave_sum_f(sum);
      const float mu = sum * (1.f / 128.f);
      const float d0 = x0 - mu, d1 = x1 - mu;
      float q = d0 * d0 + d1 * d1;
      q = wave_sum_f(q);
      const float rstd = rsqrtf(q * (1.f / 128.f) + LN_EPS);
      a0[i] = d0 * rstd * g0 + b0; a1[i] = d1 * rstd * g1 + b1;
    }
    bf16_t* vt = p.VT + ((long)tile * 4 + h) * 128 * 128;
    u32x4 o;
    o.x = pk_bf16(a0[0], a0[1]); o.y = pk_bf16(a0[2], a0[3]); o.z = pk_bf16(a0[4], a0[5]); o.w = pk_bf16(a0[6], a0[7]);
    *(u32x4*)(vt + (2 * lane) * 128 + wid * 16) = o;
    o.x = pk_bf16(a0[8], a0[9]); o.y = pk_bf16(a0[10], a0[11]); o.z = pk_bf16(a0[12], a0[13]); o.w = pk_bf16(a0[14], a0[15]);
    *(u32x4*)(vt + (2 * lane) * 128 + wid * 16 + 8) = o;
    o.x = pk_bf16(a1[0], a1[1]); o.y = pk_bf16(a1[2], a1[3]); o.z = pk_bf16(a1[4], a1[5]); o.w = pk_bf16(a1[6], a1[7]);
    *(u32x4*)(vt + (2 * lane + 1) * 128 + wid * 16) = o;
    o.x = pk_bf16(a1[8], a1[9]); o.y = pk_bf16(a1[10], a1[11]); o.z = pk_bf16(a1[12], a1[13]); o.w = pk_bf16(a1[14], a1[15]);
    *(u32x4*)(vt + (2 * lane + 1) * 128 + wid * 16 + 8) = o;
  }
  wg_sync_mem();
  for (int h = 0; h < 4; ++h) {
    wg_gemm<128>(p.wsb + h * 128 * 128, 128, p.VT + ((long)tile * 4 + h) * 128 * 128, 128, 128, [&](f32x4 (&acc)[4][2], int wr, int wc, int fr, int fq) {
#pragma unroll
      for (int m = 0; m < 4; ++m)
#pragma unroll
        for (int n = 0; n < 2; ++n) {
          const int rl = wr * 64 + m * 16 + fr, col = wc * 32 + n * 16 + fq * 4;
          const float bs = p.b_sp[h * 128 + rl];
          const u32x2 uv = *(const u32x2*)(p.ZB + (t0 + rl) * INW + h * 128 + col);
          u32x2 w;
          w.x = pk_bf16(bf_lo(uv.x) * (acc[m][n][0] + bs), bf_hi(uv.x) * (acc[m][n][1] + bs));
          w.y = pk_bf16(bf_lo(uv.y) * (acc[m][n][2] + bs), bf_hi(uv.y) * (acc[m][n][3] + bs));
          *(u32x2*)(p.Y + (t0 + rl) * DM + h * 128 + col) = w;
        }
    });
  }
}

__device__ __forceinline__ void ln_rows16(const float* __restrict__ PRE, long r0, const float* __restrict__ g, const float* __restrict__ b, bf16_t* __restrict__ Out, int lane) {
#pragma unroll 2
  for (int i = 0; i < 16; ++i) {
    const bf16_t* pr = (const bf16_t*)PRE + (r0 + i) * DM;
    float4 v[4];
    float sum = 0.f;
#pragma unroll
    for (int j = 0; j < 4; ++j) { const u32x2 pv = *(const u32x2*)(pr + j * 256 + lane * 4); v[j].x = bf_lo(pv.x); v[j].y = bf_hi(pv.x); v[j].z = bf_lo(pv.y); v[j].w = bf_hi(pv.y); sum += (v[j].x + v[j].y) + (v[j].z + v[j].w); }
    sum = wave_sum_f(sum);
    const float mu = sum * (1.f / DM);
    float q = 0.f;
#pragma unroll
    for (int j = 0; j < 4; ++j) { v[j].x -= mu; v[j].y -= mu; v[j].z -= mu; v[j].w -= mu; q += (v[j].x * v[j].x + v[j].y * v[j].y) + (v[j].z * v[j].z + v[j].w * v[j].w); }
    q = wave_sum_f(q);
    const float rstd = rsqrtf(q * (1.f / DM) + LN_EPS);
#pragma unroll
    for (int j = 0; j < 4; ++j) {
      const int c0 = j * 256 + lane * 4;
      const float4 gg = *(const float4*)(g + c0), bb = *(const float4*)(b + c0);
      u32x2 w; w.x = pk_bf16(v[j].x * rstd * gg.x + bb.x, v[j].y * rstd * gg.y + bb.y); w.y = pk_bf16(v[j].z * rstd * gg.z + bb.z, v[j].w * rstd * gg.w + bb.w);
      *(u32x2*)(Out + (r0 + i) * DM + c0) = w;
    }
  }
}

__device__ __forceinline__ void ln_rows16_q(const float* __restrict__ PRE, long r0, const float* __restrict__ g, const float* __restrict__ b, bf16_t* __restrict__ Out,
                                            unsigned char* __restrict__ XQ, float* __restrict__ SX, int lane) {
#pragma unroll 2
  for (int i = 0; i < 16; ++i) {
    const bf16_t* pr = (const bf16_t*)PRE + (r0 + i) * DM;
    float4 v[4];
    float sum = 0.f;
#pragma unroll
    for (int j = 0; j < 4; ++j) { const u32x2 pv = *(const u32x2*)(pr + j * 256 + lane * 4); v[j].x = bf_lo(pv.x); v[j].y = bf_hi(pv.x); v[j].z = bf_lo(pv.y); v[j].w = bf_hi(pv.y); sum += (v[j].x + v[j].y) + (v[j].z + v[j].w); }
    sum = wave_sum_f(sum);
    const float mu = sum * (1.f / DM);
    float q = 0.f;
#pragma unroll
    for (int j = 0; j < 4; ++j) { v[j].x -= mu; v[j].y -= mu; v[j].z -= mu; v[j].w -= mu; q += (v[j].x * v[j].x + v[j].y * v[j].y) + (v[j].z * v[j].z + v[j].w * v[j].w); }
    q = wave_sum_f(q);
    const float rstd = rsqrtf(q * (1.f / DM) + LN_EPS);
    float amax = 0.f;
#pragma unroll
    for (int j = 0; j < 4; ++j) {
      const int c0 = j * 256 + lane * 4;
      const float4 gg = *(const float4*)(g + c0), bb = *(const float4*)(b + c0);
      v[j].x = v[j].x * rstd * gg.x + bb.x; v[j].y = v[j].y * rstd * gg.y + bb.y; v[j].z = v[j].z * rstd * gg.z + bb.z; v[j].w = v[j].w * rstd * gg.w + bb.w;
      u32x2 w; w.x = pk_bf16(v[j].x, v[j].y); w.y = pk_bf16(v[j].z, v[j].w);
      *(u32x2*)(Out + (r0 + i) * DM + c0) = w;
      amax = fmaxf(amax, fmaxf(fmaxf(fabsf(v[j].x), fabsf(v[j].y)), fmaxf(fabsf(v[j].z), fabsf(v[j].w))));
    }
    amax = wave_max_f(amax);
    const float inv = amax > 0.f ? 127.f / amax : 0.f;
#pragma unroll
    for (int j = 0; j < 4; ++j) *(unsigned*)(XQ + (r0 + i) * DM + j * 256 + lane * 4) = pack4_i8(v[j].x * inv, v[j].y * inv, v[j].z * inv, v[j].w * inv);
    if (lane == 0) SX[r0 + i] = amax * (1.f / 127.f);
  }
}

__device__ __forceinline__ void phase_outproj(const P& p, int tile) {
  const long t0 = (long)tile * 128;
  {
    const int lane = threadIdx.x & 63, wid = threadIdx.x >> 6;
#pragma unroll 2
    for (int i = 0; i < 16; ++i) {
      const long row = t0 + wid * 16 + i;
      u32x2 v[4];
      float amax = 0.f;
#pragma unroll
      for (int j = 0; j < 4; ++j) {
        v[j] = *(const u32x2*)(p.Y + row * DM + 256 * j + lane * 4);
        amax = fmaxf(amax, fmaxf(fmaxf(fabsf(bf_lo(v[j].x)), fabsf(bf_hi(v[j].x))), fmaxf(fabsf(bf_lo(v[j].y)), fabsf(bf_hi(v[j].y)))));
      }
      amax = wave_max_f(amax);
      const float inv = amax > 0.f ? 127.f / amax : 0.f;
#pragma unroll
      for (int j = 0; j < 4; ++j) *(unsigned*)(p.YQ + row * DM + 256 * j + lane * 4) = pack4_i8(bf_lo(v[j].x) * inv, bf_hi(v[j].x) * inv, bf_lo(v[j].y) * inv, bf_hi(v[j].y) * inv);
      if (lane == 0) p.SY[row] = amax * (1.f / 127.f);
    }
  }
  wg_sync_mem();
  for (int nt = 0; nt < 4; ++nt) {
    wg_gemm_i8<256>(p.YQ + t0 * DM, DM, p.w_moQ + (long)nt * 256 * DM, DM, DM, [&](v4i_t (&acc)[4][4], int wr, int wc, int fr, int fq) {
#pragma unroll
      for (int m = 0; m < 4; ++m) {
        const long row = t0 + wr * 64 + m * 16 + fr;
        const float sr = p.SY[row];
#pragma unroll
        for (int n = 0; n < 4; ++n) {
          const int col = nt * 256 + wc * 64 + n * 16 + fq * 4;
          const float4 xv = *(const float4*)(p.x + row * DM + col);
          const float4 sw = *(const float4*)(p.sw_mo + col);
          u32x2 o; o.x = pk_bf16(ALPHA * xv.x + (float)acc[m][n][0] * (sr * sw.x), ALPHA * xv.y + (float)acc[m][n][1] * (sr * sw.y));
          o.y = pk_bf16(ALPHA * xv.z + (float)acc[m][n][2] * (sr * sw.z), ALPHA * xv.w + (float)acc[m][n][3] * (sr * sw.w));
          *(u32x2*)((bf16_t*)p.PRE + row * DM + col) = o;
        }
      }
    });
  }
  wg_sync_mem();
  ln_rows16_q(p.PRE, t0 + (threadIdx.x >> 6) * 16, p.ln1_g, p.ln1_b, p.X1, p.X1Q, p.SX1, threadIdx.x & 63);
}

__device__ __forceinline__ void phase_kv(const P& p, int unit) {
  const int rt = unit >> 5, nc = unit & 31;
  wg_gemm<64>(p.memB + (long)rt * 128 * DM, DM, p.w_xkvT + (long)nc * 64 * DM, DM, DM, [&](f32x4 (&acc)[4][1], int wr, int wc, int fr, int fq) {
    const int b = rt >> 1, col = nc * 64 + wc * 16 + fq * 4, hh = (col >> 8) & 3, d = col & 255;
#pragma unroll
    for (int m = 0; m < 4; ++m) {
      const int mm = (rt & 1) * 128 + wr * 64 + m * 16 + fr;
      u32x2 w; w.x = pk_bf16(acc[m][0][0], acc[m][0][1]); w.y = pk_bf16(acc[m][0][2], acc[m][0][3]);
      *(u32x2*)((col < 1024 ? p.Kc : p.Vc) + ((long)(b * 4 + hh) * 256 + mm) * 256 + d) = w;
    }
  });
}

__device__ __forceinline__ void phase_gh(const P& p, int unit) {
  if (unit < 128) {
    const int bh = unit >> 3, rt = (unit >> 2) & 1, nt = unit & 3, h = bh & 3, b = bh >> 2;
    wg_gemm<256>(p.Kc + ((long)bh * 256 + rt * 128) * 256, 256, p.wxqB + (long)nt * 256 * DM + h * 256, DM, 256, [&](f32x4 (&acc)[4][4], int wr, int wc, int fr, int fq) {
#pragma unroll
      for (int m = 0; m < 4; ++m)
#pragma unroll
        for (int n = 0; n < 4; ++n) {
          const long row = (long)b * 1024 + h * 256 + rt * 128 + wr * 64 + m * 16 + fr; const int col = nt * 256 + wc * 64 + n * 16 + fq * 4;
          u32x2 w; w.x = pk_bf16(acc[m][n][0], acc[m][n][1]); w.y = pk_bf16(acc[m][n][2], acc[m][n][3]);
          *(u32x2*)(p.GTb + row * DM + col) = w;
        }
    });
  } else {
    const int u = unit - 128, bh = u >> 3, rt = u & 7, h = bh & 3, b = bh >> 2;
    wg_gemm<256>(p.w_xoT + (long)rt * 128 * DM + h * 256, DM, p.Vc + (long)bh * 256 * 256, 256, 256, [&](f32x4 (&acc)[4][4], int wr, int wc, int fr, int fq) {
#pragma unroll
      for (int m = 0; m < 4; ++m)
#pragma unroll
        for (int n = 0; n < 4; ++n) {
          const long row = (long)b * 1024 + rt * 128 + wr * 64 + m * 16 + fr; const int col = h * 256 + wc * 64 + n * 16 + fq * 4;
          u32x2 w; w.x = pk_bf16(acc[m][n][0], acc[m][n][1]); w.y = pk_bf16(acc[m][n][2], acc[m][n][3]);
          *(u32x2*)(p.HT + row * DM + col) = w;
        }
    });
  }
}

__device__ __forceinline__ void phase_gquant(const P& p) {
  const int lane = threadIdx.x & 63, wid = threadIdx.x >> 6;
#pragma unroll
  for (int i = 0; i < 2; ++i) {
    const long row = (long)blockIdx.x * 16 + wid * 2 + i;
    u32x2 v[4];
    float amax = 0.f;
#pragma unroll
    for (int j = 0; j < 4; ++j) {
      v[j] = *(const u32x2*)(p.GTb + row * DM + 256 * j + lane * 4);
      amax = fmaxf(amax, fmaxf(fmaxf(fabsf(bf_lo(v[j].x)), fabsf(bf_hi(v[j].x))), fmaxf(fabsf(bf_lo(v[j].y)), fabsf(bf_hi(v[j].y)))));
    }
    amax = wave_max_f(amax);
    const float inv = amax > 0.f ? 127.f / amax : 0.f;
#pragma unroll
    for (int j = 0; j < 4; ++j) *(unsigned*)(p.GTq + row * DM + 256 * j + lane * 4) = pack4_i8(bf_lo(v[j].x) * inv, bf_hi(v[j].x) * inv, bf_lo(v[j].y) * inv, bf_hi(v[j].y) * inv);
    if (lane == 0) p.sG[row] = amax * (1.f / 127.f);
  }
  {
    const long row = (long)blockIdx.x * 8 + wid;
    u32x2 v[4];
    float amax = 0.f;
#pragma unroll
    for (int j = 0; j < 4; ++j) {
      v[j] = *(const u32x2*)(p.w_pqT + row * DM + 256 * j + lane * 4);
      amax = fmaxf(amax, fmaxf(fmaxf(fabsf(bf_lo(v[j].x)), fabsf(bf_hi(v[j].x))), fmaxf(fabsf(bf_lo(v[j].y)), fabsf(bf_hi(v[j].y)))));
    }
    amax = wave_max_f(amax);
    const float inv = amax > 0.f ? 127.f / amax : 0.f;
#pragma unroll
    for (int j = 0; j < 4; ++j) *(unsigned*)(p.MTq + row * DM + 256 * j + lane * 4) = pack4_i8(bf_lo(v[j].x) * inv, bf_hi(v[j].x) * inv, bf_lo(v[j].y) * inv, bf_hi(v[j].y) * inv);
    if (lane == 0) p.sMT[row] = amax * (1.f / 127.f);
  }
}

__device__ __forceinline__ void phase_scores(const P& p, int tile) {
  const long t0 = (long)tile * 128;
  const int b = tile >> 6;
  LAS float* red = (LAS float*)((LAS char*)smem_raw + RED_OFF);
  for (int h = 0; h < 4; ++h) {
    bf16_t* Pw = p.Pb + t0 * DM + h * 256;
    wg_gemm_i8<256>((const signed char*)p.X1Q + t0 * DM, DM, p.GTq + ((long)b * 1024 + h * 256) * DM, DM, DM, [&](v4i_t (&iacc)[4][4], int wr, int wc, int fr, int fq) {
      f32x4 acc[4][4];
      float rmax[4];
#pragma unroll
      for (int m = 0; m < 4; ++m) {
        const float sr = p.SX1[t0 + wr * 64 + m * 16 + fr] * 0.0625f;
#pragma unroll
        for (int n = 0; n < 4; ++n) {
          const float4 sw = *(const float4*)(p.sG + b * 1024 + h * 256 + wc * 64 + n * 16 + fq * 4);
          acc[m][n][0] = (float)iacc[m][n][0] * (sr * sw.x); acc[m][n][1] = (float)iacc[m][n][1] * (sr * sw.y);
          acc[m][n][2] = (float)iacc[m][n][2] * (sr * sw.z); acc[m][n][3] = (float)iacc[m][n][3] * (sr * sw.w);
        }
      }
#pragma unroll
      for (int m = 0; m < 4; ++m) {
        float mx = -3.0e38f;
#pragma unroll
        for (int n = 0; n < 4; ++n) mx = fmaxf(mx, fmaxf(fmaxf(acc[m][n][0], acc[m][n][1]), fmaxf(acc[m][n][2], acc[m][n][3])));
        mx = fmaxf(mx, __shfl_xor(mx, 16)); mx = fmaxf(mx, __shfl_xor(mx, 32));
        if (fq == 0) red[(wr * 64 + m * 16 + fr) * 4 + wc] = mx;
      }
      __syncthreads();
#pragma unroll
      for (int m = 0; m < 4; ++m) {
        const f32x4 r = *(LAS const f32x4*)(red + (wr * 64 + m * 16 + fr) * 4);
        rmax[m] = fmaxf(fmaxf(r[0], r[1]), fmaxf(r[2], r[3]));
      }
#pragma unroll
      for (int m = 0; m < 4; ++m) {
        float sm = 0.f;
#pragma unroll
        for (int n = 0; n < 4; ++n)
#pragma unroll
          for (int j = 0; j < 4; ++j) { const float e = __expf(acc[m][n][j] - rmax[m]); acc[m][n][j] = e; sm += e; }
        sm += __shfl_xor(sm, 16); sm += __shfl_xor(sm, 32);
        if (fq == 0) red[512 + (wr * 64 + m * 16 + fr) * 4 + wc] = sm;
      }
      __syncthreads();
#pragma unroll
      for (int m = 0; m < 4; ++m) {
        const f32x4 r = *(LAS const f32x4*)(red + 512 + (wr * 64 + m * 16 + fr) * 4);
        const float inv = 1.f / ((r[0] + r[1]) + (r[2] + r[3]));
        const int rl = wr * 64 + m * 16 + fr;
#pragma unroll
        for (int n = 0; n < 4; ++n) {
          u32x2 w; w.x = pk_bf16(acc[m][n][0] * inv, acc[m][n][1] * inv); w.y = pk_bf16(acc[m][n][2] * inv, acc[m][n][3] * inv);
          *(u32x2*)(Pw + rl * DM + wc * 64 + n * 16 + fq * 4) = w;
        }
      }
    });
  }
}

__device__ __forceinline__ void phase_oproj(const P& p, int tile) {
  const long t0 = (long)tile * 128;
  for (int nt = 0; nt < 4; ++nt) {
    wg_gemm<256>(p.Pb + t0 * DM, DM, p.HT + ((long)(tile >> 6) * 1024 + nt * 256) * DM, DM, DM, [&](f32x4 (&acc)[4][4], int wr, int wc, int fr, int fq) {
#pragma unroll
      for (int m = 0; m < 4; ++m)
#pragma unroll
        for (int n = 0; n < 4; ++n) {
          const long row = t0 + wr * 64 + m * 16 + fr; const int col = nt * 256 + wc * 64 + n * 16 + fq * 4;
          const u32x2 xv = *(const u32x2*)(p.X1 + row * DM + col);
          u32x2 o; o.x = pk_bf16(ALPHA * bf_lo(xv.x) + acc[m][n][0], ALPHA * bf_hi(xv.x) + acc[m][n][1]); o.y = pk_bf16(ALPHA * bf_lo(xv.y) + acc[m][n][2], ALPHA * bf_hi(xv.y) + acc[m][n][3]);
          *(u32x2*)((bf16_t*)p.PRE + row * DM + col) = o;
        }
    });
  }
  wg_sync_mem();
  ln_rows16_q(p.PRE, t0 + (threadIdx.x >> 6) * 16, p.ln2_g, p.ln2_b, p.X2, p.XQ, p.SX, threadIdx.x & 63);
}

__device__ __forceinline__ unsigned f2key(float f) { const unsigned b = __float_as_uint(f); return b ^ ((unsigned)((int)b >> 31) | 0x80000000u); }
__device__ __forceinline__ float key2f(unsigned k) { return __uint_as_float(k ^ ((k & 0x80000000u) ? 0x80000000u : 0xffffffffu)); }
__device__ __forceinline__ void phase_pq(const P& p, int tile) {
  const long t0 = (long)tile * 128;
  for (int nt = 0; nt < 8; ++nt) {
    wg_gemm_i8<256>((const signed char*)p.XQ + t0 * DM, DM, p.MTq + (long)nt * 256 * DM, DM, DM, [&](v4i_t (&acc)[4][4], int wr, int wc, int fr, int fq) {
#pragma unroll
      for (int m = 0; m < 4; ++m) {
        const long row = t0 + wr * 64 + m * 16 + fr;
        const float sr = p.SX[row];
#pragma unroll
        for (int n = 0; n < 4; ++n) {
          const int col = nt * 256 + wc * 64 + n * 16 + fq * 4;
          const float4 sw = *(const float4*)(p.sMT + col);
          u32x2 w; w.x = pk_f16((float)acc[m][n][0] * (sr * sw.x), (float)acc[m][n][1] * (sr * sw.y)); w.y = pk_f16((float)acc[m][n][2] * (sr * sw.z), (float)acc[m][n][3] * (sr * sw.w));
          *(u32x2*)((unsigned short*)p.KEYS + row * 2048 + col) = w;
        }
      }
    });
  }
}

__device__ __forceinline__ void phase_mt(const P& p, int unit) {
  const int hp = unit >> 2, nt = unit & 3;
  wg_gemm<256>(p.skb + (long)hp * 128 * 128, 128, p.wpqB + (long)nt * 256 * 2048 + hp * 128, 2048, 128, [&](f32x4 (&acc)[4][4], int wr, int wc, int fr, int fq) {
#pragma unroll
    for (int m = 0; m < 4; ++m)
#pragma unroll
      for (int n = 0; n < 4; ++n) {
        const int row = hp * 128 + wr * 64 + m * 16 + fr, col = nt * 256 + wc * 64 + n * 16 + fq * 4;
        u32x2 w; w.x = pk_bf16(acc[m][n][0], acc[m][n][1]); w.y = pk_bf16(acc[m][n][2], acc[m][n][3]);
        *(u32x2*)((bf16_t*)p.w_pqT + (long)row * DM + col) = w;
      }
  });
}

__device__ __forceinline__ unsigned cand_entry(int s) {
  unsigned e = 255u; int base = 0;
#pragma unroll
  for (int i = 0; i < 16; ++i) { const int cnt = 16 / (i + 1); if (s >= base && s < base + cnt) e = (unsigned)i | ((unsigned)(s - base) << 4); base += cnt; }
  return e;
}
template <int CTRL> __device__ __forceinline__ unsigned dpp_u(unsigned x) { return (unsigned)__builtin_amdgcn_mov_dpp((int)x, CTRL, 0xf, 0xf, true); }
template <int CTRL> __device__ __forceinline__ float dpp_f(float x) { return __int_as_float(__builtin_amdgcn_mov_dpp(__float_as_int(x), CTRL, 0xf, 0xf, true)); }
__device__ __forceinline__ unsigned umin_(unsigned a, unsigned b) { return a < b ? a : b; }
__device__ __forceinline__ unsigned row_min_u(unsigned x) {
  x = umin_(x, dpp_u<0x128>(x)); x = umin_(x, dpp_u<0x124>(x)); x = umin_(x, dpp_u<0x122>(x)); x = umin_(x, dpp_u<0x121>(x)); return x;
}
__device__ __forceinline__ float row_max_f(float x) { x = fmaxf(x, dpp_f<0x128>(x)); x = fmaxf(x, dpp_f<0x124>(x)); x = fmaxf(x, dpp_f<0x122>(x)); x = fmaxf(x, dpp_f<0x121>(x)); return x; }
__device__ __forceinline__ float row_sum_f(float x) { x += dpp_f<0x128>(x); x += dpp_f<0x124>(x); x += dpp_f<0x122>(x); x += dpp_f<0x121>(x); return x; }

#define KEYS_OFF 65536
#define KEY_STRIDE 528
template <int N> __device__ __forceinline__ unsigned top16_row(const unsigned (&k)[N], int r) {
  unsigned pm1 = 0xFFFFFFFEu, mine = 0;
#pragma unroll
  for (int rd = 0; rd < 16; ++rd) {
    unsigned d = pm1 - k[0];
#pragma unroll
    for (int i = 1; i < N; ++i) d = umin_(d, pm1 - k[i]);
    d = row_min_u(d);
    const unsigned nxt = pm1 - d;
    mine = (r == rd) ? nxt : mine;
    pm1 = nxt - 1;
  }
  return mine;
}

__device__ __forceinline__ void phase_route(const P& p, int tile) {
  const long t0 = (long)tile * 128;
  const int tid = otid(), lane = tid & 63, wid = tid >> 6, r = lane & 15, g = lane >> 4;
  LAS char* lds = (LAS char*)smem_raw;
  LAS unsigned char* tab = (LAS unsigned char*)(lds + RED_OFF);
  if (tid < 64) tab[tid] = (unsigned char)cand_entry(tid);
  unsigned ci[4], cj[4]; bool cval[4];
#pragma unroll
  for (int q = 0; q < 4; ++q) { const unsigned e = cand_entry(r * 4 + q); cval[q] = (e != 255u); ci[q] = ((unsigned)(g * 16) + (e & 15u)) * 4u; cj[q] = ((unsigned)(g * 16) + ((e >> 4) & 15u)) * 4u; }
  __syncthreads();
  auto load_keys = [&](int hp, u32x4 (&kb)[4]) {
#pragma unroll
    for (int ps = 0; ps < 4; ++ps) kb[ps] = *(const u32x4*)((const unsigned short*)p.KEYS + (t0 + wid * 16 + ps * 4 + g) * 2048 + hp * 128 + r * 8);
  };
  auto top_keys = [&](const u32x4 (&kb)[4], unsigned (&tp)[4]) {
#pragma unroll
    for (int ps = 0; ps < 4; ++ps) {
      const unsigned w[4] = {kb[ps].x, kb[ps].y, kb[ps].z, kb[ps].w};
      unsigned k[8];
#pragma unroll
      for (int i = 0; i < 4; ++i) {
        k[2 * i] = (f2key(f16_lo(w[i])) & ~127u) | (unsigned)(127 - (r * 8 + 2 * i));
        k[2 * i + 1] = (f2key(f16_hi(w[i])) & ~127u) | (unsigned)(126 - (r * 8 + 2 * i));
      }
      tp[ps] = top16_row<8>(k, r);
    }
  };
  u32x4 kA[4], kB[4];
  load_keys(0, kA);
  for (int h = 0; h < 8; ++h) {
    unsigned top[2][4];
    load_keys(h * 2 + 1, kB);
    top_keys(kA, top[0]);
    load_keys(h < 7 ? h * 2 + 2 : 15, kA);
    top_keys(kB, top[1]);
#pragma unroll
    for (int ps = 0; ps < 4; ++ps) {
      const int tk = wid * 16 + ps * 4 + g;
      const unsigned A = top[0][ps], B = top[1][ps];
      const float fa = key2f(A & ~127u), fb = key2f(B & ~127u);
      unsigned k2[4];
#pragma unroll
      for (int q = 0; q < 4; ++q) {
        const float va = __int_as_float(__builtin_amdgcn_ds_bpermute((int)ci[q], __float_as_int(fa)));
        const float vb = __int_as_float(__builtin_amdgcn_ds_bpermute((int)cj[q], __float_as_int(fb)));
        const unsigned kk = (f2key(va + vb) & ~63u) | (unsigned)(63 - (r * 4 + q));
        k2[q] = cval[q] ? kk : 0u;
      }
      const unsigned mine = top16_row<4>(k2, r);
      const unsigned slot = 63u - (mine & 63u);
      const unsigned e = tab[slot];
      const unsigned ka = (unsigned)__builtin_amdgcn_ds_bpermute((int)(((unsigned)(g * 16) + (e & 15u)) * 4u), (int)A);
      const unsigned kb = (unsigned)__builtin_amdgcn_ds_bpermute((int)(((unsigned)(g * 16) + ((e >> 4) & 15u)) * 4u), (int)B);
      const int expert = (int)((127u - (ka & 127u)) * 128u + (127u - (kb & 127u)));
      const float c = key2f(mine & ~63u);
      const float mx = row_max_f(c);
      const float ex = __expf(c - mx);
      const float sm = row_sum_f(ex);
      p.experts[(t0 + tk) * 128 + h * 16 + r] = expert;
      p.gates[(t0 + tk) * 128 + h * 16 + r] = ex / sm;
    }
  }
}

__device__ __forceinline__ f32x2_t ub01(unsigned w) { return (f32x2_t){(float)(w & 0xffu), (float)((w >> 8) & 0xffu)}; }
__device__ __forceinline__ f32x2_t ub23(unsigned w) { return (f32x2_t){(float)((w >> 16) & 0xffu), (float)(w >> 24)}; }
__device__ __forceinline__ int sum8_i(int x) {
  x += (int)dpp_u<0xB1>((unsigned)x); x += (int)dpp_u<0x4E>((unsigned)x); x += (int)dpp_u<0x141>((unsigned)x); return x;
}
struct GMeta { u32x4 xq; int er0, er1; };
__device__ __forceinline__ void phase_gdown(const P& p) {
  const int tid = otid(), lane = tid & 63, wid = tid >> 6, grp = lane >> 3, r8 = lane & 7;
  const int slice = blockIdx.x & 7, chunk = blockIdx.x >> 3;
  const unsigned char* tab = p.WDq + slice * 128 + r8 * 16;
  const char* sl = p.slabs + (size_t)(chunk * 8 + wid) * SLAB_BYTES;
  int* pd = (int*)(sl + OFF_ZB) + slice * 128 * 128;
  const unsigned char* xqb = (const unsigned char*)(sl + OFF_X2Q);
  const int* exb = (const int*)(sl + OFF_EXP);
  auto meta = [&](int ti, GMeta& m) {
    const int t = (ti < 127 ? ti : 127);
    m.xq = *(const u32x4*)(xqb + t * DM + slice * 128 + r8 * 16);
    m.er0 = exb[t * 128 + lane]; m.er1 = exb[t * 128 + 64 + lane];
  };
  auto issue = [&](const GMeta& m, u32x4 (&w)[16]) {
#pragma unroll
    for (int it = 0; it < 16; ++it) {
      const int e = __builtin_amdgcn_ds_bpermute(((it & 7) * 8 + grp) * 4, (it < 8) ? m.er0 : m.er1);
      w[it] = *(const u32x4*)(tab + (long)e * DM);
    }
  };
  auto consume = [&](int ti, const GMeta& m, const u32x4 (&w)[16]) {
    int c0 = 0, c1 = 0;
#pragma unroll
    for (int it = 0; it < 16; ++it) {
      int acc = __builtin_amdgcn_sdot4((int)w[it].x, (int)m.xq.x, 0, false);
      acc = __builtin_amdgcn_sdot4((int)w[it].y, (int)m.xq.y, acc, false); acc = __builtin_amdgcn_sdot4((int)w[it].z, (int)m.xq.z, acc, false); acc = __builtin_amdgcn_sdot4((int)w[it].w, (int)m.xq.w, acc, false);
      acc = sum8_i(acc);
      const bool mine = ((it & 7) == r8);
      c0 = (mine && it < 8) ? acc : c0;
      c1 = (mine && it >= 8) ? acc : c1;
    }
    pd[ti * 128 + r8 * 8 + grp] = c0; pd[ti * 128 + 64 + r8 * 8 + grp] = c1;
  };
  GMeta mA, mB; u32x4 wA[16], wB[16];
  meta(0, mA); issue(mA, wA); meta(1, mB);
  for (int ti = 0; ti < 128; ti += 2) {
    issue(mB, wB);
    consume(ti, mA, wA);
    meta(ti + 2, mA);
    issue(mA, wA);
    consume(ti + 1, mB, wB);
    meta(ti + 3, mB);
  }
}
__device__ __forceinline__ int cq_index(int k) { return ((k >> 5) * 8 + (k & 7)) * 4 + ((k >> 3) & 3); }
__device__ __forceinline__ void phase_gcomb(const P& p, int tile) {
  const int tid = otid(), lane = tid & 63, wid = tid >> 6;
  signed char* cq = (signed char*)(p.slabs + (size_t)tile * SLAB_BYTES + OFF_CQ);
  float* sc = (float*)(p.slabs + (size_t)tile * SLAB_BYTES + OFF_SC);
#pragma unroll 4
  for (int ti = 0; ti < 16; ++ti) {
    const int tl = wid * 16 + ti;
    const long t = (long)tile * 128 + tl;
    int s0 = 0, s1 = 0;
#pragma unroll
    for (int j = 0; j < 8; ++j) { s0 += p.PD[(j * 128 + tl) * 128 + lane]; s1 += p.PD[(j * 128 + tl) * 128 + 64 + lane]; }
    const int e0 = p.experts[t * 128 + lane], e1 = p.experts[t * 128 + 64 + lane];
    const float sx = p.SX[t];
    const float c0 = p.gates[t * 128 + lane] * gelu_f((float)s0 * p.sd[e0] * sx) * p.su[e0];
    const float c1 = p.gates[t * 128 + 64 + lane] * gelu_f((float)s1 * p.sd[e1] * sx) * p.su[e1];
    float amax = fmaxf(fabsf(c0), fabsf(c1));
    amax = wave_max_f(amax);
    const float inv = amax > 0.f ? 127.f / amax : 0.f;
    cq[tl * 128 + cq_index(lane)] = (signed char)__float2int_rn(c0 * inv);
    cq[tl * 128 + cq_index(lane + 64)] = (signed char)__float2int_rn(c1 * inv);
    if (lane == 0) sc[tl] = amax * (1.f / 127.f);
  }
}
struct UMeta { int er0, er1; unsigned cq[4]; };
__device__ __forceinline__ void phase_gup(const P& p) {
  const int tid = otid(), lane = tid & 63, wid = tid >> 6, grp = lane >> 3, r8 = lane & 7;
  const int slice = blockIdx.x & 7, chunk = blockIdx.x >> 3;
  const unsigned char* tab = p.WUq + slice * 128 + r8 * 16;
  char* sl = p.slabs + (size_t)(chunk * 8 + wid) * SLAB_BYTES;
  const int* exb = (const int*)(sl + OFF_EXP);
  const unsigned* cqb = (const unsigned*)(sl + OFF_CQ);
  const float* scb = (const float*)(sl + OFF_SC);
  bf16_t* h3b = (bf16_t*)(sl + OFF_ZB);
  auto meta = [&](int ti, UMeta& m) {
    const int t = (ti < 127 ? ti : 127);
    m.er0 = exb[t * 128 + lane]; m.er1 = exb[t * 128 + 64 + lane];
#pragma unroll
    for (int j = 0; j < 4; ++j) m.cq[j] = cqb[t * 32 + j * 8 + grp];
  };
  auto issue = [&](const UMeta& m, u32x4 (&w)[16]) {
#pragma unroll
    for (int it = 0; it < 16; ++it) {
      const int e = __builtin_amdgcn_ds_bpermute(((it & 7) * 8 + grp) * 4, (it < 8) ? m.er0 : m.er1);
      w[it] = *(const u32x4*)(tab + (long)e * DM);
    }
  };
  auto consume = [&](int ti, const UMeta& m, const u32x4 (&w)[16]) {
    int o[16];
#pragma unroll
    for (int i = 0; i < 16; ++i) o[i] = 0;
#pragma unroll
    for (int j = 0; j < 4; ++j) {
      const unsigned x0[4] = {w[4 * j].x, w[4 * j].y, w[4 * j].z, w[4 * j].w}, x1[4] = {w[4 * j + 1].x, w[4 * j + 1].y, w[4 * j + 1].z, w[4 * j + 1].w};
      const unsigned x2[4] = {w[4 * j + 2].x, w[4 * j + 2].y, w[4 * j + 2].z, w[4 * j + 2].w}, x3[4] = {w[4 * j + 3].x, w[4 * j + 3].y, w[4 * j + 3].z, w[4 * j + 3].w};
#pragma unroll
      for (int d = 0; d < 4; ++d) {
        const unsigned t0 = __builtin_amdgcn_perm(x1[d], x0[d], 0x05010400u), t1 = __builtin_amdgcn_perm(x1[d], x0[d], 0x07030602u);
        const unsigned u0 = __builtin_amdgcn_perm(x3[d], x2[d], 0x05010400u), u1 = __builtin_amdgcn_perm(x3[d], x2[d], 0x07030602u);
        o[d * 4 + 0] = __builtin_amdgcn_sdot4((int)__builtin_amdgcn_perm(u0, t0, 0x05040100u), (int)m.cq[j], o[d * 4 + 0], false);
        o[d * 4 + 1] = __builtin_amdgcn_sdot4((int)__builtin_amdgcn_perm(u0, t0, 0x07060302u), (int)m.cq[j], o[d * 4 + 1], false);
        o[d * 4 + 2] = __builtin_amdgcn_sdot4((int)__builtin_amdgcn_perm(u1, t1, 0x05040100u), (int)m.cq[j], o[d * 4 + 2], false);
        o[d * 4 + 3] = __builtin_amdgcn_sdot4((int)__builtin_amdgcn_perm(u1, t1, 0x07060302u), (int)m.cq[j], o[d * 4 + 3], false);
      }
    }
    const float sct = scb[ti];
    float f[16];
#pragma unroll
    for (int i = 0; i < 16; ++i) {
      int a = o[i];
      a += (int)dpp_u<0x128>((unsigned)a);
      a += __shfl_xor(a, 16);
      a += __shfl_xor(a, 32);
      f[i] = (float)a * sct;
    }
    if (grp == 0) {
      bf16_t* dst = h3b + ti * DM + slice * 128 + r8 * 16;
      u32x4 q0, q1;
      q0.x = pk_bf16(f[0], f[1]); q0.y = pk_bf16(f[2], f[3]); q0.z = pk_bf16(f[4], f[5]); q0.w = pk_bf16(f[6], f[7]);
      q1.x = pk_bf16(f[8], f[9]); q1.y = pk_bf16(f[10], f[11]); q1.z = pk_bf16(f[12], f[13]); q1.w = pk_bf16(f[14], f[15]);
      *(u32x4*)dst = q0; *(u32x4*)(dst + 8) = q1;
    }
  };
  UMeta mA, mB; u32x4 wA[16], wB[16];
  meta(0, mA); issue(mA, wA); meta(1, mB);
  for (int ti = 0; ti < 128; ti += 2) {
    issue(mB, wB);
    consume(ti, mA, wA);
    meta(ti + 2, mA);
    issue(mA, wA);
    consume(ti + 1, mB, wB);
    meta(ti + 3, mB);
  }
}
__device__ __forceinline__ void phase_ln3(const P& p, int tile) {
  const int tid = otid(), lane = tid & 63, wid = tid >> 6;
#pragma unroll 2
  for (int ti = 0; ti < 16; ++ti) {
    const long t = (long)tile * 128 + wid * 16 + ti;
    float4 v[4];
    float sum = 0.f;
#pragma unroll
    for (int j = 0; j < 4; ++j) {
      const int c0 = j * 256 + lane * 4;
      const u32x2 hv = *(const u32x2*)((const bf16_t*)p.H3 + t * DM + c0);
      const u32x2 xv = *(const u32x2*)(p.X2 + t * DM + c0);
      v[j].x = bf_lo(hv.x) + ALPHA * bf_lo(xv.x); v[j].y = bf_hi(hv.x) + ALPHA * bf_hi(xv.x); v[j].z = bf_lo(hv.y) + ALPHA * bf_lo(xv.y); v[j].w = bf_hi(hv.y) + ALPHA * bf_hi(xv.y);
      sum += (v[j].x + v[j].y) + (v[j].z + v[j].w);
    }
    sum = wave_sum_f(sum);
    const float mu = sum * (1.f / DM);
    float q = 0.f;
#pragma unroll
    for (int j = 0; j < 4; ++j) { v[j].x -= mu; v[j].y -= mu; v[j].z -= mu; v[j].w -= mu; q += (v[j].x * v[j].x + v[j].y * v[j].y) + (v[j].z * v[j].z + v[j].w * v[j].w); }
    q = wave_sum_f(q);
    const float rstd = rsqrtf(q * (1.f / DM) + LN_EPS);
#pragma unroll
    for (int j = 0; j < 4; ++j) {
      const int c0 = j * 256 + lane * 4;
      const float4 gg = *(const float4*)(p.ln3_g + c0), bb = *(const float4*)(p.ln3_b + c0);
      float4 o; o.x = v[j].x * rstd * gg.x + bb.x; o.y = v[j].y * rstd * gg.y + bb.y; o.z = v[j].z * rstd * gg.z + bb.z; o.w = v[j].w * rstd * gg.w + bb.w;
      *(float4*)(p.out + t * DM + c0) = o;
    }
  }
}

__device__ __forceinline__ void prep_transpose_tile(const float* __restrict__ W, bf16_t* __restrict__ WT, int K, int N, int tileidx) {
  LAS float* scr = (LAS float*)smem_raw;
  const int ntn = N / 64, k0 = (tileidx / ntn) * 64, n0 = (tileidx % ntn) * 64, tid = threadIdx.x;
#pragma unroll
  for (int i = 0; i < 8; ++i) { const int e = tid + i * 512, kk = e >> 6, nn = e & 63; scr[kk * 65 + nn] = W[(long)(k0 + kk) * N + n0 + nn]; }
  __syncthreads();
#pragma unroll
  for (int i = 0; i < 4; ++i) { const int e = tid + i * 512, nn = e >> 5, kp = (e & 31) * 2; *(unsigned*)(WT + (long)(n0 + nn) * K + k0 + kp) = pk_bf16(scr[kp * 65 + nn], scr[(kp + 1) * 65 + nn]); }
  __syncthreads();
}
__device__ __forceinline__ void prep_quant_strip(const float* __restrict__ W, signed char* __restrict__ Q, float* __restrict__ sc, int K, int N, int strip) {
  LAS float* scr = (LAS float*)smem_raw;
  LAS float* pmax = scr + 64 * 65;
  LAS float* inv = pmax + 8 * 64;
  const int n0 = strip * 64, tid = threadIdx.x, nn = tid & 63, kg = tid >> 6;
  float amax = 0.f;
#pragma unroll 4
  for (int k0 = 0; k0 < K; k0 += 64)
#pragma unroll
    for (int i = 0; i < 8; ++i) amax = fmaxf(amax, fabsf(W[(long)(k0 + kg + 8 * i) * N + n0 + nn]));
  pmax[kg * 64 + nn] = amax;
  __syncthreads();
  if (tid < 64) {
    float m = 0.f;
#pragma unroll
    for (int j = 0; j < 8; ++j) m = fmaxf(m, pmax[j * 64 + tid]);
    inv[tid] = m > 0.f ? 127.f / m : 0.f;
    sc[n0 + tid] = m * (1.f / 127.f);
  }
  __syncthreads();
  const float iv = inv[nn];
  float cur[8];
#pragma unroll
  for (int i = 0; i < 8; ++i) cur[i] = W[(long)(kg + 8 * i) * N + n0 + nn];
  for (int k0 = 0; k0 < K; k0 += 64) {
    float nxt[8];
    const int k1 = k0 + 64 < K ? k0 + 64 : k0;
#pragma unroll
    for (int i = 0; i < 8; ++i) nxt[i] = W[(long)(k1 + kg + 8 * i) * N + n0 + nn];
#pragma unroll
    for (int i = 0; i < 8; ++i) { const int kk = kg + 8 * i; scr[kk * 65 + nn] = cur[i] * iv; }
#pragma unroll
    for (int i = 0; i < 8; ++i) cur[i] = nxt[i];
    __syncthreads();
#pragma unroll
    for (int i = 0; i < 2; ++i) {
      const int dd = tid + i * 512, n = dd >> 4, k4 = (dd & 15) * 4;
      *(unsigned*)(Q + (long)(n0 + n) * K + k0 + k4) = pack4_i8(scr[k4 * 65 + n], scr[(k4 + 1) * 65 + n], scr[(k4 + 2) * 65 + n], scr[(k4 + 3) * 65 + n]);
    }
    __syncthreads();
  }
}
__device__ __forceinline__ void prep_cvt(const float* __restrict__ in, bf16_t* __restrict__ out, long n8) {
  for (long i = (long)blockIdx.x * 512 + threadIdx.x; i < n8; i += (long)gridDim.x * 512) {
    const float4 a = *(const float4*)(in + i * 8), b = *(const float4*)(in + i * 8 + 4);
    u32x4 o; o.x = pk_bf16(a.x, a.y); o.y = pk_bf16(a.z, a.w); o.z = pk_bf16(b.x, b.y); o.w = pk_bf16(b.z, b.w);
    *(u32x4*)(out + i * 8) = o;
  }
}
__device__ __forceinline__ void phase_prep(const P& p) {
  const int T_IN = 16 * 40, T_SQ = 16 * 16, T_W2 = 16 * 32;
  const int total = T_IN + T_SQ + T_SQ + T_W2 + T_SQ + T_W2;
  for (int it = blockIdx.x; it < total; it += gridDim.x) {
    int r = it;
    if (r < T_IN) { if (r < 40) prep_quant_strip(p.w_in, p.w_inQ, p.sw_in, DM, INW, r); continue; } r -= T_IN;
    if (r < T_SQ) { if (r < 16) prep_quant_strip(p.w_mo, p.w_moQ, p.sw_mo, DM, DM, r); continue; } r -= T_SQ;
    if (r < T_SQ) { continue; } r -= T_SQ;
    if (r < T_W2) { prep_transpose_tile(p.w_xkv, (bf16_t*)p.w_xkvT, DM, 2048, r); continue; } r -= T_W2;
    if (r < T_SQ) { prep_transpose_tile(p.w_xo, (bf16_t*)p.w_xoT, DM, DM, r); continue; } r -= T_SQ;
    (void)r;
  }
  prep_cvt(p.mem, (bf16_t*)p.memB, (long)1024 * DM / 8);
  prep_cvt(p.sub_keys, (bf16_t*)p.skb, (long)8 * 2 * 128 * 128 / 8);
  prep_cvt(p.w_pq, (bf16_t*)p.wpqB, (long)DM * 2048 / 8);
  prep_cvt(p.w_xq, (bf16_t*)p.wxqB, (long)DM * DM / 8);
  {
    const int lane = threadIdx.x & 63, b = blockIdx.x;
    const bool strip_wg = b < 40 || (b >= 128 && b < 144);
    const int rank = b < 128 ? b - 40 : b - 144 + 88;
    {
    for (int row = strip_wg ? 2 * 16384 : rank * 8 + (threadIdx.x >> 6); row < 2 * 16384; row += 1600) {
      const int tb = row >> 14, e = row & 16383;
      const float* src = (tb ? p.w_up : p.w_down) + (long)e * DM;
      float4 v[4];
      float amax = 0.f;
#pragma unroll
      for (int i = 0; i < 4; ++i) { v[i] = *(const float4*)(src + 256 * i + lane * 4); amax = fmaxf(amax, fmaxf(fmaxf(fabsf(v[i].x), fabsf(v[i].y)), fmaxf(fabsf(v[i].z), fabsf(v[i].w)))); }
      amax = wave_max_f(amax);
      const float inv = amax > 0.f ? 127.f / amax : 0.f;
      unsigned char* dst = (unsigned char*)(tb ? p.WUq : p.WDq) + (long)e * DM;
      const float off = 0.f;
#pragma unroll
      for (int i = 0; i < 4; ++i) *(unsigned*)(dst + 256 * i + lane * 4) = pack4_i8(v[i].x * inv + off, v[i].y * inv + off, v[i].z * inv + off, v[i].w * inv + off);
      if (lane == 0) { float* sc = (float*)(tb ? p.su : p.sd); sc[e] = amax * (1.f / 127.f); }
    }
    }
  }
  for (int i = blockIdx.x * 512 + threadIdx.x; i < 4 * 128 * 128 / 2; i += gridDim.x * 512) {
    const int e = i * 2, t = (e >> 7) & 127, sidx = e & 127;
    const float2 v = *(const float2*)(p.w_sp + e);
    *(unsigned*)((bf16_t*)p.wsb + e) = pk_bf16(sidx <= t ? v.x : 0.f, (sidx + 1) <= t ? v.y : 0.f);
  }
}
__device__ __forceinline__ void phase_xcvt(const P& p, int tile) {
  const int lane = threadIdx.x & 63, wid = threadIdx.x >> 6;
  signed char* xq = (signed char*)(p.slabs + (size_t)tile * SLAB_BYTES + OFF_XB);
  float* sxr = (float*)(p.slabs + (size_t)tile * SLAB_BYTES + OFF_SXB);
#pragma unroll 2
  for (int i = 0; i < 16; ++i) {
    const int rl = wid * 16 + i;
    const float* src = p.x + ((long)tile * 128 + rl) * DM;
    float4 v[4];
    float amax = 0.f;
#pragma unroll
    for (int j = 0; j < 4; ++j) { v[j] = *(const float4*)(src + 256 * j + lane * 4); amax = fmaxf(amax, fmaxf(fmaxf(fabsf(v[j].x), fabsf(v[j].y)), fmaxf(fabsf(v[j].z), fabsf(v[j].w)))); }
    amax = wave_max_f(amax);
    const float inv = amax > 0.f ? 127.f / amax : 0.f;
#pragma unroll
    for (int j = 0; j < 4; ++j) *(unsigned*)(xq + rl * DM + 256 * j + lane * 4) = pack4_i8(v[j].x * inv, v[j].y * inv, v[j].z * inv, v[j].w * inv);
    if (lane == 0) sxr[rl] = amax * (1.f / 127.f);
  }
}
__device__ __forceinline__ void phase_halo(const P& p, int tile) {
  const int tid = otid();
  if (tid < 128) {
    const int rr = tid >> 6, c = (tid & 63) * 8;
    const bf16_t* zr = p.ZB + ((long)tile * 128 + 126 + rr) * INW;
    const u32x4 hb = *(const u32x4*)(zr + 1024 + c), gc = *(const u32x4*)(zr + 2048 + c);
    u32x4 o;
    o.x = pk_bf16(bf_lo(hb.x) * bf_lo(gc.x), bf_hi(hb.x) * bf_hi(gc.x)); o.y = pk_bf16(bf_lo(hb.y) * bf_lo(gc.y), bf_hi(hb.y) * bf_hi(gc.y));
    o.z = pk_bf16(bf_lo(hb.z) * bf_lo(gc.z), bf_hi(hb.z) * bf_hi(gc.z)); o.w = pk_bf16(bf_lo(hb.w) * bf_lo(gc.w), bf_hi(hb.w) * bf_hi(gc.w));
    *(u32x4*)(p.HALO + ((long)tile * 2 + rr) * 512 + c) = o;
  }
}

__device__ __forceinline__ P tile_view(const P& p, int tile) {
  P q = p;
  char* sl = p.slabs + (size_t)tile * SLAB_BYTES;
  const long t0 = (long)tile * 128;
  q.XB = (bf16_t*)(sl + OFF_XB) - t0 * DM; q.X1 = (bf16_t*)(sl + OFF_XB) - t0 * DM;
  q.experts = (int*)(sl + OFF_EXP) - t0 * 128; q.gates = (float*)(sl + OFF_GATE) - t0 * 128;
  q.ZB = (bf16_t*)(sl + OFF_ZB) - t0 * INW; q.PRE = (float*)((bf16_t*)(sl + OFF_ZB) - t0 * DM); q.KEYS = (unsigned*)((unsigned short*)(sl + OFF_ZB) - t0 * 2048);
  q.PD = (int*)(sl + OFF_ZB); q.H3 = (float*)((bf16_t*)(sl + OFF_ZB) - t0 * DM);
  q.VT = (bf16_t*)(sl + OFF_VT) - (long)tile * 4 * 128 * 128; q.X1Q = (unsigned char*)(sl + OFF_VT) - t0 * DM; q.XQ = (unsigned char*)(sl + OFF_X2Q) - t0 * DM;
  q.Y = (bf16_t*)(sl + OFF_Y) - t0 * DM; q.Pb = (bf16_t*)(sl + OFF_Y) - t0 * DM;
  q.Q = (bf16_t*)(sl + OFF_Q) - t0 * DM; q.X2 = (bf16_t*)(sl + OFF_Q) - t0 * DM; q.YQ = (signed char*)(sl + OFF_Q) - t0 * DM;
  return q;
}

#define XB_TMO      128
#define XB_XCNT(j)  (256  + 64 * (j))
#define XB_XSUB(j)  (1280 + 64 * (j))
#define XB_XGEN(j)  (2304 + 64 * (j))
#define XB_TOP      3328
#define XB_TOPGEN   3392
#define XB_SPIN_CAP (1u << 18)

__device__ __forceinline__ unsigned xb_ld(unsigned* p)              { return __hip_atomic_load(p, __ATOMIC_RELAXED, __HIP_MEMORY_SCOPE_AGENT); }
__device__ __forceinline__ unsigned xb_add(unsigned* p, unsigned v) { return __hip_atomic_fetch_add(p, v, __ATOMIC_RELAXED, __HIP_MEMORY_SCOPE_AGENT); }
__device__ __forceinline__ unsigned xb_xcc_id() { return (unsigned)__builtin_amdgcn_s_getreg((3 << 11) | 20) & 0xFu; }
#define XB_SPIN(cond, bar) do { unsigned _sp = 0; while (cond) { __builtin_amdgcn_s_sleep(1); \
    if ((++_sp & 255u) == 0u) { if (xb_ld(&(bar)[XB_TMO])) break; if (_sp > XB_SPIN_CAP) { atomicAdd(&(bar)[XB_TMO], 1u); break; } } } } while (0)

struct XcdBarrier {
    unsigned* bar; unsigned x;
    volatile LAS unsigned* st;
};

__device__ __forceinline__ XcdBarrier xcd_barrier_post(unsigned* bar, volatile LAS unsigned* st) {
    XcdBarrier b; b.bar = bar; b.x = xb_xcc_id(); b.st = st;
    if (threadIdx.x == 0) (void)xb_add(&bar[XB_XCNT(b.x)], 1u);
    return b;
}
__device__ __forceinline__ void xcd_barrier_complete(unsigned* bar, unsigned x, unsigned& nloc, unsigned& nx) {
    const unsigned G = gridDim.x * gridDim.y * gridDim.z;
    unsigned sum, cnt, mine, sp = 0u;
    for (;;) {
        sum = 0u; cnt = 0u; mine = 0u;
#pragma unroll
        for (unsigned j = 0; j < 16; ++j) { const unsigned c = xb_ld(&bar[XB_XCNT(j)]); sum += c; cnt += (c > 0u) ? 1u : 0u; mine = (j == x) ? c : mine; }
        if (sum == G) break;
        __builtin_amdgcn_s_sleep(1);
        if ((++sp & 255u) == 0u) { if (xb_ld(&bar[XB_TMO])) break; if (sp > XB_SPIN_CAP) { atomicAdd(&bar[XB_TMO], 1u); break; } }
    }
    nloc = mine > 0u ? mine : 1u; nx = cnt > 0u ? cnt : 1u;
}

__device__ __forceinline__ void xcd_barrier(const XcdBarrier& b) {
    asm volatile("s_waitcnt vmcnt(0)" ::: "memory");
    __syncthreads();
    if (threadIdx.x == 0) {
        unsigned* bar = b.bar;
        __builtin_amdgcn_s_waitcnt(0);
        unsigned nloc = b.st[0], nx = b.st[1];
        if (nloc == 0u) { xcd_barrier_complete(bar, b.x, nloc, nx); b.st[0] = nloc; b.st[1] = nx; }
        const unsigned old = xb_add(&bar[XB_XSUB(b.x)], 1u);
        const unsigned gen = old / nloc;
        if (old + 1u == (gen + 1u) * nloc) {
            __builtin_amdgcn_fence(__ATOMIC_RELEASE, "agent");
            asm volatile("s_waitcnt vmcnt(0)" ::: "memory");
            const unsigned og = xb_add(&bar[XB_TOP], 1u);
            const unsigned tg = og / nx;
            if (og + 1u == (tg + 1u) * nx) xb_add(&bar[XB_TOPGEN], 1u);
            else XB_SPIN(xb_ld(&bar[XB_TOPGEN]) == tg, bar);
            __builtin_amdgcn_fence(__ATOMIC_ACQUIRE, "agent");
            xb_add(&bar[XB_XGEN(b.x)], 1u);
            asm volatile("s_waitcnt vmcnt(0)" ::: "memory");
        } else {
            XB_SPIN(xb_ld(&bar[XB_XGEN(b.x)]) == gen, bar);
            __builtin_amdgcn_fence(__ATOMIC_ACQUIRE, "agent");
            asm volatile("s_waitcnt vmcnt(0)" ::: "memory");
        }
    }
    __syncthreads();
}


__global__ __launch_bounds__(512) void mega_k(P pg) {
  const int tile = blockIdx.x;
  volatile LAS unsigned* xbw = (volatile LAS unsigned*)((LAS char*)smem_raw + XB_LDS_OFF);
  if (threadIdx.x < 4) xbw[threadIdx.x] = 0u;
  __syncthreads();
  XcdBarrier xb = xcd_barrier_post(pg.bar, xbw);
  const P p = tile_view(pg, tile);
  phase_prep(pg);
  phase_xcvt(p, tile);
  xcd_barrier(xb);
  phase_inproj(p, tile);
  wg_sync_mem();
  phase_halo(p, tile);
  phase_kv(p, tile);
  if (tile < 64) phase_mt(p, tile);
  xcd_barrier(xb);
  phase_gh(p, tile);
  wg_sync_mem();
  phase_mixer(p, tile);
  wg_sync_mem();
  phase_outproj(p, tile);
  wg_sync_mem();
  xcd_barrier(xb);
  phase_gquant(pg);
  xcd_barrier(xb);
  phase_scores(p, tile);
  wg_sync_mem();
  phase_oproj(p, tile);
  wg_sync_mem();
  phase_pq(p, tile);
  wg_sync_mem();
  phase_route(p, tile);
  xcd_barrier(xb);
  phase_gdown(pg);
  xcd_barrier(xb);
  phase_gcomb(p, tile);
  xcd_barrier(xb);
  phase_gup(pg);
  xcd_barrier(xb);
  phase_ln3(p, tile);
}

extern "C" void kernel_launch(void* const* d_in, const int* in_sizes, int n_in, void* d_out, int out_size, void* d_ws, size_t ws_size, hipStream_t stream) {
  static int grid_blocks = 0;
  if (grid_blocks == 0) {
    int dev = 0, cus = 0, per_cu = 0;
    (void)hipGetDevice(&dev);
    (void)hipDeviceGetAttribute(&cus, hipDeviceAttributeMultiprocessorCount, dev);
    if (hipFuncSetAttribute((const void*)mega_k, hipFuncAttributeMaxDynamicSharedMemorySize, LDS_BYTES) != hipSuccess) fprintf(stderr, "kernel_launch: hipFuncSetAttribute failed\n");
    if (hipOccupancyMaxActiveBlocksPerMultiprocessor(&per_cu, (const void*)mega_k, 512, LDS_BYTES) != hipSuccess || per_cu < 1) { fprintf(stderr, "kernel_launch: occupancy query says %d blocks/CU\n", per_cu); per_cu = 1; }
    (void)hipGetLastError();
    grid_blocks = NTOK / 128;
    if (cus * per_cu < grid_blocks) fprintf(stderr, "kernel_launch: device holds only %d x %d resident blocks, need %d\n", cus, per_cu, grid_blocks);
  }
  char* w8 = (char*)d_ws;
  const size_t MiB = (size_t)1 << 20;
  P p{};
  p.x = (const float*)d_in[0]; p.mem = (const float*)d_in[1]; p.w_in = (const float*)d_in[2]; p.b_in = (const float*)d_in[3];
  p.sgu_g = (const float*)d_in[4]; p.sgu_b = (const float*)d_in[5]; p.w_sp = (const float*)d_in[6]; p.b_sp = (const float*)d_in[7];
  p.conv_w = (const float*)d_in[8]; p.w_mo = (const float*)d_in[9]; p.ln1_g = (const float*)d_in[10]; p.ln1_b = (const float*)d_in[11];
  p.w_xq = (const float*)d_in[12]; p.w_xkv = (const float*)d_in[13]; p.w_xo = (const float*)d_in[14]; p.ln2_g = (const float*)d_in[15]; p.ln2_b = (const float*)d_in[16];
  p.w_pq = (const float*)d_in[17]; p.sub_keys = (const float*)d_in[18]; p.w_down = (const float*)d_in[19]; p.w_up = (const float*)d_in[20];
  p.ln3_g = (const float*)d_in[21]; p.ln3_b = (const float*)d_in[22];
  p.out = (float*)d_out;
  p.slabs = w8;
  bf16_t* wb = (bf16_t*)(w8 + 384 * MiB);
  p.w_inT = wb; p.w_inQ = (signed char*)wb; wb += (size_t)INW * DM / 2; p.sw_in = (float*)wb; wb += 2 * INW; p.w_moT = wb; p.w_moQ = (signed char*)wb; wb += (size_t)DM * DM / 2; p.sw_mo = (float*)wb; wb += 2 * DM; p.wsb = wb; wb += 4 * 128 * 128;
  p.w_xqT = wb; p.GTq = (signed char*)wb; wb += (size_t)4 * 1024 * DM / 2; p.sG = (float*)wb; wb += 2 * 4096; p.w_xkvT = wb; wb += (size_t)2048 * DM; p.w_xoT = wb; wb += (size_t)DM * DM;
  p.memB = wb; wb += (size_t)1024 * DM; p.Kc = wb; wb += (size_t)1024 * DM; p.Vc = wb; wb += (size_t)1024 * DM; p.wxqB = wb; wb += (size_t)DM * DM; p.GTb = wb; wb += (size_t)4 * 1024 * DM; p.HT = wb; wb += (size_t)4 * 1024 * DM;
  p.w_pqT = wb; wb += (size_t)2048 * DM; p.MTq = (signed char*)wb; wb += (size_t)2048 * DM / 2; p.sMT = (float*)wb; wb += 2 * 2048; p.wpqB = wb; wb += (size_t)2048 * DM; p.skb = wb; wb += (size_t)8 * 2 * 128 * 128;
  p.WDq = (const unsigned char*)wb; wb += (size_t)16384 * DM / 2; p.WUq = (const unsigned char*)wb; wb += (size_t)16384 * DM / 2;
  p.sd = (const float*)wb; wb += 2 * 16384; p.su = (const float*)wb; wb += 2 * 16384;
  p.HALO = wb; wb += (size_t)256 * 2 * 512;
  p.SX = (float*)wb; wb += 2 * NTOK; p.SY = (float*)wb; wb += 2 * NTOK; p.SX1 = (float*)wb; wb += 2 * NTOK;
  p.bar = (unsigned*)wb; wb += 2 * 4096;
  if ((size_t)((char*)wb - w8) > ws_size) fprintf(stderr, "kernel_launch: workspace too small\n");
  (void)hipMemsetAsync(p.bar, 0, (XCD_BAR_WORDS + 128) * 4, stream);
  void* args[] = {&p};
  hipError_t e = hipLaunchCooperativeKernel((const void*)mega_k, dim3(grid_blocks), dim3(512), args, LDS_BYTES, stream);
  if (e != hipSuccess) fprintf(stderr, "cooperative launch failed: %s (grid %d)\n", hipGetErrorString(e), grid_blocks);
}
```

```cpp
#include <hip/hip_runtime.h>
#include <stdint.h>
#include <cstdio>

#define DM 1024
#define NTOK 32768
#define SEQ 8192
#define INW 2560
#define ALPHA 1.189207115002721f
#define LN_EPS 1e-5f

__device__ __forceinline__ float gelu_f(float v) {
  const float t = __builtin_amdgcn_rcpf(fabsf(v) * 0.2316418882f + 1.0f);
  float q = t * 0.5307027145f + (-0.7265760135f); q = q * t + 0.7107068705f; q = q * t + (-0.142248368f); q = q * t + 0.127414796f; q = q * t;
  const float e = __builtin_amdgcn_exp2f((v * v) * (-0.72134752044f));
  const float m = v * (q * e);
  return v < 0.f ? m : v - m;
}

typedef unsigned short bf16_t;
typedef short bf16x8 __attribute__((ext_vector_type(8)));
typedef float f32x4 __attribute__((ext_vector_type(4)));
typedef unsigned u32x4 __attribute__((ext_vector_type(4)));
typedef unsigned u32x2 __attribute__((ext_vector_type(2)));
#define LAS __attribute__((address_space(3)))
extern __shared__ __attribute__((aligned(16))) char smem_raw[];

typedef float f32x2_t __attribute__((ext_vector_type(2)));
typedef __bf16 bf16x2_t __attribute__((ext_vector_type(2)));
typedef _Float16 f16x2_t __attribute__((ext_vector_type(2)));
__device__ __forceinline__ unsigned pk_f16(float lo, float hi) { const f32x2_t v = {lo, hi}; return __builtin_bit_cast(unsigned, __builtin_convertvector(v, f16x2_t)); }
__device__ __forceinline__ float f16_lo(unsigned u) { return (float)__builtin_bit_cast(f16x2_t, u)[0]; }
__device__ __forceinline__ float f16_hi(unsigned u) { return (float)__builtin_bit_cast(f16x2_t, u)[1]; }
__device__ __forceinline__ unsigned pk_bf16(float lo, float hi) { const f32x2_t v = {lo, hi}; return __builtin_bit_cast(unsigned, __builtin_convertvector(v, bf16x2_t)); }
__device__ __forceinline__ int otid() { int t = threadIdx.x; asm volatile("" : "+v"(t)); return t; }
template <int CTRL> __device__ __forceinline__ float dppf_(float x) { return __int_as_float(__builtin_amdgcn_mov_dpp(__float_as_int(x), CTRL, 0xf, 0xf, true)); }
__device__ __forceinline__ float wave_sum_f(float x) {
  x += dppf_<0x128>(x); x += dppf_<0x124>(x); x += dppf_<0x122>(x); x += dppf_<0x121>(x);
  x += __shfl_xor(x, 16); x += __shfl_xor(x, 32); return x;
}
__device__ __forceinline__ float wave_max_f(float x) {
  x = fmaxf(x, dppf_<0x128>(x)); x = fmaxf(x, dppf_<0x124>(x)); x = fmaxf(x, dppf_<0x122>(x)); x = fmaxf(x, dppf_<0x121>(x));
  x = fmaxf(x, __shfl_xor(x, 16)); x = fmaxf(x, __shfl_xor(x, 32)); return x;
}
__device__ __forceinline__ unsigned pack4_i8(float a, float b, float c, float d) {
  const int ia = __float2int_rn(a), ib = __float2int_rn(b), ic = __float2int_rn(c), id = __float2int_rn(d);
  return ((unsigned)ia & 0xffu) | (((unsigned)ib & 0xffu) << 8) | (((unsigned)ic & 0xffu) << 16) | ((unsigned)id << 24);
}
__device__ __forceinline__ float bf_lo(unsigned u) { return __uint_as_float(u << 16); }
__device__ __forceinline__ float bf_hi(unsigned u) { return __uint_as_float(u & 0xffff0000u); }

__device__ __forceinline__ int swz(int row) { return (((row >> 1) & 1) << 2) | (((row >> 3) & 1) << 1); }
struct NoPre { __device__ __forceinline__ void operator()(int, int, int, int) const {} };
template <int BN, class Epi, class Pre = NoPre>
__device__ __forceinline__ void wg_gemm(const bf16_t* __restrict__ A, int lda, const bf16_t* __restrict__ Bt, int ldb, int K, Epi&& epi, Pre&& pre = Pre()) {
  constexpr int NT = BN / 64;
  constexpr int STAGE_BYTES = (128 + BN) * 128;
  constexpr int LA = 2, LB = BN / 64;
  LAS char* lds = (LAS char*)smem_raw;
  const int tid = otid(), lane = tid & 63, wid = tid >> 6, wr = wid >> 2, wc = wid & 3, fr = lane & 15, fq = lane >> 4;
  f32x4 acc[4][NT];
#pragma unroll
  for (int m = 0; m < 4; ++m)
#pragma unroll
    for (int n = 0; n < NT; ++n) acc[m][n] = (f32x4){0.f, 0.f, 0.f, 0.f};
  const int nk = K / 64;
  auto piece = [&](int buf, int kt, int i) {
    LAS char* base = lds + buf * STAGE_BYTES;
    if (i < LA) {
      const int q = tid + i * 512, row = q >> 3, c = (q & 7) ^ swz(row);
      __builtin_amdgcn_global_load_lds((const unsigned*)(A + (long)row * lda + kt * 64 + c * 8), (LAS unsigned*)(base + q * 16), 16, 0, 2);
    } else {
      const int q = tid + (i - LA) * 512, row = q >> 3, c = (q & 7) ^ swz(row);
      __builtin_amdgcn_global_load_lds((const unsigned*)(Bt + (long)row * ldb + kt * 64 + c * 8), (LAS unsigned*)(base + 16384 + q * 16), 16, 0, 0);
    }
  };
  auto stage = [&](int buf, int kt) {
#pragma unroll
    for (int i = 0; i < LA + LB; ++i) piece(buf, kt, i);
  };
  __builtin_amdgcn_s_barrier();
  asm volatile("" ::: "memory");
  stage(0, 0);
  if (nk > 1) stage(1, 1);
  for (int kt = 0; kt < nk; ++kt) {
    if (kt + 1 < nk) asm volatile("s_waitcnt vmcnt(%0)" ::"n"(LA + LB) : "memory");
    else asm volatile("s_waitcnt vmcnt(0)" ::: "memory");
    __builtin_amdgcn_s_barrier();
    asm volatile("" ::: "memory");
    if (kt == nk - 1) pre(wr, wc, fr, fq);
    LAS const char* base = lds + (kt % 3) * STAGE_BYTES;
    bf16x8 af[4][2], bfr[NT][2];
#pragma unroll
    for (int m = 0; m < 4; ++m)
#pragma unroll
      for (int kk = 0; kk < 2; ++kk) {
        const int row = wr * 64 + m * 16 + fr, c = (kk * 4 + fq) ^ swz(fr);
        af[m][kk] = *(LAS const bf16x8*)(base + row * 128 + c * 16);
      }
#pragma unroll
    for (int n = 0; n < NT; ++n)
#pragma unroll
      for (int kk = 0; kk < 2; ++kk) {
        const int row = wc * (BN / 4) + n * 16 + fr, c = (kk * 4 + fq) ^ swz(fr);
        bfr[n][kk] = *(LAS const bf16x8*)(base + 16384 + row * 128 + c * 16);
      }
#pragma unroll
    for (int kk = 0; kk < 2; ++kk)
#pragma unroll
      for (int m = 0; m < 4; ++m) {
        if (kk * 4 + m < LA + LB) {
          __builtin_amdgcn_sched_barrier(0);
          if (kt + 2 < nk) piece((kt + 2) % 3, kt + 2, kk * 4 + m);
          __builtin_amdgcn_sched_barrier(0);
        }
#pragma unroll
        for (int n = 0; n < NT; ++n) acc[m][n] = __builtin_amdgcn_mfma_f32_16x16x32_bf16(bfr[n][kk], af[m][kk], acc[m][n], 0, 0, 0);
      }
  }
  epi(acc, wr, wc, fr, fq);
}

typedef int v4i_t __attribute__((ext_vector_type(4)));
template <int BN, class Epi, class Pre = NoPre>
__device__ __forceinline__ void wg_gemm_i8(const signed char* __restrict__ A, int lda, const signed char* __restrict__ Bt, int ldb, int K, Epi&& epi, Pre&& pre = Pre()) {
  constexpr int NT = BN / 64;
  constexpr int STAGE_BYTES = (128 + BN) * 128;
  constexpr int LA = 2, LB = BN / 64;
  LAS char* lds = (LAS char*)smem_raw;
  const int tid = otid(), lane = tid & 63, wid = tid >> 6, wr = wid >> 2, wc = wid & 3, fr = lane & 15, fq = lane >> 4;
  v4i_t acc[4][NT];
#pragma unroll
  for (int m = 0; m < 4; ++m)
#pragma unroll
    for (int n = 0; n < NT; ++n) acc[m][n] = (v4i_t){0, 0, 0, 0};
  const int nk = K / 128;
  auto piece = [&](int buf, int kt, int i) {
    LAS char* base = lds + buf * STAGE_BYTES;
    if (i < LA) {
      const int q = tid + i * 512, row = q >> 3, c = (q & 7) ^ swz(row);
      __builtin_amdgcn_global_load_lds((const unsigned*)(A + (long)row * lda + kt * 128 + c * 16), (LAS unsigned*)(base + q * 16), 16, 0, 2);
    } else {
      const int q = tid + (i - LA) * 512, row = q >> 3, c = (q & 7) ^ swz(row);
      __builtin_amdgcn_global_load_lds((const unsigned*)(Bt + (long)row * ldb + kt * 128 + c * 16), (LAS unsigned*)(base + 16384 + q * 16), 16, 0, 0);
    }
  };
  auto stage = [&](int buf, int kt) {
#pragma unroll
    for (int i = 0; i < LA + LB; ++i) piece(buf, kt, i);
  };
  __builtin_amdgcn_s_barrier();
  asm volatile("" ::: "memory");
  stage(0, 0);
  if (nk > 1) stage(1, 1);
  for (int kt = 0; kt < nk; ++kt) {
    if (kt + 1 < nk) asm volatile("s_waitcnt vmcnt(%0)" ::"n"(LA + LB) : "memory");
    else asm volatile("s_waitcnt vmcnt(0)" ::: "memory");
    __builtin_amdgcn_s_barrier();
    asm volatile("" ::: "memory");
    if (kt == nk - 1) pre(wr, wc, fr, fq);
    LAS const char* base = lds + (kt % 3) * STAGE_BYTES;
    v4i_t af[4][2], bfr[NT][2];
#pragma unroll
    for (int m = 0; m < 4; ++m)
#pragma unroll
      for (int kk = 0; kk < 2; ++kk) {
        const int row = wr * 64 + m * 16 + fr, c = (kk * 4 + fq) ^ swz(fr);
        af[m][kk] = *(LAS const v4i_t*)(base + row * 128 + c * 16);
      }
#pragma unroll
    for (int n = 0; n < NT; ++n)
#pragma unroll
      for (int kk = 0; kk < 2; ++kk) {
        const int row = wc * (BN / 4) + n * 16 + fr, c = (kk * 4 + fq) ^ swz(fr);
        bfr[n][kk] = *(LAS const v4i_t*)(base + 16384 + row * 128 + c * 16);
      }
#pragma unroll
    for (int kk = 0; kk < 2; ++kk)
#pragma unroll
      for (int m = 0; m < 4; ++m) {
        if (kk * 4 + m < LA + LB) {
          __builtin_amdgcn_sched_barrier(0);
          if (kt + 2 < nk) piece((kt + 2) % 3, kt + 2, kk * 4 + m);
          __builtin_amdgcn_sched_barrier(0);
        }
#pragma unroll
        for (int n = 0; n < NT; ++n) acc[m][n] = __builtin_amdgcn_mfma_i32_16x16x64_i8(bfr[n][kk], af[m][kk], acc[m][n], 0, 0, 0);
      }
  }
  epi(acc, wr, wc, fr, fq);
}

#define XCD_BAR_WORDS 3456
#define GEMM_LDS_BYTES (3 * (128 + 256) * 128)
#define RED_OFF GEMM_LDS_BYTES
#define XB_LDS_OFF (GEMM_LDS_BYTES + 4096)
#define LDS_BYTES (GEMM_LDS_BYTES + 4096 + 16)

struct P {
  const float* x; const float* mem; const float* b_in; const float* sgu_g; const float* sgu_b; const float* b_sp; const float* conv_w;
  const float* ln1_g; const float* ln1_b; const float* ln2_g; const float* ln2_b; const float* ln3_g; const float* ln3_b;
  const bf16_t* XB; const bf16_t* w_inT; const bf16_t* w_moT; const bf16_t* wsb;
  bf16_t* ZB; bf16_t* VT; bf16_t* Y; float* PRE; bf16_t* X1;
  const bf16_t* w_xqT; const bf16_t* w_xkvT; const bf16_t* w_xoT; const bf16_t* memB;
  bf16_t* Kc; bf16_t* Vc; bf16_t* Q; bf16_t* Pb; bf16_t* X2;
  const bf16_t* wxqB; bf16_t* GTb; bf16_t* HT;
  const bf16_t* w_pqT;
  const bf16_t* wpqB;
  const bf16_t* skb; unsigned* KEYS; unsigned char* X1Q; int* experts; float* gates;
  const unsigned char* WDq; const unsigned char* WUq; const float* sd; const float* su; float* out;
  signed char* w_inQ; float* sw_in; signed char* GTq; float* sG; signed char* MTq; float* sMT; signed char* w_moQ; float* sw_mo; signed char* YQ; float* SY; float* SX1;
  char* slabs;
  unsigned* bar; unsigned char* XQ; float* SX; int* PD; float* H3;
  bf16_t* HALO;
  const float* w_in; const float* w_mo; const float* w_sp; const float* w_xq; const float* w_xkv; const float* w_xo; const float* w_pq; const float* sub_keys; const float* w_down; const float* w_up;
};

#define SLAB_BYTES (1536 * 1024)
#define OFF_XB 0
#define OFF_EXP 0
#define OFF_GATE (64 * 1024)
#define OFF_CQ (128 * 1024)
#define OFF_SC (144 * 1024)
#define OFF_X2Q (128 * 1024)
#define OFF_ZB (256 * 1024)
#define OFF_VT (896 * 1024)
#define OFF_Y (1024 * 1024)
#define OFF_Q (1280 * 1024)
__device__ __forceinline__ void wg_sync_mem() { asm volatile("s_waitcnt vmcnt(0) lgkmcnt(0)" ::: "memory"); __syncthreads(); }

#define OFF_SXB (128 * 1024)
__device__ __forceinline__ void phase_inproj(const P& p, int tile) {
  const signed char* xq = (const signed char*)(p.slabs + (size_t)tile * SLAB_BYTES + OFF_XB);
  const float* sxr = (const float*)(p.slabs + (size_t)tile * SLAB_BYTES + OFF_SXB);
  for (int nt = 0; nt < INW / 256; ++nt) {
    float4 bvr[4], swr[4]; float srr[4];
    wg_gemm_i8<256>(xq, DM, p.w_inQ + (long)nt * 256 * DM, DM, DM, [&](v4i_t (&acc)[4][4], int wr, int wc, int fr, int fq) {
#pragma unroll
      for (int m = 0; m < 4; ++m) {
        const int rl = wr * 64 + m * 16 + fr;
        const float sr = srr[m];
#pragma unroll
        for (int n = 0; n < 4; ++n) {
          const int row = tile * 128 + rl, col = nt * 256 + wc * 64 + n * 16 + fq * 4;
          const float4 bv = bvr[n], sw = swr[n];
          float o0 = (float)acc[m][n][0] * (sr * sw.x) + bv.x, o1 = (float)acc[m][n][1] * (sr * sw.y) + bv.y, o2 = (float)acc[m][n][2] * (sr * sw.z) + bv.z, o3 = (float)acc[m][n][3] * (sr * sw.w) + bv.w;
          if (nt < 4) { o0 = gelu_f(o0); o1 = gelu_f(o1); o2 = gelu_f(o2); o3 = gelu_f(o3); }
          u32x2 w; w.x = pk_bf16(o0, o1); w.y = pk_bf16(o2, o3);
          *(u32x2*)(p.ZB + (long)row * INW + col) = w;
        }
      }
    }, [&](int wr, int wc, int fr, int fq) {
#pragma unroll
      for (int m = 0; m < 4; ++m) srr[m] = sxr[wr * 64 + m * 16 + fr];
#pragma unroll
      for (int n = 0; n < 4; ++n) { const int col = nt * 256 + wc * 64 + n * 16 + fq * 4; bvr[n] = *(const float4*)(p.b_in + col); swr[n] = *(const float4*)(p.sw_in + col); }
    });
  }
}

__device__ __forceinline__ void phase_mixer(const P& p, int tile) {
  const int tid = otid(), lane = tid & 63, wid = tid >> 6;
  const long t0 = (long)tile * 128;
  const bool seq_start = ((tile & 63) == 0);
  {
    const int c = (tid & 63) * 8, s0 = (tid >> 6) * 16;
    float w[3][8];
#pragma unroll
    for (int k = 0; k < 3; ++k) {
      const float4 w0 = *(const float4*)(p.conv_w + k * 512 + c), w1 = *(const float4*)(p.conv_w + k * 512 + c + 4);
      w[k][0] = w0.x; w[k][1] = w0.y; w[k][2] = w0.z; w[k][3] = w0.w; w[k][4] = w1.x; w[k][5] = w1.y; w[k][6] = w1.z; w[k][7] = w1.w;
    }
    float p2[8], p1[8];
    auto prod_row = [&](int rl, float (&pr)[8]) {
      if (rl >= 0) {
        const bf16_t* zr = p.ZB + (t0 + rl) * INW;
        const u32x4 hb = *(const u32x4*)(zr + 1024 + c), gc = *(const u32x4*)(zr + 2048 + c);
        pr[0] = bf_lo(hb.x) * bf_lo(gc.x); pr[1] = bf_hi(hb.x) * bf_hi(gc.x); pr[2] = bf_lo(hb.y) * bf_lo(gc.y); pr[3] = bf_hi(hb.y) * bf_hi(gc.y);
        pr[4] = bf_lo(hb.z) * bf_lo(gc.z); pr[5] = bf_hi(hb.z) * bf_hi(gc.z); pr[6] = bf_lo(hb.w) * bf_lo(gc.w); pr[7] = bf_hi(hb.w) * bf_hi(gc.w);
      } else if (!seq_start) {
        const u32x4 zc = *(const u32x4*)(p.HALO + ((long)(tile - 1) * 2 + (rl + 2)) * 512 + c);
        pr[0] = bf_lo(zc.x); pr[1] = bf_hi(zc.x); pr[2] = bf_lo(zc.y); pr[3] = bf_hi(zc.y); pr[4] = bf_lo(zc.z); pr[5] = bf_hi(zc.z); pr[6] = bf_lo(zc.w); pr[7] = bf_hi(zc.w);
      } else {
#pragma unroll
        for (int j = 0; j < 8; ++j) pr[j] = 0.f;
      }
    };
    prod_row(s0 - 2, p2);
    prod_row(s0 - 1, p1);
#pragma unroll 4
    for (int i = 0; i < 16; ++i) {
      const long t = t0 + s0 + i;
      float p0[8];
      prod_row(s0 + i, p0);
      const u32x4 gb = *(const u32x4*)(p.ZB + t * INW + 1536 + c);
      float conv[8];
#pragma unroll
      for (int j = 0; j < 8; ++j) conv[j] = w[0][j] * p2[j] + w[1][j] * p1[j] + w[2][j] * p0[j];
      u32x4 o;
      o.x = pk_bf16(bf_lo(gb.x) * conv[0], bf_hi(gb.x) * conv[1]); o.y = pk_bf16(bf_lo(gb.y) * conv[2], bf_hi(gb.y) * conv[3]);
      o.z = pk_bf16(bf_lo(gb.z) * conv[4], bf_hi(gb.z) * conv[5]); o.w = pk_bf16(bf_lo(gb.w) * conv[6], bf_hi(gb.w) * conv[7]);
      *(u32x4*)(p.Y + t * DM + 512 + c) = o;
#pragma unroll
      for (int j = 0; j < 8; ++j) { p2[j] = p1[j]; p1[j] = p0[j]; }
    }
  }
  for (int h = 0; h < 4; ++h) {
    float a0[16], a1[16];
    const float g0 = p.sgu_g[h * 128 + 2 * lane], g1 = p.sgu_g[h * 128 + 2 * lane + 1], b0 = p.sgu_b[h * 128 + 2 * lane], b1 = p.sgu_b[h * 128 + 2 * lane + 1];
#pragma unroll
    for (int i = 0; i < 16; ++i) {
      const unsigned v = *(const unsigned*)(p.ZB + (t0 + wid * 16 + i) * INW + 512 + h * 128 + 2 * lane);
      const float x0 = bf_lo(v), x1 = bf_hi(v);
      float sum = x0 + x1;
      sum = wave_sum_f(sum);
      const float mu = sum * (1.f / 128.f);
      const float d0 = x0 - mu, d1 = x1 - mu;
      float q = d0 * d0 + d1 * d1;
      q = wave_sum_f(q);
      const float rstd = rsqrtf(q * (1.f / 128.f) + LN_EPS);
      a0[i] = d0 * rstd * g0 + b0; a1[i] = d1 * rstd * g1 + b1;
    }
    bf16_t* vt = p.VT + ((long)tile * 4 + h) * 128 * 128;
    u32x4 o;
    o.x = pk_bf16(a0[0], a0[1]); o.y = pk_bf16(a0[2], a0[3]); o.z = pk_bf16(a0[4], a0[5]); o.w = pk_bf16(a0[6], a0[7]);
    *(u32x4*)(vt + (2 * lane) * 128 + wid * 16) = o;
    o.x = pk_bf16(a0[8], a0[9]); o.y = pk_bf16(a0[10], a0[11]); o.z = pk_bf16(a0[12], a0[13]); o.w = pk_bf16(a0[14], a0[15]);
    *(u32x4*)(vt + (2 * lane) * 128 + wid * 16 + 8) = o;
    o.x = pk_bf16(a1[0], a1[1]); o.y = pk_bf16(a1[2], a1[3]); o.z = pk_bf16(a1[4], a1[5]); o.w = pk_bf16(a1[6], a1[7]);
    *(u32x4*)(vt + (2 * lane + 1) * 128 + wid * 16) = o;
    o.x = pk_bf16(a1[8], a1[9]); o.y = pk_bf16(a1[10], a1[11]); o.z = pk_bf16(a1[12], a1[13]); o.w = pk_bf16(a1[14], a1[15]);
    *(u32x4*)(vt + (2 * lane + 1) * 128 + wid * 16 + 8) = o;
  }
  wg_sync_mem();
  for (int h = 0; h < 4; ++h) {
    u32x2 uv[4][2]; float bs[4];
    wg_gemm<128>(p.wsb + h * 128 * 128, 128, p.VT + ((long)tile * 4 + h) * 128 * 128, 128, 128, [&](f32x4 (&acc)[4][2], int wr, int wc, int fr, int fq) {
#pragma unroll
      for (int m = 0; m < 4; ++m)
#pragma unroll
        for (int n = 0; n < 2; ++n) {
          const int rl = wr * 64 + m * 16 + fr, col = wc * 32 + n * 16 + fq * 4;
          u32x2 w;
          w.x = pk_bf16(bf_lo(uv[m][n].x) * (acc[m][n][0] + bs[m]), bf_hi(uv[m][n].x) * (acc[m][n][1] + bs[m]));
          w.y = pk_bf16(bf_lo(uv[m][n].y) * (acc[m][n][2] + bs[m]), bf_hi(uv[m][n].y) * (acc[m][n][3] + bs[m]));
          *(u32x2*)(p.Y + (t0 + rl) * DM + h * 128 + col) = w;
        }
    }, [&](int wr, int wc, int fr, int fq) {
#pragma unroll
      for (int m = 0; m < 4; ++m) {
        const int rl = wr * 64 + m * 16 + fr;
        bs[m] = p.b_sp[h * 128 + rl];
#pragma unroll
        for (int n = 0; n < 2; ++n) uv[m][n] = *(const u32x2*)(p.ZB + (t0 + rl) * INW + h * 128 + wc * 32 + n * 16 + fq * 4);
      }
    });
  }
}

__device__ __forceinline__ void ln_rows16(const float* __restrict__ PRE, long r0, const float* __restrict__ g, const float* __restrict__ b, bf16_t* __restrict__ Out, int lane) {
#pragma unroll 2
  for (int i = 0; i < 16; ++i) {
    const bf16_t* pr = (const bf16_t*)PRE + (r0 + i) * DM;
    float4 v[4];
    float sum = 0.f;
#pragma unroll
    for (int j = 0; j < 4; ++j) { const u32x2 pv = *(const u32x2*)(pr + j * 256 + lane * 4); v[j].x = bf_lo(pv.x); v[j].y = bf_hi(pv.x); v[j].z = bf_lo(pv.y); v[j].w = bf_hi(pv.y); sum += (v[j].x + v[j].y) + (v[j].z + v[j].w); }
    sum = wave_sum_f(sum);
    const float mu = sum * (1.f / DM);
    float q = 0.f;
#pragma unroll
    for (int j = 0; j < 4; ++j) { v[j].x -= mu; v[j].y -= mu; v[j].z -= mu; v[j].w -= mu; q += (v[j].x * v[j].x + v[j].y * v[j].y) + (v[j].z * v[j].z + v[j].w * v[j].w); }
    q = wave_sum_f(q);
    const float rstd = rsqrtf(q * (1.f / DM) + LN_EPS);
#pragma unroll
    for (int j = 0; j < 4; ++j) {
      const int c0 = j * 256 + lane * 4;
      const float4 gg = *(const float4*)(g + c0), bb = *(const float4*)(b + c0);
      u32x2 w; w.x = pk_bf16(v[j].x * rstd * gg.x + bb.x, v[j].y * rstd * gg.y + bb.y); w.y = pk_bf16(v[j].z * rstd * gg.z + bb.z, v[j].w * rstd * gg.w + bb.w);
      *(u32x2*)(Out + (r0 + i) * DM + c0) = w;
    }
  }
}

__device__ __forceinline__ void ln_rows16_q(const float* __restrict__ PRE, long r0, const float* __restrict__ g, const float* __restrict__ b, bf16_t* __restrict__ Out,
                                            unsigned char* __restrict__ XQ, float* __restrict__ SX, int lane) {
#pragma unroll 2
  for (int i = 0; i < 16; ++i) {
    const bf16_t* pr = (const bf16_t*)PRE + (r0 + i) * DM;
    float4 v[4];
    float sum = 0.f;
#pragma unroll
    for (int j = 0; j < 4; ++j) { const u32x2 pv = *(const u32x2*)(pr + j * 256 + lane * 4); v[j].x = bf_lo(pv.x); v[j].y = bf_hi(pv.x); v[j].z = bf_lo(pv.y); v[j].w = bf_hi(pv.y); sum += (v[j].x + v[j].y) + (v[j].z + v[j].w); }
    sum = wave_sum_f(sum);
    const float mu = sum * (1.f / DM);
    float q = 0.f;
#pragma unroll
    for (int j = 0; j < 4; ++j) { v[j].x -= mu; v[j].y -= mu; v[j].z -= mu; v[j].w -= mu; q += (v[j].x * v[j].x + v[j].y * v[j].y) + (v[j].z * v[j].z + v[j].w * v[j].w); }
    q = wave_sum_f(q);
    const float rstd = rsqrtf(q * (1.f / DM) + LN_EPS);
    float amax = 0.f;
#pragma unroll
    for (int j = 0; j < 4; ++j) {
      const int c0 = j * 256 + lane * 4;
      const float4 gg = *(const float4*)(g + c0), bb = *(const float4*)(b + c0);
      v[j].x = v[j].x * rstd * gg.x + bb.x; v[j].y = v[j].y * rstd * gg.y + bb.y; v[j].z = v[j].z * rstd * gg.z + bb.z; v[j].w = v[j].w * rstd * gg.w + bb.w;
      u32x2 w; w.x = pk_bf16(v[j].x, v[j].y); w.y = pk_bf16(v[j].z, v[j].w);
      *(u32x2*)(Out + (r0 + i) * DM + c0) = w;
      amax = fmaxf(amax, fmaxf(fmaxf(fabsf(v[j].x), fabsf(v[j].y)), fmaxf(fabsf(v[j].z), fabsf(v[j].w))));
    }
    amax = wave_max_f(amax);
    const float inv = amax > 0.f ? 127.f / amax : 0.f;
#pragma unroll
    for (int j = 0; j < 4; ++j) *(unsigned*)(XQ + (r0 + i) * DM + j * 256 + lane * 4) = pack4_i8(v[j].x * inv, v[j].y * inv, v[j].z * inv, v[j].w * inv);
    if (lane == 0) SX[r0 + i] = amax * (1.f / 127.f);
  }
}

__device__ __forceinline__ void phase_outproj(const P& p, int tile) {
  const long t0 = (long)tile * 128;
  {
    const int lane = threadIdx.x & 63, wid = threadIdx.x >> 6;
#pragma unroll 2
    for (int i = 0; i < 16; ++i) {
      const long row = t0 + wid * 16 + i;
      u32x2 v[4];
      float amax = 0.f;
#pragma unroll
      for (int j = 0; j < 4; ++j) {
        v[j] = *(const u32x2*)(p.Y + row * DM + 256 * j + lane * 4);
        amax = fmaxf(amax, fmaxf(fmaxf(fabsf(bf_lo(v[j].x)), fabsf(bf_hi(v[j].x))), fmaxf(fabsf(bf_lo(v[j].y)), fabsf(bf_hi(v[j].y)))));
      }
      amax = wave_max_f(amax);
      const float inv = amax > 0.f ? 127.f / amax : 0.f;
#pragma unroll
      for (int j = 0; j < 4; ++j) *(unsigned*)(p.YQ + row * DM + 256 * j + lane * 4) = pack4_i8(bf_lo(v[j].x) * inv, bf_hi(v[j].x) * inv, bf_lo(v[j].y) * inv, bf_hi(v[j].y) * inv);
      if (lane == 0) p.SY[row] = amax * (1.f / 127.f);
    }
  }
  wg_sync_mem();
  for (int nt = 0; nt < 4; ++nt) {
    float4 xr[4][4], swr[4]; float srr[4];
    wg_gemm_i8<256>(p.YQ + t0 * DM, DM, p.w_moQ + (long)nt * 256 * DM, DM, DM, [&](v4i_t (&acc)[4][4], int wr, int wc, int fr, int fq) {
#pragma unroll
      for (int m = 0; m < 4; ++m) {
        const long row = t0 + wr * 64 + m * 16 + fr;
        const float sr = srr[m];
#pragma unroll
        for (int n = 0; n < 4; ++n) {
          const int col = nt * 256 + wc * 64 + n * 16 + fq * 4;
          const float4 xv = xr[m][n];
          const float4 sw = swr[n];
          u32x2 o; o.x = pk_bf16(ALPHA * xv.x + (float)acc[m][n][0] * (sr * sw.x), ALPHA * xv.y + (float)acc[m][n][1] * (sr * sw.y));
          o.y = pk_bf16(ALPHA * xv.z + (float)acc[m][n][2] * (sr * sw.z), ALPHA * xv.w + (float)acc[m][n][3] * (sr * sw.w));
          *(u32x2*)((bf16_t*)p.PRE + row * DM + col) = o;
        }
      }
    }, [&](int wr, int wc, int fr, int fq) {
#pragma unroll
      for (int m = 0; m < 4; ++m)
#pragma unroll
        for (int n = 0; n < 4; ++n) xr[m][n] = *(const float4*)(p.x + (t0 + wr * 64 + m * 16 + fr) * DM + nt * 256 + wc * 64 + n * 16 + fq * 4);
#pragma unroll
      for (int m = 0; m < 4; ++m) srr[m] = p.SY[t0 + wr * 64 + m * 16 + fr];
#pragma unroll
      for (int n = 0; n < 4; ++n) swr[n] = *(const float4*)(p.sw_mo + nt * 256 + wc * 64 + n * 16 + fq * 4);
    });
  }
  wg_sync_mem();
  ln_rows16_q(p.PRE, t0 + (threadIdx.x >> 6) * 16, p.ln1_g, p.ln1_b, p.X1, p.X1Q, p.SX1, threadIdx.x & 63);
}

__device__ __forceinline__ void phase_kv(const P& p, int unit) {
  const int rt = unit >> 5, nc = unit & 31;
  wg_gemm<64>(p.memB + (long)rt * 128 * DM, DM, p.w_xkvT + (long)nc * 64 * DM, DM, DM, [&](f32x4 (&acc)[4][1], int wr, int wc, int fr, int fq) {
    const int b = rt >> 1, col = nc * 64 + wc * 16 + fq * 4, hh = (col >> 8) & 3, d = col & 255;
#pragma unroll
    for (int m = 0; m < 4; ++m) {
      const int mm = (rt & 1) * 128 + wr * 64 + m * 16 + fr;
      u32x2 w; w.x = pk_bf16(acc[m][0][0], acc[m][0][1]); w.y = pk_bf16(acc[m][0][2], acc[m][0][3]);
      *(u32x2*)((col < 1024 ? p.Kc : p.Vc) + ((long)(b * 4 + hh) * 256 + mm) * 256 + d) = w;
    }
  });
}

__device__ __forceinline__ void phase_gh(const P& p, int unit) {
  if (unit < 128) {
    const int bh = unit >> 3, rt = (unit >> 2) & 1, nt = unit & 3, h = bh & 3, b = bh >> 2;
    wg_gemm<256>(p.Kc + ((long)bh * 256 + rt * 128) * 256, 256, p.wxqB + (long)nt * 256 * DM + h * 256, DM, 256, [&](f32x4 (&acc)[4][4], int wr, int wc, int fr, int fq) {
#pragma unroll
      for (int m = 0; m < 4; ++m)
#pragma unroll
        for (int n = 0; n < 4; ++n) {
          const long row = (long)b * 1024 + h * 256 + rt * 128 + wr * 64 + m * 16 + fr; const int col = nt * 256 + wc * 64 + n * 16 + fq * 4;
          u32x2 w; w.x = pk_bf16(acc[m][n][0], acc[m][n][1]); w.y = pk_bf16(acc[m][n][2], acc[m][n][3]);
          *(u32x2*)(p.GTb + row * DM + col) = w;
        }
    });
  } else {
    const int u = unit - 128, bh = u >> 3, rt = u & 7, h = bh & 3, b = bh >> 2;
    wg_gemm<256>(p.w_xoT + (long)rt * 128 * DM + h * 256, DM, p.Vc + (long)bh * 256 * 256, 256, 256, [&](f32x4 (&acc)[4][4], int wr, int wc, int fr, int fq) {
#pragma unroll
      for (int m = 0; m < 4; ++m)
#pragma unroll
        for (int n = 0; n < 4; ++n) {
          const long row = (long)b * 1024 + rt * 128 + wr * 64 + m * 16 + fr; const int col = h * 256 + wc * 64 + n * 16 + fq * 4;
          u32x2 w; w.x = pk_bf16(acc[m][n][0], acc[m][n][1]); w.y = pk_bf16(acc[m][n][2], acc[m][n][3]);
          *(u32x2*)(p.HT + row * DM + col) = w;
        }
    });
  }
}

__device__ __forceinline__ void phase_gquant(const P& p) {
  const int lane = threadIdx.x & 63, wid = threadIdx.x >> 6;
#pragma unroll
  for (int i = 0; i < 2; ++i) {
    const long row = (long)blockIdx.x * 16 + wid * 2 + i;
    u32x2 v[4];
    float amax = 0.f;
#pragma unroll
    for (int j = 0; j < 4; ++j) {
      v[j] = *(const u32x2*)(p.GTb + row * DM + 256 * j + lane * 4);
      amax = fmaxf(amax, fmaxf(fmaxf(fabsf(bf_lo(v[j].x)), fabsf(bf_hi(v[j].x))), fmaxf(fabsf(bf_lo(v[j].y)), fabsf(bf_hi(v[j].y)))));
    }
    amax = wave_max_f(amax);
    const float inv = amax > 0.f ? 127.f / amax : 0.f;
#pragma unroll
    for (int j = 0; j < 4; ++j) *(unsigned*)(p.GTq + row * DM + 256 * j + lane * 4) = pack4_i8(bf_lo(v[j].x) * inv, bf_hi(v[j].x) * inv, bf_lo(v[j].y) * inv, bf_hi(v[j].y) * inv);
    if (lane == 0) p.sG[row] = amax * (1.f / 127.f);
  }
  {
    const long row = (long)blockIdx.x * 8 + wid;
    u32x2 v[4];
    float amax = 0.f;
#pragma unroll
    for (int j = 0; j < 4; ++j) {
      v[j] = *(const u32x2*)(p.w_pqT + row * DM + 256 * j + lane * 4);
      amax = fmaxf(amax, fmaxf(fmaxf(fabsf(bf_lo(v[j].x)), fabsf(bf_hi(v[j].x))), fmaxf(fabsf(bf_lo(v[j].y)), fabsf(bf_hi(v[j].y)))));
    }
    amax = wave_max_f(amax);
    const float inv = amax > 0.f ? 127.f / amax : 0.f;
#pragma unroll
    for (int j = 0; j < 4; ++j) *(unsigned*)(p.MTq + row * DM + 256 * j + lane * 4) = pack4_i8(bf_lo(v[j].x) * inv, bf_hi(v[j].x) * inv, bf_lo(v[j].y) * inv, bf_hi(v[j].y) * inv);
    if (lane == 0) p.sMT[row] = amax * (1.f / 127.f);
  }
}

__device__ __forceinline__ void phase_scores(const P& p, int tile) {
  const long t0 = (long)tile * 128;
  const int b = tile >> 6;
  LAS float* red = (LAS float*)((LAS char*)smem_raw + RED_OFF);
  for (int h = 0; h < 4; ++h) {
    bf16_t* Pw = p.Pb + t0 * DM + h * 256;
    float4 swr[4]; float srr[4];
    wg_gemm_i8<256>((const signed char*)p.X1Q + t0 * DM, DM, p.GTq + ((long)b * 1024 + h * 256) * DM, DM, DM, [&](v4i_t (&iacc)[4][4], int wr, int wc, int fr, int fq) {
      f32x4 acc[4][4];
      float rmax[4];
#pragma unroll
      for (int m = 0; m < 4; ++m) {
        const float sr = srr[m] * 0.0625f;
#pragma unroll
        for (int n = 0; n < 4; ++n) {
          const float4 sw = swr[n];
          acc[m][n][0] = (float)iacc[m][n][0] * (sr * sw.x); acc[m][n][1] = (float)iacc[m][n][1] * (sr * sw.y);
          acc[m][n][2] = (float)iacc[m][n][2] * (sr * sw.z); acc[m][n][3] = (float)iacc[m][n][3] * (sr * sw.w);
        }
      }
#pragma unroll
      for (int m = 0; m < 4; ++m) {
        float mx = -3.0e38f;
#pragma unroll
        for (int n = 0; n < 4; ++n) mx = fmaxf(mx, fmaxf(fmaxf(acc[m][n][0], acc[m][n][1]), fmaxf(acc[m][n][2], acc[m][n][3])));
        mx = fmaxf(mx, __shfl_xor(mx, 16)); mx = fmaxf(mx, __shfl_xor(mx, 32));
        if (fq == 0) red[(wr * 64 + m * 16 + fr) * 4 + wc] = mx;
      }
      __syncthreads();
#pragma unroll
      for (int m = 0; m < 4; ++m) {
        const f32x4 r = *(LAS const f32x4*)(red + (wr * 64 + m * 16 + fr) * 4);
        rmax[m] = fmaxf(fmaxf(r[0], r[1]), fmaxf(r[2], r[3]));
      }
#pragma unroll
      for (int m = 0; m < 4; ++m) {
        float sm = 0.f;
#pragma unroll
        for (int n = 0; n < 4; ++n)
#pragma unroll
          for (int j = 0; j < 4; ++j) { const float e = __expf(acc[m][n][j] - rmax[m]); acc[m][n][j] = e; sm += e; }
        sm += __shfl_xor(sm, 16); sm += __shfl_xor(sm, 32);
        if (fq == 0) red[512 + (wr * 64 + m * 16 + fr) * 4 + wc] = sm;
      }
      __syncthreads();
#pragma unroll
      for (int m = 0; m < 4; ++m) {
        const f32x4 r = *(LAS const f32x4*)(red + 512 + (wr * 64 + m * 16 + fr) * 4);
        const float inv = 1.f / ((r[0] + r[1]) + (r[2] + r[3]));
        const int rl = wr * 64 + m * 16 + fr;
#pragma unroll
        for (int n = 0; n < 4; ++n) {
          u32x2 w; w.x = pk_bf16(acc[m][n][0] * inv, acc[m][n][1] * inv); w.y = pk_bf16(acc[m][n][2] * inv, acc[m][n][3] * inv);
          *(u32x2*)(Pw + rl * DM + wc * 64 + n * 16 + fq * 4) = w;
        }
      }
    }, [&](int wr, int wc, int fr, int fq) {
#pragma unroll
      for (int m = 0; m < 4; ++m) srr[m] = p.SX1[t0 + wr * 64 + m * 16 + fr];
#pragma unroll
      for (int n = 0; n < 4; ++n) swr[n] = *(const float4*)(p.sG + b * 1024 + h * 256 + wc * 64 + n * 16 + fq * 4);
    });
  }
}

__device__ __forceinline__ void phase_oproj(const P& p, int tile) {
  const long t0 = (long)tile * 128;
  for (int nt = 0; nt < 4; ++nt) {
    u32x2 xr[4][4];
    wg_gemm<256>(p.Pb + t0 * DM, DM, p.HT + ((long)(tile >> 6) * 1024 + nt * 256) * DM, DM, DM, [&](f32x4 (&acc)[4][4], int wr, int wc, int fr, int fq) {
#pragma unroll
      for (int m = 0; m < 4; ++m)
#pragma unroll
        for (int n = 0; n < 4; ++n) {
          const long row = t0 + wr * 64 + m * 16 + fr; const int col = nt * 256 + wc * 64 + n * 16 + fq * 4;
          const u32x2 xv = xr[m][n];
          u32x2 o; o.x = pk_bf16(ALPHA * bf_lo(xv.x) + acc[m][n][0], ALPHA * bf_hi(xv.x) + acc[m][n][1]); o.y = pk_bf16(ALPHA * bf_lo(xv.y) + acc[m][n][2], ALPHA * bf_hi(xv.y) + acc[m][n][3]);
          *(u32x2*)((bf16_t*)p.PRE + row * DM + col) = o;
        }
    }, [&](int wr, int wc, int fr, int fq) {
#pragma unroll
      for (int m = 0; m < 4; ++m)
#pragma unroll
        for (int n = 0; n < 4; ++n) xr[m][n] = *(const u32x2*)(p.X1 + (t0 + wr * 64 + m * 16 + fr) * DM + nt * 256 + wc * 64 + n * 16 + fq * 4);
    });
  }
  wg_sync_mem();
  ln_rows16_q(p.PRE, t0 + (threadIdx.x >> 6) * 16, p.ln2_g, p.ln2_b, p.X2, p.XQ, p.SX, threadIdx.x & 63);
}

__device__ __forceinline__ unsigned f2key(float f) { const unsigned b = __float_as_uint(f); return b ^ ((unsigned)((int)b >> 31) | 0x80000000u); }
__device__ __forceinline__ float key2f(unsigned k) { return __uint_as_float(k ^ ((k & 0x80000000u) ? 0x80000000u : 0xffffffffu)); }
__device__ __forceinline__ void phase_pq(const P& p, int tile) {
  const long t0 = (long)tile * 128;
  for (int nt = 0; nt < 8; ++nt) {
    float4 swr[4]; float srr[4];
    wg_gemm_i8<256>((const signed char*)p.XQ + t0 * DM, DM, p.MTq + (long)nt * 256 * DM, DM, DM, [&](v4i_t (&acc)[4][4], int wr, int wc, int fr, int fq) {
#pragma unroll
      for (int m = 0; m < 4; ++m) {
        const long row = t0 + wr * 64 + m * 16 + fr;
        const float sr = srr[m];
#pragma unroll
        for (int n = 0; n < 4; ++n) {
          const int col = nt * 256 + wc * 64 + n * 16 + fq * 4;
          const float4 sw = swr[n];
          u32x2 w; w.x = pk_f16((float)acc[m][n][0] * (sr * sw.x), (float)acc[m][n][1] * (sr * sw.y)); w.y = pk_f16((float)acc[m][n][2] * (sr * sw.z), (float)acc[m][n][3] * (sr * sw.w));
          *(u32x2*)((unsigned short*)p.KEYS + row * 2048 + col) = w;
        }
      }
    }, [&](int wr, int wc, int fr, int fq) {
#pragma unroll
      for (int m = 0; m < 4; ++m) srr[m] = p.SX[t0 + wr * 64 + m * 16 + fr];
#pragma unroll
      for (int n = 0; n < 4; ++n) swr[n] = *(const float4*)(p.sMT + nt * 256 + wc * 64 + n * 16 + fq * 4);
    });
  }
}

__device__ __forceinline__ void phase_mt(const P& p, int unit) {
  const int hp = unit >> 2, nt = unit & 3;
  wg_gemm<256>(p.skb + (long)hp * 128 * 128, 128, p.wpqB + (long)nt * 256 * 2048 + hp * 128, 2048, 128, [&](f32x4 (&acc)[4][4], int wr, int wc, int fr, int fq) {
#pragma unroll
    for (int m = 0; m < 4; ++m)
#pragma unroll
      for (int n = 0; n < 4; ++n) {
        const int row = hp * 128 + wr * 64 + m * 16 + fr, col = nt * 256 + wc * 64 + n * 16 + fq * 4;
        u32x2 w; w.x = pk_bf16(acc[m][n][0], acc[m][n][1]); w.y = pk_bf16(acc[m][n][2], acc[m][n][3]);
        *(u32x2*)((bf16_t*)p.w_pqT + (long)row * DM + col) = w;
      }
  });
}

__device__ __forceinline__ unsigned cand_entry(int s) {
  unsigned e = 255u; int base = 0;
#pragma unroll
  for (int i = 0; i < 16; ++i) { const int cnt = 16 / (i + 1); if (s >= base && s < base + cnt) e = (unsigned)i | ((unsigned)(s - base) << 4); base += cnt; }
  return e;
}
template <int CTRL> __device__ __forceinline__ unsigned dpp_u(unsigned x) { return (unsigned)__builtin_amdgcn_mov_dpp((int)x, CTRL, 0xf, 0xf, true); }
template <int CTRL> __device__ __forceinline__ float dpp_f(float x) { return __int_as_float(__builtin_amdgcn_mov_dpp(__float_as_int(x), CTRL, 0xf, 0xf, true)); }
__device__ __forceinline__ unsigned umin_(unsigned a, unsigned b) { return a < b ? a : b; }
__device__ __forceinline__ unsigned row_min_u(unsigned x) {
  x = umin_(x, dpp_u<0x128>(x)); x = umin_(x, dpp_u<0x124>(x)); x = umin_(x, dpp_u<0x122>(x)); x = umin_(x, dpp_u<0x121>(x)); return x;
}
__device__ __forceinline__ float row_max_f(float x) { x = fmaxf(x, dpp_f<0x128>(x)); x = fmaxf(x, dpp_f<0x124>(x)); x = fmaxf(x, dpp_f<0x122>(x)); x = fmaxf(x, dpp_f<0x121>(x)); return x; }
__device__ __forceinline__ float row_sum_f(float x) { x += dpp_f<0x128>(x); x += dpp_f<0x124>(x); x += dpp_f<0x122>(x); x += dpp_f<0x121>(x); return x; }

#define KEYS_OFF 65536
#define KEY_STRIDE 528
template <int N> __device__ __forceinline__ unsigned top16_row(const unsigned (&k)[N], int r) {
  unsigned pm1 = 0xFFFFFFFEu, mine = 0;
#pragma unroll
  for (int rd = 0; rd < 16; ++rd) {
    unsigned d = pm1 - k[0];
#pragma unroll
    for (int i = 1; i < N; ++i) d = umin_(d, pm1 - k[i]);
    d = row_min_u(d);
    const unsigned nxt = pm1 - d;
    mine = (r == rd) ? nxt : mine;
    pm1 = nxt - 1;
  }
  return mine;
}

__device__ __forceinline__ void phase_route(const P& p, int tile) {
  const long t0 = (long)tile * 128;
  const int tid = otid(), lane = tid & 63, wid = tid >> 6, r = lane & 15, g = lane >> 4;
  LAS char* lds = (LAS char*)smem_raw;
  LAS unsigned char* tab = (LAS unsigned char*)(lds + RED_OFF);
  if (tid < 64) tab[tid] = (unsigned char)cand_entry(tid);
  unsigned ci[4], cj[4]; bool cval[4];
#pragma unroll
  for (int q = 0; q < 4; ++q) { const unsigned e = cand_entry(r * 4 + q); cval[q] = (e != 255u); ci[q] = ((unsigned)(g * 16) + (e & 15u)) * 4u; cj[q] = ((unsigned)(g * 16) + ((e >> 4) & 15u)) * 4u; }
  __syncthreads();
  auto load_keys = [&](int hp, u32x4 (&kb)[4]) {
#pragma unroll
    for (int ps = 0; ps < 4; ++ps) kb[ps] = *(const u32x4*)((const unsigned short*)p.KEYS + (t0 + wid * 16 + ps * 4 + g) * 2048 + hp * 128 + r * 8);
  };
  auto top_keys = [&](const u32x4 (&kb)[4], unsigned (&tp)[4]) {
#pragma unroll
    for (int ps = 0; ps < 4; ++ps) {
      const unsigned w[4] = {kb[ps].x, kb[ps].y, kb[ps].z, kb[ps].w};
      unsigned k[8];
#pragma unroll
      for (int i = 0; i < 4; ++i) {
        k[2 * i] = (f2key(f16_lo(w[i])) & ~127u) | (unsigned)(127 - (r * 8 + 2 * i));
        k[2 * i + 1] = (f2key(f16_hi(w[i])) & ~127u) | (unsigned)(126 - (r * 8 + 2 * i));
      }
      tp[ps] = top16_row<8>(k, r);
    }
  };
  u32x4 kA[4], kB[4];
  load_keys(0, kA);
  for (int h = 0; h < 8; ++h) {
    unsigned top[2][4];
    load_keys(h * 2 + 1, kB);
    top_keys(kA, top[0]);
    load_keys(h < 7 ? h * 2 + 2 : 15, kA);
    top_keys(kB, top[1]);
#pragma unroll
    for (int ps = 0; ps < 4; ++ps) {
      const int tk = wid * 16 + ps * 4 + g;
      const unsigned A = top[0][ps], B = top[1][ps];
      const float fa = key2f(A & ~127u), fb = key2f(B & ~127u);
      unsigned k2[4];
#pragma unroll
      for (int q = 0; q < 4; ++q) {
        const float va = __int_as_float(__builtin_amdgcn_ds_bpermute((int)ci[q], __float_as_int(fa)));
        const float vb = __int_as_float(__builtin_amdgcn_ds_bpermute((int)cj[q], __float_as_int(fb)));
        const unsigned kk = (f2key(va + vb) & ~63u) | (unsigned)(63 - (r * 4 + q));
        k2[q] = cval[q] ? kk : 0u;
      }
      const unsigned mine = top16_row<4>(k2, r);
      const unsigned slot = 63u - (mine & 63u);
      const unsigned e = tab[slot];
      const unsigned ka = (unsigned)__builtin_amdgcn_ds_bpermute((int)(((unsigned)(g * 16) + (e & 15u)) * 4u), (int)A);
      const unsigned kb = (unsigned)__builtin_amdgcn_ds_bpermute((int)(((unsigned)(g * 16) + ((e >> 4) & 15u)) * 4u), (int)B);
      const int expert = (int)((127u - (ka & 127u)) * 128u + (127u - (kb & 127u)));
      const float c = key2f(mine & ~63u);
      const float mx = row_max_f(c);
      const float ex = __expf(c - mx);
      const float sm = row_sum_f(ex);
      p.experts[(t0 + tk) * 128 + h * 16 + r] = expert;
      p.gates[(t0 + tk) * 128 + h * 16 + r] = ex / sm;
    }
  }
}

__device__ __forceinline__ f32x2_t ub01(unsigned w) { return (f32x2_t){(float)(w & 0xffu), (float)((w >> 8) & 0xffu)}; }
__device__ __forceinline__ f32x2_t ub23(unsigned w) { return (f32x2_t){(float)((w >> 16) & 0xffu), (float)(w >> 24)}; }
__device__ __forceinline__ int sum8_i(int x) {
  x += (int)dpp_u<0xB1>((unsigned)x); x += (int)dpp_u<0x4E>((unsigned)x); x += (int)dpp_u<0x141>((unsigned)x); return x;
}
struct GMeta { u32x4 xq; int er0, er1; };
__device__ __forceinline__ void phase_gdown(const P& p) {
  const int tid = otid(), lane = tid & 63, wid = tid >> 6, grp = lane >> 3, r8 = lane & 7;
  const int slice = blockIdx.x & 7, chunk = blockIdx.x >> 3;
  const unsigned char* tab = p.WDq + slice * 128 + r8 * 16;
  const char* sl = p.slabs + (size_t)(chunk * 8 + wid) * SLAB_BYTES;
  int* pd = (int*)(sl + OFF_ZB) + slice * 128 * 128;
  const unsigned char* xqb = (const unsigned char*)(sl + OFF_X2Q);
  const int* exb = (const int*)(sl + OFF_EXP);
  auto meta = [&](int ti, GMeta& m) {
    const int t = (ti < 127 ? ti : 127);
    m.xq = *(const u32x4*)(xqb + t * DM + slice * 128 + r8 * 16);
    m.er0 = exb[t * 128 + lane]; m.er1 = exb[t * 128 + 64 + lane];
  };
  auto issue = [&](const GMeta& m, u32x4 (&w)[16]) {
#pragma unroll
    for (int it = 0; it < 16; ++it) {
      const int e = __builtin_amdgcn_ds_bpermute(((it & 7) * 8 + grp) * 4, (it < 8) ? m.er0 : m.er1);
      w[it] = *(const u32x4*)(tab + (long)e * DM);
    }
  };
  auto consume = [&](int ti, const GMeta& m, const u32x4 (&w)[16]) {
    int c0 = 0, c1 = 0;
#pragma unroll
    for (int it = 0; it < 16; ++it) {
      int acc = __builtin_amdgcn_sdot4((int)w[it].x, (int)m.xq.x, 0, false);
      acc = __builtin_amdgcn_sdot4((int)w[it].y, (int)m.xq.y, acc, false); acc = __builtin_amdgcn_sdot4((int)w[it].z, (int)m.xq.z, acc, false); acc = __builtin_amdgcn_sdot4((int)w[it].w, (int)m.xq.w, acc, false);
      acc = sum8_i(acc);
      const bool mine = ((it & 7) == r8);
      c0 = (mine && it < 8) ? acc : c0;
      c1 = (mine && it >= 8) ? acc : c1;
    }
    pd[ti * 128 + r8 * 8 + grp] = c0; pd[ti * 128 + 64 + r8 * 8 + grp] = c1;
  };
  GMeta mA, mB; u32x4 wA[16], wB[16];
  meta(0, mA); issue(mA, wA); meta(1, mB);
  for (int ti = 0; ti < 128; ti += 2) {
    issue(mB, wB);
    consume(ti, mA, wA);
    meta(ti + 2, mA);
    issue(mA, wA);
    consume(ti + 1, mB, wB);
    meta(ti + 3, mB);
  }
}
__device__ __forceinline__ int cq_index(int k) { return ((k >> 5) * 8 + (k & 7)) * 4 + ((k >> 3) & 3); }
__device__ __forceinline__ void phase_gcomb(const P& p, int tile) {
  const int tid = otid(), lane = tid & 63, wid = tid >> 6;
  signed char* cq = (signed char*)(p.slabs + (size_t)tile * SLAB_BYTES + OFF_CQ);
  float* sc = (float*)(p.slabs + (size_t)tile * SLAB_BYTES + OFF_SC);
#pragma unroll 4
  for (int ti = 0; ti < 16; ++ti) {
    const int tl = wid * 16 + ti;
    const long t = (long)tile * 128 + tl;
    int s0 = 0, s1 = 0;
#pragma unroll
    for (int j = 0; j < 8; ++j) { s0 += p.PD[(j * 128 + tl) * 128 + lane]; s1 += p.PD[(j * 128 + tl) * 128 + 64 + lane]; }
    const int e0 = p.experts[t * 128 + lane], e1 = p.experts[t * 128 + 64 + lane];
    const float sx = p.SX[t];
    const float c0 = p.gates[t * 128 + lane] * gelu_f((float)s0 * p.sd[e0] * sx) * p.su[e0];
    const float c1 = p.gates[t * 128 + 64 + lane] * gelu_f((float)s1 * p.sd[e1] * sx) * p.su[e1];
    float amax = fmaxf(fabsf(c0), fabsf(c1));
    amax = wave_max_f(amax);
    const float inv = amax > 0.f ? 127.f / amax : 0.f;
    cq[tl * 128 + cq_index(lane)] = (signed char)__float2int_rn(c0 * inv);
    cq[tl * 128 + cq_index(lane + 64)] = (signed char)__float2int_rn(c1 * inv);
    if (lane == 0) sc[tl] = amax * (1.f / 127.f);
  }
}
struct UMeta { int er0, er1; unsigned cq[4]; };
__device__ __forceinline__ void phase_gup(const P& p) {
  const int tid = otid(), lane = tid & 63, wid = tid >> 6, grp = lane >> 3, r8 = lane & 7;
  const int slice = blockIdx.x & 7, chunk = blockIdx.x >> 3;
  const unsigned char* tab = p.WUq + slice * 128 + r8 * 16;
  char* sl = p.slabs + (size_t)(chunk * 8 + wid) * SLAB_BYTES;
  const int* exb = (const int*)(sl + OFF_EXP);
  const unsigned* cqb = (const unsigned*)(sl + OFF_CQ);
  const float* scb = (const float*)(sl + OFF_SC);
  bf16_t* h3b = (bf16_t*)(sl + OFF_ZB);
  auto meta = [&](int ti, UMeta& m) {
    const int t = (ti < 127 ? ti : 127);
    m.er0 = exb[t * 128 + lane]; m.er1 = exb[t * 128 + 64 + lane];
#pragma unroll
    for (int j = 0; j < 4; ++j) m.cq[j] = cqb[t * 32 + j * 8 + grp];
  };
  auto issue = [&](const UMeta& m, u32x4 (&w)[16]) {
#pragma unroll
    for (int it = 0; it < 16; ++it) {
      const int e = __builtin_amdgcn_ds_bpermute(((it & 7) * 8 + grp) * 4, (it < 8) ? m.er0 : m.er1);
      w[it] = *(const u32x4*)(tab + (long)e * DM);
    }
  };
  auto consume = [&](int ti, const UMeta& m, const u32x4 (&w)[16]) {
    int o[16];
#pragma unroll
    for (int i = 0; i < 16; ++i) o[i] = 0;
#pragma unroll
    for (int j = 0; j < 4; ++j) {
      const unsigned x0[4] = {w[4 * j].x, w[4 * j].y, w[4 * j].z, w[4 * j].w}, x1[4] = {w[4 * j + 1].x, w[4 * j + 1].y, w[4 * j + 1].z, w[4 * j + 1].w};
      const unsigned x2[4] = {w[4 * j + 2].x, w[4 * j + 2].y, w[4 * j + 2].z, w[4 * j + 2].w}, x3[4] = {w[4 * j + 3].x, w[4 * j + 3].y, w[4 * j + 3].z, w[4 * j + 3].w};
#pragma unroll
      for (int d = 0; d < 4; ++d) {
        const unsigned t0 = __builtin_amdgcn_perm(x1[d], x0[d], 0x05010400u), t1 = __builtin_amdgcn_perm(x1[d], x0[d], 0x07030602u);
        const unsigned u0 = __builtin_amdgcn_perm(x3[d], x2[d], 0x05010400u), u1 = __builtin_amdgcn_perm(x3[d], x2[d], 0x07030602u);
        o[d * 4 + 0] = __builtin_amdgcn_sdot4((int)__builtin_amdgcn_perm(u0, t0, 0x05040100u), (int)m.cq[j], o[d * 4 + 0], false);
        o[d * 4 + 1] = __builtin_amdgcn_sdot4((int)__builtin_amdgcn_perm(u0, t0, 0x07060302u), (int)m.cq[j], o[d * 4 + 1], false);
        o[d * 4 + 2] = __builtin_amdgcn_sdot4((int)__builtin_amdgcn_perm(u1, t1, 0x05040100u), (int)m.cq[j], o[d * 4 + 2], false);
        o[d * 4 + 3] = __builtin_amdgcn_sdot4((int)__builtin_amdgcn_perm(u1, t1, 0x07060302u), (int)m.cq[j], o[d * 4 + 3], false);
      }
    }
    const float sct = scb[ti];
    float f[16];
#pragma unroll
    for (int i = 0; i < 16; ++i) {
      int a = o[i];
      a += (int)dpp_u<0x128>((unsigned)a);
      a += __shfl_xor(a, 16);
      a += __shfl_xor(a, 32);
      f[i] = (float)a * sct;
    }
    if (grp == 0) {
      bf16_t* dst = h3b + ti * DM + slice * 128 + r8 * 16;
      u32x4 q0, q1;
      q0.x = pk_bf16(f[0], f[1]); q0.y = pk_bf16(f[2], f[3]); q0.z = pk_bf16(f[4], f[5]); q0.w = pk_bf16(f[6], f[7]);
      q1.x = pk_bf16(f[8], f[9]); q1.y = pk_bf16(f[10], f[11]); q1.z = pk_bf16(f[12], f[13]); q1.w = pk_bf16(f[14], f[15]);
      *(u32x4*)dst = q0; *(u32x4*)(dst + 8) = q1;
    }
  };
  UMeta mA, mB; u32x4 wA[16], wB[16];
  meta(0, mA); issue(mA, wA); meta(1, mB);
  for (int ti = 0; ti < 128; ti += 2) {
    issue(mB, wB);
    consume(ti, mA, wA);
    meta(ti + 2, mA);
    issue(mA, wA);
    consume(ti + 1, mB, wB);
    meta(ti + 3, mB);
  }
}
__device__ __forceinline__ void phase_ln3(const P& p, int tile) {
  const int tid = otid(), lane = tid & 63, wid = tid >> 6;
#pragma unroll 2
  for (int ti = 0; ti < 16; ++ti) {
    const long t = (long)tile * 128 + wid * 16 + ti;
    float4 v[4];
    float sum = 0.f;
#pragma unroll
    for (int j = 0; j < 4; ++j) {
      const int c0 = j * 256 + lane * 4;
      const u32x2 hv = *(const u32x2*)((const bf16_t*)p.H3 + t * DM + c0);
      const u32x2 xv = *(const u32x2*)(p.X2 + t * DM + c0);
      v[j].x = bf_lo(hv.x) + ALPHA * bf_lo(xv.x); v[j].y = bf_hi(hv.x) + ALPHA * bf_hi(xv.x); v[j].z = bf_lo(hv.y) + ALPHA * bf_lo(xv.y); v[j].w = bf_hi(hv.y) + ALPHA * bf_hi(xv.y);
      sum += (v[j].x + v[j].y) + (v[j].z + v[j].w);
    }
    sum = wave_sum_f(sum);
    const float mu = sum * (1.f / DM);
    float q = 0.f;
#pragma unroll
    for (int j = 0; j < 4; ++j) { v[j].x -= mu; v[j].y -= mu; v[j].z -= mu; v[j].w -= mu; q += (v[j].x * v[j].x + v[j].y * v[j].y) + (v[j].z * v[j].z + v[j].w * v[j].w); }
    q = wave_sum_f(q);
    const float rstd = rsqrtf(q * (1.f / DM) + LN_EPS);
#pragma unroll
    for (int j = 0; j < 4; ++j) {
      const int c0 = j * 256 + lane * 4;
      const float4 gg = *(const float4*)(p.ln3_g + c0), bb = *(const float4*)(p.ln3_b + c0);
      float4 o; o.x = v[j].x * rstd * gg.x + bb.x; o.y = v[j].y * rstd * gg.y + bb.y; o.z = v[j].z * rstd * gg.z + bb.z; o.w = v[j].w * rstd * gg.w + bb.w;
      *(float4*)(p.out + t * DM + c0) = o;
    }
  }
}

__device__ __forceinline__ void prep_transpose_tile(const float* __restrict__ W, bf16_t* __restrict__ WT, int K, int N, int tileidx) {
  LAS float* scr = (LAS float*)smem_raw;
  const int ntn = N / 64, k0 = (tileidx / ntn) * 64, n0 = (tileidx % ntn) * 64, tid = threadIdx.x;
#pragma unroll
  for (int i = 0; i < 8; ++i) { const int e = tid + i * 512, kk = e >> 6, nn = e & 63; scr[kk * 65 + nn] = W[(long)(k0 + kk) * N + n0 + nn]; }
  __syncthreads();
#pragma unroll
  for (int i = 0; i < 4; ++i) { const int e = tid + i * 512, nn = e >> 5, kp = (e & 31) * 2; *(unsigned*)(WT + (long)(n0 + nn) * K + k0 + kp) = pk_bf16(scr[kp * 65 + nn], scr[(kp + 1) * 65 + nn]); }
  __syncthreads();
}
__device__ __forceinline__ void prep_quant_strip(const float* __restrict__ W, signed char* __restrict__ Q, float* __restrict__ sc, int K, int N, int strip) {
  LAS float* scr = (LAS float*)smem_raw;
  LAS float* pmax = scr + 64 * 65;
  LAS float* inv = pmax + 8 * 64;
  const int n0 = strip * 64, tid = threadIdx.x, nn = tid & 63, kg = tid >> 6;
  float amax = 0.f;
#pragma unroll 4
  for (int k0 = 0; k0 < K; k0 += 64)
#pragma unroll
    for (int i = 0; i < 8; ++i) amax = fmaxf(amax, fabsf(W[(long)(k0 + kg + 8 * i) * N + n0 + nn]));
  pmax[kg * 64 + nn] = amax;
  __syncthreads();
  if (tid < 64) {
    float m = 0.f;
#pragma unroll
    for (int j = 0; j < 8; ++j) m = fmaxf(m, pmax[j * 64 + tid]);
    inv[tid] = m > 0.f ? 127.f / m : 0.f;
    sc[n0 + tid] = m * (1.f / 127.f);
  }
  __syncthreads();
  const float iv = inv[nn];
  float cur[8];
#pragma unroll
  for (int i = 0; i < 8; ++i) cur[i] = W[(long)(kg + 8 * i) * N + n0 + nn];
  for (int k0 = 0; k0 < K; k0 += 64) {
    float nxt[8];
    const int k1 = k0 + 64 < K ? k0 + 64 : k0;
#pragma unroll
    for (int i = 0; i < 8; ++i) nxt[i] = W[(long)(k1 + kg + 8 * i) * N + n0 + nn];
#pragma unroll
    for (int i = 0; i < 8; ++i) { const int kk = kg + 8 * i; scr[kk * 65 + nn] = cur[i] * iv; }
#pragma unroll
    for (int i = 0; i < 8; ++i) cur[i] = nxt[i];
    __syncthreads();
#pragma unroll
    for (int i = 0; i < 2; ++i) {
      const int dd = tid + i * 512, n = dd >> 4, k4 = (dd & 15) * 4;
      *(unsigned*)(Q + (long)(n0 + n) * K + k0 + k4) = pack4_i8(scr[k4 * 65 + n], scr[(k4 + 1) * 65 + n], scr[(k4 + 2) * 65 + n], scr[(k4 + 3) * 65 + n]);
    }
    __syncthreads();
  }
}
__device__ __forceinline__ void prep_cvt(const float* __restrict__ in, bf16_t* __restrict__ out, long n8) {
  for (long i = (long)blockIdx.x * 512 + threadIdx.x; i < n8; i += (long)gridDim.x * 512) {
    const float4 a = *(const float4*)(in + i * 8), b = *(const float4*)(in + i * 8 + 4);
    u32x4 o; o.x = pk_bf16(a.x, a.y); o.y = pk_bf16(a.z, a.w); o.z = pk_bf16(b.x, b.y); o.w = pk_bf16(b.z, b.w);
    *(u32x4*)(out + i * 8) = o;
  }
}
__device__ __forceinline__ void phase_prep(const P& p) {
  const int T_IN = 16 * 40, T_SQ = 16 * 16, T_W2 = 16 * 32;
  const int total = T_IN + T_SQ + T_SQ + T_W2 + T_SQ + T_W2;
  for (int it = blockIdx.x; it < total; it += gridDim.x) {
    int r = it;
    if (r < T_IN) { if (r < 40) prep_quant_strip(p.w_in, p.w_inQ, p.sw_in, DM, INW, r); continue; } r -= T_IN;
    if (r < T_SQ) { if (r < 16) prep_quant_strip(p.w_mo, p.w_moQ, p.sw_mo, DM, DM, r); continue; } r -= T_SQ;
    if (r < T_SQ) { continue; } r -= T_SQ;
    if (r < T_W2) { prep_transpose_tile(p.w_xkv, (bf16_t*)p.w_xkvT, DM, 2048, r); continue; } r -= T_W2;
    if (r < T_SQ) { prep_transpose_tile(p.w_xo, (bf16_t*)p.w_xoT, DM, DM, r); continue; } r -= T_SQ;
    (void)r;
  }
  prep_cvt(p.mem, (bf16_t*)p.memB, (long)1024 * DM / 8);
  prep_cvt(p.sub_keys, (bf16_t*)p.skb, (long)8 * 2 * 128 * 128 / 8);
  prep_cvt(p.w_pq, (bf16_t*)p.wpqB, (long)DM * 2048 / 8);
  prep_cvt(p.w_xq, (bf16_t*)p.wxqB, (long)DM * DM / 8);
  {
    const int lane = threadIdx.x & 63, b = blockIdx.x;
    const bool strip_wg = b < 40 || (b >= 128 && b < 144);
    const int rank = b < 128 ? b - 40 : b - 144 + 88;
    {
    for (int row = strip_wg ? 2 * 16384 : rank * 8 + (threadIdx.x >> 6); row < 2 * 16384; row += 1600) {
      const int tb = row >> 14, e = row & 16383;
      const float* src = (tb ? p.w_up : p.w_down) + (long)e * DM;
      float4 v[4];
      float amax = 0.f;
#pragma unroll
      for (int i = 0; i < 4; ++i) { v[i] = *(const float4*)(src + 256 * i + lane * 4); amax = fmaxf(amax, fmaxf(fmaxf(fabsf(v[i].x), fabsf(v[i].y)), fmaxf(fabsf(v[i].z), fabsf(v[i].w)))); }
      amax = wave_max_f(amax);
      const float inv = amax > 0.f ? 127.f / amax : 0.f;
      unsigned char* dst = (unsigned char*)(tb ? p.WUq : p.WDq) + (long)e * DM;
      const float off = 0.f;
#pragma unroll
      for (int i = 0; i < 4; ++i) *(unsigned*)(dst + 256 * i + lane * 4) = pack4_i8(v[i].x * inv + off, v[i].y * inv + off, v[i].z * inv + off, v[i].w * inv + off);
      if (lane == 0) { float* sc = (float*)(tb ? p.su : p.sd); sc[e] = amax * (1.f / 127.f); }
    }
    }
  }
  for (int i = blockIdx.x * 512 + threadIdx.x; i < 4 * 128 * 128 / 2; i += gridDim.x * 512) {
    const int e = i * 2, t = (e >> 7) & 127, sidx = e & 127;
    const float2 v = *(const float2*)(p.w_sp + e);
    *(unsigned*)((bf16_t*)p.wsb + e) = pk_bf16(sidx <= t ? v.x : 0.f, (sidx + 1) <= t ? v.y : 0.f);
  }
}
__device__ __forceinline__ void phase_xcvt(const P& p, int tile) {
  const int lane = threadIdx.x & 63, wid = threadIdx.x >> 6;
  signed char* xq = (signed char*)(p.slabs + (size_t)tile * SLAB_BYTES + OFF_XB);
  float* sxr = (float*)(p.slabs + (size_t)tile * SLAB_BYTES + OFF_SXB);
#pragma unroll 2
  for (int i = 0; i < 16; ++i) {
    const int rl = wid * 16 + i;
    const float* src = p.x + ((long)tile * 128 + rl) * DM;
    float4 v[4];
    float amax = 0.f;
#pragma unroll
    for (int j = 0; j < 4; ++j) { v[j] = *(const float4*)(src + 256 * j + lane * 4); amax = fmaxf(amax, fmaxf(fmaxf(fabsf(v[j].x), fabsf(v[j].y)), fmaxf(fabsf(v[j].z), fabsf(v[j].w)))); }
    amax = wave_max_f(amax);
    const float inv = amax > 0.f ? 127.f / amax : 0.f;
#pragma unroll
    for (int j = 0; j < 4; ++j) *(unsigned*)(xq + rl * DM + 256 * j + lane * 4) = pack4_i8(v[j].x * inv, v[j].y * inv, v[j].z * inv, v[j].w * inv);
    if (lane == 0) sxr[rl] = amax * (1.f / 127.f);
  }
}
__device__ __forceinline__ void phase_halo(const P& p, int tile) {
  const int tid = otid();
  if (tid < 128) {
    const int rr = tid >> 6, c = (tid & 63) * 8;
    const bf16_t* zr = p.ZB + ((long)tile * 128 + 126 + rr) * INW;
    const u32x4 hb = *(const u32x4*)(zr + 1024 + c), gc = *(const u32x4*)(zr + 2048 + c);
    u32x4 o;
    o.x = pk_bf16(bf_lo(hb.x) * bf_lo(gc.x), bf_hi(hb.x) * bf_hi(gc.x)); o.y = pk_bf16(bf_lo(hb.y) * bf_lo(gc.y), bf_hi(hb.y) * bf_hi(gc.y));
    o.z = pk_bf16(bf_lo(hb.z) * bf_lo(gc.z), bf_hi(hb.z) * bf_hi(gc.z)); o.w = pk_bf16(bf_lo(hb.w) * bf_lo(gc.w), bf_hi(hb.w) * bf_hi(gc.w));
    *(u32x4*)(p.HALO + ((long)tile * 2 + rr) * 512 + c) = o;
  }
}

__device__ __forceinline__ P tile_view(const P& p, int tile) {
  P q = p;
  char* sl = p.slabs + (size_t)tile * SLAB_BYTES;
  const long t0 = (long)tile * 128;
  q.XB = (bf16_t*)(sl + OFF_XB) - t0 * DM; q.X1 = (bf16_t*)(sl + OFF_XB) - t0 * DM;
  q.experts = (int*)(sl + OFF_EXP) - t0 * 128; q.gates = (float*)(sl + OFF_GATE) - t0 * 128;
  q.ZB = (bf16_t*)(sl + OFF_ZB) - t0 * INW; q.PRE = (float*)((bf16_t*)(sl + OFF_ZB) - t0 * DM); q.KEYS = (unsigned*)((unsigned short*)(sl + OFF_ZB) - t0 * 2048);
  q.PD = (int*)(sl + OFF_ZB); q.H3 = (float*)((bf16_t*)(sl + OFF_ZB) - t0 * DM);
  q.VT = (bf16_t*)(sl + OFF_VT) - (long)tile * 4 * 128 * 128; q.X1Q = (unsigned char*)(sl + OFF_VT) - t0 * DM; q.XQ = (unsigned char*)(sl + OFF_X2Q) - t0 * DM;
  q.Y = (bf16_t*)(sl + OFF_Y) - t0 * DM; q.Pb = (bf16_t*)(sl + OFF_Y) - t0 * DM;
  q.Q = (bf16_t*)(sl + OFF_Q) - t0 * DM; q.X2 = (bf16_t*)(sl + OFF_Q) - t0 * DM; q.YQ = (signed char*)(sl + OFF_Q) - t0 * DM;
  return q;
}

#define XB_TMO      128
#define XB_XCNT(j)  (256  + 64 * (j))
#define XB_XSUB(j)  (1280 + 64 * (j))
#define XB_XGEN(j)  (2304 + 64 * (j))
#define XB_TOP      3328
#define XB_TOPGEN   3392
#define XB_SPIN_CAP (1u << 18)

__device__ __forceinline__ unsigned xb_ld(unsigned* p)              { return __hip_atomic_load(p, __ATOMIC_RELAXED, __HIP_MEMORY_SCOPE_AGENT); }
__device__ __forceinline__ unsigned xb_add(unsigned* p, unsigned v) { return __hip_atomic_fetch_add(p, v, __ATOMIC_RELAXED, __HIP_MEMORY_SCOPE_AGENT); }
__device__ __forceinline__ unsigned xb_xcc_id() { return (unsigned)__builtin_amdgcn_s_getreg((3 << 11) | 20) & 0xFu; }
#define XB_SPIN(cond, bar) do { unsigned _sp = 0; while (cond) { __builtin_amdgcn_s_sleep(1); \
    if ((++_sp & 255u) == 0u) { if (xb_ld(&(bar)[XB_TMO])) break; if (_sp > XB_SPIN_CAP) { atomicAdd(&(bar)[XB_TMO], 1u); break; } } } } while (0)

struct XcdBarrier {
    unsigned* bar; unsigned x;
    volatile LAS unsigned* st;
};

__device__ __forceinline__ XcdBarrier xcd_barrier_post(unsigned* bar, volatile LAS unsigned* st) {
    XcdBarrier b; b.bar = bar; b.x = xb_xcc_id(); b.st = st;
    if (threadIdx.x == 0) (void)xb_add(&bar[XB_XCNT(b.x)], 1u);
    return b;
}
__device__ __forceinline__ void xcd_barrier_complete(unsigned* bar, unsigned x, unsigned& nloc, unsigned& nx) {
    const unsigned G = gridDim.x * gridDim.y * gridDim.z;
    unsigned sum, cnt, mine, sp = 0u;
    for (;;) {
        sum = 0u; cnt = 0u; mine = 0u;
#pragma unroll
        for (unsigned j = 0; j < 16; ++j) { const unsigned c = xb_ld(&bar[XB_XCNT(j)]); sum += c; cnt += (c > 0u) ? 1u : 0u; mine = (j == x) ? c : mine; }
        if (sum == G) break;
        __builtin_amdgcn_s_sleep(1);
        if ((++sp & 255u) == 0u) { if (xb_ld(&bar[XB_TMO])) break; if (sp > XB_SPIN_CAP) { atomicAdd(&bar[XB_TMO], 1u); break; } }
    }
    nloc = mine > 0u ? mine : 1u; nx = cnt > 0u ? cnt : 1u;
}

__device__ __forceinline__ void xcd_barrier(const XcdBarrier& b) {
    asm volatile("s_waitcnt vmcnt(0)" ::: "memory");
    __syncthreads();
    if (threadIdx.x == 0) {
        unsigned* bar = b.bar;
        __builtin_amdgcn_s_waitcnt(0);
        unsigned nloc = b.st[0], nx = b.st[1];
        if (nloc == 0u) { xcd_barrier_complete(bar, b.x, nloc, nx); b.st[0] = nloc; b.st[1] = nx; }
        const unsigned old = xb_add(&bar[XB_XSUB(b.x)], 1u);
        const unsigned gen = old / nloc;
        if (old + 1u == (gen + 1u) * nloc) {
            __builtin_amdgcn_fence(__ATOMIC_RELEASE, "agent");
            asm volatile("s_waitcnt vmcnt(0)" ::: "memory");
            const unsigned og = xb_add(&bar[XB_TOP], 1u);
            const unsigned tg = og / nx;
            if (og + 1u == (tg + 1u) * nx) xb_add(&bar[XB_TOPGEN], 1u);
            else XB_SPIN(xb_ld(&bar[XB_TOPGEN]) == tg, bar);
            __builtin_amdgcn_fence(__ATOMIC_ACQUIRE, "agent");
            xb_add(&bar[XB_XGEN(b.x)], 1u);
            asm volatile("s_waitcnt vmcnt(0)" ::: "memory");
        } else {
            XB_SPIN(xb_ld(&bar[XB_XGEN(b.x)]) == gen, bar);
            __builtin_amdgcn_fence(__ATOMIC_ACQUIRE, "agent");
            asm volatile("s_waitcnt vmcnt(0)" ::: "memory");
        }
    }
    __syncthreads();
}


__global__ __launch_bounds__(512) void mega_k(P pg) {
  const int tile = blockIdx.x;
  volatile LAS unsigned* xbw = (volatile LAS unsigned*)((LAS char*)smem_raw + XB_LDS_OFF);
  if (threadIdx.x < 4) xbw[threadIdx.x] = 0u;
  __syncthreads();
  XcdBarrier xb = xcd_barrier_post(pg.bar, xbw);
  const P p = tile_view(pg, tile);
  phase_prep(pg);
  phase_xcvt(p, tile);
  xcd_barrier(xb);
  phase_inproj(p, tile);
  wg_sync_mem();
  phase_halo(p, tile);
  phase_kv(p, tile);
  if (tile < 64) phase_mt(p, tile);
  xcd_barrier(xb);
  phase_gh(p, tile);
  wg_sync_mem();
  phase_mixer(p, tile);
  wg_sync_mem();
  phase_outproj(p, tile);
  wg_sync_mem();
  xcd_barrier(xb);
  phase_gquant(pg);
  xcd_barrier(xb);
  phase_scores(p, tile);
  wg_sync_mem();
  phase_oproj(p, tile);
  wg_sync_mem();
  phase_pq(p, tile);
  wg_sync_mem();
  phase_route(p, tile);
  xcd_barrier(xb);
  phase_gdown(pg);
  xcd_barrier(xb);
  phase_gcomb(p, tile);
  xcd_barrier(xb);
  phase_gup(pg);
  xcd_barrier(xb);
  phase_ln3(p, tile);
}

extern "C" void kernel_launch(void* const* d_in, const int* in_sizes, int n_in, void* d_out, int out_size, void* d_ws, size_t ws_size, hipStream_t stream) {
  static int grid_blocks = 0;
  if (grid_blocks == 0) {
    int dev = 0, cus = 0, per_cu = 0;
    (void)hipGetDevice(&dev);
    (void)hipDeviceGetAttribute(&cus, hipDeviceAttributeMultiprocessorCount, dev);
    if (hipFuncSetAttribute((const void*)mega_k, hipFuncAttributeMaxDynamicSharedMemorySize, LDS_BYTES) != hipSuccess) fprintf(stderr, "kernel_launch: hipFuncSetAttribute failed\n");
    if (hipOccupancyMaxActiveBlocksPerMultiprocessor(&per_cu, (const void*)mega_k, 512, LDS_BYTES) != hipSuccess || per_cu < 1) { fprintf(stderr, "kernel_launch: occupancy query says %d blocks/CU\n", per_cu); per_cu = 1; }
    (void)hipGetLastError();
    grid_blocks = NTOK / 128;
    if (cus * per_cu < grid_blocks) fprintf(stderr, "kernel_launch: device holds only %d x %d resident blocks, need %d\n", cus, per_cu, grid_blocks);
  }
  char* w8 = (char*)d_ws;
  const size_t MiB = (size_t)1 << 20;
  P p{};
  p.x = (const float*)d_in[0]; p.mem = (const float*)d_in[1]; p.w_in = (const float*)d_in[2]; p.b_in = (const float*)d_in[3];
  p.sgu_g = (const float*)d_in[4]; p.sgu_b = (const float*)d_in[5]; p.w_sp = (const float*)d_in[6]; p.b_sp = (const float*)d_in[7];
  p.conv_w = (const float*)d_in[8]; p.w_mo = (const float*)d_in[9]; p.ln1_g = (const float*)d_in[10]; p.ln1_b = (const float*)d_in[11];
  p.w_xq = (const float*)d_in[12]; p.w_xkv = (const float*)d_in[13]; p.w_xo = (const float*)d_in[14]; p.ln2_g = (const float*)d_in[15]; p.ln2_b = (const float*)d_in[16];
  p.w_pq = (const float*)d_in[17]; p.sub_keys = (const float*)d_in[18]; p.w_down = (const float*)d_in[19]; p.w_up = (const float*)d_in[20];
  p.ln3_g = (const float*)d_in[21]; p.ln3_b = (const float*)d_in[22];
  p.out = (float*)d_out;
  p.slabs = w8;
  bf16_t* wb = (bf16_t*)(w8 + 384 * MiB);
  p.w_inT = wb; p.w_inQ = (signed char*)wb; wb += (size_t)INW * DM / 2; p.sw_in = (float*)wb; wb += 2 * INW; p.w_moT = wb; p.w_moQ = (signed char*)wb; wb += (size_t)DM * DM / 2; p.sw_mo = (float*)wb; wb += 2 * DM; p.wsb = wb; wb += 4 * 128 * 128;
  p.w_xqT = wb; p.GTq = (signed char*)wb; wb += (size_t)4 * 1024 * DM / 2; p.sG = (float*)wb; wb += 2 * 4096; p.w_xkvT = wb; wb += (size_t)2048 * DM; p.w_xoT = wb; wb += (size_t)DM * DM;
  p.memB = wb; wb += (size_t)1024 * DM; p.Kc = wb; wb += (size_t)1024 * DM; p.Vc = wb; wb += (size_t)1024 * DM; p.wxqB = wb; wb += (size_t)DM * DM; p.GTb = wb; wb += (size_t)4 * 1024 * DM; p.HT = wb; wb += (size_t)4 * 1024 * DM;
  p.w_pqT = wb; wb += (size_t)2048 * DM; p.MTq = (signed char*)wb; wb += (size_t)2048 * DM / 2; p.sMT = (float*)wb; wb += 2 * 2048; p.wpqB = wb; wb += (size_t)2048 * DM; p.skb = wb; wb += (size_t)8 * 2 * 128 * 128;
  p.WDq = (const unsigned char*)wb; wb += (size_t)16384 * DM / 2; p.WUq = (const unsigned char*)wb; wb += (size_t)16384 * DM / 2;
  p.sd = (const float*)wb; wb += 2 * 16384; p.su = (const float*)wb; wb += 2 * 16384;
  p.HALO = wb; wb += (size_t)256 * 2 * 512;
  p.SX = (float*)wb; wb += 2 * NTOK; p.SY = (float*)wb; wb += 2 * NTOK; p.SX1 = (float*)wb; wb += 2 * NTOK;
  p.bar = (unsigned*)wb; wb += 2 * 4096;
  if ((size_t)((char*)wb - w8) > ws_size) fprintf(stderr, "kernel_launch: workspace too small\n");
  (void)hipMemsetAsync(p.bar, 0, (XCD_BAR_WORDS + 128) * 4, stream);
  void* args[] = {&p};
  hipError_t e = hipLaunchCooperativeKernel((const void*)mega_k, dim3(grid_blocks), dim3(512), args, LDS_BYTES, stream);
  if (e != hipSuccess) fprintf(stderr, "cooperative launch failed: %s (grid %d)\n", hipGetErrorString(e), grid_blocks);
}
```

```cpp
#include <hip/hip_runtime.h>
#include <stdint.h>
#include <cstdio>

#define DM 1024
#define NTOK 32768
#define SEQ 8192
#define INW 2560
#define ALPHA 1.189207115002721f
#define LN_EPS 1e-5f

__device__ __forceinline__ float gelu_f(float v) {
  const float t = __builtin_amdgcn_rcpf(fabsf(v) * 0.2316418882f + 1.0f);
  float q = t * 0.5307027145f + (-0.7265760135f); q = q * t + 0.7107068705f; q = q * t + (-0.142248368f); q = q * t + 0.127414796f; q = q * t;
  const float e = __builtin_amdgcn_exp2f((v * v) * (-0.72134752044f));
  const float m = v * (q * e);
  return v < 0.f ? m : v - m;
}

typedef unsigned short bf16_t;
typedef short bf16x8 __attribute__((ext_vector_type(8)));
typedef float f32x4 __attribute__((ext_vector_type(4)));
typedef unsigned u32x4 __attribute__((ext_vector_type(4)));
typedef unsigned u32x2 __attribute__((ext_vector_type(2)));
#define LAS __attribute__((address_space(3)))
extern __shared__ __attribute__((aligned(16))) char smem_raw[];

typedef float f32x2_t __attribute__((ext_vector_type(2)));
typedef __bf16 bf16x2_t __attribute__((ext_vector_type(2)));
typedef _Float16 f16x2_t __attribute__((ext_vector_type(2)));
__device__ __forceinline__ unsigned pk_f16(float lo, float hi) { const f32x2_t v = {lo, hi}; return __builtin_bit_cast(unsigned, __builtin_convertvector(v, f16x2_t)); }
__device__ __forceinline__ float f16_lo(unsigned u) { return (float)__builtin_bit_cast(f16x2_t, u)[0]; }
__device__ __forceinline__ float f16_hi(unsigned u) { return (float)__builtin_bit_cast(f16x2_t, u)[1]; }
__device__ __forceinline__ unsigned pk_bf16(float lo, float hi) { const f32x2_t v = {lo, hi}; return __builtin_bit_cast(unsigned, __builtin_convertvector(v, bf16x2_t)); }
__device__ __forceinline__ int otid() { int t = threadIdx.x; asm volatile("" : "+v"(t)); return t; }
template <int CTRL> __device__ __forceinline__ float dppf_(float x) { return __int_as_float(__builtin_amdgcn_mov_dpp(__float_as_int(x), CTRL, 0xf, 0xf, true)); }
__device__ __forceinline__ float wave_sum_f(float x) {
  x += dppf_<0x128>(x); x += dppf_<0x124>(x); x += dppf_<0x122>(x); x += dppf_<0x121>(x);
  { const auto s = __builtin_amdgcn_permlane16_swap(__float_as_uint(x), __float_as_uint(x), false, false); x = __uint_as_float(s[0]) + __uint_as_float(s[1]); }
  { const auto s = __builtin_amdgcn_permlane32_swap(__float_as_uint(x), __float_as_uint(x), false, false); x = __uint_as_float(s[0]) + __uint_as_float(s[1]); }
  return x;
}
__device__ __forceinline__ float wave_max_f(float x) {
  x = fmaxf(x, dppf_<0x128>(x)); x = fmaxf(x, dppf_<0x124>(x)); x = fmaxf(x, dppf_<0x122>(x)); x = fmaxf(x, dppf_<0x121>(x));
  { const auto s = __builtin_amdgcn_permlane16_swap(__float_as_uint(x), __float_as_uint(x), false, false); x = fmaxf(__uint_as_float(s[0]), __uint_as_float(s[1])); }
  { const auto s = __builtin_amdgcn_permlane32_swap(__float_as_uint(x), __float_as_uint(x), false, false); x = fmaxf(__uint_as_float(s[0]), __uint_as_float(s[1])); }
  return x;
}
__device__ __forceinline__ unsigned pack4_i8(float a, float b, float c, float d) {
  const int ia = __float2int_rn(a), ib = __float2int_rn(b), ic = __float2int_rn(c), id = __float2int_rn(d);
  return ((unsigned)ia & 0xffu) | (((unsigned)ib & 0xffu) << 8) | (((unsigned)ic & 0xffu) << 16) | ((unsigned)id << 24);
}
__device__ __forceinline__ float bf_lo(unsigned u) { return __uint_as_float(u << 16); }
__device__ __forceinline__ float bf_hi(unsigned u) { return __uint_as_float(u & 0xffff0000u); }

__device__ __forceinline__ int swz(int row) { return (((row >> 1) & 1) << 2) | (((row >> 3) & 1) << 1); }
__device__ __forceinline__ int perm32(int rho) { const int n = rho >> 4, i = rho & 15; return 8 * (i >> 2) + 4 * n + (i & 3); }
__device__ __forceinline__ int ccol(int n, int fq) { return (n >> 1) * 32 + fq * 8 + (n & 1) * 4; }
__device__ __forceinline__ int perm64(int rho) { const int n = rho >> 4, i = rho & 15; return 16 * (i >> 2) + 4 * n + (i & 3); }
__device__ __forceinline__ int ccol64(int n, int fq) { return fq * 16 + n * 4; }
__device__ __forceinline__ void store_rows16x64(unsigned short* blk, long ld, int fr, int fq, u32x4 w0, u32x4 w1) {
  const bool lo = fr < 8;
  u32x4 t, r;
  t.x = lo ? w1.x : w0.x; t.y = lo ? w1.y : w0.y; t.z = lo ? w1.z : w0.z; t.w = lo ? w1.w : w0.w;
  r.x = (unsigned)__builtin_amdgcn_mov_dpp((int)t.x, 0x128, 0xf, 0xf, true); r.y = (unsigned)__builtin_amdgcn_mov_dpp((int)t.y, 0x128, 0xf, 0xf, true);
  r.z = (unsigned)__builtin_amdgcn_mov_dpp((int)t.z, 0x128, 0xf, 0xf, true); r.w = (unsigned)__builtin_amdgcn_mov_dpp((int)t.w, 0x128, 0xf, 0xf, true);
  u32x4 a, b;
  a.x = lo ? w0.x : r.x; a.y = lo ? w0.y : r.y; a.z = lo ? w0.z : r.z; a.w = lo ? w0.w : r.w;
  b.x = lo ? r.x : w1.x; b.y = lo ? r.y : w1.y; b.z = lo ? r.z : w1.z; b.w = lo ? r.w : w1.w;
  unsigned short* pa = blk + (long)(fr & 7) * ld + (lo ? 0 : 32) + fq * 8;
  *(u32x4*)pa = a;
  *(u32x4*)(pa + 8 * ld) = b;
}
__device__ __forceinline__ void lds_dma16(const void* g, LAS void* l) {
  const int m0v = __builtin_amdgcn_readfirstlane((int)(unsigned)(__UINTPTR_TYPE__)l);
  asm volatile("s_mov_b32 m0, %1\n\ts_nop 0\n\tglobal_load_lds_dwordx4 %0, off" ::"v"(g), "s"(m0v) : "memory");
}
struct NoPre { __device__ __forceinline__ void operator()(int, int, int, int) const {} };
template <int BN, class Epi, class Pre = NoPre>
__device__ __forceinline__ void wg_gemm(const bf16_t* __restrict__ A, int lda, const bf16_t* __restrict__ Bt, int ldb, int K, Epi&& epi, Pre&& pre = Pre()) {
  constexpr int NT = BN / 64;
  constexpr int STAGE_BYTES = (128 + BN) * 128;
  constexpr int LA = 2, LB = BN / 64;
  LAS char* lds = (LAS char*)smem_raw;
  const int tid = otid(), lane = tid & 63, wid = tid >> 6, wr = wid >> 2, wc = wid & 3, fr = lane & 15, fq = lane >> 4;
  f32x4 acc[4][NT];
#pragma unroll
  for (int m = 0; m < 4; ++m)
#pragma unroll
    for (int n = 0; n < NT; ++n) acc[m][n] = (f32x4){0.f, 0.f, 0.f, 0.f};
  const int nk = K / 64;
  auto piece = [&](int buf, int kt, int i) {
    LAS char* base = lds + buf * STAGE_BYTES;
    if (i < LA) {
      const int q = tid + i * 512, row = q >> 3, c = (q & 7) ^ swz(row);
      lds_dma16(A + (long)row * lda + kt * 64 + c * 8, base + q * 16);
    } else {
      const int q = tid + (i - LA) * 512, row = q >> 3, c = (q & 7) ^ swz(row);
      const int srow = NT >= 2 ? ((row & ~31) | perm32(row & 31)) : row;
      lds_dma16(Bt + (long)srow * ldb + kt * 64 + c * 8, base + 16384 + q * 16);
    }
  };
  auto stage = [&](int buf, int kt) {
#pragma unroll
    for (int i = 0; i < LA + LB; ++i) piece(buf, kt, i);
  };
  __builtin_amdgcn_s_barrier();
  asm volatile("" ::: "memory");
  stage(0, 0);
  if (nk > 1) stage(1, 1);
  for (int kt = 0; kt < nk; ++kt) {
    if (kt + 1 < nk) asm volatile("s_waitcnt vmcnt(%0)" ::"n"(LA + LB) : "memory");
    else asm volatile("s_waitcnt vmcnt(0)" ::: "memory");
    __builtin_amdgcn_s_barrier();
    asm volatile("" ::: "memory");
    if (kt == nk - 1) pre(wr, wc, fr, fq);
    LAS const char* base = lds + (kt % 3) * STAGE_BYTES;
    bf16x8 af[4][2], bfr[NT][2];
#pragma unroll
    for (int kk = 0; kk < 2; ++kk) {
#pragma unroll
      for (int n = 0; n < NT; ++n) {
        const int row = wc * (BN / 4) + n * 16 + fr, c = (kk * 4 + fq) ^ swz(fr);
        bfr[n][kk] = *(LAS const bf16x8*)(base + 16384 + row * 128 + c * 16);
      }
#pragma unroll
      for (int m = 0; m < 4; ++m) {
        const int row = wr * 64 + m * 16 + fr, c = (kk * 4 + fq) ^ swz(fr);
        af[m][kk] = *(LAS const bf16x8*)(base + row * 128 + c * 16);
      }
    }
#pragma unroll
    for (int kk = 0; kk < 2; ++kk)
#pragma unroll
      for (int m = 0; m < 4; ++m) {
        if (kk * 4 + m < LA + LB) {
          __builtin_amdgcn_sched_barrier(0);
          if (kt + 2 < nk) piece((kt + 2) % 3, kt + 2, kk * 4 + m);
          __builtin_amdgcn_sched_barrier(0);
        }
#pragma unroll
        for (int n = 0; n < NT; ++n) acc[m][n] = __builtin_amdgcn_mfma_f32_16x16x32_bf16(bfr[n][kk], af[m][kk], acc[m][n], 0, 0, 0);
      }
  }
  epi(acc, wr, wc, fr, fq);
}

typedef int v4i_t __attribute__((ext_vector_type(4)));
template <int BN, int PERM = 32, class Epi, class Pre = NoPre>
__device__ __forceinline__ void wg_gemm_i8(const signed char* __restrict__ A, int lda, const signed char* __restrict__ Bt, int ldb, int K, Epi&& epi, Pre&& pre = Pre()) {
  constexpr int NT = BN / 64;
  constexpr int STAGE_BYTES = (128 + BN) * 128;
  constexpr int LA = 2, LB = BN / 64;
  LAS char* lds = (LAS char*)smem_raw;
  const int tid = otid(), lane = tid & 63, wid = tid >> 6, wr = wid >> 2, wc = wid & 3, fr = lane & 15, fq = lane >> 4;
  v4i_t acc[4][NT];
#pragma unroll
  for (int m = 0; m < 4; ++m)
#pragma unroll
    for (int n = 0; n < NT; ++n) acc[m][n] = (v4i_t){0, 0, 0, 0};
  const int nk = K / 128;
  auto piece = [&](int buf, int kt, int i) {
    LAS char* base = lds + buf * STAGE_BYTES;
    if (i < LA) {
      const int q = tid + i * 512, row = q >> 3, c = (q & 7) ^ swz(row);
      lds_dma16(A + (long)row * lda + kt * 128 + c * 16, base + q * 16);
    } else {
      const int q = tid + (i - LA) * 512, row = q >> 3, c = (q & 7) ^ swz(row);
      const int srow = PERM == 64 ? ((row & ~63) | perm64(row & 63)) : (NT >= 2 ? ((row & ~31) | perm32(row & 31)) : row);
      lds_dma16(Bt + (long)srow * ldb + kt * 128 + c * 16, base + 16384 + q * 16);
    }
  };
  auto stage = [&](int buf, int kt) {
#pragma unroll
    for (int i = 0; i < LA + LB; ++i) piece(buf, kt, i);
  };
  __builtin_amdgcn_s_barrier();
  asm volatile("" ::: "memory");
  stage(0, 0);
  if (nk > 1) stage(1, 1);
  for (int kt = 0; kt < nk; ++kt) {
    if (kt + 1 < nk) asm volatile("s_waitcnt vmcnt(%0)" ::"n"(LA + LB) : "memory");
    else asm volatile("s_waitcnt vmcnt(0)" ::: "memory");
    __builtin_amdgcn_s_barrier();
    asm volatile("" ::: "memory");
    if (kt == nk - 1) pre(wr, wc, fr, fq);
    LAS const char* base = lds + (kt % 3) * STAGE_BYTES;
    v4i_t af[4][2], bfr[NT][2];
#pragma unroll
    for (int kk = 0; kk < 2; ++kk) {
#pragma unroll
      for (int n = 0; n < NT; ++n) {
        const int row = wc * (BN / 4) + n * 16 + fr, c = (kk * 4 + fq) ^ swz(fr);
        bfr[n][kk] = *(LAS const v4i_t*)(base + 16384 + row * 128 + c * 16);
      }
#pragma unroll
      for (int m = 0; m < 4; ++m) {
        const int row = wr * 64 + m * 16 + fr, c = (kk * 4 + fq) ^ swz(fr);
        af[m][kk] = *(LAS const v4i_t*)(base + row * 128 + c * 16);
      }
    }
#pragma unroll
    for (int kk = 0; kk < 2; ++kk)
#pragma unroll
      for (int m = 0; m < 4; ++m) {
        if (kk * 4 + m < LA + LB) {
          __builtin_amdgcn_sched_barrier(0);
          if (kt + 2 < nk) piece((kt + 2) % 3, kt + 2, kk * 4 + m);
          __builtin_amdgcn_sched_barrier(0);
        }
#pragma unroll
        for (int n = 0; n < NT; ++n) acc[m][n] = __builtin_amdgcn_mfma_i32_16x16x64_i8(bfr[n][kk], af[m][kk], acc[m][n], 0, 0, 0);
      }
  }
  epi(acc, wr, wc, fr, fq);
}
typedef long v2l_t __attribute__((ext_vector_type(2)));
template <int BN, int PERM = 32, class Epi, class Pre = NoPre>
__device__ __forceinline__ __device__ __forceinline__ void wg_gemm_f8(const signed char* __restrict__ A, int lda, const signed char* __restrict__ Bt, int ldb, int K, Epi&& epi, Pre&& pre = Pre()) {
  constexpr int NT = BN / 64;
  constexpr int STAGE_BYTES = (128 + BN) * 128;
  constexpr int LA = 2, LB = BN / 64;
  LAS char* lds = (LAS char*)smem_raw;
  const int tid = otid(), lane = tid & 63, wid = tid >> 6, wr = wid >> 2, wc = wid & 3, fr = lane & 15, fq = lane >> 4;
  f32x4 acc[4][NT];
#pragma unroll
  for (int m = 0; m < 4; ++m)
#pragma unroll
    for (int n = 0; n < NT; ++n) acc[m][n] = (f32x4){0.f, 0.f, 0.f, 0.f};
  const int nk = K / 128;
  auto piece = [&](int buf, int kt, int i) {
    LAS char* base = lds + buf * STAGE_BYTES;
    if (i < LA) {
      const int q = tid + i * 512, row = q >> 3, c = (q & 7) ^ swz(row);
      lds_dma16(A + (long)row * lda + kt * 128 + c * 16, base + q * 16);
    } else {
      const int q = tid + (i - LA) * 512, row = q >> 3, c = (q & 7) ^ swz(row);
      const int srow = PERM == 64 ? ((row & ~63) | perm64(row & 63)) : (NT >= 2 ? ((row & ~31) | perm32(row & 31)) : row);
      lds_dma16(Bt + (long)srow * ldb + kt * 128 + c * 16, base + 16384 + q * 16);
    }
  };
  auto stage = [&](int buf, int kt) {
#pragma unroll
    for (int i = 0; i < LA + LB; ++i) piece(buf, kt, i);
  };
  __builtin_amdgcn_s_barrier();
  asm volatile("" ::: "memory");
  stage(0, 0);
  if (nk > 1) stage(1, 1);
  for (int kt = 0; kt < nk; ++kt) {
    if (kt + 1 < nk) asm volatile("s_waitcnt vmcnt(%0)" ::"n"(LA + LB) : "memory");
    else asm volatile("s_waitcnt vmcnt(0)" ::: "memory");
    __builtin_amdgcn_s_barrier();
    asm volatile("" ::: "memory");
    if (kt == nk - 1) pre(wr, wc, fr, fq);
    LAS const char* base = lds + (kt % 3) * STAGE_BYTES;
    v4i_t af[4][2], bfr[NT][2];
#pragma unroll
    for (int kk = 0; kk < 2; ++kk) {
#pragma unroll
      for (int n = 0; n < NT; ++n) {
        const int row = wc * (BN / 4) + n * 16 + fr, c = (kk * 4 + fq) ^ swz(fr);
        bfr[n][kk] = *(LAS const v4i_t*)(base + 16384 + row * 128 + c * 16);
      }
#pragma unroll
      for (int m = 0; m < 4; ++m) {
        const int row = wr * 64 + m * 16 + fr, c = (kk * 4 + fq) ^ swz(fr);
        af[m][kk] = *(LAS const v4i_t*)(base + row * 128 + c * 16);
      }
    }
#pragma unroll
    for (int kk = 0; kk < 2; ++kk)
#pragma unroll
      for (int m = 0; m < 4; ++m) {
        if (kk * 4 + m < LA + LB) {
          __builtin_amdgcn_sched_barrier(0);
          if (kt + 2 < nk) piece((kt + 2) % 3, kt + 2, kk * 4 + m);
          __builtin_amdgcn_sched_barrier(0);
        }
#pragma unroll
        for (int n = 0; n < NT; ++n) { const v2l_t bq = __builtin_bit_cast(v2l_t, bfr[n][kk]), aq = __builtin_bit_cast(v2l_t, af[m][kk]);
          acc[m][n] = __builtin_amdgcn_mfma_f32_16x16x32_fp8_fp8(bq[0], aq[0], acc[m][n], 0, 0, 0); acc[m][n] = __builtin_amdgcn_mfma_f32_16x16x32_fp8_fp8(bq[1], aq[1], acc[m][n], 0, 0, 0); }
      }
  }
  epi(acc, wr, wc, fr, fq);
}

#define XCD_BAR_WORDS 3456
#define GEMM_LDS_BYTES (3 * (128 + 256) * 128)
#define RED_OFF GEMM_LDS_BYTES
#define XB_LDS_OFF (GEMM_LDS_BYTES + 4096)
#define PSC_OFF (GEMM_LDS_BYTES + 4096 + 16)
#define LDS_BYTES (PSC_OFF + 8192)

struct P {
  const float* x; const float* mem; const float* b_in; const float* sgu_g; const float* sgu_b; const float* b_sp; const float* conv_w;
  const float* ln1_g; const float* ln1_b; const float* ln2_g; const float* ln2_b; const float* ln3_g; const float* ln3_b;
  const bf16_t* XB; const bf16_t* w_inT; const bf16_t* w_moT; const bf16_t* wsb;
  bf16_t* ZB; bf16_t* VT; bf16_t* Y; float* PRE; bf16_t* X1;
  const bf16_t* w_xqT; const bf16_t* w_xkvT; const bf16_t* w_xoT; const bf16_t* memB;
  bf16_t* Kc; bf16_t* Vc; bf16_t* Q; bf16_t* Pb; bf16_t* X2;
  const bf16_t* wxqB; bf16_t* GTb; bf16_t* HT;
  const bf16_t* w_pqT;
  const bf16_t* wpqB;
  const bf16_t* skb; unsigned* KEYS; unsigned char* X1Q; int* experts; float* gates;
  const unsigned char* WDq; const unsigned char* WUq; const float* sd; const float* su; float* out;
  signed char* w_inQ; float* sw_in; signed char* GTq; float* sG; signed char* MTq; float* sMT; signed char* w_moQ; float* sw_mo; signed char* YQ; float* SY; signed char* HT8; float* sH8; signed char* P8; float* SX1;
  char* slabs;
  unsigned* bar; unsigned char* XQ; float* SX; int* PD; float* H3;
  bf16_t* HALO;
  const float* w_in; const float* w_mo; const float* w_sp; const float* w_xq; const float* w_xkv; const float* w_xo; const float* w_pq; const float* sub_keys; const float* w_down; const float* w_up;
};

#define SLAB_BYTES (1536 * 1024)
#define OFF_XB 0
#define OFF_EXP 0
#define OFF_GATE (64 * 1024)
#define OFF_CQ (512 * 1024)
#define OFF_SC (528 * 1024)
#define OFF_X2Q (128 * 1024)
#define OFF_ZB (256 * 1024)
#define OFF_VT (896 * 1024)
#define OFF_Y (1024 * 1024)
#define OFF_Q (1280 * 1024)
__device__ __forceinline__ void wg_sync_mem() { asm volatile("s_waitcnt vmcnt(0) lgkmcnt(0)" ::: "memory"); __syncthreads(); }

#define OFF_SXB (128 * 1024)
__device__ __forceinline__ void phase_inproj(const P& p, int tile) {
  const signed char* xq = (const signed char*)(p.slabs + (size_t)tile * SLAB_BYTES + OFF_XB);
  const float* sxr = (const float*)(p.slabs + (size_t)tile * SLAB_BYTES + OFF_SXB);
  for (int nt = 0; nt < INW / 256; ++nt) {
    float4 bvr[4], swr[4]; float srr[4];
    wg_gemm_i8<256>(xq, DM, p.w_inQ + (long)nt * 256 * DM, DM, DM, [&](v4i_t (&acc)[4][4], int wr, int wc, int fr, int fq) {
u32x2 wpair;
#pragma unroll
      for (int m = 0; m < 4; ++m) {
        const int rl = wr * 64 + m * 16 + fr;
        const float sr = srr[m];
#pragma unroll
        for (int n = 0; n < 4; ++n) {
          const int row = tile * 128 + rl, col = nt * 256 + wc * 64 + ccol(n, fq);
          const float4 bv = bvr[n], sw = swr[n];
          float o0 = (float)acc[m][n][0] * (sr * sw.x) + bv.x, o1 = (float)acc[m][n][1] * (sr * sw.y) + bv.y, o2 = (float)acc[m][n][2] * (sr * sw.z) + bv.z, o3 = (float)acc[m][n][3] * (sr * sw.w) + bv.w;
          if (nt < 4) { o0 = gelu_f(o0); o1 = gelu_f(o1); o2 = gelu_f(o2); o3 = gelu_f(o3); }
          u32x2 w; w.x = pk_bf16(o0, o1); w.y = pk_bf16(o2, o3);
          if (!(n & 1)) wpair = w; else *(u32x4*)(p.ZB + (long)row * INW + col - 4) = (u32x4){wpair.x, wpair.y, w.x, w.y};
        }
      }
    }, [&](int wr, int wc, int fr, int fq) {
#pragma unroll
      for (int m = 0; m < 4; ++m) srr[m] = sxr[wr * 64 + m * 16 + fr];
#pragma unroll
      for (int n = 0; n < 4; ++n) { const int col = nt * 256 + wc * 64 + ccol(n, fq); bvr[n] = *(const float4*)(p.b_in + col); swr[n] = *(const float4*)(p.sw_in + col); }
    });
  }
}

__device__ __forceinline__ void phase_mixer(const P& p, int tile, int mask) {
  const int tid = otid(), lane = tid & 63, wid = tid >> 6;
  const long t0 = (long)tile * 128;
  const bool seq_start = ((tile & 63) == 0);
  if (mask & 1)
  {
    const int c = (tid & 63) * 8, s0 = (tid >> 6) * 16;
    float w[3][8];
#pragma unroll
    for (int k = 0; k < 3; ++k) {
      const float4 w0 = *(const float4*)(p.conv_w + k * 512 + c), w1 = *(const float4*)(p.conv_w + k * 512 + c + 4);
      w[k][0] = w0.x; w[k][1] = w0.y; w[k][2] = w0.z; w[k][3] = w0.w; w[k][4] = w1.x; w[k][5] = w1.y; w[k][6] = w1.z; w[k][7] = w1.w;
    }
    float p2[8], p1[8];
    auto prod_row = [&](int rl, float (&pr)[8]) {
      if (rl >= 0) {
        const bf16_t* zr = p.ZB + (t0 + rl) * INW;
        const u32x4 hb = *(const u32x4*)(zr + 1024 + c), gc = *(const u32x4*)(zr + 2048 + c);
        pr[0] = bf_lo(hb.x) * bf_lo(gc.x); pr[1] = bf_hi(hb.x) * bf_hi(gc.x); pr[2] = bf_lo(hb.y) * bf_lo(gc.y); pr[3] = bf_hi(hb.y) * bf_hi(gc.y);
        pr[4] = bf_lo(hb.z) * bf_lo(gc.z); pr[5] = bf_hi(hb.z) * bf_hi(gc.z); pr[6] = bf_lo(hb.w) * bf_lo(gc.w); pr[7] = bf_hi(hb.w) * bf_hi(gc.w);
      } else if (!seq_start) {
        const u32x4 zc = *(const u32x4*)(p.HALO + ((long)(tile - 1) * 2 + (rl + 2)) * 512 + c);
        pr[0] = bf_lo(zc.x); pr[1] = bf_hi(zc.x); pr[2] = bf_lo(zc.y); pr[3] = bf_hi(zc.y); pr[4] = bf_lo(zc.z); pr[5] = bf_hi(zc.z); pr[6] = bf_lo(zc.w); pr[7] = bf_hi(zc.w);
      } else {
#pragma unroll
        for (int j = 0; j < 8; ++j) pr[j] = 0.f;
      }
    };
    prod_row(s0 - 2, p2);
    prod_row(s0 - 1, p1);
    u32x4 hbN, gcN, gbN;
    auto raw = [&](int rl) { const bf16_t* zr = p.ZB + (t0 + rl) * INW; hbN = *(const u32x4*)(zr + 1024 + c); gcN = *(const u32x4*)(zr + 2048 + c); gbN = *(const u32x4*)(zr + 1536 + c); };
    raw(s0);
#pragma unroll 2
    for (int i = 0; i < 16; ++i) {
      const long t = t0 + s0 + i;
      const u32x4 hb = hbN, gc = gcN, gb = gbN;
      raw(s0 + (i < 15 ? i + 1 : 15));
      float p0[8];
      p0[0] = bf_lo(hb.x) * bf_lo(gc.x); p0[1] = bf_hi(hb.x) * bf_hi(gc.x); p0[2] = bf_lo(hb.y) * bf_lo(gc.y); p0[3] = bf_hi(hb.y) * bf_hi(gc.y);
      p0[4] = bf_lo(hb.z) * bf_lo(gc.z); p0[5] = bf_hi(hb.z) * bf_hi(gc.z); p0[6] = bf_lo(hb.w) * bf_lo(gc.w); p0[7] = bf_hi(hb.w) * bf_hi(gc.w);
      float conv[8];
#pragma unroll
      for (int j = 0; j < 8; ++j) conv[j] = w[0][j] * p2[j] + w[1][j] * p1[j] + w[2][j] * p0[j];
      u32x4 o;
      o.x = pk_bf16(bf_lo(gb.x) * conv[0], bf_hi(gb.x) * conv[1]); o.y = pk_bf16(bf_lo(gb.y) * conv[2], bf_hi(gb.y) * conv[3]);
      o.z = pk_bf16(bf_lo(gb.z) * conv[4], bf_hi(gb.z) * conv[5]); o.w = pk_bf16(bf_lo(gb.w) * conv[6], bf_hi(gb.w) * conv[7]);
      *(u32x4*)(p.Y + t * DM + 512 + c) = o;
#pragma unroll
      for (int j = 0; j < 8; ++j) { p2[j] = p1[j]; p1[j] = p0[j]; }
    }
  }
  if (mask & 2)
  for (int h = 0; h < 4; ++h) {
    float a0[16], a1[16];
    const float g0 = p.sgu_g[h * 128 + 2 * lane], g1 = p.sgu_g[h * 128 + 2 * lane + 1], b0 = p.sgu_b[h * 128 + 2 * lane], b1 = p.sgu_b[h * 128 + 2 * lane + 1];
#pragma unroll
    for (int i = 0; i < 16; ++i) {
      const unsigned v = *(const unsigned*)(p.ZB + (t0 + wid * 16 + i) * INW + 512 + h * 128 + 2 * lane);
      const float x0 = bf_lo(v), x1 = bf_hi(v);
      float sum = x0 + x1;
      sum = wave_sum_f(sum);
      const float mu = sum * (1.f / 128.f);
      const float d0 = x0 - mu, d1 = x1 - mu;
      float q = d0 * d0 + d1 * d1;
      q = wave_sum_f(q);
      const float rstd = rsqrtf(q * (1.f / 128.f) + LN_EPS);
      a0[i] = d0 * rstd * g0 + b0; a1[i] = d1 * rstd * g1 + b1;
    }
    LAS char* tl = (LAS char*)smem_raw + h * (128 * 272);
    u32x4 o;
    o.x = pk_bf16(a0[0], a0[1]); o.y = pk_bf16(a0[2], a0[3]); o.z = pk_bf16(a0[4], a0[5]); o.w = pk_bf16(a0[6], a0[7]);
    *(LAS u32x4*)(tl + (2 * lane) * 272 + wid * 32) = o;
    o.x = pk_bf16(a0[8], a0[9]); o.y = pk_bf16(a0[10], a0[11]); o.z = pk_bf16(a0[12], a0[13]); o.w = pk_bf16(a0[14], a0[15]);
    *(LAS u32x4*)(tl + (2 * lane) * 272 + wid * 32 + 16) = o;
    o.x = pk_bf16(a1[0], a1[1]); o.y = pk_bf16(a1[2], a1[3]); o.z = pk_bf16(a1[4], a1[5]); o.w = pk_bf16(a1[6], a1[7]);
    *(LAS u32x4*)(tl + (2 * lane + 1) * 272 + wid * 32) = o;
    o.x = pk_bf16(a1[8], a1[9]); o.y = pk_bf16(a1[10], a1[11]); o.z = pk_bf16(a1[12], a1[13]); o.w = pk_bf16(a1[14], a1[15]);
    *(LAS u32x4*)(tl + (2 * lane + 1) * 272 + wid * 32 + 16) = o;
  }
  if (mask & 2) {
    __syncthreads();
#pragma unroll
    for (int h = 0; h < 4; ++h) {
      bf16_t* vt = p.VT + ((long)tile * 4 + h) * 128 * 128;
      LAS const char* tl = (LAS const char*)smem_raw + h * (128 * 272);
#pragma unroll
      for (int it = 0; it < 4; ++it) {
        const int q = tid + it * 512, row = q >> 4, c16 = q & 15;
        *(u32x4*)(vt + row * 128 + c16 * 8) = *(LAS const u32x4*)(tl + row * 272 + c16 * 16);
      }
    }
  }
  wg_sync_mem();
  if (mask & 4)
  for (int h = 0; h < 4; ++h) {
    u32x2 uv[4][2]; float bs[4];
    wg_gemm<128>(p.wsb + h * 128 * 128, 128, p.VT + ((long)tile * 4 + h) * 128 * 128, 128, 128, [&](f32x4 (&acc)[4][2], int wr, int wc, int fr, int fq) {
u32x2 wpair;
#pragma unroll
      for (int m = 0; m < 4; ++m)
#pragma unroll
        for (int n = 0; n < 2; ++n) {
          const int rl = wr * 64 + m * 16 + fr, col = wc * 32 + ccol(n, fq);
          u32x2 w;
          w.x = pk_bf16(bf_lo(uv[m][n].x) * (acc[m][n][0] + bs[m]), bf_hi(uv[m][n].x) * (acc[m][n][1] + bs[m]));
          w.y = pk_bf16(bf_lo(uv[m][n].y) * (acc[m][n][2] + bs[m]), bf_hi(uv[m][n].y) * (acc[m][n][3] + bs[m]));
          if (!(n & 1)) wpair = w; else *(u32x4*)(p.Y + (t0 + rl) * DM + h * 128 + col - 4) = (u32x4){wpair.x, wpair.y, w.x, w.y};
        }
    }, [&](int wr, int wc, int fr, int fq) {
#pragma unroll
      for (int m = 0; m < 4; ++m) {
        const int rl = wr * 64 + m * 16 + fr;
        bs[m] = p.b_sp[h * 128 + rl];
#pragma unroll
        for (int n = 0; n < 2; ++n) uv[m][n] = *(const u32x2*)(p.ZB + (t0 + rl) * INW + h * 128 + wc * 32 + ccol(n, fq));
      }
    });
  }
}

__device__ __forceinline__ void ln_rows16(const float* __restrict__ PRE, long r0, const float* __restrict__ g, const float* __restrict__ b, bf16_t* __restrict__ Out, int lane) {
#pragma unroll 2
  for (int i = 0; i < 16; ++i) {
    const bf16_t* pr = (const bf16_t*)PRE + (r0 + i) * DM;
    float4 v[4];
    float sum = 0.f;
#pragma unroll
    for (int j = 0; j < 4; ++j) { const u32x2 pv = *(const u32x2*)(pr + j * 256 + lane * 4); v[j].x = bf_lo(pv.x); v[j].y = bf_hi(pv.x); v[j].z = bf_lo(pv.y); v[j].w = bf_hi(pv.y); sum += (v[j].x + v[j].y) + (v[j].z + v[j].w); }
    sum = wave_sum_f(sum);
    const float mu = sum * (1.f / DM);
    float q = 0.f;
#pragma unroll
    for (int j = 0; j < 4; ++j) { v[j].x -= mu; v[j].y -= mu; v[j].z -= mu; v[j].w -= mu; q += (v[j].x * v[j].x + v[j].y * v[j].y) + (v[j].z * v[j].z + v[j].w * v[j].w); }
    q = wave_sum_f(q);
    const float rstd = rsqrtf(q * (1.f / DM) + LN_EPS);
#pragma unroll
    for (int j = 0; j < 4; ++j) {
      const int c0 = j * 256 + lane * 4;
      const float4 gg = *(const float4*)(g + c0), bb = *(const float4*)(b + c0);
      u32x2 w; w.x = pk_bf16(v[j].x * rstd * gg.x + bb.x, v[j].y * rstd * gg.y + bb.y); w.y = pk_bf16(v[j].z * rstd * gg.z + bb.z, v[j].w * rstd * gg.w + bb.w);
      *(u32x2*)(Out + (r0 + i) * DM + c0) = w;
    }
  }
}

__device__ __forceinline__ void ln_rows16_q(const float* __restrict__ PRE, long r0, const float* __restrict__ g, const float* __restrict__ b, bf16_t* __restrict__ Out,
                                            unsigned char* __restrict__ XQ, float* __restrict__ SX, int lane) {
#pragma unroll 2
  for (int i = 0; i < 16; ++i) {
    const bf16_t* pr = (const bf16_t*)PRE + (r0 + i) * DM;
    float4 v[4];
    float sum = 0.f;
#pragma unroll
    for (int j = 0; j < 4; ++j) { const u32x2 pv = *(const u32x2*)(pr + j * 256 + lane * 4); v[j].x = bf_lo(pv.x); v[j].y = bf_hi(pv.x); v[j].z = bf_lo(pv.y); v[j].w = bf_hi(pv.y); sum += (v[j].x + v[j].y) + (v[j].z + v[j].w); }
    sum = wave_sum_f(sum);
    const float mu = sum * (1.f / DM);
    float q = 0.f;
#pragma unroll
    for (int j = 0; j < 4; ++j) { v[j].x -= mu; v[j].y -= mu; v[j].z -= mu; v[j].w -= mu; q += (v[j].x * v[j].x + v[j].y * v[j].y) + (v[j].z * v[j].z + v[j].w * v[j].w); }
    q = wave_sum_f(q);
    const float rstd = rsqrtf(q * (1.f / DM) + LN_EPS);
    float amax = 0.f;
#pragma unroll
    for (int j = 0; j < 4; ++j) {
      const int c0 = j * 256 + lane * 4;
      const float4 gg = *(const float4*)(g + c0), bb = *(const float4*)(b + c0);
      v[j].x = v[j].x * rstd * gg.x + bb.x; v[j].y = v[j].y * rstd * gg.y + bb.y; v[j].z = v[j].z * rstd * gg.z + bb.z; v[j].w = v[j].w * rstd * gg.w + bb.w;
      amax = fmaxf(amax, fmaxf(fmaxf(fabsf(v[j].x), fabsf(v[j].y)), fmaxf(fabsf(v[j].z), fabsf(v[j].w))));
    }
    amax = wave_max_f(amax);
    const float inv = amax > 0.f ? 127.f / amax : 0.f;
#pragma unroll
    for (int j = 0; j < 4; ++j) *(unsigned*)(XQ + (r0 + i) * DM + j * 256 + lane * 4) = pack4_i8(v[j].x * inv, v[j].y * inv, v[j].z * inv, v[j].w * inv);
    if (lane == 0) SX[r0 + i] = amax * (1.f / 127.f);
  }
}

__device__ __forceinline__ void ln_rows16_qs(const float* __restrict__ PRE, long r0, const float* __restrict__ g, const float* __restrict__ b, bf16_t* __restrict__ Out,
                                            unsigned char* __restrict__ XQ, float* __restrict__ SX, int lane, int rl0) {
  LAS const float* red = (LAS const float*)((LAS const char*)smem_raw + RED_OFF);
  float4 ggv[4], bbv[4];
#pragma unroll
  for (int j = 0; j < 4; ++j) { ggv[j] = *(const float4*)(g + j * 256 + lane * 4); bbv[j] = *(const float4*)(b + j * 256 + lane * 4); }
  int pvn[4];
  {
    const signed char* tb0 = (const signed char*)((const bf16_t*)PRE + (r0 - rl0) * DM);
#pragma unroll
    for (int j = 0; j < 4; ++j) pvn[j] = *(const int*)(tb0 + rl0 * DM + j * 256 + lane * 4);
  }
#pragma unroll 1
  for (int i = 0; i < 16; ++i) {
    const signed char* tb = (const signed char*)((const bf16_t*)PRE + (r0 - rl0) * DM);
    const signed char* pr = tb + (rl0 + i) * DM;
    LAS const float* ps = (LAS const float*)((LAS const char*)smem_raw + PSC_OFF) + (rl0 + i) * 16 + (lane >> 4);
    float4 v[4];
#pragma unroll
    for (int j = 0; j < 4; ++j) {
      const int pv = pvn[j]; const float s = ps[j * 4];
      v[j].x = s * (float)(signed char)(pv & 0xff); v[j].y = s * (float)(signed char)((pv >> 8) & 0xff); v[j].z = s * (float)(signed char)((pv >> 16) & 0xff); v[j].w = s * (float)(pv >> 24);
    }
    {
      const signed char* prn = tb + (rl0 + (i < 15 ? i + 1 : 15)) * DM;
#pragma unroll
      for (int j = 0; j < 4; ++j) pvn[j] = *(const int*)(prn + j * 256 + lane * 4);
    }
    const f32x4 s4 = *(LAS const f32x4*)(red + (rl0 + i) * 4), q4 = *(LAS const f32x4*)(red + 512 + (rl0 + i) * 4);
    const float mu = ((s4[0] + s4[1]) + (s4[2] + s4[3])) * (1.f / DM);
    const float rstd = rsqrtf(fmaxf(((q4[0] + q4[1]) + (q4[2] + q4[3])) * (1.f / DM) - mu * mu, 0.f) + LN_EPS);
#pragma unroll
    for (int j = 0; j < 4; ++j) { v[j].x -= mu; v[j].y -= mu; v[j].z -= mu; v[j].w -= mu; }
    float amax = 0.f;
#pragma unroll
    for (int j = 0; j < 4; ++j) {
      const int c0 = j * 256 + lane * 4;
      const float4 gg = ggv[j], bb = bbv[j];
      v[j].x = v[j].x * rstd * gg.x + bb.x; v[j].y = v[j].y * rstd * gg.y + bb.y; v[j].z = v[j].z * rstd * gg.z + bb.z; v[j].w = v[j].w * rstd * gg.w + bb.w;
      amax = fmaxf(amax, fmaxf(fmaxf(fabsf(v[j].x), fabsf(v[j].y)), fmaxf(fabsf(v[j].z), fabsf(v[j].w))));
    }
    amax = wave_max_f(amax);
    const float inv = amax > 0.f ? 127.f / amax : 0.f;
#pragma unroll
    for (int j = 0; j < 4; ++j) *(unsigned*)(XQ + (r0 + i) * DM + j * 256 + lane * 4) = pack4_i8(v[j].x * inv, v[j].y * inv, v[j].z * inv, v[j].w * inv);
    if (lane == 0) SX[r0 + i] = amax * (1.f / 127.f);
  }
}

__device__ __forceinline__ void pre_store_q(signed char* preq, const float (&vv)[4][4], int rl, int nt, int wc, int fq) {
  float am = 0.f;
#pragma unroll
  for (int n = 0; n < 4; ++n) am = fmaxf(am, fmaxf(fmaxf(fabsf(vv[n][0]), fabsf(vv[n][1])), fmaxf(fabsf(vv[n][2]), fabsf(vv[n][3]))));
  { const auto s = __builtin_amdgcn_permlane16_swap(__float_as_uint(am), __float_as_uint(am), false, false); am = fmaxf(__uint_as_float(s[0]), __uint_as_float(s[1])); }
  { const auto s = __builtin_amdgcn_permlane32_swap(__float_as_uint(am), __float_as_uint(am), false, false); am = fmaxf(__uint_as_float(s[0]), __uint_as_float(s[1])); }
  const float inv = am > 0.f ? 127.f / am : 0.f;
  u32x4 w;
#pragma unroll
  for (int n = 0; n < 4; ++n) w[n] = pack4_i8(vv[n][0] * inv, vv[n][1] * inv, vv[n][2] * inv, vv[n][3] * inv);
  *(u32x4*)(preq + rl * DM + nt * 256 + wc * 64 + fq * 16) = w;
  if (fq == 0) ((LAS float*)((LAS char*)smem_raw + PSC_OFF))[rl * 16 + nt * 4 + wc] = am * (1.f / 127.f);
}
__device__ __forceinline__ void publish_row_stats(const float (&rs)[4], const float (&rq)[4]) {
  const int tid = otid(), lane = tid & 63, wid = tid >> 6, wr = wid >> 2, wc = wid & 3, fr = lane & 15, fq = lane >> 4;
  LAS float* red = (LAS float*)((LAS char*)smem_raw + RED_OFF);
#pragma unroll
  for (int m = 0; m < 4; ++m) {
    float a = rs[m], q = rq[m];
    a += __shfl_xor(a, 16); a += __shfl_xor(a, 32); q += __shfl_xor(q, 16); q += __shfl_xor(q, 32);
    if (fq == 0) { red[(wr * 64 + m * 16 + fr) * 4 + wc] = a; red[512 + (wr * 64 + m * 16 + fr) * 4 + wc] = q; }
  }
}
__device__ __forceinline__ void phase_outproj(const P& p, int tile) {
  const long t0 = (long)tile * 128;
  const signed char* xqt = (const signed char*)(p.slabs + (size_t)tile * SLAB_BYTES + OFF_XB);
  const float* sxt = (const float*)(p.slabs + (size_t)tile * SLAB_BYTES + OFF_SXB);
  {
    const int lane = threadIdx.x & 63, wid = threadIdx.x >> 6;
    u32x2 vn[4];
#pragma unroll
    for (int j = 0; j < 4; ++j) vn[j] = *(const u32x2*)(p.Y + (t0 + wid * 16) * DM + 256 * j + lane * 4);
#pragma unroll 1
    for (int i = 0; i < 16; ++i) {
      const long row = t0 + wid * 16 + i;
      u32x2 v[4];
      float amax = 0.f;
#pragma unroll
      for (int j = 0; j < 4; ++j) {
        v[j] = vn[j];
        amax = fmaxf(amax, fmaxf(fmaxf(fabsf(bf_lo(v[j].x)), fabsf(bf_hi(v[j].x))), fmaxf(fabsf(bf_lo(v[j].y)), fabsf(bf_hi(v[j].y)))));
      }
      {
        const long rown = t0 + wid * 16 + (i < 15 ? i + 1 : 15);
#pragma unroll
        for (int j = 0; j < 4; ++j) vn[j] = *(const u32x2*)(p.Y + rown * DM + 256 * j + lane * 4);
      }
      amax = wave_max_f(amax);
      const float inv = amax > 0.f ? 127.f / amax : 0.f;
#pragma unroll
      for (int j = 0; j < 4; ++j) *(unsigned*)(p.YQ + row * DM + 256 * j + lane * 4) = pack4_i8(bf_lo(v[j].x) * inv, bf_hi(v[j].x) * inv, bf_lo(v[j].y) * inv, bf_hi(v[j].y) * inv);
      if (lane == 0) p.SY[row] = amax * (1.f / 127.f);
    }
  }
  wg_sync_mem();
  float rs[4] = {0.f, 0.f, 0.f, 0.f}, rq[4] = {0.f, 0.f, 0.f, 0.f};
  for (int nt = 0; nt < 4; ++nt) {
    unsigned xr[4][4]; float4 swr[4]; float srr[4], sxq[4];
    wg_gemm_i8<256, 64>(p.YQ + t0 * DM, DM, p.w_moQ + (long)nt * 256 * DM, DM, DM, [&](v4i_t (&acc)[4][4], int wr, int wc, int fr, int fq) {
      signed char* preq = (signed char*)((bf16_t*)p.PRE + t0 * DM);
#pragma unroll
      for (int m = 0; m < 4; ++m) {
        const float sr = srr[m];
        float vv[4][4];
#pragma unroll
        for (int n = 0; n < 4; ++n) {
          const int xq4 = (int)xr[m][n]; const float rx = ALPHA * sxq[m];
          const float xv_x = rx * (float)(signed char)(xq4 & 0xff), xv_y = rx * (float)(signed char)((xq4 >> 8) & 0xff), xv_z = rx * (float)(signed char)((xq4 >> 16) & 0xff), xv_w = rx * (float)(xq4 >> 24);
          const float4 sw = swr[n];
          const float v0 = xv_x + (float)acc[m][n][0] * (sr * sw.x), v1 = xv_y + (float)acc[m][n][1] * (sr * sw.y);
          const float v2 = xv_z + (float)acc[m][n][2] * (sr * sw.z), v3 = xv_w + (float)acc[m][n][3] * (sr * sw.w);
          rs[m] += (v0 + v1) + (v2 + v3); rq[m] += (v0 * v0 + v1 * v1) + (v2 * v2 + v3 * v3);
          vv[n][0] = v0; vv[n][1] = v1; vv[n][2] = v2; vv[n][3] = v3;
        }
        pre_store_q(preq, vv, wr * 64 + m * 16 + fr, nt, wc, fq);
      }
    }, [&](int wr, int wc, int fr, int fq) {
#pragma unroll
      for (int m = 0; m < 4; ++m) {
        const u32x4 x4 = *(const u32x4*)(xqt + (wr * 64 + m * 16 + fr) * DM + nt * 256 + wc * 64 + fq * 16);
        xr[m][0] = x4.x; xr[m][1] = x4.y; xr[m][2] = x4.z; xr[m][3] = x4.w;
      }
#pragma unroll
      for (int m = 0; m < 4; ++m) { srr[m] = p.SY[t0 + wr * 64 + m * 16 + fr]; sxq[m] = sxt[wr * 64 + m * 16 + fr]; }
#pragma unroll
      for (int n = 0; n < 4; ++n) swr[n] = *(const float4*)(p.sw_mo + nt * 256 + wc * 64 + ccol64(n, fq));
    });
  }
  publish_row_stats(rs, rq);
  wg_sync_mem();
  ln_rows16_qs(p.PRE, t0 + (threadIdx.x >> 6) * 16, p.ln1_g, p.ln1_b, p.X1, p.X1Q, p.SX1, threadIdx.x & 63, (threadIdx.x >> 6) * 16);
}

__device__ __forceinline__ void phase_kv(const P& p, int unit) {
  const int rt = unit >> 5, nc = unit & 31;
  wg_gemm<64>(p.memB + (long)rt * 128 * DM, DM, p.w_xkvT + (long)nc * 64 * DM, DM, DM, [&](f32x4 (&acc)[4][1], int wr, int wc, int fr, int fq) {
    const int b = rt >> 1, col = nc * 64 + wc * 16 + fq * 4, hh = (col >> 8) & 3, d = col & 255;
#pragma unroll
    for (int m = 0; m < 4; ++m) {
      const int mm = (rt & 1) * 128 + wr * 64 + m * 16 + fr;
      u32x2 w; w.x = pk_bf16(acc[m][0][0], acc[m][0][1]); w.y = pk_bf16(acc[m][0][2], acc[m][0][3]);
      *(u32x2*)((col < 1024 ? p.Kc : p.Vc) + ((long)(b * 4 + hh) * 256 + mm) * 256 + d) = w;
    }
  });
}

__device__ __forceinline__ void phase_gh(const P& p, int unit) {
  if (unit < 128) {
    const int bh = unit >> 3, rt = (unit >> 2) & 1, nt = unit & 3, h = bh & 3, b = bh >> 2;
    wg_gemm<256>(p.Kc + ((long)bh * 256 + rt * 128) * 256, 256, p.wxqB + (long)nt * 256 * DM + h * 256, DM, 256, [&](f32x4 (&acc)[4][4], int wr, int wc, int fr, int fq) {
u32x2 wpair;
#pragma unroll
      for (int m = 0; m < 4; ++m)
#pragma unroll
        for (int n = 0; n < 4; ++n) {
          const long row = (long)b * 1024 + h * 256 + rt * 128 + wr * 64 + m * 16 + fr; const int col = nt * 256 + wc * 64 + ccol(n, fq);
          u32x2 w; w.x = pk_bf16(acc[m][n][0], acc[m][n][1]); w.y = pk_bf16(acc[m][n][2], acc[m][n][3]);
          if (!(n & 1)) wpair = w; else *(u32x4*)(p.GTb + row * DM + col - 4) = (u32x4){wpair.x, wpair.y, w.x, w.y};
        }
    });
  } else {
    const int u = unit - 128, bh = u >> 3, rt = u & 7, h = bh & 3, b = bh >> 2;
    wg_gemm<256>(p.w_xoT + (long)rt * 128 * DM + h * 256, DM, p.Vc + (long)bh * 256 * 256, 256, 256, [&](f32x4 (&acc)[4][4], int wr, int wc, int fr, int fq) {
u32x2 wpair;
#pragma unroll
      for (int m = 0; m < 4; ++m)
#pragma unroll
        for (int n = 0; n < 4; ++n) {
          const long row = (long)b * 1024 + rt * 128 + wr * 64 + m * 16 + fr; const int col = h * 256 + wc * 64 + ccol(n, fq);
          u32x2 w; w.x = pk_bf16(acc[m][n][0], acc[m][n][1]); w.y = pk_bf16(acc[m][n][2], acc[m][n][3]);
          if (!(n & 1)) wpair = w; else *(u32x4*)(p.HT + row * DM + col - 4) = (u32x4){wpair.x, wpair.y, w.x, w.y};
        }
    });
  }
}

__device__ __forceinline__ void phase_gquant(const P& p) {
  const int lane = threadIdx.x & 63, wid = threadIdx.x >> 6;
#pragma unroll
  for (int i = 0; i < 2; ++i) {
    const long row = (long)blockIdx.x * 16 + wid * 2 + i;
    u32x2 v[4];
    float amax = 0.f;
#pragma unroll
    for (int j = 0; j < 4; ++j) {
      v[j] = *(const u32x2*)(p.GTb + row * DM + 256 * j + lane * 4);
      amax = fmaxf(amax, fmaxf(fmaxf(fabsf(bf_lo(v[j].x)), fabsf(bf_hi(v[j].x))), fmaxf(fabsf(bf_lo(v[j].y)), fabsf(bf_hi(v[j].y)))));
    }
    amax = wave_max_f(amax);
    const float inv = amax > 0.f ? 127.f / amax : 0.f;
#pragma unroll
    for (int j = 0; j < 4; ++j) *(unsigned*)(p.GTq + row * DM + 256 * j + lane * 4) = pack4_i8(bf_lo(v[j].x) * inv, bf_hi(v[j].x) * inv, bf_lo(v[j].y) * inv, bf_hi(v[j].y) * inv);
    if (lane == 0) p.sG[row] = amax * (1.f / 127.f);
  }
#pragma unroll
  for (int i = 0; i < 2; ++i) {
    const long row = (long)blockIdx.x * 16 + wid * 2 + i;
    u32x2 v[4];
    float amax = 0.f;
#pragma unroll
    for (int j = 0; j < 4; ++j) {
      v[j] = *(const u32x2*)(p.HT + row * DM + 256 * j + lane * 4);
      amax = fmaxf(amax, fmaxf(fmaxf(fabsf(bf_lo(v[j].x)), fabsf(bf_hi(v[j].x))), fmaxf(fabsf(bf_lo(v[j].y)), fabsf(bf_hi(v[j].y)))));
    }
    amax = wave_max_f(amax);
    const float inv = amax > 0.f ? 240.f / amax : 0.f;
#pragma unroll
    for (int j = 0; j < 4; ++j) {
      int w = __builtin_amdgcn_cvt_pk_fp8_f32(bf_lo(v[j].x) * inv, bf_hi(v[j].x) * inv, 0, false);
      w = __builtin_amdgcn_cvt_pk_fp8_f32(bf_lo(v[j].y) * inv, bf_hi(v[j].y) * inv, w, true);
      *(int*)(p.HT8 + row * DM + 256 * j + lane * 4) = w;
    }
    if (lane == 0) p.sH8[row] = amax * (1.f / 240.f);
  }
  {
    const long row = (long)blockIdx.x * 8 + wid;
    u32x2 v[4];
    float amax = 0.f;
#pragma unroll
    for (int j = 0; j < 4; ++j) {
      v[j] = *(const u32x2*)(p.w_pqT + row * DM + 256 * j + lane * 4);
      amax = fmaxf(amax, fmaxf(fmaxf(fabsf(bf_lo(v[j].x)), fabsf(bf_hi(v[j].x))), fmaxf(fabsf(bf_lo(v[j].y)), fabsf(bf_hi(v[j].y)))));
    }
    amax = wave_max_f(amax);
    const float inv = amax > 0.f ? 127.f / amax : 0.f;
#pragma unroll
    for (int j = 0; j < 4; ++j) *(unsigned*)(p.MTq + row * DM + 256 * j + lane * 4) = pack4_i8(bf_lo(v[j].x) * inv, bf_hi(v[j].x) * inv, bf_lo(v[j].y) * inv, bf_hi(v[j].y) * inv);
    if (lane == 0) p.sMT[row] = amax * (1.f / 127.f);
  }
}

__device__ __forceinline__ void phase_scores(const P& p, int tile) {
  const long t0 = (long)tile * 128;
  const int b = tile >> 6;
  LAS float* red = (LAS float*)((LAS char*)smem_raw + RED_OFF);
  for (int h = 0; h < 4; ++h) {
    signed char* P8w = p.P8 + t0 * DM + h * 256;
    float4 swr[4]; float srr[4];
    wg_gemm_i8<256, 64>((const signed char*)p.X1Q + t0 * DM, DM, p.GTq + ((long)b * 1024 + h * 256) * DM, DM, DM, [&](v4i_t (&iacc)[4][4], int wr, int wc, int fr, int fq) {
      u32x2 wpair;
      f32x4 acc[4][4];
      float rmax[4];
#pragma unroll
      for (int m = 0; m < 4; ++m) {
        const float sr = srr[m] * 0.0625f;
#pragma unroll
        for (int n = 0; n < 4; ++n) {
          const float4 sw = swr[n];
          acc[m][n][0] = (float)iacc[m][n][0] * (sr * sw.x); acc[m][n][1] = (float)iacc[m][n][1] * (sr * sw.y);
          acc[m][n][2] = (float)iacc[m][n][2] * (sr * sw.z); acc[m][n][3] = (float)iacc[m][n][3] * (sr * sw.w);
        }
      }
#pragma unroll
      for (int m = 0; m < 4; ++m) {
        float mx = -3.0e38f;
#pragma unroll
        for (int n = 0; n < 4; ++n) mx = fmaxf(mx, fmaxf(fmaxf(acc[m][n][0], acc[m][n][1]), fmaxf(acc[m][n][2], acc[m][n][3])));
        mx = fmaxf(mx, __shfl_xor(mx, 16)); mx = fmaxf(mx, __shfl_xor(mx, 32));
        if (fq == 0) red[(wr * 64 + m * 16 + fr) * 4 + wc] = mx;
      }
      __syncthreads();
#pragma unroll
      for (int m = 0; m < 4; ++m) {
        const f32x4 r = *(LAS const f32x4*)(red + (wr * 64 + m * 16 + fr) * 4);
        rmax[m] = fmaxf(fmaxf(r[0], r[1]), fmaxf(r[2], r[3]));
      }
#pragma unroll
      for (int m = 0; m < 4; ++m) {
        float sm = 0.f;
#pragma unroll
        for (int n = 0; n < 4; ++n)
#pragma unroll
          for (int j = 0; j < 4; ++j) { const float e = __expf(acc[m][n][j] - rmax[m]); acc[m][n][j] = e; sm += e; }
        sm += __shfl_xor(sm, 16); sm += __shfl_xor(sm, 32);
        if (fq == 0) red[512 + (wr * 64 + m * 16 + fr) * 4 + wc] = sm;
      }
      __syncthreads();
#pragma unroll
      for (int m = 0; m < 4; ++m) {
        const f32x4 r = *(LAS const f32x4*)(red + 512 + (wr * 64 + m * 16 + fr) * 4);
        const float inv = 256.f / ((r[0] + r[1]) + (r[2] + r[3]));
        const int rl = wr * 64 + m * 16 + fr;
        u32x4 w8;
#pragma unroll
        for (int n = 0; n < 4; ++n) {
          int w = __builtin_amdgcn_cvt_pk_fp8_f32(acc[m][n][0] * inv, acc[m][n][1] * inv, 0, false);
          w = __builtin_amdgcn_cvt_pk_fp8_f32(acc[m][n][2] * inv, acc[m][n][3] * inv, w, true);
          w8[n] = (unsigned)w;
        }
        *(u32x4*)(P8w + rl * DM + wc * 64 + fq * 16) = w8;
      }
    }, [&](int wr, int wc, int fr, int fq) {
#pragma unroll
      for (int m = 0; m < 4; ++m) srr[m] = p.SX1[t0 + wr * 64 + m * 16 + fr];
#pragma unroll
      for (int n = 0; n < 4; ++n) swr[n] = *(const float4*)(p.sG + b * 1024 + h * 256 + wc * 64 + ccol64(n, fq));
    });
  }
}

__device__ __forceinline__ void phase_oproj(const P& p, int tile) {
  const long t0 = (long)tile * 128;
  float rs[4] = {0.f, 0.f, 0.f, 0.f}, rq[4] = {0.f, 0.f, 0.f, 0.f};
  for (int nt = 0; nt < 4; ++nt) {
    unsigned xr[4][4]; float sxr1[4]; float4 swr[4];
    wg_gemm_f8<256, 64>(p.P8 + t0 * DM, DM, p.HT8 + ((long)(tile >> 6) * 1024 + nt * 256) * DM, DM, DM, [&](f32x4 (&acc)[4][4], int wr, int wc, int fr, int fq) {
      signed char* preq = (signed char*)((bf16_t*)p.PRE + t0 * DM);
#pragma unroll
      for (int m = 0; m < 4; ++m) {
        float vv[4][4];
#pragma unroll
        for (int n = 0; n < 4; ++n) {
          const int xq4 = (int)xr[m][n]; const float rsc = ALPHA * sxr1[m];
          const float4 sw = swr[n];
          const float v0 = rsc * (float)(signed char)(xq4 & 0xff) + acc[m][n][0] * sw.x, v1 = rsc * (float)(signed char)((xq4 >> 8) & 0xff) + acc[m][n][1] * sw.y;
          const float v2 = rsc * (float)(signed char)((xq4 >> 16) & 0xff) + acc[m][n][2] * sw.z, v3 = rsc * (float)(xq4 >> 24) + acc[m][n][3] * sw.w;
          rs[m] += (v0 + v1) + (v2 + v3); rq[m] += (v0 * v0 + v1 * v1) + (v2 * v2 + v3 * v3);
          vv[n][0] = v0; vv[n][1] = v1; vv[n][2] = v2; vv[n][3] = v3;
        }
        pre_store_q(preq, vv, wr * 64 + m * 16 + fr, nt, wc, fq);
      }
    }, [&](int wr, int wc, int fr, int fq) {
#pragma unroll
      for (int m = 0; m < 4; ++m) sxr1[m] = p.SX1[t0 + wr * 64 + m * 16 + fr];
#pragma unroll
      for (int n = 0; n < 4; ++n) { float4 t = *(const float4*)(p.sH8 + (tile >> 6) * 1024 + nt * 256 + wc * 64 + ccol64(n, fq)); t.x *= (1.f / 256.f); t.y *= (1.f / 256.f); t.z *= (1.f / 256.f); t.w *= (1.f / 256.f); swr[n] = t; }
#pragma unroll
      for (int m = 0; m < 4; ++m) {
        const u32x4 x4 = *(const u32x4*)(p.X1Q + (t0 + wr * 64 + m * 16 + fr) * DM + nt * 256 + wc * 64 + fq * 16);
        xr[m][0] = x4.x; xr[m][1] = x4.y; xr[m][2] = x4.z; xr[m][3] = x4.w;
      }
    });
  }
  publish_row_stats(rs, rq);
  wg_sync_mem();
  ln_rows16_qs(p.PRE, t0 + (threadIdx.x >> 6) * 16, p.ln2_g, p.ln2_b, p.X2, p.XQ, p.SX, threadIdx.x & 63, (threadIdx.x >> 6) * 16);
}

__device__ __forceinline__ unsigned f2key(float f) { const unsigned b = __float_as_uint(f); return b ^ ((unsigned)((int)b >> 31) | 0x80000000u); }
__device__ __forceinline__ float key2f(unsigned k) { return __uint_as_float(k ^ ((k & 0x80000000u) ? 0x80000000u : 0xffffffffu)); }

__device__ __forceinline__ void phase_mt(const P& p, int unit) {
  const int hp = unit >> 2, nt = unit & 3;
  wg_gemm<256>(p.skb + (long)hp * 128 * 128, 128, p.wpqB + (long)nt * 256 * 2048 + hp * 128, 2048, 128, [&](f32x4 (&acc)[4][4], int wr, int wc, int fr, int fq) {
u32x2 wpair;
#pragma unroll
    for (int m = 0; m < 4; ++m)
#pragma unroll
      for (int n = 0; n < 4; ++n) {
        const int row = hp * 128 + wr * 64 + m * 16 + fr, col = nt * 256 + wc * 64 + ccol(n, fq);
        u32x2 w; w.x = pk_bf16(acc[m][n][0], acc[m][n][1]); w.y = pk_bf16(acc[m][n][2], acc[m][n][3]);
        if (!(n & 1)) wpair = w; else *(u32x4*)((bf16_t*)p.w_pqT + (long)row * DM + col - 4) = (u32x4){wpair.x, wpair.y, w.x, w.y};
      }
  });
}

__device__ __forceinline__ unsigned cand_entry(int s) {
  unsigned e = 255u; int base = 0;
#pragma unroll
  for (int i = 0; i < 16; ++i) { const int cnt = 16 / (i + 1); if (s >= base && s < base + cnt) e = (unsigned)i | ((unsigned)(s - base) << 4); base += cnt; }
  return e;
}
template <int CTRL> __device__ __forceinline__ unsigned dpp_u(unsigned x) { return (unsigned)__builtin_amdgcn_mov_dpp((int)x, CTRL, 0xf, 0xf, true); }
template <int CTRL> __device__ __forceinline__ float dpp_f(float x) { return __int_as_float(__builtin_amdgcn_mov_dpp(__float_as_int(x), CTRL, 0xf, 0xf, true)); }
__device__ __forceinline__ unsigned umin_(unsigned a, unsigned b) { return a < b ? a : b; }
__device__ __forceinline__ unsigned row_min_u(unsigned x) {
  x = umin_(x, dpp_u<0x128>(x)); x = umin_(x, dpp_u<0x124>(x)); x = umin_(x, dpp_u<0x122>(x)); x = umin_(x, dpp_u<0x121>(x)); return x;
}
__device__ __forceinline__ float row_max_f(float x) { x = fmaxf(x, dpp_f<0x128>(x)); x = fmaxf(x, dpp_f<0x124>(x)); x = fmaxf(x, dpp_f<0x122>(x)); x = fmaxf(x, dpp_f<0x121>(x)); return x; }
__device__ __forceinline__ float row_sum_f(float x) { x += dpp_f<0x128>(x); x += dpp_f<0x124>(x); x += dpp_f<0x122>(x); x += dpp_f<0x121>(x); return x; }

#define KEYS_OFF 65536
#define KEY_STRIDE 528
template <int N> __device__ __forceinline__ unsigned top16_row(const unsigned (&k)[N], int r) {
  unsigned pm1 = 0xFFFFFFFEu, mine = 0;
#pragma unroll
  for (int rd = 0; rd < 16; ++rd) {
    unsigned d = pm1 - k[0];
#pragma unroll
    for (int i = 1; i < N; ++i) d = umin_(d, pm1 - k[i]);
    d = row_min_u(d);
    const unsigned nxt = pm1 - d;
    mine = (r == rd) ? nxt : mine;
    pm1 = nxt - 1;
  }
  return mine;
}

__device__ __forceinline__ void table_row_load(const P& p, int row, int lane, float4 (&v)[4]) {
  const int tb = row >> 14, e = row & 16383;
  const float* src = (tb ? p.w_up : p.w_down) + (long)e * DM;
#pragma unroll
  for (int i = 0; i < 4; ++i) v[i] = *(const float4*)(src + 256 * i + lane * 4);
}
__device__ __forceinline__ void table_row_finish(const P& p, int row, int lane, const float4 (&v)[4]) {
  const int tb = row >> 14, e = row & 16383;
  float amax = 0.f;
#pragma unroll
  for (int i = 0; i < 4; ++i) amax = fmaxf(amax, fmaxf(fmaxf(fabsf(v[i].x), fabsf(v[i].y)), fmaxf(fabsf(v[i].z), fabsf(v[i].w))));
  amax = wave_max_f(amax);
  const float inv = amax > 0.f ? 127.f / amax : 0.f;
  unsigned char* dst = (unsigned char*)(tb ? p.WUq : p.WDq) + (long)e * DM;
#pragma unroll
  for (int i = 0; i < 4; ++i) *(unsigned*)(dst + 256 * i + lane * 4) = pack4_i8(v[i].x * inv, v[i].y * inv, v[i].z * inv, v[i].w * inv);
  if (lane == 0) { float* sc = (float*)(tb ? p.su : p.sd); sc[e] = amax * (1.f / 127.f); }
}
#define CE_(x, y) { const float hi_ = fmaxf(x, y), lo_ = fminf(x, y); x = hi_; y = lo_; }
__device__ __forceinline__ void sort16_desc(float (&a)[16]) {
  CE_(a[0], a[1]); CE_(a[2], a[3]); CE_(a[4], a[5]); CE_(a[6], a[7]); CE_(a[8], a[9]); CE_(a[10], a[11]);
  CE_(a[12], a[13]); CE_(a[14], a[15]); CE_(a[0], a[2]); CE_(a[1], a[3]); CE_(a[4], a[6]); CE_(a[5], a[7]);
  CE_(a[8], a[10]); CE_(a[9], a[11]); CE_(a[12], a[14]); CE_(a[13], a[15]); CE_(a[1], a[2]); CE_(a[5], a[6]);
  CE_(a[9], a[10]); CE_(a[13], a[14]); CE_(a[0], a[4]); CE_(a[1], a[5]); CE_(a[2], a[6]); CE_(a[3], a[7]);
  CE_(a[8], a[12]); CE_(a[9], a[13]); CE_(a[10], a[14]); CE_(a[11], a[15]); CE_(a[2], a[4]); CE_(a[3], a[5]);
  CE_(a[10], a[12]); CE_(a[11], a[13]); CE_(a[1], a[2]); CE_(a[3], a[4]); CE_(a[5], a[6]); CE_(a[9], a[10]);
  CE_(a[11], a[12]); CE_(a[13], a[14]); CE_(a[0], a[8]); CE_(a[1], a[9]); CE_(a[2], a[10]); CE_(a[3], a[11]);
  CE_(a[4], a[12]); CE_(a[5], a[13]); CE_(a[6], a[14]); CE_(a[7], a[15]); CE_(a[4], a[8]); CE_(a[5], a[9]);
  CE_(a[6], a[10]); CE_(a[7], a[11]); CE_(a[2], a[4]); CE_(a[3], a[5]); CE_(a[6], a[8]); CE_(a[7], a[9]);
  CE_(a[10], a[12]); CE_(a[11], a[13]); CE_(a[1], a[2]); CE_(a[3], a[4]); CE_(a[5], a[6]); CE_(a[7], a[8]);
  CE_(a[9], a[10]); CE_(a[11], a[12]); CE_(a[13], a[14]);
}
__device__ __forceinline__ void bitonic16_desc(float (&c)[16]) {
#pragma unroll
  for (int k = 8; k >= 1; k >>= 1)
#pragma unroll
    for (int i = 0; i < 16; ++i)
      if (!(i & k)) CE_(c[i], c[i + k]);
}
template <int CTRL> __device__ __forceinline__ void merge16_xlane(float (&c)[16]) {
  float o[16];
#pragma unroll
  for (int i = 0; i < 16; ++i) o[i] = dpp_f<CTRL>(c[15 - i]);
#pragma unroll
  for (int i = 0; i < 16; ++i) c[i] = fmaxf(c[i], o[i]);
  bitonic16_desc(c);
}
#define XCH_OFF 69632
#define SC_STRIDE 528
__host__ __device__ constexpr int cand_i(int q, int s) {
  return q == 0 ? 0 : q == 1 ? (s < 8 ? 1 : s < 11 ? 4 : s < 13 ? 5 : s < 15 ? 6 : 0) : q == 2 ? (s < 5 ? 2 : s < 9 ? 3 : s < 11 ? 7 : s - 3) : (s < 3 ? 13 + s : 0);
}
__host__ __device__ constexpr int cand_j(int q, int s) {
  return q == 0 ? s : q == 1 ? (s < 8 ? s : s < 11 ? s - 8 : s < 13 ? s - 11 : s < 15 ? s - 13 : s) : q == 2 ? (s < 5 ? s : s < 9 ? s - 5 : s < 11 ? s - 9 : 0) : (s < 3 ? 0 : s);
}
__device__ __forceinline__ void phase_pq_route(const P& p, int tile) {
  const long t0 = (long)tile * 128;
  const int tid = otid(), lane = tid & 63, wid = tid >> 6;
  LAS char* lds = (LAS char*)smem_raw;
  const int sl = lane >> 2, sq = lane & 3;
  const unsigned kb2 = 96u - (unsigned)(sq * 32);
  int f1 = sq == 1, f2 = sq == 2, f3 = sq == 3;
  asm volatile("" : "+v"(f1), "+v"(f2), "+v"(f3));
  const bool q1 = f1 != 0, q2 = f2 != 0, q3 = f3 != 0;
  auto top_sorted = [&](int half, float (&c)[16]) {
    LAS const char* row = lds + (wid * 16 + sl) * SC_STRIDE + half * 256 + sq * 64;
    u32x4 kw[4];
#pragma unroll
    for (int i = 0; i < 4; ++i) kw[i] = *(LAS const u32x4*)(row + i * 16);
    float a[16], b[16];
#pragma unroll
    for (int i = 0; i < 2; ++i) {
      const unsigned wa[4] = {kw[i].x, kw[i].y, kw[i].z, kw[i].w};
      const unsigned wb[4] = {kw[i + 2].x, kw[i + 2].y, kw[i + 2].z, kw[i + 2].w};
#pragma unroll
      for (int e = 0; e < 4; ++e) {
        const unsigned ja = i * 8 + e * 2, jb = ja + 16;
        a[i * 8 + e * 2] = __uint_as_float(__float_as_uint(f16_lo(wa[e])) + kb2 + (31u - ja));
        a[i * 8 + e * 2 + 1] = __uint_as_float(__float_as_uint(f16_hi(wa[e])) + kb2 + (30u - ja));
        b[i * 8 + e * 2] = __uint_as_float(__float_as_uint(f16_lo(wb[e])) + kb2 + (31u - jb));
        b[i * 8 + e * 2 + 1] = __uint_as_float(__float_as_uint(f16_hi(wb[e])) + kb2 + (30u - jb));
      }
    }
    sort16_desc(a); sort16_desc(b);
#pragma unroll
    for (int i = 0; i < 16; ++i) c[i] = fmaxf(a[i], b[15 - i]);
    bitonic16_desc(c);
    merge16_xlane<0xB1>(c);
    merge16_xlane<0x4E>(c);
    if (sq == 0) {
      LAS char* dst = lds + XCH_OFF + ((wid * 2 + half) * 16 + sl) * 64;
#pragma unroll
      for (int j = 0; j < 4; ++j) *(LAS f32x4*)(dst + j * 16) = (f32x4){c[4 * j], c[4 * j + 1], c[4 * j + 2], c[4 * j + 3]};
    }
  };
  for (int h = 0; h < 8; ++h) {
    float4 swr[4]; float srr[4];
    wg_gemm_i8<256>((const signed char*)p.XQ + t0 * DM, DM, p.MTq + (long)h * 256 * DM, DM, DM, [&](v4i_t (&acc)[4][4], int wr, int wc, int fr, int fq) {
      asm volatile("s_waitcnt lgkmcnt(0)" ::: "memory");
      __builtin_amdgcn_s_barrier();
      asm volatile("" ::: "memory");
      u32x2 wpair;
#pragma unroll
      for (int m = 0; m < 4; ++m) {
        const float sr = srr[m];
#pragma unroll
        for (int n = 0; n < 4; ++n) {
          const float4 sw = swr[n];
          u32x2 w; w.x = pk_f16((float)acc[m][n][0] * (sr * sw.x), (float)acc[m][n][1] * (sr * sw.y)); w.y = pk_f16((float)acc[m][n][2] * (sr * sw.z), (float)acc[m][n][3] * (sr * sw.w));
          if (!(n & 1)) wpair = w;
          else *(LAS u32x4*)(lds + (wr * 64 + m * 16 + fr) * SC_STRIDE + (wc * 64 + ccol(n, fq) - 4) * 2) = (u32x4){wpair.x, wpair.y, w.x, w.y};
        }
      }
    }, [&](int wr, int wc, int fr, int fq) {
#pragma unroll
      for (int m = 0; m < 4; ++m) srr[m] = p.SX[t0 + wr * 64 + m * 16 + fr];
#pragma unroll
      for (int n = 0; n < 4; ++n) swr[n] = *(const float4*)(p.sMT + h * 256 + wc * 64 + ccol(n, fq));
    });
    asm volatile("s_waitcnt lgkmcnt(0)" ::: "memory");
    __builtin_amdgcn_s_barrier();
    asm volatile("" ::: "memory");
    float4 tv0[4], tv1[4];
    const int gw = blockIdx.x * 8 + wid;
    float cA[16], cB[16];
    __builtin_amdgcn_sched_barrier(0);
    top_sorted(0, cA);
    __builtin_amdgcn_sched_barrier(0);
    top_sorted(1, cB);
    __builtin_amdgcn_sched_barrier(0);
    table_row_load(p, gw + 2048 * (2 * h), lane, tv0); table_row_load(p, gw + 2048 * (2 * h + 1), lane, tv1);
    float fa[16], fb[16];
#pragma unroll
    for (int i = 0; i < 16; ++i) { fa[i] = __uint_as_float(__float_as_uint(cA[i]) & ~127u); fb[i] = __uint_as_float(__float_as_uint(cB[i]) & ~127u); }
    float k2[16];
#pragma unroll
    for (int s = 0; s < 16; ++s) {
      float va = fa[cand_i(0, s)], vb = fb[cand_j(0, s)];
      unsigned code = 255u - (unsigned)(cand_i(0, s) * 16 + cand_j(0, s));
      va = q1 ? fa[cand_i(1, s)] : va; vb = q1 ? fb[cand_j(1, s)] : vb; code = q1 ? 255u - (unsigned)(cand_i(1, s) * 16 + cand_j(1, s)) : code;
      va = q2 ? fa[cand_i(2, s)] : va; vb = q2 ? fb[cand_j(2, s)] : vb; code = q2 ? 255u - (unsigned)(cand_i(2, s) * 16 + cand_j(2, s)) : code;
      va = q3 ? fa[cand_i(3, s)] : va; vb = q3 ? fb[cand_j(3, s)] : vb; code = q3 ? 255u - (unsigned)(cand_i(3, s) * 16 + cand_j(3, s)) : code;
      unsigned kk = (__float_as_uint(va + vb) & ~255u) | code;
      if (s == 15) kk = q1 ? 0xff800000u : kk;
      if (s >= 3) kk = q3 ? 0xff800000u : kk;
      k2[s] = __uint_as_float(kk);
    }
    sort16_desc(k2);
    merge16_xlane<0xB1>(k2);
    merge16_xlane<0x4E>(k2);
    {
      const float mx = __uint_as_float(__float_as_uint(k2[0]) & ~255u);
      LAS char* x2 = lds + XCH_OFF + 16384 + (wid * 16 + sl) * 64;
      if (sq == 0) {
#pragma unroll
        for (int j = 0; j < 4; ++j) *(LAS f32x4*)(x2 + j * 16) = (f32x4){k2[4 * j], k2[4 * j + 1], k2[4 * j + 2], k2[4 * j + 3]};
      }
      const u32x4 mv = *(LAS const u32x4*)(x2 + sq * 16);
      const unsigned m[4] = {mv.x, mv.y, mv.z, mv.w};
      int ee[4]; float ex[4]; float s4 = 0.f;
#pragma unroll
      for (int t = 0; t < 4; ++t) {
        const unsigned code = 255u - (m[t] & 255u);
        const unsigned ka = *(LAS const unsigned*)(lds + XCH_OFF + ((wid * 2 + 0) * 16 + sl) * 64 + (code >> 4) * 4);
        const unsigned kb = *(LAS const unsigned*)(lds + XCH_OFF + ((wid * 2 + 1) * 16 + sl) * 64 + (code & 15u) * 4);
        ee[t] = (int)((127u - (ka & 127u)) * 128u + (127u - (kb & 127u)));
        ex[t] = __expf(__uint_as_float(m[t] & ~255u) - mx);
        s4 += ex[t];
      }
      s4 += dpp_f<0xB1>(s4); s4 += dpp_f<0x4E>(s4);
      const float inv = 1.f / s4;
      const long o = (t0 + wid * 16 + sl) * 128 + h * 16 + sq * 4;
      *(v4i_t*)(p.experts + o) = (v4i_t){ee[0], ee[1], ee[2], ee[3]};
      *(f32x4*)(p.gates + o) = (f32x4){ex[0] * inv, ex[1] * inv, ex[2] * inv, ex[3] * inv};
    }
    table_row_finish(p, gw + 2048 * (2 * h), lane, tv0); table_row_finish(p, gw + 2048 * (2 * h + 1), lane, tv1);
  }
}

__device__ __forceinline__ f32x2_t ub01(unsigned w) { return (f32x2_t){(float)(w & 0xffu), (float)((w >> 8) & 0xffu)}; }
__device__ __forceinline__ f32x2_t ub23(unsigned w) { return (f32x2_t){(float)((w >> 16) & 0xffu), (float)(w >> 24)}; }
__device__ __forceinline__ int sum8_i(int x) {
  x += (int)dpp_u<0xB1>((unsigned)x); x += (int)dpp_u<0x4E>((unsigned)x); x += (int)dpp_u<0x141>((unsigned)x); return x;
}
struct GMeta { u32x4 xq; int er0, er1; };
__device__ __forceinline__ void phase_gdown(const P& p) {
  const int tid = otid(), lane = tid & 63, wid = tid >> 6, grp = lane >> 3, r8 = lane & 7;
  const int slice = blockIdx.x & 7, chunk = blockIdx.x >> 3;
  const __amdgpu_buffer_rsrc_t tabr = __builtin_amdgcn_make_buffer_rsrc((void*)p.WDq, 0, 16384 * DM, 0x00020000);
  const int tabo = slice * 128 + r8 * 16;
  const char* sl = p.slabs + (size_t)(chunk * 8 + wid) * SLAB_BYTES;
  unsigned* pd = (unsigned*)(sl + OFF_ZB) + slice * 128 * 64;
  const unsigned char* xqb = (const unsigned char*)(sl + OFF_X2Q);
  const int* exb = (const int*)(sl + OFF_EXP);
  const int gbase = (lane & ~7) * 4;
  auto meta = [&](int tg, v4i_t (&ex)[4], u32x4& xq) {
    const int t = (tg < 16 ? tg : 15) * 8 + grp;
#pragma unroll
    for (int i = 0; i < 4; ++i) ex[i] = *(const v4i_t*)(exb + t * 128 + r8 * 16 + i * 4);
    xq = *(const u32x4*)(xqb + t * DM + slice * 128 + r8 * 16);
  };
  auto gather = [&](const v4i_t (&ex)[4], int bb, int i) -> u32x4 {
    const int e = __builtin_amdgcn_ds_bpermute(gbase + bb * 4, ex[i >> 2][i & 3]);
    return __builtin_amdgcn_raw_buffer_load_b128(tabr, (e << 10) + tabo, 0, 0);
  };
  v4i_t exC[4], exN[4]; u32x4 xqC, xqN;
  u32x4 w[16];
  meta(0, exC, xqC);
#pragma unroll
  for (int i = 0; i < 16; ++i) w[i] = gather(exC, 0, i);
#pragma unroll 1
  for (int tg = 0; tg < 16; ++tg) {
    int out[16];
#pragma unroll
    for (int i = 0; i < 16; ++i) out[i] = 0;
#pragma unroll
    for (int bb = 0; bb < 8; ++bb) {
      if (bb == 5) meta(tg + 1, exN, xqN);
#pragma unroll
      for (int i = 0; i < 16; ++i) {
        int acc = __builtin_amdgcn_sdot4((int)w[i].x, (int)xqC.x, 0, false);
        acc = __builtin_amdgcn_sdot4((int)w[i].y, (int)xqC.y, acc, false); acc = __builtin_amdgcn_sdot4((int)w[i].z, (int)xqC.z, acc, false); acc = __builtin_amdgcn_sdot4((int)w[i].w, (int)xqC.w, acc, false);
        w[i] = (bb < 7) ? gather(exC, bb + 1, i) : gather(exN, 0, i);
        acc = sum8_i(acc);
        const int slot = bb * 2 + (i >> 3);
        out[slot] = ((i & 7) == r8) ? acc : out[slot];
        if ((i & 3) == 3) __builtin_amdgcn_sched_barrier(0);
      }
    }
    {
      u32x4 q0, q1;
#pragma unroll
      for (int jj = 0; jj < 4; ++jj) {
        q0[jj] = ((unsigned)((out[jj] + 32) >> 6) & 0xffffu) | ((unsigned)((out[jj + 8] + 32) >> 6) << 16);
        q1[jj] = ((unsigned)((out[jj + 4] + 32) >> 6) & 0xffffu) | ((unsigned)((out[jj + 12] + 32) >> 6) << 16);
      }
      unsigned* dst = pd + (tg * 8 + grp) * 64 + r8 * 4;
      *(u32x4*)dst = q0; *(u32x4*)(dst + 32) = q1;
    }
#pragma unroll
    for (int i = 0; i < 4; ++i) exC[i] = exN[i];
    xqC = xqN;
  }
}
__device__ __forceinline__ int cq_index(int k) { return ((k >> 5) * 8 + (k & 7)) * 4 + ((k >> 3) & 3); }
__device__ __forceinline__ void gcomb_stage(const P& p) {
  const int tid = otid();
  LAS f32x2_t* dus = (LAS f32x2_t*)smem_raw;
  for (int k4 = tid; k4 < 16384 / 4; k4 += 512) {
    const float4 d4 = *(const float4*)(p.sd + k4 * 4), u4 = *(const float4*)(p.su + k4 * 4);
    *(LAS f32x4*)(dus + k4 * 4) = (f32x4){d4.x, u4.x, d4.y, u4.y};
    *(LAS f32x4*)(dus + k4 * 4 + 2) = (f32x4){d4.z, u4.z, d4.w, u4.w};
  }
}
__device__ __forceinline__ void phase_gcomb(const P& p, int tile) {
  const int tid = otid(), lane = tid & 63, wid = tid >> 6;
  signed char* cq = (signed char*)(p.slabs + (size_t)tile * SLAB_BYTES + OFF_CQ);
  float* sc = (float*)(p.slabs + (size_t)tile * SLAB_BYTES + OFF_SC);
  LAS f32x2_t* dus = (LAS f32x2_t*)smem_raw;
  int wN[8], e0N, e1N; float g0N, g1N, sxN;
  auto loadtok = [&](int ti) {
    const int tl = wid * 16 + (ti < 16 ? ti : 15);
    const long t = (long)tile * 128 + tl;
#pragma unroll
    for (int j = 0; j < 8; ++j) wN[j] = p.PD[(j * 128 + tl) * 64 + (lane >> 5) * 32 + (lane & 7) * 4 + ((lane >> 3) & 3)];
    e0N = p.experts[t * 128 + lane]; e1N = p.experts[t * 128 + 64 + lane];
    g0N = p.gates[t * 128 + lane]; g1N = p.gates[t * 128 + 64 + lane];
    sxN = p.SX[t];
  };
  loadtok(0);
#pragma unroll 2
  for (int ti = 0; ti < 16; ++ti) {
    const int tl = wid * 16 + ti;
    int s0 = 0, s1 = 0;
#pragma unroll
    for (int j = 0; j < 8; ++j) { const int w = wN[j]; s0 += (int)(short)(w & 0xffff); s1 += w >> 16; }
    s0 <<= 6; s1 <<= 6;
    const int e0 = e0N, e1 = e1N;
    const float sx = sxN, gt0 = g0N, gt1 = g1N;
    loadtok(ti + 1);
    const f32x2_t du0 = dus[e0], du1 = dus[e1];
    const float c0 = gt0 * gelu_f((float)s0 * du0[0] * sx) * du0[1];
    const float c1 = gt1 * gelu_f((float)s1 * du1[0] * sx) * du1[1];
    float amax = fmaxf(fabsf(c0), fabsf(c1));
    amax = wave_max_f(amax);
    const float inv = amax > 0.f ? 127.f / amax : 0.f;
    cq[tl * 128 + cq_index(lane)] = (signed char)__float2int_rn(c0 * inv);
    cq[tl * 128 + cq_index(lane + 64)] = (signed char)__float2int_rn(c1 * inv);
    if (lane == 0) sc[tl] = amax * (1.f / 127.f);
  }
}
struct UMeta { int er0, er1; unsigned cq[4]; };
template <class Mid> __device__ __forceinline__ void phase_gup(const P& p, Mid&& mid) {
  const int tid = otid(), lane = tid & 63, wid = tid >> 6, grp = lane >> 3, r8 = lane & 7;
  const int slice = blockIdx.x & 7, chunk = blockIdx.x >> 3;
  const __amdgpu_buffer_rsrc_t tabr = __builtin_amdgcn_make_buffer_rsrc((void*)p.WUq, 0, 16384 * DM, 0x00020000);
  const int tabo = slice * 128 + r8 * 16;
  char* sl = p.slabs + (size_t)(chunk * 8 + wid) * SLAB_BYTES;
  const int* exb = (const int*)(sl + OFF_EXP);
  const unsigned* cqb = (const unsigned*)(sl + OFF_CQ);
  const float* scb = (const float*)(sl + OFF_SC);
  signed char* h3q = (signed char*)(sl + OFF_ZB);
  float* h3s = (float*)(sl + OFF_ZB + 128 * 1024);
  auto meta = [&](int tg, v4i_t (&ex)[4], u32x4& cqv, float& scv) {
    const int t = (tg < 16 ? tg : 15) * 8 + grp;
#pragma unroll
    for (int i = 0; i < 4; ++i) ex[i] = *(const v4i_t*)(exb + t * 128 + r8 * 16 + i * 4);
    cqv = *(const u32x4*)(cqb + t * 32 + r8 * 4);
    scv = scb[t];
  };
  const int gbase = (lane & ~7) * 4;
#define GUP_BCAST(v, src) __builtin_amdgcn_ds_bpermute(gbase + (src) * 4, (int)(v))
  auto gather = [&](const v4i_t (&ex)[4], int bb, int j, int b) -> u32x4 {
    const int pick = (bb >> 1) * 32 + b * 8 + (bb & 1) * 4 + j;
    const int reg = pick & 15;
    const int e = GUP_BCAST(ex[reg >> 2][reg & 3], pick >> 4);
    return __builtin_amdgcn_raw_buffer_load_b128(tabr, (e << 10) + tabo, 0, 0);
  };
  v4i_t exC[4], exN[4]; u32x4 cqC, cqN; float scC, scN;
  u32x4 w[16];
  {
    const int t = grp;
#pragma unroll
    for (int i = 0; i < 4; ++i) exC[i] = *(const v4i_t*)(exb + t * 128 + r8 * 16 + i * 4);
  }
#pragma unroll
  for (int q = 0; q < 4; ++q)
#pragma unroll
    for (int b = 0; b < 4; ++b) w[q * 4 + b] = gather(exC, 0, q, b);
  mid();
  cqC = *(const u32x4*)(cqb + grp * 32 + r8 * 4);
  scC = scb[grp];
#pragma unroll 1
  for (int tg = 0; tg < 16; ++tg) {
    int o[16];
#pragma unroll
    for (int i = 0; i < 16; ++i) o[i] = 0;
#pragma unroll
    for (int bb = 0; bb < 8; ++bb) {
      if (bb == 5) meta(tg + 1, exN, cqN, scN);
#pragma unroll
      for (int q = 0; q < 4; ++q) {
        const int D = (bb >> 1) * 8 + (bb & 1) * 4 + q;
        const int cq = GUP_BCAST(cqC[D & 3], D >> 2);
        const unsigned x0[4] = {w[4 * q].x, w[4 * q].y, w[4 * q].z, w[4 * q].w}, x1[4] = {w[4 * q + 1].x, w[4 * q + 1].y, w[4 * q + 1].z, w[4 * q + 1].w};
        const unsigned x2[4] = {w[4 * q + 2].x, w[4 * q + 2].y, w[4 * q + 2].z, w[4 * q + 2].w}, x3[4] = {w[4 * q + 3].x, w[4 * q + 3].y, w[4 * q + 3].z, w[4 * q + 3].w};
#pragma unroll
        for (int b = 0; b < 4; ++b) w[4 * q + b] = (bb < 7) ? gather(exC, bb + 1, q, b) : gather(exN, 0, q, b);
#pragma unroll
        for (int d = 0; d < 4; ++d) {
          const unsigned t0 = __builtin_amdgcn_perm(x1[d], x0[d], 0x05010400u), t1 = __builtin_amdgcn_perm(x1[d], x0[d], 0x07030602u);
          const unsigned u0 = __builtin_amdgcn_perm(x3[d], x2[d], 0x05010400u), u1 = __builtin_amdgcn_perm(x3[d], x2[d], 0x07030602u);
          o[d * 4 + 0] = __builtin_amdgcn_sdot4((int)__builtin_amdgcn_perm(u0, t0, 0x05040100u), cq, o[d * 4 + 0], false);
          o[d * 4 + 1] = __builtin_amdgcn_sdot4((int)__builtin_amdgcn_perm(u0, t0, 0x07060302u), cq, o[d * 4 + 1], false);
          o[d * 4 + 2] = __builtin_amdgcn_sdot4((int)__builtin_amdgcn_perm(u1, t1, 0x05040100u), cq, o[d * 4 + 2], false);
          o[d * 4 + 3] = __builtin_amdgcn_sdot4((int)__builtin_amdgcn_perm(u1, t1, 0x07060302u), cq, o[d * 4 + 3], false);
        }
        __builtin_amdgcn_sched_barrier(0);
      }
    }
    {
      int am = 0;
#pragma unroll
      for (int i = 0; i < 16; ++i) am = max(am, o[i] < 0 ? -o[i] : o[i]);
      am = max(am, (int)dpp_u<0xB1>((unsigned)am)); am = max(am, (int)dpp_u<0x4E>((unsigned)am)); am = max(am, (int)dpp_u<0x141>((unsigned)am));
      const float fam = (float)am, inv = am > 0 ? 127.f / fam : 0.f;
      u32x4 q;
#pragma unroll
      for (int w4 = 0; w4 < 4; ++w4) q[w4] = pack4_i8((float)o[4 * w4] * inv, (float)o[4 * w4 + 1] * inv, (float)o[4 * w4 + 2] * inv, (float)o[4 * w4 + 3] * inv);
      *(u32x4*)(h3q + (tg * 8 + grp) * DM + slice * 128 + r8 * 16) = q;
      if (r8 == 0) h3s[slice * 128 + tg * 8 + grp] = fam * scC * (1.f / 127.f);
    }
#pragma unroll
    for (int i = 0; i < 4; ++i) exC[i] = exN[i];
    cqC = cqN; scC = scN;
  }
#undef GUP_BCAST
}
__device__ __forceinline__ void phase_ln3(const P& p, int tile) {
  const int tid = otid(), lane = tid & 63, wid = tid >> 6;
  const signed char* h3q = (const signed char*)(p.slabs + (size_t)tile * SLAB_BYTES + OFF_ZB);
  const float* h3s = (const float*)(p.slabs + (size_t)tile * SLAB_BYTES + OFF_ZB + 128 * 1024);
  float4 gg[4], bb[4];
#pragma unroll
  for (int j = 0; j < 4; ++j) { gg[j] = *(const float4*)(p.ln3_g + j * 256 + lane * 4); bb[j] = *(const float4*)(p.ln3_b + j * 256 + lane * 4); }
  int hqC[4], xqC[4], hqN[4], xqN[4]; float hsC[4], hsN[4], rsC, rsN;
  auto load = [&](int ti, int (&hq)[4], int (&xq)[4], float (&hs)[4], float& rs) {
    const int tl = wid * 16 + (ti < 16 ? ti : 15);
    const long t = (long)tile * 128 + tl;
    rs = ALPHA * p.SX[t];
#pragma unroll
    for (int j = 0; j < 4; ++j) {
      const int c0 = j * 256 + lane * 4;
      hq[j] = *(const int*)(h3q + tl * DM + c0);
      hs[j] = h3s[(2 * j + (lane >> 5)) * 128 + tl];
      xq[j] = *(const int*)(p.XQ + t * DM + c0);
    }
  };
  load(0, hqC, xqC, hsC, rsC);
#pragma unroll 1
  for (int ti = 0; ti < 16; ++ti) {
    const long t = (long)tile * 128 + wid * 16 + ti;
    load(ti + 1, hqN, xqN, hsN, rsN);
    float4 v[4];
    float sum = 0.f;
#pragma unroll
    for (int j = 0; j < 4; ++j) {
      const int hq4 = hqC[j], xq4 = xqC[j]; const float hs = hsC[j], rs = rsC;
      v[j].x = hs * (float)(signed char)(hq4 & 0xff) + rs * (float)(signed char)(xq4 & 0xff); v[j].y = hs * (float)(signed char)((hq4 >> 8) & 0xff) + rs * (float)(signed char)((xq4 >> 8) & 0xff);
      v[j].z = hs * (float)(signed char)((hq4 >> 16) & 0xff) + rs * (float)(signed char)((xq4 >> 16) & 0xff); v[j].w = hs * (float)(hq4 >> 24) + rs * (float)(xq4 >> 24);
      sum += (v[j].x + v[j].y) + (v[j].z + v[j].w);
    }
    sum = wave_sum_f(sum);
    const float mu = sum * (1.f / DM);
    float q = 0.f;
#pragma unroll
    for (int j = 0; j < 4; ++j) { v[j].x -= mu; v[j].y -= mu; v[j].z -= mu; v[j].w -= mu; q += (v[j].x * v[j].x + v[j].y * v[j].y) + (v[j].z * v[j].z + v[j].w * v[j].w); }
    q = wave_sum_f(q);
    const float rstd = rsqrtf(q * (1.f / DM) + LN_EPS);
#pragma unroll
    for (int j = 0; j < 4; ++j) {
      const int c0 = j * 256 + lane * 4;
      float4 o; o.x = v[j].x * rstd * gg[j].x + bb[j].x; o.y = v[j].y * rstd * gg[j].y + bb[j].y; o.z = v[j].z * rstd * gg[j].z + bb[j].z; o.w = v[j].w * rstd * gg[j].w + bb[j].w;
      *(float4*)(p.out + t * DM + c0) = o;
    }
#pragma unroll
    for (int j = 0; j < 4; ++j) { hqC[j] = hqN[j]; xqC[j] = xqN[j]; hsC[j] = hsN[j]; }
    rsC = rsN;
  }
}

__device__ __forceinline__ void prep_transpose_tile(const float* __restrict__ W, bf16_t* __restrict__ WT, int K, int N, int tileidx) {
  LAS float* scr = (LAS float*)smem_raw;
  const int ntn = N / 64, k0 = (tileidx / ntn) * 64, n0 = (tileidx % ntn) * 64, tid = threadIdx.x;
#pragma unroll
  for (int i = 0; i < 8; ++i) { const int e = tid + i * 512, kk = e >> 6, nn = e & 63; scr[kk * 65 + nn] = W[(long)(k0 + kk) * N + n0 + nn]; }
  __syncthreads();
#pragma unroll
  for (int i = 0; i < 4; ++i) { const int e = tid + i * 512, nn = e >> 5, kp = (e & 31) * 2; *(unsigned*)(WT + (long)(n0 + nn) * K + k0 + kp) = pk_bf16(scr[kp * 65 + nn], scr[(kp + 1) * 65 + nn]); }
  __syncthreads();
}
__device__ __forceinline__ void prep_quant_strip(const float* __restrict__ W, signed char* __restrict__ Q, float* __restrict__ sc, int K, int N, int strip) {
  LAS float* scr = (LAS float*)smem_raw;
  LAS float* pmax = scr + 64 * 65;
  LAS float* inv = pmax + 8 * 64;
  const int n0 = strip * 64, tid = threadIdx.x, nn = tid & 63, kg = tid >> 6;
  float amax = 0.f;
#pragma unroll 4
  for (int k0 = 0; k0 < K; k0 += 64)
#pragma unroll
    for (int i = 0; i < 8; ++i) amax = fmaxf(amax, fabsf(W[(long)(k0 + kg + 8 * i) * N + n0 + nn]));
  pmax[kg * 64 + nn] = amax;
  __syncthreads();
  if (tid < 64) {
    float m = 0.f;
#pragma unroll
    for (int j = 0; j < 8; ++j) m = fmaxf(m, pmax[j * 64 + tid]);
    inv[tid] = m > 0.f ? 127.f / m : 0.f;
    sc[n0 + tid] = m * (1.f / 127.f);
  }
  __syncthreads();
  const float iv = inv[nn];
  float cur[8];
#pragma unroll
  for (int i = 0; i < 8; ++i) cur[i] = W[(long)(kg + 8 * i) * N + n0 + nn];
  for (int k0 = 0; k0 < K; k0 += 64) {
    float nxt[8];
    const int k1 = k0 + 64 < K ? k0 + 64 : k0;
#pragma unroll
    for (int i = 0; i < 8; ++i) nxt[i] = W[(long)(k1 + kg + 8 * i) * N + n0 + nn];
#pragma unroll
    for (int i = 0; i < 8; ++i) { const int kk = kg + 8 * i; scr[kk * 65 + nn] = cur[i] * iv; }
#pragma unroll
    for (int i = 0; i < 8; ++i) cur[i] = nxt[i];
    __syncthreads();
#pragma unroll
    for (int i = 0; i < 2; ++i) {
      const int dd = tid + i * 512, n = dd >> 4, k4 = (dd & 15) * 4;
      *(unsigned*)(Q + (long)(n0 + n) * K + k0 + k4) = pack4_i8(scr[k4 * 65 + n], scr[(k4 + 1) * 65 + n], scr[(k4 + 2) * 65 + n], scr[(k4 + 3) * 65 + n]);
    }
    __syncthreads();
  }
}
__device__ __forceinline__ void prep_cvt(const float* __restrict__ in, bf16_t* __restrict__ out, long n8) {
  for (long i = (long)blockIdx.x * 512 + threadIdx.x; i < n8; i += (long)gridDim.x * 512) {
    const float4 a = *(const float4*)(in + i * 8), b = *(const float4*)(in + i * 8 + 4);
    u32x4 o; o.x = pk_bf16(a.x, a.y); o.y = pk_bf16(a.z, a.w); o.z = pk_bf16(b.x, b.y); o.w = pk_bf16(b.z, b.w);
    *(u32x4*)(out + i * 8) = o;
  }
}
__device__ __forceinline__ void phase_prep(const P& p) {
  const int T_IN = 16 * 40, T_SQ = 16 * 16, T_W2 = 16 * 32;
  const int total = T_IN + T_SQ + T_SQ + T_W2 + T_SQ + T_W2;
  for (int it = blockIdx.x; it < total; it += gridDim.x) {
    int r = it;
    if (r < T_IN) { if (r < 40) prep_quant_strip(p.w_in, p.w_inQ, p.sw_in, DM, INW, r); continue; } r -= T_IN;
    if (r < T_SQ) { if (r < 16) prep_quant_strip(p.w_mo, p.w_moQ, p.sw_mo, DM, DM, r); continue; } r -= T_SQ;
    if (r < T_SQ) { continue; } r -= T_SQ;
    if (r < T_W2) { prep_transpose_tile(p.w_xkv, (bf16_t*)p.w_xkvT, DM, 2048, r); continue; } r -= T_W2;
    if (r < T_SQ) { prep_transpose_tile(p.w_xo, (bf16_t*)p.w_xoT, DM, DM, r); continue; } r -= T_SQ;
    (void)r;
  }
  prep_cvt(p.mem, (bf16_t*)p.memB, (long)1024 * DM / 8);
  prep_cvt(p.sub_keys, (bf16_t*)p.skb, (long)8 * 2 * 128 * 128 / 8);
  prep_cvt(p.w_pq, (bf16_t*)p.wpqB, (long)DM * 2048 / 8);
  prep_cvt(p.w_xq, (bf16_t*)p.wxqB, (long)DM * DM / 8);
  for (int i = blockIdx.x * 512 + threadIdx.x; i < 4 * 128 * 128 / 2; i += gridDim.x * 512) {
    const int e = i * 2, t = (e >> 7) & 127, sidx = e & 127;
    const float2 v = *(const float2*)(p.w_sp + e);
    *(unsigned*)((bf16_t*)p.wsb + e) = pk_bf16(sidx <= t ? v.x : 0.f, (sidx + 1) <= t ? v.y : 0.f);
  }
}
__device__ __forceinline__ void phase_xcvt(const P& p, int tile) {
  const int lane = threadIdx.x & 63, wid = threadIdx.x >> 6;
  signed char* xq = (signed char*)(p.slabs + (size_t)tile * SLAB_BYTES + OFF_XB);
  float* sxr = (float*)(p.slabs + (size_t)tile * SLAB_BYTES + OFF_SXB);
#pragma unroll 2
  for (int i = 0; i < 16; ++i) {
    const int rl = wid * 16 + i;
    const float* src = p.x + ((long)tile * 128 + rl) * DM;
    float4 v[4];
    float amax = 0.f;
#pragma unroll
    for (int j = 0; j < 4; ++j) { v[j] = *(const float4*)(src + 256 * j + lane * 4); amax = fmaxf(amax, fmaxf(fmaxf(fabsf(v[j].x), fabsf(v[j].y)), fmaxf(fabsf(v[j].z), fabsf(v[j].w)))); }
    amax = wave_max_f(amax);
    const float inv = amax > 0.f ? 127.f / amax : 0.f;
#pragma unroll
    for (int j = 0; j < 4; ++j) *(unsigned*)(xq + rl * DM + 256 * j + lane * 4) = pack4_i8(v[j].x * inv, v[j].y * inv, v[j].z * inv, v[j].w * inv);
    if (lane == 0) sxr[rl] = amax * (1.f / 127.f);
  }
}
__device__ __forceinline__ void phase_halo(const P& p, int tile) {
  const int tid = otid();
  if (tid < 128) {
    const int rr = tid >> 6, c = (tid & 63) * 8;
    const bf16_t* zr = p.ZB + ((long)tile * 128 + 126 + rr) * INW;
    const u32x4 hb = *(const u32x4*)(zr + 1024 + c), gc = *(const u32x4*)(zr + 2048 + c);
    u32x4 o;
    o.x = pk_bf16(bf_lo(hb.x) * bf_lo(gc.x), bf_hi(hb.x) * bf_hi(gc.x)); o.y = pk_bf16(bf_lo(hb.y) * bf_lo(gc.y), bf_hi(hb.y) * bf_hi(gc.y));
    o.z = pk_bf16(bf_lo(hb.z) * bf_lo(gc.z), bf_hi(hb.z) * bf_hi(gc.z)); o.w = pk_bf16(bf_lo(hb.w) * bf_lo(gc.w), bf_hi(hb.w) * bf_hi(gc.w));
    *(u32x4*)(p.HALO + ((long)tile * 2 + rr) * 512 + c) = o;
  }
}

__device__ __forceinline__ P tile_view(const P& p, int tile) {
  P q = p;
  char* sl = p.slabs + (size_t)tile * SLAB_BYTES;
  const long t0 = (long)tile * 128;
  q.XB = (bf16_t*)(sl + OFF_XB) - t0 * DM; q.X1 = (bf16_t*)(sl + OFF_XB) - t0 * DM;
  q.experts = (int*)(sl + OFF_EXP) - t0 * 128; q.gates = (float*)(sl + OFF_GATE) - t0 * 128;
  q.ZB = (bf16_t*)(sl + OFF_ZB) - t0 * INW; q.PRE = (float*)((bf16_t*)(sl + OFF_ZB) - t0 * DM); q.KEYS = (unsigned*)((unsigned short*)(sl + OFF_ZB) - t0 * 2048);
  q.PD = (int*)(sl + OFF_ZB); q.H3 = (float*)((bf16_t*)(sl + OFF_ZB) - t0 * DM);
  q.VT = (bf16_t*)(sl + OFF_VT) - (long)tile * 4 * 128 * 128; q.X1Q = (unsigned char*)(sl + OFF_VT) - t0 * DM; q.XQ = (unsigned char*)(sl + OFF_X2Q) - t0 * DM;
  q.Y = (bf16_t*)(sl + OFF_Y) - t0 * DM; q.Pb = (bf16_t*)(sl + OFF_Y) - t0 * DM; q.P8 = (signed char*)(sl + OFF_Y) - t0 * DM;
  q.Q = (bf16_t*)(sl + OFF_Q) - t0 * DM; q.X2 = (bf16_t*)(sl + OFF_Q) - t0 * DM; q.YQ = (signed char*)(sl + OFF_Q) - t0 * DM;
  return q;
}

#define XB_TMO      128
#define XB_XCNT(j)  (256  + 64 * (j))
#define XB_XSUB(j)  (1280 + 64 * (j))
#define XB_XGEN(j)  (2304 + 64 * (j))
#define XB_TOP      3328
#define XB_TOPGEN   3392
#define XB_SPIN_CAP (1u << 18)

__device__ __forceinline__ unsigned xb_ld(unsigned* p)              { return __hip_atomic_load(p, __ATOMIC_RELAXED, __HIP_MEMORY_SCOPE_AGENT); }
__device__ __forceinline__ unsigned xb_add(unsigned* p, unsigned v) { return __hip_atomic_fetch_add(p, v, __ATOMIC_RELAXED, __HIP_MEMORY_SCOPE_AGENT); }
__device__ __forceinline__ unsigned xb_xcc_id() { return (unsigned)__builtin_amdgcn_s_getreg((3 << 11) | 20) & 0xFu; }
#define XB_SPIN(cond, bar) do { unsigned _sp = 0; while (cond) { __builtin_amdgcn_s_sleep(1); \
    if ((++_sp & 255u) == 0u) { if (xb_ld(&(bar)[XB_TMO])) break; if (_sp > XB_SPIN_CAP) { atomicAdd(&(bar)[XB_TMO], 1u); break; } } } } while (0)

struct XcdBarrier {
    unsigned* bar; unsigned x;
    volatile LAS unsigned* st;
};

__device__ __forceinline__ XcdBarrier xcd_barrier_post(unsigned* bar, volatile LAS unsigned* st) {
    XcdBarrier b; b.bar = bar; b.x = xb_xcc_id(); b.st = st;
    if (threadIdx.x == 0) (void)xb_add(&bar[XB_XCNT(b.x)], 1u);
    return b;
}
__device__ __forceinline__ void xcd_barrier_complete(unsigned* bar, unsigned x, unsigned& nloc, unsigned& nx) {
    const unsigned G = gridDim.x * gridDim.y * gridDim.z;
    unsigned sum, cnt, mine, sp = 0u;
    for (;;) {
        sum = 0u; cnt = 0u; mine = 0u;
#pragma unroll
        for (unsigned j = 0; j < 16; ++j) { const unsigned c = xb_ld(&bar[XB_XCNT(j)]); sum += c; cnt += (c > 0u) ? 1u : 0u; mine = (j == x) ? c : mine; }
        if (sum == G) break;
        __builtin_amdgcn_s_sleep(1);
        if ((++sp & 255u) == 0u) { if (xb_ld(&bar[XB_TMO])) break; if (sp > XB_SPIN_CAP) { atomicAdd(&bar[XB_TMO], 1u); break; } }
    }
    nloc = mine > 0u ? mine : 1u; nx = cnt > 0u ? cnt : 1u;
}

__device__ __forceinline__ void xcd_barrier(const XcdBarrier& b) {
    asm volatile("s_waitcnt vmcnt(0)" ::: "memory");
    __syncthreads();
    if (threadIdx.x == 0) {
        unsigned* bar = b.bar;
        __builtin_amdgcn_s_waitcnt(0);
        unsigned nloc = b.st[0], nx = b.st[1];
        if (nloc == 0u) { xcd_barrier_complete(bar, b.x, nloc, nx); b.st[0] = nloc; b.st[1] = nx; }
        const unsigned old = xb_add(&bar[XB_XSUB(b.x)], 1u);
        const unsigned gen = old / nloc;
        if (old + 1u == (gen + 1u) * nloc) {
            __builtin_amdgcn_fence(__ATOMIC_RELEASE, "agent");
            asm volatile("s_waitcnt vmcnt(0)" ::: "memory");
            const unsigned og = xb_add(&bar[XB_TOP], 1u);
            const unsigned tg = og / nx;
            if (og + 1u == (tg + 1u) * nx) xb_add(&bar[XB_TOPGEN], 1u);
            else XB_SPIN(xb_ld(&bar[XB_TOPGEN]) == tg, bar);
            __builtin_amdgcn_fence(__ATOMIC_ACQUIRE, "agent");
            xb_add(&bar[XB_XGEN(b.x)], 1u);
            asm volatile("s_waitcnt vmcnt(0)" ::: "memory");
        } else {
            XB_SPIN(xb_ld(&bar[XB_XGEN(b.x)]) == gen, bar);
            __builtin_amdgcn_fence(__ATOMIC_ACQUIRE, "agent");
            asm volatile("s_waitcnt vmcnt(0)" ::: "memory");
        }
    }
    __syncthreads();
}


#define SB_XSUB(j) (XCD_BAR_WORDS + 32 * (j))
#define SB_TOP     (XCD_BAR_WORDS + 512)
#define SB_TOPGEN  (XCD_BAR_WORDS + 576)
__device__ __forceinline__ void sb_arrive(const XcdBarrier& b) {
    asm volatile("s_waitcnt vmcnt(0)" ::: "memory");
    __syncthreads();
    if (threadIdx.x == 0) {
        unsigned* bar = b.bar;
        __builtin_amdgcn_s_waitcnt(0);
        unsigned nloc = b.st[0], nx = b.st[1];
        if (nloc == 0u) { xcd_barrier_complete(bar, b.x, nloc, nx); b.st[0] = nloc; b.st[1] = nx; }
        const unsigned old = xb_add(&bar[SB_XSUB(b.x)], 1u);
        const unsigned gen = old / nloc;
        if (old + 1u == (gen + 1u) * nloc) {
            __builtin_amdgcn_fence(__ATOMIC_RELEASE, "agent");
            asm volatile("s_waitcnt vmcnt(0)" ::: "memory");
            const unsigned og = xb_add(&bar[SB_TOP], 1u);
            const unsigned tg = og / nx;
            if (og + 1u == (tg + 1u) * nx) xb_add(&bar[SB_TOPGEN], 1u);
        }
    }
}
__device__ __forceinline__ void sb_wait(const XcdBarrier& b, unsigned n) {
    if (threadIdx.x == 0) {
        unsigned* bar = b.bar;
        XB_SPIN(xb_ld(&bar[SB_TOPGEN]) < n, bar);
        __builtin_amdgcn_fence(__ATOMIC_ACQUIRE, "agent");
        asm volatile("s_waitcnt vmcnt(0)" ::: "memory");
    }
    asm volatile("s_waitcnt vmcnt(0)" ::: "memory");
    __syncthreads();
}

__global__ __launch_bounds__(512) void mega_k(P pg) {
  const int tile = (blockIdx.x & 7) * 32 + (blockIdx.x >> 3);
  volatile LAS unsigned* xbw = (volatile LAS unsigned*)((LAS char*)smem_raw + XB_LDS_OFF);
  if (threadIdx.x < 4) xbw[threadIdx.x] = 0u;
  __syncthreads();
  XcdBarrier xb = xcd_barrier_post(pg.bar, xbw);
  const P p = tile_view(pg, tile);
  phase_prep(pg);
  sb_arrive(xb);
  phase_xcvt(p, tile);
  sb_wait(xb, 1u);
  phase_inproj(p, tile);
  wg_sync_mem();
  phase_halo(p, tile);
  phase_kv(p, tile);
  if (tile < 64) phase_mt(p, tile);
  sb_arrive(xb);
  phase_mixer(p, tile, 2);
  sb_wait(xb, 2u);
  phase_gh(p, tile);
  sb_arrive(xb);
  phase_mixer(p, tile, 5);
  sb_wait(xb, 3u);
  phase_gquant(pg);
  sb_arrive(xb);
  phase_outproj(p, tile);
  sb_wait(xb, 4u);
  phase_scores(p, tile);
  wg_sync_mem();
  phase_oproj(p, tile);
  wg_sync_mem();
  phase_pq_route(p, tile);
  xcd_barrier(xb);
  phase_gdown(pg);
  gcomb_stage(p);
  xcd_barrier(xb);
  phase_gcomb(p, tile);
  phase_gup(pg, [&] { xcd_barrier(xb); });
  xcd_barrier(xb);
  phase_ln3(p, tile);
}

extern "C" void kernel_launch(void* const* d_in, const int* in_sizes, int n_in, void* d_out, int out_size, void* d_ws, size_t ws_size, hipStream_t stream) {
  static int grid_blocks = 0;
  if (grid_blocks == 0) {
    int dev = 0, cus = 0, per_cu = 0;
    (void)hipGetDevice(&dev);
    (void)hipDeviceGetAttribute(&cus, hipDeviceAttributeMultiprocessorCount, dev);
    if (hipFuncSetAttribute((const void*)mega_k, hipFuncAttributeMaxDynamicSharedMemorySize, LDS_BYTES) != hipSuccess) fprintf(stderr, "kernel_launch: hipFuncSetAttribute failed\n");
    if (hipOccupancyMaxActiveBlocksPerMultiprocessor(&per_cu, (const void*)mega_k, 512, LDS_BYTES) != hipSuccess || per_cu < 1) { fprintf(stderr, "kernel_launch: occupancy query says %d blocks/CU\n", per_cu); per_cu = 1; }
    (void)hipGetLastError();
    grid_blocks = NTOK / 128;
    if (cus * per_cu < grid_blocks) fprintf(stderr, "kernel_launch: device holds only %d x %d resident blocks, need %d\n", cus, per_cu, grid_blocks);
  }
  char* w8 = (char*)d_ws;
  const size_t MiB = (size_t)1 << 20;
  P p{};
  p.x = (const float*)d_in[0]; p.mem = (const float*)d_in[1]; p.w_in = (const float*)d_in[2]; p.b_in = (const float*)d_in[3];
  p.sgu_g = (const float*)d_in[4]; p.sgu_b = (const float*)d_in[5]; p.w_sp = (const float*)d_in[6]; p.b_sp = (const float*)d_in[7];
  p.conv_w = (const float*)d_in[8]; p.w_mo = (const float*)d_in[9]; p.ln1_g = (const float*)d_in[10]; p.ln1_b = (const float*)d_in[11];
  p.w_xq = (const float*)d_in[12]; p.w_xkv = (const float*)d_in[13]; p.w_xo = (const float*)d_in[14]; p.ln2_g = (const float*)d_in[15]; p.ln2_b = (const float*)d_in[16];
  p.w_pq = (const float*)d_in[17]; p.sub_keys = (const float*)d_in[18]; p.w_down = (const float*)d_in[19]; p.w_up = (const float*)d_in[20];
  p.ln3_g = (const float*)d_in[21]; p.ln3_b = (const float*)d_in[22];
  p.out = (float*)d_out;
  p.slabs = w8;
  bf16_t* wb = (bf16_t*)(w8 + 384 * MiB);
  p.w_inT = wb; p.w_inQ = (signed char*)wb; wb += (size_t)INW * DM / 2; p.sw_in = (float*)wb; wb += 2 * INW; p.w_moT = wb; p.w_moQ = (signed char*)wb; wb += (size_t)DM * DM / 2; p.sw_mo = (float*)wb; wb += 2 * DM; p.wsb = wb; wb += 4 * 128 * 128;
  p.w_xqT = wb; p.GTq = (signed char*)wb; wb += (size_t)4 * 1024 * DM / 2; p.sG = (float*)wb; wb += 2 * 4096; p.w_xkvT = wb; wb += (size_t)2048 * DM; p.w_xoT = wb; wb += (size_t)DM * DM;
  p.memB = wb; wb += (size_t)1024 * DM; p.Kc = wb; wb += (size_t)1024 * DM; p.Vc = wb; wb += (size_t)1024 * DM; p.wxqB = wb; wb += (size_t)DM * DM; p.GTb = wb; wb += (size_t)4 * 1024 * DM; p.HT = wb; wb += (size_t)4 * 1024 * DM; p.HT8 = (signed char*)wb; wb += (size_t)4 * 1024 * DM / 2; p.sH8 = (float*)wb; wb += 2 * 4096;
  p.w_pqT = wb; wb += (size_t)2048 * DM; p.MTq = (signed char*)wb; wb += (size_t)2048 * DM / 2; p.sMT = (float*)wb; wb += 2 * 2048; p.wpqB = wb; wb += (size_t)2048 * DM; p.skb = wb; wb += (size_t)8 * 2 * 128 * 128;
  p.WDq = (const unsigned char*)wb; wb += (size_t)16384 * DM / 2; p.WUq = (const unsigned char*)wb; wb += (size_t)16384 * DM / 2;
  p.sd = (const float*)wb; wb += 2 * 16384; p.su = (const float*)wb; wb += 2 * 16384;
  p.HALO = wb; wb += (size_t)256 * 2 * 512;
  p.SX = (float*)wb; wb += 2 * NTOK; p.SY = (float*)wb; wb += 2 * NTOK; p.SX1 = (float*)wb; wb += 2 * NTOK;
  p.bar = (unsigned*)wb; wb += 2 * 4096;
  if ((size_t)((char*)wb - w8) > ws_size) fprintf(stderr, "kernel_launch: workspace too small\n");
  (void)hipMemsetAsync(p.bar, 0, (XCD_BAR_WORDS + 640) * 4, stream);
  void* args[] = {&p};
  hipError_t e = hipLaunchCooperativeKernel((const void*)mega_k, dim3(grid_blocks), dim3(512), args, LDS_BYTES, stream);
  if (e != hipSuccess) fprintf(stderr, "cooperative launch failed: %s (grid %d)\n", hipGetErrorString(e), grid_blocks);
}
```
